# Optimizing an MI355X kernel written in HIP

```python
import jax, jax.numpy as jnp
from jax import lax
import numpy as np

D_MODEL = 2048
BATCH = 4
SEQ = 4096
DEPTH = 1

CHUNK = 64
Q_BLOCK = 2 * CHUNK
MIX_WIDTH = D_MODEL
ATTN_WIDTH = MIX_WIDTH // 2
ATTN_HEADS = 8
ATTN_HEAD_DIM = ATTN_WIDTH // ATTN_HEADS
LRU_WIDTH = MIX_WIDTH - ATTN_WIDTH
LRU_BLOCKS = 8
LRU_BLOCK_DIM = LRU_WIDTH // LRU_BLOCKS
CONV_WIDTH = 4
LRU_C = 8.0
OFF_Q = 0
OFF_K = OFF_Q + ATTN_WIDTH
OFF_V = OFF_K + ATTN_WIDTH
OFF_F = OFF_V + ATTN_WIDTH
OFF_LX = OFF_F + ATTN_HEADS
OFF_LY = OFF_LX + LRU_WIDTH
IN_COLS = OFF_LY + LRU_WIDTH
PEER_HEADS = 8
PEER_N_KEYS = 128
PEER_N_EXPERTS = PEER_N_KEYS * PEER_N_KEYS
PEER_QUERY_DIM = 256
PEER_HALF = PEER_QUERY_DIM // 2
PEER_TOPK = 16
PEER_TOKEN_BLOCK = 128
N_ADA = 6
EPS = 1e-6

kernel_name = 'hymba_fox_rglru_peer_adaln'


def _rmsnorm(x, g):
    xf = x.astype(jnp.float32)
    y = xf * lax.rsqrt(jnp.mean(xf * xf, axis=-1, keepdims=True) + EPS)
    return y.astype(x.dtype) * g


def _forgetting_attention(q, k, v, log_f):
    n_blocks = q.shape[2] // Q_BLOCK
    cum = jnp.cumsum(log_f, axis=-1)
    scale = ATTN_HEAD_DIM ** -0.5
    outs = []
    for blk in range(n_blocks):
        start = blk * Q_BLOCK
        end = start + Q_BLOCK
        qb = q[:, :, start:end]
        kb = k[:, :, :end]
        vb = v[:, :, :end]
        logits = jnp.einsum('bhqd,bhkd->bhqk', qb, kb).astype(jnp.float32) * scale
        logits = logits + cum[:, :, start:end, None] - cum[:, :, None, :end]
        mask = jnp.arange(end)[None, :] <= (start + jnp.arange(Q_BLOCK))[:, None]
        logits = jnp.where(mask, logits, -jnp.inf)
        p = jax.nn.softmax(logits, axis=-1)
        outs.append(jnp.einsum('bhqk,bhkd->bhqd', p.astype(v.dtype), vb))
    return jnp.concatenate(outs, axis=2)


def _causal_depthwise_conv(x, w, b):
    y = lax.conv_general_dilated(
        x, w[:, None, :], window_strides=(1,), padding=[(CONV_WIDTH - 1, 0)],
        dimension_numbers=('NWC', 'WIO', 'NWC'), feature_group_count=x.shape[-1])
    return y + b


def _rg_lru(xc, w_a, b_a, w_x, b_x, lam):
    B, S, _ = xc.shape
    xb = xc.reshape(B, S, LRU_BLOCKS, LRU_BLOCK_DIM)
    r = jax.nn.sigmoid(jnp.einsum('bsni,nij->bsnj', xb, w_a).reshape(B, S, LRU_WIDTH) + b_a)
    i = jax.nn.sigmoid(jnp.einsum('bsni,nij->bsnj', xb, w_x).reshape(B, S, LRU_WIDTH) + b_x)
    log_a = -LRU_C * r.astype(jnp.float32) * jax.nn.softplus(-lam.astype(jnp.float32))
    a = jnp.exp(log_a)
    bterm = jnp.sqrt(-jnp.expm1(2.0 * log_a)) * (i * xc).astype(jnp.float32)

    def combine(lhs, rhs):
        a1, b1 = lhs
        a2, b2 = rhs
        return a1 * a2, a2 * b1 + b2

    _, h = lax.associative_scan(combine, (a, bterm), axis=1)
    return h.astype(xc.dtype)


def _hybrid_mixer(h, w_in, b_f, conv_w, conv_b, lru_w_a, lru_b_a, lru_w_x, lru_b_x,
                  lru_lambda, g_attn_out, g_lru_out, w_out):
    B, S, _ = h.shape
    proj = h @ w_in

    def heads(t):
        return t.reshape(B, S, ATTN_HEADS, ATTN_HEAD_DIM).transpose(0, 2, 1, 3)

    q = heads(proj[..., OFF_Q:OFF_K])
    k = heads(proj[..., OFF_K:OFF_V])
    v = heads(proj[..., OFF_V:OFF_F])
    f_logit = (proj[..., OFF_F:OFF_LX] + b_f).astype(jnp.float32)
    log_f = jax.nn.log_sigmoid(f_logit).transpose(0, 2, 1)
    attn = _forgetting_attention(q, k, v, log_f)
    attn = attn.transpose(0, 2, 1, 3).reshape(B, S, ATTN_WIDTH)

    lx = proj[..., OFF_LX:OFF_LY]
    ly = proj[..., OFF_LY:IN_COLS]
    xc = _causal_depthwise_conv(lx, conv_w, conv_b)
    lru = _rg_lru(xc, lru_w_a, lru_b_a, lru_w_x, lru_b_x, lru_lambda) * jax.nn.gelu(ly)

    merged = jnp.concatenate([_rmsnorm(attn, g_attn_out), _rmsnorm(lru, g_lru_out)], axis=-1)
    return merged @ w_out


def _peer(h, w_q, k1, k2, u, vt):
    B, S, D = h.shape
    q = (h @ w_q).reshape(B, S, PEER_HEADS, 2, PEER_HALF)
    s1 = jnp.einsum('bshd,hnd->bshn', q[..., 0, :], k1).astype(jnp.float32)
    s2 = jnp.einsum('bshd,hnd->bshn', q[..., 1, :], k2).astype(jnp.float32)
    v1, i1 = lax.top_k(s1, PEER_TOPK)
    v2, i2 = lax.top_k(s2, PEER_TOPK)
    cand = (v1[..., :, None] + v2[..., None, :]).reshape(B, S, PEER_HEADS, PEER_TOPK * PEER_TOPK)
    vs, ic = lax.top_k(cand, PEER_TOPK)
    e = (jnp.take_along_axis(i1, ic // PEER_TOPK, axis=-1) * PEER_N_KEYS
         + jnp.take_along_axis(i2, ic % PEER_TOPK, axis=-1))
    w = jax.nn.softmax(vs, axis=-1).astype(h.dtype)

    nb = (B * S) // PEER_TOKEN_BLOCK
    hb = h.reshape(nb, PEER_TOKEN_BLOCK, D)
    eb = e.reshape(nb, PEER_TOKEN_BLOCK, PEER_HEADS, PEER_TOPK)
    wb = w.reshape(nb, PEER_TOKEN_BLOCK, PEER_HEADS, PEER_TOPK)

    def expert_block(args):
        hx, ex, wx = args
        ug = jnp.take(u, ex, axis=0)
        act = jax.nn.gelu(jnp.einsum('thkd,td->thk', ug, hx)) * wx
        vg = jnp.take(vt, ex, axis=0)
        return jnp.einsum('thk,thkd->td', act, vg)

    y = lax.map(expert_block, (hb, eb, wb))
    return y.reshape(B, S, D)


def setup_inputs(seed: int = 0) -> dict:
    key = jax.random.key(seed)
    ks = jax.random.split(key, 26)
    f32 = jnp.float32
    L, D = DEPTH, D_MODEL

    def nrm(k, shape, scale):
        return jax.random.normal(k, shape, f32) * scale

    a0 = jax.random.uniform(ks[12], (L, LRU_WIDTH), f32, 0.9, 0.999) ** (1.0 / LRU_C)
    return {
        'x': nrm(ks[0], (BATCH, SEQ, D), 1.0),
        'c': nrm(ks[1], (BATCH, D), 1.0),
        'w_ada': nrm(ks[2], (L, D, N_ADA * D), 0.5 * D ** -0.5),
        'b_ada': nrm(ks[3], (L, N_ADA * D), 0.01),
        'g_mix': 1.0 + nrm(ks[4], (L, D), 0.05),
        'w_in': nrm(ks[5], (L, D, IN_COLS), D ** -0.5),
        'b_f': jax.random.uniform(ks[6], (L, ATTN_HEADS), f32, 1.0, 4.0),
        'conv_w': nrm(ks[7], (L, CONV_WIDTH, LRU_WIDTH), CONV_WIDTH ** -0.5),
        'conv_b': nrm(ks[8], (L, LRU_WIDTH), 0.01),
        'lru_w_a': nrm(ks[9], (L, LRU_BLOCKS, LRU_BLOCK_DIM, LRU_BLOCK_DIM), LRU_BLOCK_DIM ** -0.5),
        'lru_b_a': nrm(ks[10], (L, LRU_WIDTH), 0.01),
        'lru_w_x': nrm(ks[11], (L, LRU_BLOCKS, LRU_BLOCK_DIM, LRU_BLOCK_DIM), LRU_BLOCK_DIM ** -0.5),
        'lru_b_x': nrm(ks[13], (L, LRU_WIDTH), 0.01),
        'lru_lambda': jnp.log(a0) - jnp.log1p(-a0),
        'g_attn_out': 1.0 + nrm(ks[14], (L, ATTN_WIDTH), 0.05),
        'g_lru_out': 1.0 + nrm(ks[15], (L, LRU_WIDTH), 0.05),
        'w_out': nrm(ks[16], (L, MIX_WIDTH, D), MIX_WIDTH ** -0.5),
        'g_ffn': 1.0 + nrm(ks[17], (L, D), 0.05),
        'peer_w_q': nrm(ks[18], (L, D, PEER_HEADS * PEER_QUERY_DIM), D ** -0.5),
        'peer_k1': nrm(ks[19], (L, PEER_HEADS, PEER_N_KEYS, PEER_HALF), PEER_HALF ** -0.5),
        'peer_k2': nrm(ks[20], (L, PEER_HEADS, PEER_N_KEYS, PEER_HALF), PEER_HALF ** -0.5),
        'peer_u': nrm(ks[21], (L, PEER_N_EXPERTS, D), D ** -0.5),
        'peer_v': nrm(ks[22], (L, PEER_N_EXPERTS, D), 1.0),
        'g_final': 1.0 + nrm(ks[23], (D,), 0.05),
    }


def reference(x, c, w_ada, b_ada, g_mix, w_in, b_f, conv_w, conv_b, lru_w_a, lru_b_a,
              lru_w_x, lru_b_x, lru_lambda, g_attn_out, g_lru_out, w_out, g_ffn,
              peer_w_q, peer_k1, peer_k2, peer_u, peer_v, g_final):
    sc = jax.nn.silu(c)
    for l in range(DEPTH):
        mod = sc @ w_ada[l] + b_ada[l]
        sh1, sc1, ga1, sh2, sc2, ga2 = jnp.split(mod, N_ADA, axis=-1)
        h = _rmsnorm(x, g_mix[l]) * (1.0 + sc1[:, None, :]) + sh1[:, None, :]
        mix = _hybrid_mixer(h, w_in[l], b_f[l], conv_w[l], conv_b[l], lru_w_a[l], lru_b_a[l],
                            lru_w_x[l], lru_b_x[l], lru_lambda[l], g_attn_out[l],
                            g_lru_out[l], w_out[l])
        x = x + ga1[:, None, :] * mix
        h = _rmsnorm(x, g_ffn[l]) * (1.0 + sc2[:, None, :]) + sh2[:, None, :]
        x = x + ga2[:, None, :] * _peer(h, peer_w_q[l], peer_k1[l], peer_k2[l], peer_u[l], peer_v[l])
    return _rmsnorm(x, g_final)
```

```cpp
#include <hip/hip_runtime.h>
#include <hip/hip_bf16.h>
#include <cstdio>
#include <cstdint>

constexpr int BATCH = 4, SEQ = 4096, DM = 2048, T = BATCH * SEQ;
constexpr int AW = 1024, NH = 8, HD = 128, LW = 1024, NLB = 8, LBD = 128;
constexpr int INC = 5128, OFF_F = 3072, OFF_LX = 3080;
constexpr int PH = 8, PNK = 128, PQD = 256, PTOPK = 16, NEXP = 16384, NSEL = PH * PTOPK;
constexpr int NADA = 6 * DM;
constexpr float EPS = 1e-6f;
constexpr int NWAVES = 8, NTHR = 512;

#ifndef MK_N_LAUNCHES
#define MK_N_LAUNCHES 1
#endif
constexpr int N_PHASES = 10;
constexpr int N_LAUNCHES = MK_N_LAUNCHES;

constexpr size_t MiB = 1u << 20;
constexpr size_t WS_CTL = 0, CTL_ZERO_BYTES = 1 * MiB;
constexpr size_t WS_MOD = 1 * MiB;
constexpr size_t WS_LF = WS_MOD + 256 * 1024;
constexpr size_t WS_KB = WS_LF + 512 * 1024;
constexpr size_t WS_SUMM = WS_KB + 512 * 1024;
constexpr size_t WS_WLRU = 5 * MiB;
constexpr size_t WS_K1 = WS_WLRU + 512 * 1024;
constexpr size_t WS_K2 = WS_K1 + 256 * 1024;
constexpr size_t WS_WIN = 6 * MiB;
constexpr size_t WS_WOUT = 26 * MiB;
constexpr size_t WS_WQ = 34 * MiB;
constexpr size_t WS_U = 42 * MiB, WS_V = 106 * MiB;
constexpr size_t WS_H = 170 * MiB;
constexpr size_t WS_Q = 234 * MiB, WS_K = 266 * MiB, WS_VV = 298 * MiB;
constexpr size_t WS_QP = 234 * MiB;
constexpr size_t WS_EIDX = 298 * MiB, WS_EW = 306 * MiB;
constexpr size_t WS_LX = 330 * MiB, WS_GLY = 362 * MiB;
constexpr size_t WS_MRG = 394 * MiB;
constexpr size_t WS_END = 458 * MiB;
static_assert(WS_K == WS_Q + 32 * MiB && WS_VV == WS_Q + 64 * MiB && WS_LX == WS_Q + 96 * MiB && WS_GLY == WS_Q + 128 * MiB, "EpiProj: destinations 32 MiB apart");
constexpr int CW_BAR = 4096;

constexpr int RING_OFF = 0, RING_BYTES = 131072;
constexpr int LDSCTL_OFF = RING_BYTES, MISC_OFF = LDSCTL_OFF + 320;
constexpr int LDS_BYTES = 147456;
static_assert(MISC_OFF + 128 <= LDS_BYTES, "LDS map");

#define GAS __attribute__((address_space(1)))
#define LAS __attribute__((address_space(3)))
typedef unsigned short bf16_t;
typedef unsigned v4u __attribute__((ext_vector_type(4)));
typedef unsigned v2u __attribute__((ext_vector_type(2)));
typedef float f32x4 __attribute__((ext_vector_type(4)));
typedef float f32x2 __attribute__((ext_vector_type(2)));
typedef short bf16x8 __attribute__((ext_vector_type(8)));
typedef __bf16 bf16x2_t __attribute__((ext_vector_type(2)));
typedef GAS unsigned gu32;
#define RLX_AGENT __ATOMIC_RELAXED, __HIP_MEMORY_SCOPE_AGENT
#define LDS_WAIT() asm volatile("s_waitcnt lgkmcnt(0)" ::: "memory")
#define VM_WAIT() asm volatile("s_waitcnt vmcnt(0)" ::: "memory")

extern __shared__ __attribute__((aligned(16))) unsigned char g_lds[];
__device__ __forceinline__ int ktid(int kw) { int l; asm volatile("v_mbcnt_lo_u32_b32 %0, -1, 0\n\tv_mbcnt_hi_u32_b32 %0, -1, %0" : "=v"(l)); return kw * 64 + l; }
__device__ __forceinline__ unsigned fbits(float x) { return __builtin_bit_cast(unsigned, x); }
__device__ __forceinline__ float bitsf(unsigned x) { return __builtin_bit_cast(float, x); }
__device__ __forceinline__ bf16x2_t asbf2(unsigned x) { return __builtin_bit_cast(bf16x2_t, x); }
__device__ __forceinline__ unsigned f2bf(float f) { unsigned u = __builtin_bit_cast(unsigned, f); return (u + 0x7fffu + ((u >> 16) & 1u)) >> 16; }
__device__ __forceinline__ unsigned pk2(float lo, float hi) { f32x2 v = {lo, hi}; bf16x2_t b = __builtin_convertvector(v, bf16x2_t); return __builtin_bit_cast(unsigned, b); }
__device__ __forceinline__ float bf_lo(unsigned d) { return __builtin_bit_cast(float, d << 16); }
__device__ __forceinline__ float bf_hi(unsigned d) { return __builtin_bit_cast(float, d & 0xffff0000u); }
__device__ __forceinline__ float fexp(float x) { return __builtin_amdgcn_exp2f(x * 1.4426950408889634f); }
__device__ __forceinline__ float sigmoidf_(float z) { return __builtin_amdgcn_rcpf(1.f + fexp(-z)); }
__device__ __forceinline__ float gelu_tanh(float x) { const float z = x * (1.5957691216057308f + 0.07135481627260025f * x * x); return x * __builtin_amdgcn_rcpf(1.f + fexp(-z)); }
__device__ __forceinline__ float softplusf_(float z) { return fmaxf(z, 0.f) + log1pf(fexp(-fabsf(z))); }
__device__ __forceinline__ float wave_sum(float v) {
#pragma unroll
    for (int o = 1; o < 64; o <<= 1) v += __shfl_xor(v, o);
    return v;
}
#define XB_TMO      128
#define XB_XCNT(j)  (256  + 64 * (j))
#define XB_XSUB(j)  (1280 + 64 * (j))
#define XB_XGEN(j)  (2304 + 64 * (j))
#define XB_TOP      3328
#define XB_TOPGEN   3392
#define XCD_BAR_WORDS 3456
#define XB_SPIN_CAP (1u << 18)

__device__ __forceinline__ unsigned xb_ld(unsigned* p)              { return __hip_atomic_load(p, __ATOMIC_RELAXED, __HIP_MEMORY_SCOPE_AGENT); }
__device__ __forceinline__ unsigned xb_add(unsigned* p, unsigned v) { return __hip_atomic_fetch_add(p, v, __ATOMIC_RELAXED, __HIP_MEMORY_SCOPE_AGENT); }
__device__ __forceinline__ unsigned xb_xcc_id() { return (unsigned)__builtin_amdgcn_s_getreg((3 << 11) | 20) & 0xFu; }
#define XB_SPIN(cond, bar) do { unsigned _sp = 0; while (cond) { __builtin_amdgcn_s_sleep(1); \
    if ((++_sp & 255u) == 0u) { if (xb_ld(&(bar)[XB_TMO])) break; if (_sp > XB_SPIN_CAP) { atomicAdd(&(bar)[XB_TMO], 1u); break; } } } } while (0)

struct XcdBarrier {
    unsigned* bar; unsigned x;
    volatile LAS unsigned* st;
};

__device__ __forceinline__ XcdBarrier xcd_barrier_post(unsigned* bar, volatile LAS unsigned* st, int kw) {
    XcdBarrier b; b.bar = bar; b.x = xb_xcc_id(); b.st = st;
    if (ktid(kw) == 0) (void)xb_add(&bar[XB_XCNT(b.x)], 1u);
    return b;
}
__device__ __forceinline__ void xcd_barrier_complete(unsigned* bar, unsigned x, unsigned& nloc, unsigned& nx) {
    const unsigned G = gridDim.x * gridDim.y * gridDim.z;
    unsigned sum, cnt, mine, sp = 0u;
    for (;;) {
        sum = 0u; cnt = 0u; mine = 0u;
#pragma unroll
        for (unsigned j = 0; j < 16; ++j) { const unsigned c = xb_ld(&bar[XB_XCNT(j)]); sum += c; cnt += (c > 0u) ? 1u : 0u; mine = (j == x) ? c : mine; }
        if (sum == G) break;
        __builtin_amdgcn_s_sleep(1);
        if ((++sp & 255u) == 0u) { if (xb_ld(&bar[XB_TMO])) break; if (sp > XB_SPIN_CAP) { atomicAdd(&bar[XB_TMO], 1u); break; } }
    }
    nloc = mine > 0u ? mine : 1u; nx = cnt > 0u ? cnt : 1u;
}

__device__ __forceinline__ void xcd_barrier(const XcdBarrier& b, int kw) {
    asm volatile("s_waitcnt vmcnt(0)" ::: "memory");
    __syncthreads();
    if (ktid(kw) == 0) {
        unsigned* bar = b.bar;
        __builtin_amdgcn_s_waitcnt(0);
        unsigned nloc = b.st[0], nx = b.st[1];
        if (nloc == 0u) { xcd_barrier_complete(bar, b.x, nloc, nx); b.st[0] = nloc; b.st[1] = nx; }
        const unsigned old = xb_add(&bar[XB_XSUB(b.x)], 1u);
        const unsigned gen = old / nloc;
        if (old + 1u == (gen + 1u) * nloc) {
            __builtin_amdgcn_fence(__ATOMIC_RELEASE, "agent");
            asm volatile("s_waitcnt vmcnt(0)" ::: "memory");
            const unsigned og = xb_add(&bar[XB_TOP], 1u);
            const unsigned tg = og / nx;
            if (og + 1u == (tg + 1u) * nx) xb_add(&bar[XB_TOPGEN], 1u);
            else XB_SPIN(xb_ld(&bar[XB_TOPGEN]) == tg, bar);
            __builtin_amdgcn_fence(__ATOMIC_ACQUIRE, "agent");
            xb_add(&bar[XB_XGEN(b.x)], 1u);
            asm volatile("s_waitcnt vmcnt(0)" ::: "memory");
        } else {
            XB_SPIN(xb_ld(&bar[XB_XGEN(b.x)]) == gen, bar);
            __builtin_amdgcn_fence(__ATOMIC_ACQUIRE, "agent");
            asm volatile("s_waitcnt vmcnt(0)" ::: "memory");
        }
    }
    __syncthreads();
}

namespace pg8 {
#define PG8_LAS __attribute__((address_space(3)))
typedef unsigned short bf16_t;
typedef short bf16x8 __attribute__((ext_vector_type(8)));
typedef float f32x4 __attribute__((ext_vector_type(4)));
typedef unsigned u32x4 __attribute__((ext_vector_type(4)));
constexpr int BM = 256, BK = 64, HALF = 128, HTB = HALF * BK * 2  , STAGE_BYTES = 8 * HTB, NXCD = 8, WGM = 8;

__host__ __device__ __forceinline__ int lds_byte(int r, int c) { const int st = (r >> 4) * 2 + (c >> 5), rr = r & 15, cc = c & 31, ob = rr * 64 + cc * 2; return st * 1024 + (ob ^ (((ob >> 9) & 1) << 5)); }
__host__ __device__ __forceinline__ void stage_rc(int b, int& R, int& C) { const int st = b / 1024, sb = b % 1024, swz = sb ^ (((sb >> 9) & 1) << 5); R = (st >> 1) * 16 + swz / 64; C = (st & 1) * 32 + (swz % 64) / 2; }
__host__ __device__ __forceinline__ int perm32(int rho) { const int n = rho >> 4, i = rho & 15; return 8 * (i >> 2) + 4 * n + (i & 3); }

struct Unit { int pm, pn; };
struct Gemm { const bf16_t* A; const bf16_t* Bt; int M, N, K; };

struct StaticOrder {
    int nM, nN, nwg, G, c;
    __host__ __device__ void init(int M, int N, int G_, int c_) { nM = M / BM; nN = N / BM; nwg = nM * nN; G = G_; c = c_; }
    __host__ __device__ bool next(int i, Unit& u) const {
        const long L = (long)i * G + c; if (L >= nwg) return false;
        int wgid = (int)L; { const int q = nwg / NXCD, r = nwg % NXCD, xcd = wgid % NXCD, off = wgid / NXCD; wgid = (xcd < r ? xcd * (q + 1) : r * (q + 1) + (xcd - r) * q) + off; }
        const int nig = WGM * nN, gid = wgid / nig, fm = gid * WGM, gsz = (nM - fm) < WGM ? (nM - fm) : WGM;
        u.pm = fm + ((wgid % nig) % gsz); u.pn = (wgid % nig) / gsz; return true;
    }
    __device__ __forceinline__ void a_ready(const Unit&) const {}
    __device__ __forceinline__ void done(const Unit&) const {}
};


__device__ __forceinline__ unsigned cvt_pk_bf16(float lo, float hi) { unsigned r; asm volatile("v_cvt_pk_bf16_f32 %0, %1, %2" : "=v"(r) : "v"(lo), "v"(hi)); return r; }

struct EpiPlain {
    static constexpr bool PERM = true, AFTER_DRAIN = false;
    bf16_t* O; int ldc;
    __device__ __forceinline__ void operator()(const f32x4 (&acc)[2][2][4][2], const Unit& u, int wr, int wc, int fr, int fq) const {
        const int row0 = u.pm * BM + wr * 64 + fr, col0 = u.pn * BM + wc * 32 + 8 * fq;
#pragma unroll
        for (int ai = 0; ai < 2; ++ai)
#pragma unroll
            for (int m = 0; m < 4; ++m) { bf16_t* rowp = O + (size_t)(row0 + ai * HALF + m * 16) * ldc + col0;
#pragma unroll
                for (int bj = 0; bj < 2; ++bj) { const f32x4 v0 = acc[ai][bj][m][0], v1 = acc[ai][bj][m][1];
                    u32x4 w; w.x = cvt_pk_bf16(v0[0], v0[1]); w.y = cvt_pk_bf16(v0[2], v0[3]); w.z = cvt_pk_bf16(v1[0], v1[1]); w.w = cvt_pk_bf16(v1[2], v1[3]);
                    *(u32x4*)(rowp + bj * HALF) = w; } }
    }
};
struct EpiProj {
    static constexpr bool PERM = true, AFTER_DRAIN = false;
    bf16_t* Q;
    __device__ __forceinline__ void operator()(const f32x4 (&acc)[2][2][4][2], const Unit& u, int wr, int wc, int fr, int fq) const {
        const int row0 = u.pm * BM + wr * 64 + fr; const int cat = u.pn >> 2, pnl = u.pn & 3;
        bf16_t* basep = Q + (size_t)cat * ((size_t)16 << 20);
        const bool headmajor = cat < 3, dogelu = cat == 4;
#pragma unroll
        for (int ai = 0; ai < 2; ++ai)
#pragma unroll
            for (int m = 0; m < 4; ++m) { const int row = row0 + ai * HALF + m * 16; const int b = row >> 12, s = row & 4095;
#pragma unroll
                for (int bj = 0; bj < 2; ++bj) { f32x4 v0 = acc[ai][bj][m][0], v1 = acc[ai][bj][m][1];
                    const int colt = pnl * BM + bj * HALF + wc * 32 + 8 * fq;
                    const int head = colt >> 7, d = colt & 127;
                    const size_t offA = ((size_t)((b * 8 + head) * 4096 + s)) * 128 + d, offB = (size_t)row * 1024 + colt;
                    bf16_t* dst = basep + (headmajor ? offA : offB);
                    if (dogelu) {
#pragma unroll
                        for (int e = 0; e < 4; ++e) { v0[e] = gelu_tanh(v0[e]); v1[e] = gelu_tanh(v1[e]); } }
                    u32x4 w; w.x = cvt_pk_bf16(v0[0], v0[1]); w.y = cvt_pk_bf16(v0[2], v0[3]); w.z = cvt_pk_bf16(v1[0], v1[1]); w.w = cvt_pk_bf16(v1[2], v1[3]);
                    *(u32x4*)dst = w; } }
    }
};
struct EpiRes {
    static constexpr bool PERM = false, AFTER_DRAIN = false;
    const float* base; float* out; int ldc; const float* gate; int gstride;
    __device__ __forceinline__ void operator()(const f32x4 (&acc)[2][2][4][2], const Unit& u, int wr, int wc, int fr, int fq) const {
        const int row0 = u.pm * BM + wr * 64 + fr, col0 = u.pn * BM + wc * 32 + 4 * fq;
        const int b = (u.pm * BM) >> 12;
        f32x4 gv[2][2];
#pragma unroll
        for (int bj = 0; bj < 2; ++bj)
#pragma unroll
            for (int n = 0; n < 2; ++n) gv[bj][n] = *(const f32x4*)(gate + (size_t)b * gstride + col0 + bj * HALF + n * 16);
#pragma unroll
        for (int ai = 0; ai < 2; ++ai)
#pragma unroll
            for (int m = 0; m < 4; ++m) { const size_t off = (size_t)(row0 + ai * HALF + m * 16) * ldc + col0;
#pragma unroll
                for (int bj = 0; bj < 2; ++bj)
#pragma unroll
                    for (int n = 0; n < 2; ++n) { const f32x4 bs = *(const f32x4*)(base + off + bj * HALF + n * 16);
                        *(f32x4*)(out + off + bj * HALF + n * 16) = bs + gv[bj][n] * acc[ai][bj][m][n]; } }
    }
};

template <class Epi, class Sched, bool ALIGN_EPI = false, bool SP2 = false>
__device__ __forceinline__ void gemm_phase(PG8_LAS unsigned char* lds, const Gemm g, const Sched& S, const Epi& E, const int kw) {
    const int tid = ktid(kw), wid = kw, lane = tid & 63, wr = wid >> 2, wc = wid & 3, fr = lane & 15, fq = lane >> 4;
    const int K = g.K, nt = K / BK;
    unsigned voffA[2], voffB[2];
#pragma unroll
    for (int i = 0; i < 2; ++i) { int R, C; stage_rc(tid * 16 + i * 8192, R, C); const int Rb = Epi::PERM ? ((R & ~31) + perm32(R & 31)) : R;
        voffA[i] = (unsigned)(R * K + C) * 2u; voffB[i] = (unsigned)(Rb * K + C) * 2u; }
    const size_t kstep = (size_t)(BK * 2);
    const size_t hstep = (size_t)HALF * K * 2;
    const size_t tstep = 2 * hstep;
    const unsigned ldsw = (unsigned)wid * 1024u;
    const int aoff = lds_byte(wr * 64 + fr, fq * 8), boff = lds_byte(wc * 32 + fr, fq * 8);
#define PG8_SA(b, h) (((b) * 2 + (h)) * HTB)
#define PG8_SB(b, h) ((4 + (b) * 2 + (h)) * HTB)
#define PG8_STAGE(bufoff, gbase, voff) do { _Pragma("unroll") for (int _i = 0; _i < 2; ++_i) \
        __builtin_amdgcn_global_load_lds((const unsigned*)((const char*)(gbase) + (voff)[_i]), (PG8_LAS unsigned*)(lds + (bufoff) + ldsw + _i * 8192), 16, 0, 0); } while (0)
#define PG8_LDA(dst, b, h) do { _Pragma("unroll") for (int m = 0; m < 4; ++m) _Pragma("unroll") for (int k = 0; k < 2; ++k) dst[m][k] = *(const PG8_LAS bf16x8*)(lds + PG8_SA(b, h) + aoff + m * 2048 + k * 1024); } while (0)
#define PG8_LDB(dst, b, h) do { _Pragma("unroll") for (int n = 0; n < 2; ++n) _Pragma("unroll") for (int k = 0; k < 2; ++k) dst[n][k] = *(const PG8_LAS bf16x8*)(lds + PG8_SB(b, h) + boff + n * 2048 + k * 1024); } while (0)
#define PG8_MMA(ai, bj, At, Bt) do { __builtin_amdgcn_s_setprio(1); _Pragma("unroll") for (int m = 0; m < 4; ++m) _Pragma("unroll") for (int n = 0; n < 2; ++n) _Pragma("unroll") for (int k = 0; k < 2; ++k) \
        acc[ai][bj][m][n] = __builtin_amdgcn_mfma_f32_16x16x32_bf16(Bt[n][k], At[m][k], acc[ai][bj][m][n], 0, 0, 0); __builtin_amdgcn_s_setprio(0); } while (0)
#define PG8_WAIT_V(n) asm volatile("s_waitcnt vmcnt(" #n ")" ::: "memory")
#define PG8_WAIT_L(n) asm volatile("s_waitcnt lgkmcnt(" #n ")" ::: "memory")
#define PG8_BAR __builtin_amdgcn_s_barrier()
#define PG8_SCHED __builtin_amdgcn_sched_barrier(0)
    Unit cur, nxt; int ui = 0;
    if (!S.next(0, cur)) return;
    f32x4 acc[2][2][4][2];
#pragma unroll
    for (int a = 0; a < 2; ++a)
#pragma unroll
        for (int b = 0; b < 2; ++b)
#pragma unroll
            for (int m = 0; m < 4; ++m)
#pragma unroll
                for (int n = 0; n < 2; ++n) acc[a][b][m][n] = (f32x4){0.f, 0.f, 0.f, 0.f};
    bf16x8 At[4][2], B0[2][2], B1[2][2];
    const char* cA = (const char*)g.A + (size_t)cur.pm * tstep; const char* cB = (const char*)g.Bt + (size_t)cur.pn * tstep;
    S.a_ready(cur);
    if constexpr (SP2) {
        PG8_STAGE(PG8_SB(0, 0), cB, voffB); PG8_STAGE(PG8_SB(0, 1), cB + hstep, voffB); PG8_STAGE(PG8_SA(0, 0), cA, voffA); PG8_STAGE(PG8_SA(0, 1), cA + hstep, voffA);
        if (wr == 1) PG8_BAR;
        PG8_WAIT_V(2); PG8_BAR;
        PG8_STAGE(PG8_SB(1, 0), cB + kstep, voffB); PG8_STAGE(PG8_SA(1, 0), cA + kstep, voffA); PG8_STAGE(PG8_SB(1, 1), cB + hstep + kstep, voffB);
        PG8_WAIT_V(6); PG8_BAR;
    } else {
        PG8_STAGE(PG8_SB(0, 0), cB, voffB); PG8_STAGE(PG8_SA(0, 0), cA, voffA); PG8_STAGE(PG8_SB(0, 1), cB + hstep, voffB); PG8_STAGE(PG8_SA(0, 1), cA + hstep, voffA);
        if (wr == 1) PG8_BAR;
        PG8_WAIT_V(4); PG8_BAR;
        PG8_STAGE(PG8_SB(1, 0), cB + kstep, voffB); PG8_STAGE(PG8_SA(1, 0), cA + kstep, voffA); PG8_STAGE(PG8_SB(1, 1), cB + hstep + kstep, voffB);
        PG8_WAIT_V(6); PG8_BAR;
    }
    for (;;) {
        const bool has_next = S.next(ui + 1, nxt);
        const char* nA = has_next ? (const char*)g.A + (size_t)nxt.pm * tstep : cA; const char* nB = has_next ? (const char*)g.Bt + (size_t)nxt.pn * tstep : cB;
        for (int t = 0; t < nt; t += 2) {
            const bool last = (t == nt - 2);
            const char* a1 = cA + (size_t)(t + 1) * kstep;
            const char* a2 = last ? nA : cA + (size_t)(t + 2) * kstep; const char* b2 = last ? nB : cB + (size_t)(t + 2) * kstep;
            const char* a3 = a2 + kstep; const char* b3 = b2 + kstep;
            if (last && has_next) S.a_ready(nxt);
            if constexpr (SP2) {
            PG8_LDB(B0, 0, 0); PG8_LDB(B1, 0, 1); PG8_SCHED; PG8_LDA(At, 0, 0); PG8_STAGE(PG8_SA(1, 1), a1 + hstep, voffA);
            PG8_WAIT_V(8); PG8_WAIT_L(0); PG8_BAR; PG8_MMA(0, 0, At, B0); PG8_MMA(0, 1, At, B1); PG8_BAR; PG8_SCHED;
            PG8_LDA(At, 0, 1); PG8_STAGE(PG8_SB(0, 0), b2, voffB); PG8_STAGE(PG8_SB(0, 1), b2 + hstep, voffB); PG8_STAGE(PG8_SA(0, 0), a2, voffA);
            PG8_WAIT_V(8); PG8_WAIT_L(0); PG8_BAR; PG8_MMA(1, 0, At, B0); PG8_MMA(1, 1, At, B1); PG8_BAR; PG8_SCHED;
            PG8_LDB(B0, 1, 0); PG8_LDB(B1, 1, 1); PG8_SCHED; PG8_LDA(At, 1, 0); PG8_STAGE(PG8_SA(0, 1), a2 + hstep, voffA);
            PG8_WAIT_V(8); PG8_WAIT_L(0); PG8_BAR; PG8_MMA(0, 0, At, B0); PG8_MMA(0, 1, At, B1); PG8_BAR; PG8_SCHED;
            PG8_LDA(At, 1, 1); PG8_STAGE(PG8_SB(1, 0), b3, voffB); PG8_STAGE(PG8_SB(1, 1), b3 + hstep, voffB); PG8_STAGE(PG8_SA(1, 0), a3, voffA);
            PG8_WAIT_V(8); PG8_WAIT_L(0); PG8_BAR; PG8_MMA(1, 0, At, B0); PG8_MMA(1, 1, At, B1); PG8_BAR; PG8_SCHED;
            } else {
            PG8_LDB(B0, 0, 0); PG8_SCHED; PG8_LDA(At, 0, 0); PG8_STAGE(PG8_SA(1, 1), a1 + hstep, voffA);
            PG8_WAIT_L(8); PG8_BAR; PG8_WAIT_L(0); PG8_MMA(0, 0, At, B0); PG8_BAR; PG8_SCHED;
            PG8_LDB(B1, 0, 1); PG8_STAGE(PG8_SB(0, 0), b2, voffB);
            PG8_BAR; PG8_WAIT_L(0); PG8_MMA(0, 1, At, B1); PG8_BAR;
            PG8_LDA(At, 0, 1); PG8_STAGE(PG8_SA(0, 0), a2, voffA);
            PG8_BAR; PG8_WAIT_L(0); PG8_MMA(1, 0, At, B0); PG8_BAR; PG8_SCHED;
            PG8_STAGE(PG8_SB(0, 1), b2 + hstep, voffB);
            PG8_WAIT_V(6); PG8_BAR; PG8_MMA(1, 1, At, B1); PG8_BAR;
            PG8_LDB(B0, 1, 0); PG8_SCHED; PG8_LDA(At, 1, 0); PG8_STAGE(PG8_SA(0, 1), a2 + hstep, voffA);
            PG8_WAIT_L(8); PG8_BAR; PG8_WAIT_L(0); PG8_MMA(0, 0, At, B0); PG8_BAR; PG8_SCHED;
            PG8_LDB(B1, 1, 1); PG8_STAGE(PG8_SB(1, 0), b3, voffB);
            PG8_BAR; PG8_WAIT_L(0); PG8_MMA(0, 1, At, B1); PG8_BAR;
            PG8_LDA(At, 1, 1); PG8_STAGE(PG8_SA(1, 0), a3, voffA);
            PG8_BAR; PG8_WAIT_L(0); PG8_MMA(1, 0, At, B0); PG8_BAR; PG8_SCHED;
            PG8_STAGE(PG8_SB(1, 1), b3 + hstep, voffB);
            PG8_WAIT_V(6); PG8_BAR; PG8_MMA(1, 1, At, B1); PG8_BAR;
            }
        }
        if constexpr (ALIGN_EPI) { if (wr == 0) PG8_BAR; }
        if constexpr (!Epi::AFTER_DRAIN) { E(acc, cur, wr, wc, fr, fq); S.done(cur); }
        if (!has_next) break;
#pragma unroll
        for (int a = 0; a < 2; ++a)
#pragma unroll
            for (int b = 0; b < 2; ++b)
#pragma unroll
                for (int m = 0; m < 4; ++m)
#pragma unroll
                    for (int n = 0; n < 2; ++n) acc[a][b][m][n] = (f32x4){0.f, 0.f, 0.f, 0.f};
        cur = nxt; cA = nA; cB = nB; ++ui;
        if constexpr (ALIGN_EPI) { if (wr == 1) PG8_BAR; }
    }
    PG8_WAIT_V(0);
    if constexpr (!ALIGN_EPI) { if (wr == 0) PG8_BAR; }
    PG8_BAR;
    if constexpr (Epi::AFTER_DRAIN) { E.fused(acc, cur, wr, wc, fr, fq, lds, wid, lane); S.done(cur); }
#undef PG8_SA
#undef PG8_SB
#undef PG8_STAGE
#undef PG8_LDA
#undef PG8_LDB
#undef PG8_MMA
#undef PG8_WAIT_V
#undef PG8_WAIT_L
#undef PG8_BAR
#undef PG8_SCHED
}
}

namespace att {
typedef unsigned short bf16;
typedef short bf16x8 __attribute__((ext_vector_type(8)));
typedef short s16x4 __attribute__((ext_vector_type(4)));
typedef float f32x16 __attribute__((ext_vector_type(16)));
typedef float f32x4 __attribute__((ext_vector_type(4)));
typedef unsigned u32x4 __attribute__((ext_vector_type(4)));
template <class A, class Bt> struct same_t { static constexpr bool v = false; };
template <class A> struct same_t<A, A> { static constexpr bool v = true; };
constexpr int D = 128;
constexpr float THR = 8.f;
constexpr bool WSKIP = false;
constexpr float SCALE = 0.08838834764831845f;
constexpr int NW = 8, QBLK = 32, KVBLK = 64, QB = NW * QBLK;
constexpr int SHM_V = KVBLK * D * 2, SHM_K = KVBLK * D * 2;
constexpr int LDS_BIAS = 2 * SHM_V + 2 * SHM_K + NW * 64 * 4;
constexpr int LDS_BYTES = LDS_BIAS + 4096 * 4;
constexpr int OP = 2048;
#define KSWZ(row, colB) ((row) * 256 + ((colB) ^ (((row) & 7) << 4)))
#define SBAR() __builtin_amdgcn_sched_barrier(0)
__device__ __forceinline__ int v_st(int k, int c) { const int kk = (k & ~0xC) | ((k & 4) << 1) | ((k & 8) >> 1); return ((kk >> 3) * 4 + (c >> 5)) * 512 + ((kk & 7) * 32 + (c & 31)) * 2; }
__device__ __forceinline__ int v_rd_base(int lane) { return ((lane & 3) << 3) | (((lane >> 2) & 3) << 6) | (((lane >> 4) & 1) << 5) | (((lane >> 5) & 1) << 8); }
constexpr int v_rd_off(int d0, int ks, int half) { return d0 * 512 + ks * 4096 + half * 2048; }
__device__ __forceinline__ int crow(int r, int hi) { return (r & 3) + 8 * (r >> 2) + 4 * hi; }
__device__ __forceinline__ unsigned cvtpk(float lo, float hi) {
    unsigned r; asm volatile("v_cvt_pk_bf16_f32 %0, %1, %2" : "=v"(r) : "v"(lo), "v"(hi)); return r;
}
__device__ __forceinline__ bf16x8 pack8(f32x4 a, f32x4 b) {
    u32x4 w = {cvtpk(a[0], a[1]), cvtpk(a[2], a[3]), cvtpk(b[0], b[1]), cvtpk(b[2], b[3])};
    return *reinterpret_cast<bf16x8*>(&w);
}
template <class T> __device__ __forceinline__ bf16x8 load8(const T* p) {
    if constexpr (same_t<T, float>::v) { return pack8(*(const f32x4*)p, *(const f32x4*)(p + 4)); }
    else { return *reinterpret_cast<const bf16x8*>(p); }
}
__device__ __forceinline__ void mask_tile(f32x16& p0, f32x16& p1, int dq, unsigned W) {
    const float NEG = -__builtin_inff();
#pragma unroll
    for (int r = 0; r < 16; ++r) {
        const int c = (r & 3) + 8 * (r >> 2);
        if ((unsigned)(dq - c) >= W) p0[r] = NEG;
        if ((unsigned)(dq - c - 32) >= W) p1[r] = NEG;
    }
}
__device__ __forceinline__ void partialSM(f32x16& p0, f32x16& p1, float& m_reg, float& mn, float& alpha) {
    float pmax = p0[0]; for (int r = 1; r < 16; ++r) pmax = fmaxf(pmax, p0[r]); for (int r = 0; r < 16; ++r) pmax = fmaxf(pmax, p1[r]);
    { auto rr = __builtin_amdgcn_permlane32_swap(__float_as_uint(pmax), __float_as_uint(pmax), false, false);
      pmax = fmaxf(__uint_as_float(rr[0]), __uint_as_float(rr[1])); }
    constexpr float C2 = 1.4426950408889634f * SCALE;
    if (__builtin_expect(__all((pmax - m_reg) * SCALE <= THR), 1)) { mn = m_reg; alpha = 1.f; }
    else { mn = fmaxf(m_reg, pmax); alpha = __builtin_amdgcn_exp2f((m_reg - mn) * C2); m_reg = mn; }
    const float mnL = -mn * C2;
    for (int r = 0; r < 16; ++r) p0[r] = fmaf(p0[r], C2, mnL); for (int r = 0; r < 16; ++r) p1[r] = fmaf(p1[r], C2, mnL);
    for (int r = 0; r < 16; ++r) p0[r] = __builtin_amdgcn_exp2f(p0[r]);
}
__device__ __forceinline__ void finishSM(f32x16& p0, f32x16& p1, float alpha, float& l_reg, bf16x8& pa0, bf16x8& pa1, bf16x8& pa2, bf16x8& pa3) {
    for (int r = 0; r < 16; ++r) p1[r] = __builtin_amdgcn_exp2f(p1[r]);
    float ps = 0; for (int r = 0; r < 16; ++r) ps += p0[r]; for (int r = 0; r < 16; ++r) ps += p1[r];
    { auto rr = __builtin_amdgcn_permlane32_swap(__float_as_uint(ps), __float_as_uint(ps), false, false);
      ps = __uint_as_float(rr[0]) + __uint_as_float(rr[1]); }
    l_reg = l_reg * alpha + ps;
#define PK4(P, B_, OUT) do { unsigned a0 = cvtpk(P[B_+0], P[B_+1]), a1 = cvtpk(P[B_+2], P[B_+3]);                          \
        unsigned b0 = cvtpk(P[B_+4], P[B_+5]), b1 = cvtpk(P[B_+6], P[B_+7]);                                             \
        auto r0 = __builtin_amdgcn_permlane32_swap(a0, b0, false, false); auto r1 = __builtin_amdgcn_permlane32_swap(a1, b1, false, false); \
        u32x4 w = {r0[0], r1[0], r0[1], r1[1]}; OUT = *reinterpret_cast<bf16x8*>(&w); } while (0)
    PK4(p0, 0, pa0); PK4(p0, 8, pa1); PK4(p1, 0, pa2); PK4(p1, 8, pa3);
#undef PK4
}
template <int KB, bool SK>
__device__ __forceinline__ void qkt(f32x16& p0, f32x16& p1, const char* K_lds, int r32, int hi, const bf16x8* qr, bool act, const float* bl) {
    if (SK && !act) { const float NEG = -__builtin_inff();
#pragma unroll
        for (int r = 0; r < 16; ++r) { p0[r] = NEG; p1[r] = NEG; } return; }
    { const f32x4 c0 = *(const f32x4*)(bl), c1 = *(const f32x4*)(bl + 8), c2 = *(const f32x4*)(bl + 16), c3 = *(const f32x4*)(bl + 24);
      const f32x4 e0 = *(const f32x4*)(bl + 32), e1 = *(const f32x4*)(bl + 40), e2 = *(const f32x4*)(bl + 48), e3 = *(const f32x4*)(bl + 56);
      p0 = (f32x16){c0[0], c0[1], c0[2], c0[3], c1[0], c1[1], c1[2], c1[3], c2[0], c2[1], c2[2], c2[3], c3[0], c3[1], c3[2], c3[3]};
      p1 = (f32x16){e0[0], e0[1], e0[2], e0[3], e1[0], e1[1], e1[2], e1[3], e2[0], e2[1], e2[2], e2[3], e3[0], e3[1], e3[2], e3[3]}; }
    const char* kb[4];
#pragma unroll
    for (int dd = 0; dd < 4; ++dd) kb[dd] = K_lds + KB * SHM_K + KSWZ(r32, (dd * 16 + hi * 8) * 2);
#pragma unroll
    for (int d0 = 0; d0 < 8; ++d0) { const char* a = kb[d0 & 3] + (d0 >> 2) * 128;
        bf16x8 b0 = *reinterpret_cast<const bf16x8*>(a);
        bf16x8 b1 = *reinterpret_cast<const bf16x8*>(a + 32 * 256);
        p0 = __builtin_amdgcn_mfma_f32_32x32x16_bf16(b0, qr[d0], p0, 0, 0, 0);
        p1 = __builtin_amdgcn_mfma_f32_32x32x16_bf16(b1, qr[d0], p1, 0, 0, 0); }
}
template <int VB, bool SK>
__device__ __forceinline__ void pv_tile(f32x16* o, int vb0, bf16x8 pa0, bf16x8 pa1, bf16x8 pa2, bf16x8 pa3, bool act) {
    if (SK && !act) return;
#define TRRD(dst, off) asm volatile("ds_read_b64_tr_b16 %0, %1 offset:%2" : "=&v"(dst) : "v"(vb0), "i"(off) : "memory")
#define PV_D0(d0) do { s16x4 l0, l1, l2, l3, h0, h1, h2, h3; constexpr int b_ = VB * SHM_V + v_rd_off(d0, 0, 0);     \
        TRRD(l0, b_); TRRD(h0, b_ + 2048); TRRD(l1, b_ + 4096); TRRD(h1, b_ + 6144); TRRD(l2, b_ + 8192); TRRD(h2, b_ + 10240); TRRD(l3, b_ + 12288); TRRD(h3, b_ + 14336); \
        asm volatile("s_waitcnt lgkmcnt(0)" ::: "memory"); SBAR();                 \
        o[d0] = __builtin_amdgcn_mfma_f32_32x32x16_bf16(pa0, (bf16x8){l0[0], l0[1], l0[2], l0[3], h0[0], h0[1], h0[2], h0[3]}, o[d0], 0, 0, 0);   \
        o[d0] = __builtin_amdgcn_mfma_f32_32x32x16_bf16(pa1, (bf16x8){l1[0], l1[1], l1[2], l1[3], h1[0], h1[1], h1[2], h1[3]}, o[d0], 0, 0, 0);   \
        o[d0] = __builtin_amdgcn_mfma_f32_32x32x16_bf16(pa2, (bf16x8){l2[0], l2[1], l2[2], l2[3], h2[0], h2[1], h2[2], h2[3]}, o[d0], 0, 0, 0);   \
        o[d0] = __builtin_amdgcn_mfma_f32_32x32x16_bf16(pa3, (bf16x8){l3[0], l3[1], l3[2], l3[3], h3[0], h3[1], h3[2], h3[3]}, o[d0], 0, 0, 0); } while (0)
    PV_D0(0); PV_D0(1); PV_D0(2); PV_D0(3);
#undef PV_D0
#undef TRRD
}


struct BlockRef { const bf16* Q; const bf16* K; const bf16* V; bf16* O; const float* KB; int P0; };
struct Seam { bf16x8 qr[8]; bf16x8 st_v0, st_v1, st_k0, st_k1; };
#define ROW(p, k0, rr) ((p) + (size_t)((k0) + (rr)) * D + sc)
#define VMW() asm volatile("s_waitcnt vmcnt(0)" ::: "memory")
#define VMWN(n) asm volatile("s_waitcnt vmcnt(%0)" :: "i"(n) : "memory")
#define SLOAD_H(Kp, Vp, k0) do { S.st_v0 = load8<bf16>(ROW(Vp, k0, sr)); S.st_v1 = load8<bf16>(ROW(Vp, k0, 32 + sr));              \
                         S.st_k0 = load8<bf16>(ROW(Kp, k0, sr)); S.st_k1 = load8<bf16>(ROW(Kp, k0, 32 + sr)); } while (0)
#define SWRITE_HK(bf) do { *(bf16x8*)(K_lds + (bf) * SHM_K + kws) = S.st_k0; *(bf16x8*)(K_lds + (bf) * SHM_K + kws + 32 * 256) = S.st_k1; } while (0)
#define SWRITE_HV(bf) do { *(bf16x8*)(V_lds + (bf) * SHM_V + vst0) = S.st_v0; *(bf16x8*)(V_lds + (bf) * SHM_V + vst1) = S.st_v1; } while (0)
#define SWRITE_H(bf) do { SWRITE_HV(bf); SWRITE_HK(bf); } while (0)
__device__ __forceinline__ void fox_prime(const BlockRef& cur, char* lds, Seam& S, int kw) {
    const int tid = ktid(kw), wid = kw, lane = tid & 63, r32 = lane & 31, hi = lane >> 5;
    const int sr = tid >> 4, sc = (tid & 15) * 8, kws = KSWZ(sr, sc * 2); char* K_lds = lds + 2 * SHM_V;
#pragma unroll
    for (int d0 = 0; d0 < 8; ++d0) S.qr[d0] = load8<bf16>(cur.Q + (size_t)(wid * QBLK + r32) * D + d0 * 16 + hi * 8);
    SLOAD_H(cur.K, cur.V, 0); VMW(); SWRITE_HK(0);
    __syncthreads();
}
__device__ __forceinline__ void fox_block(const BlockRef& cur, const BlockRef& nxt, char* lds, Seam& S, int kw) {
    constexpr bool SK = false; constexpr unsigned W = 0x7fffffffu;
    const int tid = ktid(kw), wid = kw, lane = tid & 63, r32 = lane & 31, hi = lane >> 5;
    const int NT = (cur.P0 + QB - 1) / KVBLK + 1;
    const int qlo = cur.P0 + wid * QBLK, qm = qlo + r32 - 4 * hi;
    char* V_lds = lds; char* K_lds = lds + 2 * SHM_V;
    float* ws = (float*)(lds + 2 * SHM_V + 2 * SHM_K) + wid * 64; float* li_l = ws, * al_l = ws + 32;
    float m_reg = -1e30f, l_reg = 0; f32x16 o[4] = {};
    const int sr = tid >> 4, sc = (tid & 15) * 8, vst0 = v_st(sr, sc), vst1 = v_st(32 + sr, sc), kws = KSWZ(sr, sc * 2);
    const int vb0 = (int)(uintptr_t)V_lds + v_rd_base(lane);
    const bf16* Kh = cur.K; const bf16* Vh = cur.V;
    float* bias_l = (float*)(lds + LDS_BIAS);
    { const int nb4 = (cur.P0 + QB) / 4; int i0 = ktid(kw); asm volatile("" : "+v"(i0));
      for (int i = i0; i < nb4; i += NW * 64) ((f32x4*)bias_l)[i] = ((const f32x4*)cur.KB)[i]; }
    __syncthreads();
    const float* KBh = bias_l + 4 * hi;
#define RESC(a) do { if (__any((a) < 1.f)) { if (hi == 0) al_l[r32] = (a); asm volatile("s_waitcnt lgkmcnt(0)" ::: "memory");              \
                     for (int d_ = 0; d_ < 4; ++d_) for (int r = 0; r < 16; ++r) o[d_][r] *= al_l[crow(r, hi)]; } } while (0)
#define KBASE(t) ((t) * KVBLK)
#define ACT(t) true
#define MASKT(P0_, P1_, t) do { const int kb_ = KBASE(t); if (kb_ + KVBLK - 1 > qlo) mask_tile(P0_, P1_, qm - kb_, W); } while (0)
    constexpr int NQL = 8;
#define SEAM_K0() do { VMWN(NQL); SWRITE_HK(0); SBAR(); } while (0)
    f32x16 pA0, pA1, pB0, pB1; float mnA, mnB, alA, alB; bf16x8 pa0, pa1, pa2, pa3;
    SWRITE_HV(0); SBAR();
    if (NT > 1) { SLOAD_H(Kh, Vh, KBASE(1)); }
    SBAR(); qkt<0, SK>(pA0, pA1, K_lds, r32, hi, S.qr, ACT(0), KBh);
    MASKT(pA0, pA1, 0); partialSM(pA0, pA1, m_reg, mnA, alA);
    if (NT > 1) { VMW(); SWRITE_H(1); }
    __syncthreads();
#define HALF_STEP(PX0, PX1, mnX, alX, PY0, PY1, alY, t, KB, VB, SB) do {                                                      \
        SBAR(); qkt<KB, SK>(PX0, PX1, K_lds, r32, hi, S.qr, ACT(t), KBh + KBASE(t));                                             \
        finishSM(PY0, PY1, alY, l_reg, pa0, pa1, pa2, pa3); SBAR();                                                           \
        if ((t) + 1 < NT) { SLOAD_H(Kh, Vh, KBASE((t) + 1)); SBAR(); }                                                        \
        pv_tile<VB, SK>(o, vb0, pa0, pa1, pa2, pa3, ACT((t) - 1)); MASKT(PX0, PX1, (t)); partialSM(PX0, PX1, m_reg, mnX, alX);  \
        __syncthreads();                                                                                                      \
        if ((t) + 1 < NT) { VMW(); SWRITE_H(SB); }                                                                            \
        RESC(alX); __syncthreads(); } while (0)
    for (int t = 1; t + 1 < NT; t += 2) {
        HALF_STEP(pB0, pB1, mnB, alB, pA0, pA1, alA, t, 1, 0, 0);
        HALF_STEP(pA0, pA1, mnA, alA, pB0, pB1, alB, t + 1, 0, 1, 1);
    }
    const bool even = (NT & 1) == 0;
    if (even) { SBAR(); qkt<1, SK>(pB0, pB1, K_lds, r32, hi, S.qr, ACT(NT - 1), KBh + KBASE(NT - 1)); SBAR(); }
    SLOAD_H(nxt.K, nxt.V, 0); SBAR();
#pragma unroll
    for (int d0 = 0; d0 < 8; ++d0) S.qr[d0] = load8<bf16>(nxt.Q + (size_t)(wid * QBLK + r32) * D + d0 * 16 + hi * 8);
    SBAR();
    finishSM(pA0, pA1, alA, l_reg, pa0, pa1, pa2, pa3); SBAR();
    pv_tile<0, SK>(o, vb0, pa0, pa1, pa2, pa3, true);
    if (even) { MASKT(pB0, pB1, NT - 1); partialSM(pB0, pB1, m_reg, mnB, alB); __syncthreads(); RESC(alB);
        finishSM(pB0, pB1, alB, l_reg, pa0, pa1, pa2, pa3); SBAR(); pv_tile<1, SK>(o, vb0, pa0, pa1, pa2, pa3, true); }
    SBAR(); SEAM_K0();
    if (hi == 0) li_l[r32] = l_reg; asm volatile("s_waitcnt lgkmcnt(0)" ::: "memory");
    float rli[16];
#pragma unroll
    for (int r = 0; r < 16; ++r) rli[r] = __builtin_amdgcn_rcpf(li_l[crow(r, hi)]);
    bf16* Ow = cur.O + (size_t)(wid * QBLK) * OP;
#pragma unroll
    for (int r = 0; r < 16; ++r) { const int orow = crow(r, hi);
#pragma unroll
        for (int d0 = 0; d0 < 4; ++d0) { const float v = o[d0][r] * rli[r];
            const float vn = __shfl_xor(v, 1);
            if ((r32 & 1) == 0) *(unsigned*)(Ow + (size_t)orow * OP + d0 * 32 + r32) = cvtpk(v, vn); } }
    __syncthreads();
#undef RESC
#undef KBASE
#undef ACT
#undef MASKT
#undef SEAM_K0
#undef HALF_STEP
}
#undef ROW
#undef VMW
#undef VMWN
#undef SLOAD_H
#undef SWRITE_HK
#undef SWRITE_HV
#undef SWRITE_H
#undef KSWZ
#undef SBAR
}

struct Frame {
    LAS unsigned char* lds;
    volatile LAS unsigned* MISC;
    gu32* ctl;
    int tid, lane, wave;
    int vcu, G, bx;
    const float *x, *c, *w_ada, *b_ada, *g_mix, *w_in, *b_f, *conv_w, *conv_b, *lru_w_a, *lru_b_a, *lru_w_x, *lru_b_x, *lru_lambda,
                *g_attn_out, *g_lru_out, *w_out, *g_ffn, *peer_w_q, *peer_k1, *peer_k2, *peer_u, *peer_v, *g_final;
    float* out;
    float *MOD, *LF, *KB, *SUMM, *EW;
    int* EIDX;
    bf16_t *WLRU, *K1, *K2, *WIN, *WOUT, *WQ, *U, *V, *H, *Q, *K, *VV, *QP, *LX, *GLY, *MRG;
};

struct Args { const float* in[24]; float* out; unsigned char* ws; int ph_lo, ph_hi, li, pad; };

__device__ __forceinline__ void p0_transpose_item(const float* W, int ldw, int K, bf16_t* WT, int kb, int scol, int drow, const float* gk, LAS float* scr, int lane) {
    const int k0 = 64 * kb;
#pragma unroll 8
    for (int i = 0; i < 32; ++i) { const int kk = 2 * i + (lane >> 5); float w = W[(size_t)(k0 + kk) * ldw + scol + (lane & 31)]; if (gk) w *= gk[k0 + kk]; scr[kk * 33 + (lane & 31)] = w; }
    LDS_WAIT(); asm volatile("" ::: "memory");
    const int c = lane & 7;
#pragma unroll
    for (int j = 0; j < 4; ++j) { const int n = (lane >> 3) + 8 * j; const LAS float* s = scr + (8 * c) * 33 + n;
        v4u o; o.x = pk2(s[0 * 33], s[1 * 33]); o.y = pk2(s[2 * 33], s[3 * 33]); o.z = pk2(s[4 * 33], s[5 * 33]); o.w = pk2(s[6 * 33], s[7 * 33]);
        *(GAS v4u*)(WT + (size_t)(drow + n) * K + k0 + 8 * c) = o; }
    LDS_WAIT(); asm volatile("" ::: "memory");
}
__device__ __forceinline__ void p0_convert(const float* src, bf16_t* dst, size_t n8, size_t gt, size_t ngt) {
#pragma unroll 4
    for (size_t i = gt; i < n8; i += ngt) { const f32x4 a = *(const GAS f32x4*)(src + i * 8), b = *(const GAS f32x4*)(src + i * 8 + 4);
        v4u o; o.x = pk2(a[0], a[1]); o.y = pk2(a[2], a[3]); o.z = pk2(b[0], b[1]); o.w = pk2(b[2], b[3]); *(GAS v4u*)(dst + i * 8) = o; }
}
__device__ __forceinline__ void p0_prologue(Frame& F) {
    {
        LAS float* scs = (LAS float*)F.lds;
        LAS float* red = scs + 4 * 2048;
        for (int i = F.tid; i < 4 * DM; i += NTHR) { const float cv = F.c[i]; scs[i] = cv * sigmoidf_(cv); }
        __syncthreads();
        for (int cb = F.bx; cb < 256; cb += F.G) {
            const int cq = F.tid % 12, rl = F.tid / 12;
            if (F.tid < 504) {
                float acc[4][4];
#pragma unroll
                for (int b = 0; b < 4; ++b)
#pragma unroll
                    for (int j = 0; j < 4; ++j) acc[b][j] = 0.f;
                const float* wp = F.w_ada + (size_t)rl * NADA + cb * 48 + cq * 4;
#pragma unroll 4
                for (int r = rl; r < DM; r += 42, wp += (size_t)42 * NADA) { const f32x4 w = *(const GAS f32x4*)wp;
#pragma unroll
                    for (int b = 0; b < 4; ++b) { const float s = scs[b * DM + r]; acc[b][0] += s * w[0]; acc[b][1] += s * w[1]; acc[b][2] += s * w[2]; acc[b][3] += s * w[3]; } }
#pragma unroll
                for (int b = 0; b < 4; ++b)
#pragma unroll
                    for (int j = 0; j < 4; ++j) red[rl * 192 + cq * 16 + b * 4 + j] = acc[b][j];
            }
            __syncthreads();
            if (F.tid < 192) { float s = 0.f;
                for (int r = 0; r < 42; ++r) s += red[r * 192 + F.tid];
                const int q = F.tid >> 4, b = (F.tid >> 2) & 3, j = F.tid & 3, col = cb * 48 + q * 4 + j;
                F.MOD[b * NADA + col] = s + F.b_ada[col]; }
            __syncthreads();
        }
    }
    {
        LAS float* scr = (LAS float*)(F.lds + F.wave * 16384);
        const int gw = F.vcu * NWAVES + F.wave, NGW = F.G * NWAVES;
        constexpr int I_IN1 = 32 * 96, I_IN2 = 32 * 64, I_SQ = 32 * 64, I_LRU = 16 * 8;
        constexpr int NITEMS = I_IN1 + I_IN2 + 2 * I_SQ + I_LRU;
        for (int it = gw; it < NITEMS; it += NGW) {
            int r = it;
            if (r < I_IN1) { const int kb = r / 96, nb = r % 96; p0_transpose_item(F.w_in, INC, DM, F.WIN, kb, 32 * nb, 32 * nb, nullptr, scr, F.lane); continue; } r -= I_IN1;
            if (r < I_IN2) { const int kb = r / 64, nb = r % 64; p0_transpose_item(F.w_in, INC, DM, F.WIN, kb, OFF_LX + 32 * nb, OFF_F + 32 * nb, nullptr, scr, F.lane); continue; } r -= I_IN2;
            if (r < I_SQ) { const int kb = r / 64, nb = r % 64; const float* gk = kb < 16 ? F.g_attn_out : F.g_lru_out - AW;
                p0_transpose_item(F.w_out, DM, DM, F.WOUT, kb, 32 * nb, 32 * nb, gk, scr, F.lane); continue; } r -= I_SQ;
            if (r < I_SQ) { const int kb = r / 64, nb = r % 64; p0_transpose_item(F.peer_w_q, DM, DM, F.WQ, kb, 32 * nb, 32 * nb, nullptr, scr, F.lane); continue; } r -= I_SQ;
            { const int mat = r >> 3, sub = r & 7, n = mat >> 1, which = mat & 1, kb = sub >> 2, nb = sub & 3;
              const float* src = (which ? F.lru_w_x : F.lru_w_a) + (size_t)n * LBD * LBD;
              p0_transpose_item(src, LBD, LBD, F.WLRU + (size_t)(n * 256 + which * 128) * LBD, kb, 32 * nb, 32 * nb, nullptr, scr, F.lane); }
        }
    }
    {
        const size_t gt = (size_t)F.vcu * NTHR + F.tid, ngt = (size_t)F.G * NTHR;
        p0_convert(F.peer_k1, F.K1, (size_t)PH * PNK * 128 / 8, gt, ngt);
        p0_convert(F.peer_k2, F.K2, (size_t)PH * PNK * 128 / 8, gt, ngt);
        p0_convert(F.peer_u, F.U, (size_t)NEXP * DM / 8, gt, ngt);
        p0_convert(F.peer_v, F.V, (size_t)NEXP * DM / 8, gt, ngt);
    }
}

template <bool WITH_F>
__device__ __forceinline__ void p_modnorm(Frame& F, const float* xin, const float* g, int off_sh, int off_sc) {
    LAS float* gsv = (LAS float*)F.lds;
    LAS float* shv = gsv + DM;
    LAS float* wfT = shv + DM;
    if (WITH_F) { for (int i = F.tid; i < 8 * DM; i += NTHR) { const int k = i >> 3, j = i & 7; wfT[j * DM + k] = F.w_in[(size_t)k * INC + OFF_F + j]; } }
    for (int rb = F.bx; rb < T / 64; rb += F.G) {
        const int b = rb >> 6;
        __syncthreads();
        for (int k = F.tid; k < DM; k += NTHR) { gsv[k] = g[k] * (1.f + F.MOD[b * NADA + off_sc + k]); shv[k] = F.MOD[b * NADA + off_sh + k]; }
        __syncthreads();
        for (int i = 0; i < 8; ++i) {
            const int row = rb * 64 + F.wave * 8 + i;
            const GAS f32x4* xr = (const GAS f32x4*)(xin + (size_t)row * DM) + F.lane;
            f32x4 v[8]; float ss = 0.f;
#pragma unroll
            for (int j = 0; j < 8; ++j) { v[j] = xr[64 * j]; ss += (v[j][0] * v[j][0] + v[j][1] * v[j][1]) + (v[j][2] * v[j][2] + v[j][3] * v[j][3]); }
            const float rstd = __builtin_amdgcn_rsqf(wave_sum(ss) * (1.f / DM) + EPS);
#pragma unroll
            for (int j = 0; j < 8; ++j) { const f32x4 gg = ((const LAS f32x4*)gsv)[F.lane + 64 * j], sh = ((const LAS f32x4*)shv)[F.lane + 64 * j]; v[j] = v[j] * rstd * gg + sh; }
            GAS v2u* o8 = (GAS v2u*)(F.H + (size_t)row * DM) + F.lane;
#pragma unroll
            for (int j = 0; j < 8; ++j) { v2u w; w.x = pk2(v[j][0], v[j][1]); w.y = pk2(v[j][2], v[j][3]); o8[64 * j] = w; }
            if (WITH_F) {
                float mine = 0.f;
#pragma unroll 1
                for (int jj = 0; jj < 8; ++jj) { float a = 0.f;
#pragma unroll
                    for (int j = 0; j < 8; ++j) { const f32x4 w = ((const LAS f32x4*)(wfT + jj * DM))[F.lane + 64 * j]; a += (v[j][0] * w[0] + v[j][1] * w[1]) + (v[j][2] * w[2] + v[j][3] * w[3]); }
                    a = wave_sum(a); mine = (F.lane == jj) ? a : mine; }
                if (F.lane < 8) { const float z = mine + F.b_f[F.lane]; const float lf = fminf(z, 0.f) - log1pf(fexp(-fabsf(z)));
                    F.LF[(size_t)(b * NH + F.lane) * SEQ + (row & (SEQ - 1))] = lf; }
            }
        }
    }
}

__device__ __forceinline__ void p2_cumsum(Frame& F) {
    LAS float* wt = (LAS float*)F.lds;
    for (int bh = F.bx; bh < BATCH * NH; bh += F.G) {
        const float* src = F.LF + (size_t)bh * SEQ + F.tid * 8;
        const f32x4 a = *(const GAS f32x4*)src, b = *(const GAS f32x4*)(src + 4);
        float p[8]; p[0] = a[0]; p[1] = p[0] + a[1]; p[2] = p[1] + a[2]; p[3] = p[2] + a[3]; p[4] = p[3] + b[0]; p[5] = p[4] + b[1]; p[6] = p[5] + b[2]; p[7] = p[6] + b[3];
        float incl = p[7];
#pragma unroll
        for (int o = 1; o < 64; o <<= 1) { const float n = __shfl_up(incl, o); if (F.lane >= o) incl += n; }
        __syncthreads();
        if (F.lane == 63) wt[F.wave] = incl;
        __syncthreads();
        float off = incl - p[7];
        for (int w = 0; w < F.wave; ++w) off += wt[w];
        constexpr float NIS = -1.0f / 0.08838834764831845f;
        f32x4 o0, o1;
        o0[0] = (off + p[0]) * NIS; o0[1] = (off + p[1]) * NIS; o0[2] = (off + p[2]) * NIS; o0[3] = (off + p[3]) * NIS;
        o1[0] = (off + p[4]) * NIS; o1[1] = (off + p[5]) * NIS; o1[2] = (off + p[6]) * NIS; o1[3] = (off + p[7]) * NIS;
        float* dst = F.KB + (size_t)bh * SEQ + F.tid * 8;
        *(GAS f32x4*)dst = o0; *(GAS f32x4*)(dst + 4) = o1;
    }
}

constexpr int L_LX = 0, L_A = 17408, L_XC = 34816, L_SA = 68608, L_SUM = 102400, L_HIN = 106496, L_END = 110592;
constexpr int XS = 132;
typedef float f32x4v __attribute__((ext_vector_type(4)));
template <bool FINAL>
__device__ __forceinline__ void lru_unit(Frame& F, int b, int chunk) {
    LAS unsigned char* L = F.lds;
    int tid_ = ktid(F.wave); asm volatile("" : "+v"(tid_));
    const int tid = tid_, lane = tid_ & 63, wave = F.wave;
    const int s0 = chunk * 64; const size_t row0 = (size_t)b * SEQ + s0;
    LAS float* hin = (LAS float*)(L + L_HIN);
    __syncthreads();
    if (FINAL) {
        for (int ch = tid; ch < LW; ch += NTHR) { float h = 0.f;
            const GAS f32x2* sp = (const GAS f32x2*)F.SUMM + (size_t)(b * 64) * LW + ch;
            for (int c = 0; c < chunk; ++c) { const f32x2 ph = sp[(size_t)c * LW]; h = ph[0] * h + ph[1]; }
            hin[ch] = h; }
    }
    float myssq = 0.f;
    for (int n = 0; n < NLB; ++n) {
        __syncthreads();
        for (int idx = tid; idx < 67 * 16; idx += NTHR) { const int r = idx >> 4, c8 = idx & 15; const int s = s0 - 3 + r;
            v4u val = {0u, 0u, 0u, 0u};
            if (s >= 0) val = *(const GAS v4u*)(F.LX + ((size_t)b * SEQ + s) * LW + n * LBD + c8 * 8);
            *(LAS v4u*)(L + L_LX + r * 256 + c8 * 16) = val; }
        __syncthreads();
        { const int tok = tid >> 3, c16 = tid & 7; const int chg = n * LBD + c16 * 16;
          float xc[16];
#pragma unroll
          for (int e = 0; e < 16; e += 4) { const f32x4 cb = *(const GAS f32x4*)(F.conv_b + chg + e); xc[e] = cb[0]; xc[e + 1] = cb[1]; xc[e + 2] = cb[2]; xc[e + 3] = cb[3]; }
#pragma unroll
          for (int k = 0; k < 4; ++k) {
              const v4u x0 = *(const LAS v4u*)(L + L_LX + (tok + k) * 256 + c16 * 32), x1 = *(const LAS v4u*)(L + L_LX + (tok + k) * 256 + c16 * 32 + 16);
              const unsigned xd[8] = {x0.x, x0.y, x0.z, x0.w, x1.x, x1.y, x1.z, x1.w};
#pragma unroll
              for (int e = 0; e < 16; e += 4) { const f32x4 w = *(const GAS f32x4*)(F.conv_w + k * LW + chg + e);
                  xc[e] += w[0] * bf_lo(xd[e / 2]); xc[e + 1] += w[1] * bf_hi(xd[e / 2]); xc[e + 2] += w[2] * bf_lo(xd[e / 2 + 1]); xc[e + 3] += w[3] * bf_hi(xd[e / 2 + 1]); } }
          v4u a0, a1; a0.x = pk2(xc[0], xc[1]); a0.y = pk2(xc[2], xc[3]); a0.z = pk2(xc[4], xc[5]); a0.w = pk2(xc[6], xc[7]);
          a1.x = pk2(xc[8], xc[9]); a1.y = pk2(xc[10], xc[11]); a1.z = pk2(xc[12], xc[13]); a1.w = pk2(xc[14], xc[15]);
          *(LAS v4u*)(L + L_A + tok * 272 + c16 * 32) = a0; *(LAS v4u*)(L + L_A + tok * 272 + c16 * 32 + 16) = a1;
          LAS float* xo = (LAS float*)(L + L_XC) + tok * XS + c16 * 16;
#pragma unroll
          for (int e = 0; e < 16; e += 4) *(LAS f32x4*)(xo + e) = (f32x4){xc[e], xc[e + 1], xc[e + 2], xc[e + 3]};
        }
        __syncthreads();
        const int r16 = lane & 15, g4 = lane >> 4;
        f32x4 acc_a[4], acc_x[4];
#pragma unroll
        for (int m = 0; m < 4; ++m) { acc_a[m] = (f32x4){0.f, 0.f, 0.f, 0.f}; acc_x[m] = (f32x4){0.f, 0.f, 0.f, 0.f}; }
        { const bf16_t* wa = F.WLRU + ((size_t)(n * 256 + 16 * wave + r16)) * LBD + 8 * g4; const bf16_t* wx = wa + (size_t)128 * LBD;
#pragma unroll
          for (int ks = 0; ks < 4; ++ks) {
              const bf16x8 ba = *(const GAS bf16x8*)(wa + 32 * ks), bx = *(const GAS bf16x8*)(wx + 32 * ks);
#pragma unroll
              for (int m = 0; m < 4; ++m) { const bf16x8 af = *(const LAS bf16x8*)(L + L_A + (16 * m + r16) * 272 + (32 * ks + 8 * g4) * 2);
                  acc_a[m] = __builtin_amdgcn_mfma_f32_16x16x32_bf16(af, ba, acc_a[m], 0, 0, 0);
                  acc_x[m] = __builtin_amdgcn_mfma_f32_16x16x32_bf16(af, bx, acc_x[m], 0, 0, 0); } } }
        { const int chl = 16 * wave + r16, chg = n * LBD + chl;
          const float ba_ = F.lru_b_a[chg], bx_ = F.lru_b_x[chg]; const float sp8 = 8.f * softplusf_(-F.lru_lambda[chg]);
          LAS float* xcp = (LAS float*)(L + L_XC) + chl; LAS float* sap = (LAS float*)(L + L_SA) + chl;
#pragma unroll
          for (int m = 0; m < 4; ++m)
#pragma unroll
              for (int i = 0; i < 4; ++i) { const int tt = 16 * m + 4 * g4 + i;
                  const float rg = sigmoidf_(acc_a[m][i] + ba_), ig = sigmoidf_(acc_x[m][i] + bx_);
                  const float la = -sp8 * rg; const float a = fexp(la); const float x2 = 2.f * la;
                  const float em1 = (x2 > -0.3f) ? x2 * (1.f + x2 * (0.5f + x2 * (0.16666667f + x2 * (0.041666668f + x2 * (0.008333334f + x2 * 0.0013888889f))))) : (fexp(x2) - 1.f);
                  const float bt = __builtin_sqrtf(fmaxf(-em1, 0.f)) * (ig * xcp[tt * XS]);
                  sap[tt * XS] = a; xcp[tt * XS] = bt; } }
        __syncthreads();
        { const int chl = tid & 127, sub = tid >> 7;
          const LAS float* sap = (const LAS float*)(L + L_SA) + (16 * sub) * XS + chl; const LAS float* sbp = (const LAS float*)(L + L_XC) + (16 * sub) * XS + chl;
          float av[16], bv[16];
#pragma unroll
          for (int j = 0; j < 16; ++j) { av[j] = sap[j * XS]; bv[j] = sbp[j * XS]; }
          float P = 1.f, Hh = 0.f;
#pragma unroll
          for (int j = 0; j < 16; ++j) { Hh = av[j] * Hh + bv[j]; P *= av[j]; }
          LAS f32x2* sm = (LAS f32x2*)(L + L_SUM);
          sm[sub * 128 + chl] = (f32x2){P, Hh};
          __syncthreads();
          if (!FINAL) {
              if (sub == 3) { float pp = 1.f, hh = 0.f;
#pragma unroll
                  for (int s = 0; s < 4; ++s) { const f32x2 ph = sm[s * 128 + chl]; hh = ph[0] * hh + ph[1]; pp *= ph[0]; }
                  *((GAS f32x2*)F.SUMM + ((size_t)(b * 64 + chunk)) * LW + n * LBD + chl) = (f32x2){pp, hh}; }
          } else {
              float h = hin[n * LBD + chl];
              for (int s = 0; s < sub; ++s) { const f32x2 ph = sm[s * 128 + chl]; h = ph[0] * h + ph[1]; }
              const bf16_t* gl = F.GLY + (row0 + 16 * sub) * LW + n * LBD + chl;
              bf16_t* op = F.MRG + (row0 + 16 * sub) * DM + AW + n * LBD + chl;
              float gv[16];
#pragma unroll
              for (int j = 0; j < 16; ++j) gv[j] = bf_lo((unsigned)gl[(size_t)j * LW]);
              LAS float* sq = (LAS float*)(L + L_SA) + (16 * sub) * XS + chl;
#pragma unroll
              for (int j = 0; j < 16; ++j) { h = av[j] * h + bv[j]; const float o = h * gv[j]; op[(size_t)j * DM] = (bf16_t)f2bf(o); sq[j * XS] = o * o; }
              __syncthreads();
              { const int tt = tid >> 3, part = tid & 7; const LAS float* q = (const LAS float*)(L + L_SA) + tt * XS + part * 16; float s = 0.f;
#pragma unroll
                for (int e = 0; e < 16; e += 4) { const f32x4 v = *(const LAS f32x4*)(q + e); s += (v[0] + v[1]) + (v[2] + v[3]); }
                s += __shfl_xor(s, 1); s += __shfl_xor(s, 2); s += __shfl_xor(s, 4); myssq += s; }
          }
        }
    }
    if (FINAL) {
        VM_WAIT(); __syncthreads();
        const int tt = tid >> 3, part = tid & 7;
        bf16_t* rowp = F.MRG + (row0 + tt) * DM;
        const float rl = __builtin_amdgcn_rsqf(myssq * (1.f / LW) + EPS);
        v4u la[16], aa[16];
#pragma unroll
        for (int e = 0; e < 16; ++e) { aa[e] = *(const GAS v4u*)(rowp + part * 128 + e * 8); }
        float sa = 0.f;
#pragma unroll
        for (int e = 0; e < 16; ++e) { const unsigned d[4] = {aa[e].x, aa[e].y, aa[e].z, aa[e].w};
#pragma unroll
            for (int q = 0; q < 4; ++q) { const float lo = bf_lo(d[q]), hi = bf_hi(d[q]); sa += lo * lo + hi * hi; } }
        sa += __shfl_xor(sa, 1); sa += __shfl_xor(sa, 2); sa += __shfl_xor(sa, 4);
        const float ra = __builtin_amdgcn_rsqf(sa * (1.f / AW) + EPS);
#pragma unroll
        for (int e = 0; e < 16; ++e) { v4u o; const unsigned d[4] = {aa[e].x, aa[e].y, aa[e].z, aa[e].w}; unsigned r[4];
#pragma unroll
            for (int q = 0; q < 4; ++q) r[q] = pk2(bf_lo(d[q]) * ra, bf_hi(d[q]) * ra);
            o.x = r[0]; o.y = r[1]; o.z = r[2]; o.w = r[3]; *(GAS v4u*)(rowp + part * 128 + e * 8) = o; }
#pragma unroll
        for (int e = 0; e < 16; ++e) { la[e] = *(const GAS v4u*)(rowp + AW + part * 128 + e * 8); }
#pragma unroll
        for (int e = 0; e < 16; ++e) { v4u o; const unsigned d[4] = {la[e].x, la[e].y, la[e].z, la[e].w}; unsigned r[4];
#pragma unroll
            for (int q = 0; q < 4; ++q) r[q] = pk2(bf_lo(d[q]) * rl, bf_hi(d[q]) * rl);
            o.x = r[0]; o.y = r[1]; o.z = r[2]; o.w = r[3]; *(GAS v4u*)(rowp + AW + part * 128 + e * 8) = o; }
    }
}

__device__ __forceinline__ att::BlockRef att_ref(Frame& F, int bh, int qb) {
    att::BlockRef r; const int b = bh >> 3, h = bh & 7;
    r.Q = F.Q + ((size_t)bh * SEQ + (size_t)qb * att::QB) * HD; r.K = F.K + (size_t)bh * SEQ * HD; r.V = F.VV + (size_t)bh * SEQ * HD;
    r.O = F.MRG + ((size_t)b * SEQ + (size_t)qb * att::QB) * DM + h * HD; r.KB = F.KB + (size_t)bh * SEQ; r.P0 = qb * att::QB;
    return r;
}
__device__ __forceinline__ void p3_attention(Frame& F, char* lds) {
    constexpr int NQB = SEQ / att::QB, NX = NQB / 2, TOTAL = BATCH * NH * NX;
    int L = F.vcu; if (L >= TOTAL) return;
    int pass = 0; int bh = L / NX, x = L % NX;
    att::BlockRef cur = att_ref(F, bh, x);
    att::Seam S;
    att::fox_prime(cur, lds, S, F.wave);
    for (;;) {
        const bool more_pass = pass == 0, more_item = L + F.G < TOTAL, last = !more_pass && !more_item;
        int passn = pass + 1, Ln = L;
        if (!more_pass) { passn = 0; Ln = more_item ? L + F.G : L; }
        const int bhn = Ln / NX, xn = Ln % NX;
        const att::BlockRef nxt = last ? cur : att_ref(F, bhn, passn ? NQB - 1 - xn : xn);
        att::fox_block(cur, nxt, lds, S, F.wave);
        if (last) break;
        cur = nxt; pass = passn; L = Ln;
    }
}

template <int N> __device__ __forceinline__ float row_ror(float v) { return __builtin_bit_cast(float, __builtin_amdgcn_update_dpp(0, __builtin_bit_cast(int, v), 0x120 + N, 0xf, 0xf, false)); }
__device__ __forceinline__ float fmax_s(float a, float b) { float r; asm("v_max_f32_e32 %0, %1, %2" : "=v"(r) : "v"(a), "v"(b)); return r; }
__device__ __forceinline__ float fmin_s(float a, float b) { float r; asm("v_min_f32_e32 %0, %1, %2" : "=v"(r) : "v"(a), "v"(b)); return r; }
__device__ __forceinline__ float row_allmax(float v) {
    asm volatile("s_nop 1\n\tv_max_f32_dpp %0, %0, %0 row_ror:8 row_mask:0xf bank_mask:0xf\n\t"
                 "s_nop 1\n\tv_max_f32_dpp %0, %0, %0 row_ror:4 row_mask:0xf bank_mask:0xf\n\t"
                 "s_nop 1\n\tv_max_f32_dpp %0, %0, %0 row_ror:2 row_mask:0xf bank_mask:0xf\n\t"
                 "s_nop 1\n\tv_max_f32_dpp %0, %0, %0 row_ror:1 row_mask:0xf bank_mask:0xf" : "+v"(v));
    return v;
}
__device__ __forceinline__ float row_allsum(float v) { v += row_ror<8>(v); v += row_ror<4>(v); v += row_ror<2>(v); v += row_ror<1>(v); return v; }
#define CE_DESC(a, b) do { const float hi_ = fmax_s(a, b), lo_ = fmin_s(a, b); a = hi_; b = lo_; } while (0)
__device__ __forceinline__ float row_top16(float (&Lv)[8], int r16) {
    CE_DESC(Lv[0], Lv[1]); CE_DESC(Lv[2], Lv[3]); CE_DESC(Lv[4], Lv[5]); CE_DESC(Lv[6], Lv[7]);
    CE_DESC(Lv[0], Lv[2]); CE_DESC(Lv[1], Lv[3]); CE_DESC(Lv[4], Lv[6]); CE_DESC(Lv[5], Lv[7]);
    CE_DESC(Lv[1], Lv[2]); CE_DESC(Lv[5], Lv[6]);
    CE_DESC(Lv[0], Lv[4]); CE_DESC(Lv[1], Lv[5]); CE_DESC(Lv[2], Lv[6]); CE_DESC(Lv[3], Lv[7]);
    CE_DESC(Lv[2], Lv[4]); CE_DESC(Lv[3], Lv[5]);
    CE_DESC(Lv[1], Lv[2]); CE_DESC(Lv[3], Lv[4]); CE_DESC(Lv[5], Lv[6]);
    float res = 0.f; const float NEG = -__builtin_inff();
#pragma unroll
    for (int k = 0; k < 16; ++k) {
        const float m = row_allmax(Lv[0]);
        res = (r16 == k) ? m : res;
        const bool win = (Lv[0] == m);
#pragma unroll
        for (int j = 0; j < 7; ++j) Lv[j] = win ? Lv[j + 1] : Lv[j];
        Lv[7] = win ? NEG : Lv[7];
    }
    return res;
}
__device__ __forceinline__ void p8_topk(Frame& F) {
    LAS unsigned char* L = F.lds;
    const int lane = F.lane, wave = F.wave, r16 = lane & 15, g4 = lane >> 4;
    for (int grp = F.bx; grp < 256; grp += F.G) {
        const int hd = grp & 7, widx = grp >> 3;
        __syncthreads();
        for (int idx = F.tid; idx < 2 * 128 * 16; idx += NTHR) { const int half = idx >> 11, row = (idx >> 4) & 127, c8 = idx & 15;
            const bf16_t* src = (half ? F.K2 : F.K1) + ((size_t)hd * PNK + row) * 128 + c8 * 8;
            *(LAS v4u*)(L + half * 34816 + row * 272 + c8 * 16) = *(const GAS v4u*)src; }
        __syncthreads();
        for (int it = wave; it < 32; it += NWAVES) {
            const int t0 = widx * 512 + it * 16;
            bf16x8 a1[4], a2[4];
            { const bf16_t* qp = F.QP + (size_t)(t0 + r16) * DM + hd * PQD + 8 * g4;
#pragma unroll
              for (int ks = 0; ks < 4; ++ks) { a1[ks] = *(const GAS bf16x8*)(qp + 32 * ks); a2[ks] = *(const GAS bf16x8*)(qp + 128 + 32 * ks); } }
            f32x4 s1[8], s2[8];
#pragma unroll
            for (int nt = 0; nt < 8; ++nt) { s1[nt] = (f32x4){0.f, 0.f, 0.f, 0.f}; s2[nt] = (f32x4){0.f, 0.f, 0.f, 0.f};
#pragma unroll
                for (int ks = 0; ks < 4; ++ks) {
                    const bf16x8 b1 = *(const LAS bf16x8*)(L + (16 * nt + r16) * 272 + (32 * ks + 8 * g4) * 2);
                    const bf16x8 b2 = *(const LAS bf16x8*)(L + 34816 + (16 * nt + r16) * 272 + (32 * ks + 8 * g4) * 2);
                    s1[nt] = __builtin_amdgcn_mfma_f32_16x16x32_bf16(a1[ks], b1, s1[nt], 0, 0, 0);
                    s2[nt] = __builtin_amdgcn_mfma_f32_16x16x32_bf16(a2[ks], b2, s2[nt], 0, 0, 0); } }
#pragma unroll
            for (int i = 0; i < 4; ++i) {
                float l1[8], l2[8];
#pragma unroll
                for (int nt = 0; nt < 8; ++nt) {
                    l1[nt] = bitsf((fbits(s1[nt][i]) & ~0x7Fu) | (unsigned)(16 * nt + r16));
                    l2[nt] = bitsf((fbits(s2[nt][i]) & ~0x7Fu) | (unsigned)(16 * nt + r16)); }
                __builtin_amdgcn_sched_barrier(0);
                const float v1 = row_top16(l1, r16); __builtin_amdgcn_sched_barrier(0);
                const float v2 = row_top16(l2, r16); __builtin_amdgcn_sched_barrier(0);
                float cnd[16];
#pragma unroll
                for (int bb = 0; bb < 16; ++bb) { const float w = __shfl(v2, bb, 16);
                    cnd[bb] = __builtin_bit_cast(float, (__builtin_bit_cast(unsigned, v1 + w) & ~0xFFu) | (unsigned)(r16 * 16 + bb)); }
                float fin = 0.f; const float NEG = -__builtin_inff();
#pragma unroll
                for (int k = 0; k < 16; ++k) {
                    const float m = row_allmax(cnd[0]);
                    fin = (r16 == k) ? m : fin;
                    const bool win = (cnd[0] == m);
#pragma unroll
                    for (int j = 0; j < 15; ++j) cnd[j] = win ? cnd[j + 1] : cnd[j];
                    cnd[15] = win ? NEG : cnd[15];
                }
                const unsigned fb = __builtin_bit_cast(unsigned, fin); const int ra = (fb >> 4) & 15, rb = fb & 15;
                const float pv1 = __shfl(v1, ra, 16), pv2 = __shfl(v2, rb, 16);
                const int i1 = __builtin_bit_cast(unsigned, pv1) & 0x7F, i2 = __builtin_bit_cast(unsigned, pv2) & 0x7F;
                const float vs = pv1 + pv2;
                const float mx = row_allmax(vs); const float ex = fexp(vs - mx); const float sm = row_allsum(ex);
                const size_t o = (size_t)(t0 + 4 * g4 + i) * NSEL + hd * PTOPK + r16;
                F.EIDX[o] = i1 * PNK + i2; F.EW[o] = ex / sm;
                __builtin_amdgcn_sched_barrier(0);
            }
        }
    }
}

#ifdef P8_NAIVE
__device__ __forceinline__ void p8_naive(Frame& F) {
    LAS float* base = (LAS float*)F.lds;
    if (F.tid < 64) {
        LAS float* sc = base + F.tid * 320; LAS int* ia = (LAS int*)(sc + 256); LAS int* ib = ia + 16;
        for (int pair = F.bx * 64 + F.tid; pair < T * PH; pair += F.G * 64) { const int t = pair >> 3, hd = pair & 7;
            for (int n = 0; n < 128; ++n) { float a = 0.f, b = 0.f;
                for (int d = 0; d < 128; ++d) { const float q1 = bf_lo((unsigned)F.QP[(size_t)t * DM + hd * 256 + d]), q2 = bf_lo((unsigned)F.QP[(size_t)t * DM + hd * 256 + 128 + d]);
                    a += q1 * F.peer_k1[((size_t)hd * 128 + n) * 128 + d]; b += q2 * F.peer_k2[((size_t)hd * 128 + n) * 128 + d]; }
                sc[n] = a; sc[128 + n] = b; }
            int na = 0, nb = 0;
            for (int n = 0; n < 128; ++n) { int c1 = 0, c2 = 0; for (int m = 0; m < 128; ++m) { c1 += (sc[m] > sc[n]) || (sc[m] == sc[n] && m < n); c2 += (sc[128 + m] > sc[128 + n]) || (sc[128 + m] == sc[128 + n] && m < n); }
                if (c1 < 16) ia[na++] = n; if (c2 < 16) ib[nb++] = n; }
            float bound = 1e30f; int pa = -1, pb = -1; float vs[16]; int ee[16];
            for (int r = 0; r < 16; ++r) { float mx = -1e30f; int ba = 0, bb = 0;
                for (int a = 0; a < 16; ++a) for (int b = 0; b < 16; ++b) { const float v = sc[ia[a]] + sc[128 + ib[b]];
                    const bool lt = v < bound || (v == bound && (ia[a] * 128 + ib[b]) > (pa * 128 + pb));
                    if (lt && (v > mx)) { mx = v; ba = ia[a]; bb = ib[b]; } }
                bound = mx; pa = ba; pb = bb; vs[r] = mx; ee[r] = ba * 128 + bb; }
            float sm = 0.f;
#pragma unroll
            for (int r = 0; r < 16; ++r) { vs[r] = expf(vs[r] - vs[0]); sm += vs[r]; }
#pragma unroll
            for (int r = 0; r < 16; ++r) { F.EIDX[(size_t)t * NSEL + hd * 16 + r] = ee[r]; F.EW[(size_t)t * NSEL + hd * 16 + r] = vs[r] / sm; }
        }
    }
}
#endif
__device__ __forceinline__ float dot8(const v4u& a, const v4u& b, float c) {
    c = __builtin_amdgcn_fdot2_f32_bf16(asbf2(a.x), asbf2(b.x), c, false);
    c = __builtin_amdgcn_fdot2_f32_bf16(asbf2(a.y), asbf2(b.y), c, false);
    c = __builtin_amdgcn_fdot2_f32_bf16(asbf2(a.z), asbf2(b.z), c, false);
    c = __builtin_amdgcn_fdot2_f32_bf16(asbf2(a.w), asbf2(b.w), c, false);
    return c;
}
__device__ __forceinline__ void p9_peer(Frame& F) {
    const int lane = F.lane; const int gw = F.vcu * NWAVES + F.wave, NGW = F.G * NWAVES;
    for (int t = gw; t < T; t += NGW) {
        const int b = t >> 12;
        const GAS v4u* hp = (const GAS v4u*)(F.H + (size_t)t * DM) + lane;
        v4u hq[4];
#pragma unroll
        for (int j = 0; j < 4; ++j) hq[j] = hp[64 * j];
        float y[32];
#pragma unroll
        for (int e = 0; e < 32; ++e) y[e] = 0.f;
        const int* ei = F.EIDX + (size_t)t * NSEL; const float* ew = F.EW + (size_t)t * NSEL;
        for (int e0 = 0; e0 < NSEL; e0 += 4) {
            int ex[4]; float wt[4];
#pragma unroll
            for (int q = 0; q < 4; ++q) { ex[q] = __builtin_amdgcn_readfirstlane(ei[e0 + q]); wt[q] = __builtin_bit_cast(float, __builtin_amdgcn_readfirstlane(__builtin_bit_cast(int, ew[e0 + q]))); }
            v4u ur[4][4], vr[4][4];
#pragma unroll
            for (int q = 0; q < 4; ++q) { const GAS v4u* up = (const GAS v4u*)(F.U + (size_t)ex[q] * DM) + lane;
#pragma unroll
                for (int j = 0; j < 4; ++j) ur[q][j] = up[64 * j]; }
#pragma unroll
            for (int q = 0; q < 4; ++q) { const GAS v4u* vp = (const GAS v4u*)(F.V + (size_t)ex[q] * DM) + lane;
#pragma unroll
                for (int j = 0; j < 4; ++j) vr[q][j] = vp[64 * j]; }
            float d[4];
#pragma unroll
            for (int q = 0; q < 4; ++q) { float c = 0.f;
#pragma unroll
                for (int j = 0; j < 4; ++j) c = dot8(hq[j], ur[q][j], c);
                d[q] = c; }
            const bool hi = lane >= 32, b4 = (lane & 16) != 0;
            float k0 = hi ? d[2] : d[0], k1 = hi ? d[3] : d[1]; const float x0 = hi ? d[0] : d[2], x1 = hi ? d[1] : d[3];
            k0 += __shfl_xor(x0, 32); k1 += __shfl_xor(x1, 32);
            float k = b4 ? k1 : k0; const float xs = b4 ? k0 : k1;
            k += __shfl_xor(xs, 16);
            k += __shfl_xor(k, 8); k += __shfl_xor(k, 4); k += __shfl_xor(k, 2); k += __shfl_xor(k, 1);
            const float g = gelu_tanh(k);
            float act[4];
            act[0] = __builtin_bit_cast(float, __builtin_amdgcn_readlane(__builtin_bit_cast(int, g), 0)) * wt[0];
            act[1] = __builtin_bit_cast(float, __builtin_amdgcn_readlane(__builtin_bit_cast(int, g), 16)) * wt[1];
            act[2] = __builtin_bit_cast(float, __builtin_amdgcn_readlane(__builtin_bit_cast(int, g), 32)) * wt[2];
            act[3] = __builtin_bit_cast(float, __builtin_amdgcn_readlane(__builtin_bit_cast(int, g), 48)) * wt[3];
#pragma unroll
            for (int q = 0; q < 4; ++q)
#pragma unroll
                for (int j = 0; j < 4; ++j) { const unsigned dd[4] = {vr[q][j].x, vr[q][j].y, vr[q][j].z, vr[q][j].w};
#pragma unroll
                    for (int c = 0; c < 4; ++c) { y[8 * j + 2 * c] += act[q] * bf_lo(dd[c]); y[8 * j + 2 * c + 1] += act[q] * bf_hi(dd[c]); } }
        }
        float* op = F.out + (size_t)t * DM; const float* ga = F.MOD + (size_t)b * NADA + 5 * DM;
        float ss = 0.f;
#pragma unroll
        for (int j = 0; j < 4; ++j) { const int col = 8 * (lane + 64 * j);
            const f32x4 xa = *(const GAS f32x4*)(op + col), xb = *(const GAS f32x4*)(op + col + 4);
            const f32x4 ga0 = *(const GAS f32x4*)(ga + col), ga1 = *(const GAS f32x4*)(ga + col + 4);
#pragma unroll
            for (int c = 0; c < 4; ++c) { y[8 * j + c] = xa[c] + ga0[c] * y[8 * j + c]; y[8 * j + 4 + c] = xb[c] + ga1[c] * y[8 * j + 4 + c];
                ss += y[8 * j + c] * y[8 * j + c] + y[8 * j + 4 + c] * y[8 * j + 4 + c]; } }
        const float rstd = __builtin_amdgcn_rsqf(wave_sum(ss) * (1.f / DM) + EPS);
#pragma unroll
        for (int j = 0; j < 4; ++j) { const int col = 8 * (lane + 64 * j);
            const f32x4 g0 = *(const GAS f32x4*)(F.g_final + col), g1 = *(const GAS f32x4*)(F.g_final + col + 4);
            f32x4 o0, o1;
#pragma unroll
            for (int c = 0; c < 4; ++c) { o0[c] = y[8 * j + c] * rstd * g0[c]; o1[c] = y[8 * j + 4 + c] * rstd * g1[c]; }
            *(GAS f32x4*)(op + col) = o0; *(GAS f32x4*)(op + col + 4) = o1; }
    }
}

#ifdef DBG_UPTO
__device__ __forceinline__ unsigned dhash(unsigned x) { x ^= x >> 16; x *= 0x7feb352du; x ^= x >> 15; x *= 0x846ca68bu; x ^= x >> 16; return x; }
__device__ __forceinline__ float dbf(const bf16_t* p, size_t i) { return __builtin_bit_cast(float, (unsigned)p[i] << 16); }
__device__ __forceinline__ float dsilu(float v) { return v / (1.f + expf(-v)); }
__device__ __forceinline__ float dgelu(float x) { return 0.5f * x * (1.f + tanhf(0.7978845608028654f * (x + 0.044715f * x * x * x))); }
__global__ void __launch_bounds__(512) dbg_check(Args args, int upto) {
    __shared__ unsigned emax[20];
    __shared__ float sbuf[8][4096 + 128];
    const int tid = threadIdx.x, lane = tid & 63, wave = tid >> 6;
    if (tid < 20) emax[tid] = 0u;
    __syncthreads();
    const float* x = args.in[0]; const float* c = args.in[1]; const float* w_ada = args.in[2]; const float* b_ada = args.in[3]; const float* g_mix = args.in[4];
    const float* w_in = args.in[5]; const float* b_f = args.in[6]; const float* conv_w = args.in[7]; const float* conv_b = args.in[8];
    const float* lru_w_a = args.in[9]; const float* lru_b_a = args.in[10]; const float* lru_w_x = args.in[11]; const float* lru_b_x = args.in[12]; const float* lru_lambda = args.in[13];
    const float* g_attn_out = args.in[14]; const float* g_lru_out = args.in[15]; const float* w_out = args.in[16];
    unsigned char* ws = args.ws; float* out = args.out;
    const float* MOD = (const float*)(ws + WS_MOD); const float* LF = (const float*)(ws + WS_LF); const float* KB = (const float*)(ws + WS_KB); const float* SUMM = (const float*)(ws + WS_SUMM);
    const bf16_t* H = (const bf16_t*)(ws + WS_H); const bf16_t* Q = (const bf16_t*)(ws + WS_Q); const bf16_t* K = (const bf16_t*)(ws + WS_K); const bf16_t* V = (const bf16_t*)(ws + WS_VV);
    const bf16_t* LX = (const bf16_t*)(ws + WS_LX); const bf16_t* GLY = (const bf16_t*)(ws + WS_GLY); const bf16_t* MRG = (const bf16_t*)(ws + WS_MRG);
#define REPORT(k, e) atomicMax(&emax[k], __float_as_uint(fminf(fmaxf((e), 0.f), 1e30f)))
    if (upto >= 1) { const int b = tid & 3, col = dhash(tid * 7 + 1) % NADA; float s = 0.f;
        for (int k = 0; k < DM; ++k) s += dsilu(c[b * DM + k]) * w_ada[(size_t)k * NADA + col];
        s += b_ada[col]; REPORT(1, fabsf(MOD[b * NADA + col] - s) / (2e-3f * (fabsf(s) + 0.05f))); }
    if (upto >= 2 && upto < 7) { const int row = dhash(tid * 13 + 5) % T, col = dhash(tid * 17 + 3) % DM, b = row >> 12; float ss = 0.f;
        for (int k = 0; k < DM; ++k) { const float v = x[(size_t)row * DM + k]; ss += v * v; }
        const float rstd = 1.f / sqrtf(ss / DM + EPS);
        const float h = x[(size_t)row * DM + col] * rstd * g_mix[col] * (1.f + MOD[b * NADA + DM + col]) + MOD[b * NADA + col];
        REPORT(2, fabsf(dbf(H, (size_t)row * DM + col) - h) / (1e-2f * (fabsf(h) + 0.1f)));
        const int j = tid & 7; float z = b_f[j];
        for (int k = 0; k < DM; ++k) z += dbf(H, (size_t)row * DM + k) * w_in[(size_t)k * INC + OFF_F + j];
        const float lf = fminf(z, 0.f) - log1pf(expf(-fabsf(z)));
        REPORT(3, fabsf(LF[(size_t)(b * NH + j) * SEQ + (row & (SEQ - 1))] - lf) / 2e-2f); }
    if (upto >= 3 && upto < 7) { const int row = dhash(tid * 19 + 11) % T, coln = dhash(tid * 23 + 7) % 5120, b = row >> 12, s = row & 4095;
        const int src = coln < 3072 ? coln : coln + 8; float v = 0.f;
        for (int k = 0; k < DM; ++k) v += dbf(H, (size_t)row * DM + k) * w_in[(size_t)k * INC + src];
        const int cat = coln >> 10, cc = coln & 1023; float got;
        if (cat < 3) { const bf16_t* base = cat == 0 ? Q : (cat == 1 ? K : V); got = dbf(base, ((size_t)((b * 8 + (cc >> 7)) * 4096 + s)) * 128 + (cc & 127)); }
        else if (cat == 3) got = dbf(LX, (size_t)row * 1024 + cc);
        else { got = dbf(GLY, (size_t)row * 1024 + cc); v = dgelu(v); }
        REPORT(4 + (cat == 4 ? 1 : 0) + (cat == 3 ? 2 : 0), fabsf(got - v) / (3e-2f * (fabsf(v) + 0.3f)));
        if (tid < 32) { float cum = 0.f, e = 0.f;
            for (int t = 0; t < SEQ; ++t) { cum += LF[(size_t)tid * SEQ + t]; e = fmaxf(e, fabsf(KB[(size_t)tid * SEQ + t] * (-0.08838834764831845f) - cum) / (1e-3f * (fabsf(cum) + 1.f))); }
            REPORT(7, e); } }
    if (upto >= 4) {
        for (int smp = 0; smp < 4; ++smp) { const unsigned hsh = dhash((wave * 4 + smp) * 31 + 17); const int bh = hsh & 31, t = (smp == 0) ? (int)((hsh >> 5) & 255) : (int)((hsh >> 5) & 4095); const int b = bh >> 3, h = bh & 7;
            float* lg = sbuf[wave]; float* qs = lg + 4096;
            qs[lane] = dbf(Q, ((size_t)bh * SEQ + t) * HD + lane); qs[64 + lane] = dbf(Q, ((size_t)bh * SEQ + t) * HD + 64 + lane);
            __builtin_amdgcn_wave_barrier();
            float mx = -1e30f;
            for (int s = lane; s <= t; s += 64) { float d = 0.f; for (int k = 0; k < HD; ++k) d += qs[k] * dbf(K, ((size_t)bh * SEQ + s) * HD + k);
                const float l = d * 0.08838834764831845f + KB[(size_t)bh * SEQ + s] * 0.08838834764831845f; lg[s] = l; mx = fmaxf(mx, l); }
            for (int o = 1; o < 64; o <<= 1) mx = fmaxf(mx, __shfl_xor(mx, o));
            float sm = 0.f;
            for (int s = lane; s <= t; s += 64) { const float p = expf(lg[s] - mx); lg[s] = p; sm += p; }
            for (int o = 1; o < 64; o <<= 1) sm += __shfl_xor(sm, o);
            __builtin_amdgcn_wave_barrier();
            float o0 = 0.f, o1 = 0.f;
            for (int s = 0; s <= t; ++s) { const float p = lg[s]; o0 += p * dbf(V, ((size_t)bh * SEQ + s) * HD + lane); o1 += p * dbf(V, ((size_t)bh * SEQ + s) * HD + 64 + lane); }
            o0 /= sm; o1 /= sm;
            if (upto == 4) {
                const float g0 = dbf(MRG, ((size_t)b * SEQ + t) * DM + h * HD + lane), g1 = dbf(MRG, ((size_t)b * SEQ + t) * DM + h * HD + 64 + lane);
                REPORT(8, fmaxf(fabsf(g0 - o0) / (3e-2f * (fabsf(o0) + 0.3f)), fabsf(g1 - o1) / (3e-2f * (fabsf(o1) + 0.3f)))); }
            __builtin_amdgcn_wave_barrier();
        }
        { const unsigned hsh = dhash(tid * 37 + 29); const int b = hsh & 3, chunk = (hsh >> 2) & 63, ch = (hsh >> 8) & 1023, n = ch >> 7, j = ch & 127;
          const float sp = log1pf(expf(-lru_lambda[ch])) ;
          float P = 1.f, Hh = 0.f;
          for (int tt = 0; tt < 64; ++tt) { const int s = chunk * 64 + tt; float ga = lru_b_a[ch], gx = lru_b_x[ch], xcj = 0.f;
              for (int i = 0; i < 128; ++i) { float xc = conv_b[n * 128 + i];
                  for (int k = 0; k < 4; ++k) { const int ss = s - 3 + k; if (ss >= 0) xc += conv_w[k * LW + n * 128 + i] * dbf(LX, ((size_t)b * SEQ + ss) * LW + n * 128 + i); }
                  ga += xc * lru_w_a[((size_t)n * 128 + i) * 128 + j]; gx += xc * lru_w_x[((size_t)n * 128 + i) * 128 + j]; if (i == j) xcj = xc; }
              const float r = 1.f / (1.f + expf(-ga)), ig = 1.f / (1.f + expf(-gx)); const float la = -8.f * r * sp; const float a = expf(la);
              const float bt = sqrtf(-expm1f(2.f * la)) * (ig * xcj); Hh = a * Hh + bt; P *= a; }
          const float gp = SUMM[(((size_t)(b * 64 + chunk)) * LW + ch) * 2], gh = SUMM[(((size_t)(b * 64 + chunk)) * LW + ch) * 2 + 1];
          REPORT(9, fmaxf(fabsf(gp - P) / (2e-2f * (fabsf(P) + 0.01f)), fabsf(gh - Hh) / (3e-2f * (fabsf(Hh) + 0.05f)))); }
    }
    if (upto >= 5) { const int row = dhash(tid * 41 + 3) % T; float sa = 0.f, sl = 0.f;
        for (int k = 0; k < 1024; ++k) { const float a = dbf(MRG, (size_t)row * DM + k), l = dbf(MRG, (size_t)row * DM + 1024 + k); sa += a * a; sl += l * l; }
        REPORT(10, fmaxf(fabsf(sa / 1024.f - 1.f), fabsf(sl / 1024.f - 1.f)) / 2e-2f);
        if (tid < 64) { const int pr = tid >> 1; const int b = pr & 3, ch = dhash(tid * 43 + 1) & 1023, n = ch >> 7, j = ch & 127, tend = 70 + (pr >> 2) * 8;
            const float sp = log1pf(expf(-lru_lambda[ch])); float hcur = 0.f;
            for (int s = 0; s <= tend; ++s) { float ga = lru_b_a[ch], gx = lru_b_x[ch], xcj = 0.f;
                for (int i = 0; i < 128; ++i) { float xc = conv_b[n * 128 + i];
                    for (int k = 0; k < 4; ++k) { const int ss = s - 3 + k; if (ss >= 0) xc += conv_w[k * LW + n * 128 + i] * dbf(LX, ((size_t)b * SEQ + ss) * LW + n * 128 + i); }
                    ga += xc * lru_w_a[((size_t)n * 128 + i) * 128 + j]; gx += xc * lru_w_x[((size_t)n * 128 + i) * 128 + j]; if (i == j) xcj = xc; }
                const float r = 1.f / (1.f + expf(-ga)), ig = 1.f / (1.f + expf(-gx)); const float la = -8.f * r * sp; const float a = expf(la);
                hcur = a * hcur + sqrtf(-expm1f(2.f * la)) * (ig * xcj); }
            sbuf[0][tid] = hcur * dbf(GLY, ((size_t)b * SEQ + tend) * LW + ch);
            sbuf[1][tid] = dbf(MRG, ((size_t)b * SEQ + tend) * DM + 1024 + ch); }
        __syncthreads();
        if (tid < 64 && (tid & 1) == 0) {
            const float r0 = sbuf[0][tid], r1 = sbuf[0][tid + 1], k0 = sbuf[1][tid], k1 = sbuf[1][tid + 1];
            REPORT(11, fabsf(r0 * k1 - r1 * k0) / (5e-2f * (fabsf(r0 * k1) + fabsf(r1 * k0) + 1e-3f))); }
    }
    if (upto >= 6 && upto < 10) { const int row = dhash(tid * 47 + 9) % T, col = dhash(tid * 53 + 13) % DM, b = row >> 12; float v = 0.f;
        for (int k = 0; k < DM; ++k) v += dbf(MRG, (size_t)row * DM + k) * w_out[(size_t)k * DM + col] * (k < 1024 ? g_attn_out[k] : g_lru_out[k - 1024]);
        const float x1 = x[(size_t)row * DM + col] + MOD[b * NADA + 2 * DM + col] * v;
        REPORT(12, fabsf(out[(size_t)row * DM + col] - x1) / (2e-2f * (fabsf(x1) + 0.2f))); }
    const float* g_ffn = args.in[17]; const float* w_q = args.in[18]; const float* pk1 = args.in[19]; const float* pk2 = args.in[20]; const float* pu = args.in[21]; const float* pv = args.in[22]; const float* g_final = args.in[23];
    const bf16_t* QP = (const bf16_t*)(ws + WS_QP); const int* EIDX = (const int*)(ws + WS_EIDX); const float* EW = (const float*)(ws + WS_EW);
    if (upto >= 7 && upto < 10) { const int row = dhash(tid * 59 + 5) % T, col = dhash(tid * 61 + 3) % DM, b = row >> 12; float ss = 0.f;
        for (int k = 0; k < DM; ++k) { const float v = out[(size_t)row * DM + k]; ss += v * v; }
        const float rstd = 1.f / sqrtf(ss / DM + EPS);
        const float h = out[(size_t)row * DM + col] * rstd * g_ffn[col] * (1.f + MOD[b * NADA + 4 * DM + col]) + MOD[b * NADA + 3 * DM + col];
        REPORT(13, fabsf(dbf(H, (size_t)row * DM + col) - h) / (1e-2f * (fabsf(h) + 0.1f))); }
    if (upto >= 8) { const int row = dhash(tid * 67 + 11) % T, col = dhash(tid * 71 + 7) % DM; float v = 0.f;
        for (int k = 0; k < DM; ++k) v += dbf(H, (size_t)row * DM + k) * w_q[(size_t)k * DM + col];
        REPORT(14, fabsf(dbf(QP, (size_t)row * DM + col) - v) / (3e-2f * (fabsf(v) + 0.3f))); }
    __syncthreads();
    if (upto >= 9 && tid < 64) { float* sc = &sbuf[0][0] + tid * 256; const unsigned hsh = dhash(tid * 73 + 19); const int t = hsh % T, hd = (hsh >> 16) & 7;
        for (int n = 0; n < 128; ++n) { float a = 0.f, bsum = 0.f;
            for (int d = 0; d < 128; ++d) { a += dbf(QP, (size_t)t * DM + hd * 256 + d) * dbf((const bf16_t*)(ws + WS_K1), ((size_t)hd * 128 + n) * 128 + d); bsum += dbf(QP, (size_t)t * DM + hd * 256 + 128 + d) * dbf((const bf16_t*)(ws + WS_K2), ((size_t)hd * 128 + n) * 128 + d); }
            sc[n] = a; sc[128 + n] = bsum; }
        float th1 = 0.f, th2 = 0.f;
        for (int n = 0; n < 128; ++n) { int c1 = 0, c2 = 0; for (int m = 0; m < 128; ++m) { c1 += sc[m] > sc[n]; c2 += sc[128 + m] > sc[128 + n]; } if (c1 == 15) th1 = sc[n]; if (c2 == 15) th2 = sc[128 + n]; }
        float best16 = -1e30f;
        {
          float bound = 1e30f;
          for (int r = 0; r < 16; ++r) { float mx = -1e30f;
              for (int a = 0; a < 128; ++a) if (sc[a] >= th1) for (int bq = 0; bq < 128; ++bq) if (sc[128 + bq] >= th2) { const float v = sc[a] + sc[128 + bq]; if (v < bound && v > mx) mx = v; }
              bound = mx; }
          best16 = bound; }
        float e = 0.f, e2 = 0.f, e3 = 0.f, mxs = -1e30f;
        for (int k = 0; k < 16; ++k) { const int ex = EIDX[(size_t)t * NSEL + hd * 16 + k]; const int i1 = ex >> 7, i2 = ex & 127;
            if (ex < 0 || ex >= NEXP) { e3 = 1e6f; continue; }
            const float v = sc[i1] + sc[128 + i2]; mxs = fmaxf(mxs, v);
            e = fmaxf(e, (best16 - v) / 3e-2f);
            for (int k2 = 0; k2 < k; ++k2) if (EIDX[(size_t)t * NSEL + hd * 16 + k2] == ex) e3 = 1e5f; }
        float sm = 0.f; for (int k = 0; k < 16; ++k) { const int ex = EIDX[(size_t)t * NSEL + hd * 16 + k] & (NEXP - 1); sm += expf(sc[ex >> 7] + sc[128 + (ex & 127)] - mxs); }
        for (int k = 0; k < 16; ++k) { const int ex = EIDX[(size_t)t * NSEL + hd * 16 + k] & (NEXP - 1); const float w = expf(sc[ex >> 7] + sc[128 + (ex & 127)] - mxs) / sm;
            e2 = fmaxf(e2, fabsf(EW[(size_t)t * NSEL + hd * 16 + k] - w) / (3e-2f * (w + 0.02f))); }
        REPORT(15, e); REPORT(17, e2); REPORT(18, e3); }
    __syncthreads();
    if (upto >= 10) {
        for (int smp = 0; smp < 2; ++smp) { const int row = dhash((wave * 2 + smp) * 79 + 23) % T, b = row >> 12;
            float x2[32]; float ss = 0.f;
#pragma unroll 1
            for (int j = 0; j < 32; ++j) { const int col = lane + 64 * j; float v = 0.f;
                for (int k = 0; k < DM; ++k) v += dbf(MRG, (size_t)row * DM + k) * w_out[(size_t)k * DM + col] * (k < 1024 ? g_attn_out[k] : g_lru_out[k - 1024]);
                sbuf[wave][col] = x[(size_t)row * DM + col] + MOD[b * NADA + 2 * DM + col] * v; }
            for (int j = 0; j < 32; ++j) sbuf[wave][2048 + lane + 64 * j] = 0.f;
            for (int e = 0; e < NSEL; ++e) { const int ex = EIDX[(size_t)row * NSEL + e] & (NEXP - 1); const float w = EW[(size_t)row * NSEL + e]; float d = 0.f;
                for (int j = 0; j < 32; ++j) { const int col = lane + 64 * j; d += dbf(H, (size_t)row * DM + col) * pu[(size_t)ex * DM + col]; }
                for (int o = 1; o < 64; o <<= 1) d += __shfl_xor(d, o);
                const float act = dgelu(d) * w;
                for (int j = 0; j < 32; ++j) { const int col = lane + 64 * j; sbuf[wave][2048 + col] += act * pv[(size_t)ex * DM + col]; } }
            for (int j = 0; j < 32; ++j) { const int col = lane + 64 * j; const float v = sbuf[wave][col] + MOD[b * NADA + 5 * DM + col] * sbuf[wave][2048 + col]; sbuf[wave][col] = v; ss += v * v; }
            for (int o = 1; o < 64; o <<= 1) ss += __shfl_xor(ss, o);
            const float rstd = 1.f / sqrtf(ss / DM + EPS); float e = 0.f;
            for (int j = 0; j < 32; ++j) { const int col = lane + 64 * j; const float r = sbuf[wave][col] * rstd * g_final[col]; e = fmaxf(e, fabsf(out[(size_t)row * DM + col] - r) / (3e-2f * (fabsf(r) + 0.3f))); }
            REPORT(16, e); (void)x2; }
    }
    __syncthreads();
    for (size_t i = tid; i < (size_t)T * DM; i += 512) out[i] = 0.f;
    __syncthreads();
    if (tid == 0) { float code = 0.f;
        for (int k = 18; k >= 1; --k) if (k != 16 && __uint_as_float(emax[k]) > 1.f) code = powf(10.f, (float)(k + 1)) * fminf(9.9f, 1.f + log10f(__uint_as_float(emax[k])));
        out[0] = code; }
}
#endif

__global__ void __launch_bounds__(NWAVES * 64, 2) hymba_fwd(Args args) {
    unsigned char* const lds = g_lds;
    Frame F;
    F.lds = (LAS unsigned char*)lds;
    F.MISC = (volatile LAS unsigned*)(F.lds + MISC_OFF);
    { const int t0_ = (int)__builtin_amdgcn_workitem_id_x();
      F.wave = __builtin_amdgcn_readfirstlane(t0_ >> 6); }
    F.tid = ktid(F.wave); F.lane = F.tid & 63;
    for (int u = F.tid; u < (LDS_BYTES - LDSCTL_OFF) / 4; u += NWAVES * 64) ((LAS unsigned*)(F.lds + LDSCTL_OFF))[u] = 0u;
    __syncthreads();
    F.G = gridDim.x; F.bx = blockIdx.x; { const int bx = blockIdx.x; F.vcu = (F.G % 8 == 0) ? (bx % 8) * (F.G / 8) + bx / 8 : bx; }
    unsigned char* ws0 = args.ws;
    F.ctl = (gu32*)(ws0 + WS_CTL);
#define FILL_PTRS(F) do { const __attribute__((address_space(4))) void* kp_ = (const __attribute__((address_space(4))) void*)__builtin_amdgcn_kernarg_segment_ptr(); asm volatile("" : "+s"(kp_)); \
    const float* const __attribute__((address_space(4)))* in_ = (const float* const __attribute__((address_space(4)))*)kp_; \
    unsigned char* ws = (unsigned char*)in_[25]; \
    { int t_ = ktid(F.wave); asm volatile("" : "+v"(t_)); F.tid = t_; F.lane = t_ & 63; } \
    F.x = in_[0]; F.c = in_[1]; F.w_ada = in_[2]; F.b_ada = in_[3]; F.g_mix = in_[4]; F.w_in = in_[5]; F.b_f = in_[6]; \
    F.conv_w = in_[7]; F.conv_b = in_[8]; F.lru_w_a = in_[9]; F.lru_b_a = in_[10]; F.lru_w_x = in_[11]; F.lru_b_x = in_[12]; \
    F.lru_lambda = in_[13]; F.g_attn_out = in_[14]; F.g_lru_out = in_[15]; F.w_out = in_[16]; F.g_ffn = in_[17]; \
    F.peer_w_q = in_[18]; F.peer_k1 = in_[19]; F.peer_k2 = in_[20]; F.peer_u = in_[21]; F.peer_v = in_[22]; F.g_final = in_[23]; \
    F.out = (float*)in_[24]; \
    F.MOD = (float*)(ws + WS_MOD); F.LF = (float*)(ws + WS_LF); F.KB = (float*)(ws + WS_KB); F.SUMM = (float*)(ws + WS_SUMM); \
    F.EW = (float*)(ws + WS_EW); F.EIDX = (int*)(ws + WS_EIDX); \
    F.WLRU = (bf16_t*)(ws + WS_WLRU); F.K1 = (bf16_t*)(ws + WS_K1); F.K2 = (bf16_t*)(ws + WS_K2); F.WIN = (bf16_t*)(ws + WS_WIN); \
    F.WOUT = (bf16_t*)(ws + WS_WOUT); F.WQ = (bf16_t*)(ws + WS_WQ); F.U = (bf16_t*)(ws + WS_U); F.V = (bf16_t*)(ws + WS_V); \
    F.H = (bf16_t*)(ws + WS_H); F.Q = (bf16_t*)(ws + WS_Q); F.K = (bf16_t*)(ws + WS_K); F.VV = (bf16_t*)(ws + WS_VV); F.QP = (bf16_t*)(ws + WS_QP); \
    F.LX = (bf16_t*)(ws + WS_LX); F.GLY = (bf16_t*)(ws + WS_GLY); F.MRG = (bf16_t*)(ws + WS_MRG); } while (0)
    XcdBarrier bar; bar.bar = (unsigned*)(F.ctl + CW_BAR); bar.x = 0; bar.st = nullptr;
    if (N_LAUNCHES == 1) bar = xcd_barrier_post((unsigned*)(F.ctl + CW_BAR), F.MISC + 8, F.wave);
#define GRID_BAR() do { if (N_LAUNCHES == 1) xcd_barrier(bar, F.wave); } while (0)
    const int lo = args.ph_lo, hi = args.ph_hi;
#ifndef PHASE_MASK
#define PHASE_MASK 0x3ff
#endif
#define IN(k) (((PHASE_MASK >> (k)) & 1) && lo <= (k) && (k) < hi)
#define BOTH(k) (IN(k) && IN((k) + 1))

    if (IN(0)) { FILL_PTRS(F); p0_prologue(F); if (BOTH(0)) GRID_BAR(); }
    if (IN(1)) { FILL_PTRS(F); p_modnorm<true>(F, F.x, F.g_mix, 0, DM); if (BOTH(1)) GRID_BAR(); }
    if (IN(2)) {
        FILL_PTRS(F); p2_cumsum(F); __syncthreads();
        pg8::Gemm g{F.H, F.WIN, T, 5120, DM}; pg8::StaticOrder S; S.init(T, 5120, F.G, (int)blockIdx.x);
        pg8::EpiProj E{F.Q};
        pg8::gemm_phase<pg8::EpiProj, pg8::StaticOrder, true, true>(F.lds + RING_OFF, g, S, E, F.wave);
        if (BOTH(2)) GRID_BAR();
    }
    if (IN(3)) {
        FILL_PTRS(F);
#ifndef NO_ATT
        p3_attention(F, (char*)lds + RING_OFF);
#endif
#ifndef NO_LRUA
        for (int u = F.vcu; u < BATCH * 64; u += F.G) lru_unit<false>(F, u >> 6, u & 63);
#endif
        if (BOTH(3)) GRID_BAR();
    }
    if (IN(4)) {
        FILL_PTRS(F);
        for (int u = F.vcu; u < BATCH * 64; u += F.G) lru_unit<true>(F, u >> 6, u & 63);
        if (BOTH(4)) GRID_BAR();
    }
    if (IN(5)) {
        FILL_PTRS(F);
        pg8::Gemm g{F.MRG, F.WOUT, T, DM, DM}; pg8::StaticOrder S; S.init(T, DM, F.G, (int)blockIdx.x);
        pg8::EpiRes E{F.x, F.out, DM, F.MOD + 2 * DM, NADA};
        pg8::gemm_phase<pg8::EpiRes, pg8::StaticOrder, true, true>(F.lds + RING_OFF, g, S, E, F.wave);
        if (BOTH(5)) GRID_BAR();
    }
    if (IN(6)) { FILL_PTRS(F); p_modnorm<false>(F, F.out, F.g_ffn, 3 * DM, 4 * DM); if (BOTH(6)) GRID_BAR(); }
    if (IN(7)) {
        FILL_PTRS(F);
        pg8::Gemm g{F.H, F.WQ, T, DM, DM}; pg8::StaticOrder S; S.init(T, DM, F.G, (int)blockIdx.x);
        pg8::EpiPlain E{F.QP, DM};
        pg8::gemm_phase<pg8::EpiPlain, pg8::StaticOrder, true, true>(F.lds + RING_OFF, g, S, E, F.wave);
        if (BOTH(7)) GRID_BAR();
    }
    #ifdef P8_NAIVE
    if (IN(8)) { FILL_PTRS(F); p8_naive(F); }
#else
    if (IN(8)) { FILL_PTRS(F); p8_topk(F); if (BOTH(8)) GRID_BAR(); }
#endif
    if (IN(9)) { FILL_PTRS(F); p9_peer(F); }
#undef IN
#undef BOTH
#undef GRID_BAR
}

extern "C" void kernel_launch(void* const* d_in, const int* in_sizes, int n_in, void* d_out, int out_size, void* d_ws, size_t ws_size, hipStream_t stream) {
    static int grid = 0;
    if (grid == 0) {
        if (n_in != 24 || in_sizes[0] != T * DM || out_size != T * DM || ws_size < WS_END) {
            fprintf(stderr, "kernel_launch: built for 24 inputs, x/out of %d floats, >= %zu bytes of workspace; got n_in %d, in0 %d, out %d, ws %zu; nothing launched\n", T * DM, (size_t)WS_END, n_in, n_in > 0 ? in_sizes[0] : -1, out_size, ws_size); grid = -1; return; }
        int dev = 0, cus = 0, per_cu = 0;
        if (hipGetDevice(&dev) != hipSuccess || hipDeviceGetAttribute(&cus, hipDeviceAttributeMultiprocessorCount, dev) != hipSuccess) { fprintf(stderr, "kernel_launch: device query failed\n"); grid = -1; return; }
        if (hipFuncSetAttribute((const void*)hymba_fwd, hipFuncAttributeMaxDynamicSharedMemorySize, LDS_BYTES) != hipSuccess) { fprintf(stderr, "kernel_launch: hipFuncSetAttribute failed\n"); grid = -1; return; }
        if (hipOccupancyMaxActiveBlocksPerMultiprocessor(&per_cu, (const void*)hymba_fwd, NWAVES * 64, LDS_BYTES) != hipSuccess || per_cu < 1)
            fprintf(stderr, "kernel_launch: note: occupancy query reports %d workgroups per CU\n", per_cu);
        (void)hipGetLastError();
        grid = cus;
    }
    if (grid < 0) return;
    if (hipMemsetAsync((char*)d_ws + WS_CTL, 0, CTL_ZERO_BYTES, stream) != hipSuccess) { fprintf(stderr, "kernel_launch: hipMemsetAsync failed\n"); return; }
    Args a{};
    for (int i = 0; i < 24; ++i) a.in[i] = (const float*)d_in[i];
    a.out = (float*)d_out; a.ws = (unsigned char*)d_ws;
#ifdef DBG_UPTO
    static_assert(N_LAUNCHES == N_PHASES, "probe builds launch one kernel per phase");
    for (int li = 0; li < DBG_UPTO; ++li) {
#else
    for (int li = 0; li < N_LAUNCHES; ++li) {
#endif
        a.ph_lo = (N_LAUNCHES == 1) ? 0 : li; a.ph_hi = (N_LAUNCHES == 1) ? N_PHASES : li + 1; a.li = li;
        hipLaunchKernelGGL(hymba_fwd, dim3(grid), dim3(NWAVES * 64), LDS_BYTES, stream, a);
        const hipError_t le = hipPeekAtLastError();
        if (le != hipSuccess) { fprintf(stderr, "kernel_launch: launch %d failed: %s\n", li, hipGetErrorName(le)); break; }
    }
#ifdef DBG_UPTO
    hipLaunchKernelGGL(dbg_check, dim3(1), dim3(512), 0, stream, a, (int)DBG_UPTO);
#endif
}
```

```cpp
#include <hip/hip_runtime.h>
#include <hip/hip_bf16.h>
#include <cstdio>
#include <cstdint>

constexpr int BATCH = 4, SEQ = 4096, DM = 2048, T = BATCH * SEQ;
constexpr int AW = 1024, NH = 8, HD = 128, LW = 1024, NLB = 8, LBD = 128;
constexpr int INC = 5128, OFF_F = 3072, OFF_LX = 3080;
constexpr int PH = 8, PNK = 128, PQD = 256, PTOPK = 16, NEXP = 16384, NSEL = PH * PTOPK;
constexpr int NADA = 6 * DM;
constexpr float EPS = 1e-6f;
constexpr int NWAVES = 8, NTHR = 512;

#ifndef MK_N_LAUNCHES
#define MK_N_LAUNCHES 1
#endif
constexpr int N_PHASES = 10;
constexpr int N_LAUNCHES = MK_N_LAUNCHES;

constexpr size_t MiB = 1u << 20;
constexpr size_t WS_CTL = 0, CTL_ZERO_BYTES = 1 * MiB;
constexpr size_t WS_MOD = 1 * MiB;
constexpr size_t WS_LF = WS_MOD + 256 * 1024;
constexpr size_t WS_KB = WS_LF + 512 * 1024;
constexpr size_t WS_SUMM = WS_KB + 512 * 1024;
constexpr size_t WS_WLRU = 5 * MiB;
constexpr size_t WS_K1 = WS_WLRU + 512 * 1024;
constexpr size_t WS_K2 = WS_K1 + 256 * 1024;
constexpr size_t WS_WIN = 6 * MiB;
constexpr size_t WS_WOUT = 26 * MiB;
constexpr size_t WS_WQ = 34 * MiB;
constexpr size_t WS_U = 42 * MiB, WS_V = 106 * MiB;
constexpr size_t WS_USC = WS_SUMM + 2 * MiB, WS_VSC = WS_USC + 64 * 1024;
constexpr size_t WS_H = 170 * MiB;
constexpr size_t WS_Q = 234 * MiB, WS_K = 266 * MiB, WS_VV = 298 * MiB;
constexpr size_t WS_QP = 234 * MiB;
constexpr size_t WS_EIDX = 298 * MiB, WS_EW = 306 * MiB;
constexpr size_t WS_LX = 330 * MiB, WS_GLY = 362 * MiB;
constexpr size_t WS_MRG = 394 * MiB;
constexpr size_t WS_END = 458 * MiB;
static_assert(WS_K == WS_Q + 32 * MiB && WS_VV == WS_Q + 64 * MiB && WS_LX == WS_Q + 96 * MiB && WS_GLY == WS_Q + 128 * MiB, "EpiProj: destinations 32 MiB apart");
constexpr int CW_BAR = 4096;

constexpr int RING_OFF = 0, RING_BYTES = 131072;
constexpr int LDSCTL_OFF = RING_BYTES, MISC_OFF = LDSCTL_OFF + 320;
constexpr int LDS_BYTES = 147456;
static_assert(MISC_OFF + 128 <= LDS_BYTES, "LDS map");

#define GAS __attribute__((address_space(1)))
#define LAS __attribute__((address_space(3)))
typedef unsigned short bf16_t;
typedef unsigned v4u __attribute__((ext_vector_type(4)));
typedef unsigned v2u __attribute__((ext_vector_type(2)));
typedef float f32x4 __attribute__((ext_vector_type(4)));
typedef float f32x2 __attribute__((ext_vector_type(2)));
typedef short bf16x8 __attribute__((ext_vector_type(8)));
typedef __bf16 bf16x2_t __attribute__((ext_vector_type(2)));
typedef GAS unsigned gu32;
#define RLX_AGENT __ATOMIC_RELAXED, __HIP_MEMORY_SCOPE_AGENT
#define LDS_WAIT() asm volatile("s_waitcnt lgkmcnt(0)" ::: "memory")
#define VM_WAIT() asm volatile("s_waitcnt vmcnt(0)" ::: "memory")

extern __shared__ __attribute__((aligned(16))) unsigned char g_lds[];
__device__ __forceinline__ int ktid(int kw) { int l; asm volatile("v_mbcnt_lo_u32_b32 %0, -1, 0\n\tv_mbcnt_hi_u32_b32 %0, -1, %0" : "=v"(l)); return kw * 64 + l; }
__device__ __forceinline__ unsigned fbits(float x) { return __builtin_bit_cast(unsigned, x); }
__device__ __forceinline__ float bitsf(unsigned x) { return __builtin_bit_cast(float, x); }
__device__ __forceinline__ bf16x2_t asbf2(unsigned x) { return __builtin_bit_cast(bf16x2_t, x); }
__device__ __forceinline__ unsigned f2bf(float f) { unsigned u = __builtin_bit_cast(unsigned, f); return (u + 0x7fffu + ((u >> 16) & 1u)) >> 16; }
__device__ __forceinline__ unsigned pk2(float lo, float hi) { f32x2 v = {lo, hi}; bf16x2_t b = __builtin_convertvector(v, bf16x2_t); return __builtin_bit_cast(unsigned, b); }
__device__ __forceinline__ float bf_lo(unsigned d) { return __builtin_bit_cast(float, d << 16); }
__device__ __forceinline__ float bf_hi(unsigned d) { return __builtin_bit_cast(float, d & 0xffff0000u); }
__device__ __forceinline__ float fexp(float x) { return __builtin_amdgcn_exp2f(x * 1.4426950408889634f); }
__device__ __forceinline__ float sigmoidf_(float z) { return __builtin_amdgcn_rcpf(1.f + fexp(-z)); }
__device__ __forceinline__ float gelu_tanh(float x) { const float z = x * (1.5957691216057308f + 0.07135481627260025f * x * x); return x * __builtin_amdgcn_rcpf(1.f + fexp(-z)); }
__device__ __forceinline__ float softplusf_(float z) { return fmaxf(z, 0.f) + log1pf(fexp(-fabsf(z))); }
__device__ __forceinline__ float wave_sum(float v) {
#pragma unroll
    for (int o = 1; o < 64; o <<= 1) v += __shfl_xor(v, o);
    return v;
}
#define XB_TMO      128
#define XB_XCNT(j)  (256  + 64 * (j))
#define XB_XSUB(j)  (1280 + 64 * (j))
#define XB_XGEN(j)  (2304 + 64 * (j))
#define XB_TOP      3328
#define XB_TOPGEN   3392
#define XCD_BAR_WORDS 3456
#define XB_SPIN_CAP (1u << 18)

__device__ __forceinline__ unsigned xb_ld(unsigned* p)              { return __hip_atomic_load(p, __ATOMIC_RELAXED, __HIP_MEMORY_SCOPE_AGENT); }
__device__ __forceinline__ unsigned xb_add(unsigned* p, unsigned v) { return __hip_atomic_fetch_add(p, v, __ATOMIC_RELAXED, __HIP_MEMORY_SCOPE_AGENT); }
__device__ __forceinline__ unsigned xb_xcc_id() { return (unsigned)__builtin_amdgcn_s_getreg((3 << 11) | 20) & 0xFu; }
#define XB_SPIN(cond, bar) do { unsigned _sp = 0; while (cond) { __builtin_amdgcn_s_sleep(1); \
    if ((++_sp & 255u) == 0u) { if (xb_ld(&(bar)[XB_TMO])) break; if (_sp > XB_SPIN_CAP) { atomicAdd(&(bar)[XB_TMO], 1u); break; } } } } while (0)

struct XcdBarrier {
    unsigned* bar; unsigned x;
    volatile LAS unsigned* st;
};

__device__ __forceinline__ XcdBarrier xcd_barrier_post(unsigned* bar, volatile LAS unsigned* st, int kw) {
    XcdBarrier b; b.bar = bar; b.x = xb_xcc_id(); b.st = st;
    if (ktid(kw) == 0) (void)xb_add(&bar[XB_XCNT(b.x)], 1u);
    return b;
}
__device__ __forceinline__ void xcd_barrier_complete(unsigned* bar, unsigned x, unsigned& nloc, unsigned& nx) {
    const unsigned G = gridDim.x * gridDim.y * gridDim.z;
    unsigned sum, cnt, mine, sp = 0u;
    for (;;) {
        sum = 0u; cnt = 0u; mine = 0u;
#pragma unroll
        for (unsigned j = 0; j < 16; ++j) { const unsigned c = xb_ld(&bar[XB_XCNT(j)]); sum += c; cnt += (c > 0u) ? 1u : 0u; mine = (j == x) ? c : mine; }
        if (sum == G) break;
        __builtin_amdgcn_s_sleep(1);
        if ((++sp & 255u) == 0u) { if (xb_ld(&bar[XB_TMO])) break; if (sp > XB_SPIN_CAP) { atomicAdd(&bar[XB_TMO], 1u); break; } }
    }
    nloc = mine > 0u ? mine : 1u; nx = cnt > 0u ? cnt : 1u;
}

__device__ __forceinline__ void xcd_barrier(const XcdBarrier& b, int kw) {
    asm volatile("s_waitcnt vmcnt(0)" ::: "memory");
    __syncthreads();
    if (ktid(kw) == 0) {
        unsigned* bar = b.bar;
        __builtin_amdgcn_s_waitcnt(0);
        unsigned nloc = b.st[0], nx = b.st[1];
        if (nloc == 0u) { xcd_barrier_complete(bar, b.x, nloc, nx); b.st[0] = nloc; b.st[1] = nx; }
        const unsigned old = xb_add(&bar[XB_XSUB(b.x)], 1u);
        const unsigned gen = old / nloc;
        if (old + 1u == (gen + 1u) * nloc) {
            __builtin_amdgcn_fence(__ATOMIC_RELEASE, "agent");
            asm volatile("s_waitcnt vmcnt(0)" ::: "memory");
            const unsigned og = xb_add(&bar[XB_TOP], 1u);
            const unsigned tg = og / nx;
            if (og + 1u == (tg + 1u) * nx) xb_add(&bar[XB_TOPGEN], 1u);
            else XB_SPIN(xb_ld(&bar[XB_TOPGEN]) == tg, bar);
            __builtin_amdgcn_fence(__ATOMIC_ACQUIRE, "agent");
            xb_add(&bar[XB_XGEN(b.x)], 1u);
            asm volatile("s_waitcnt vmcnt(0)" ::: "memory");
        } else {
            XB_SPIN(xb_ld(&bar[XB_XGEN(b.x)]) == gen, bar);
            __builtin_amdgcn_fence(__ATOMIC_ACQUIRE, "agent");
            asm volatile("s_waitcnt vmcnt(0)" ::: "memory");
        }
    }
    __syncthreads();
}

namespace pg8 {
#define PG8_LAS __attribute__((address_space(3)))
typedef unsigned short bf16_t;
typedef short bf16x8 __attribute__((ext_vector_type(8)));
typedef float f32x4 __attribute__((ext_vector_type(4)));
typedef unsigned u32x4 __attribute__((ext_vector_type(4)));
constexpr int BM = 256, BK = 64, HALF = 128, HTB = HALF * BK * 2  , STAGE_BYTES = 8 * HTB, NXCD = 8, WGM = 8;

__host__ __device__ __forceinline__ int lds_byte(int r, int c) { const int st = (r >> 4) * 2 + (c >> 5), rr = r & 15, cc = c & 31, ob = rr * 64 + cc * 2; return st * 1024 + (ob ^ (((ob >> 9) & 1) << 5)); }
__host__ __device__ __forceinline__ void stage_rc(int b, int& R, int& C) { const int st = b / 1024, sb = b % 1024, swz = sb ^ (((sb >> 9) & 1) << 5); R = (st >> 1) * 16 + swz / 64; C = (st & 1) * 32 + (swz % 64) / 2; }
__host__ __device__ __forceinline__ int perm32(int rho) { const int n = rho >> 4, i = rho & 15; return 8 * (i >> 2) + 4 * n + (i & 3); }

struct Unit { int pm, pn; };
struct Gemm { const bf16_t* A; const bf16_t* Bt; int M, N, K; };

struct StaticOrder {
    int nM, nN, nwg, G, c;
    __host__ __device__ void init(int M, int N, int G_, int c_) { nM = M / BM; nN = N / BM; nwg = nM * nN; G = G_; c = c_; }
    __host__ __device__ bool next(int i, Unit& u) const {
        const long L = (long)i * G + c; if (L >= nwg) return false;
        int wgid = (int)L; { const int q = nwg / NXCD, r = nwg % NXCD, xcd = wgid % NXCD, off = wgid / NXCD; wgid = (xcd < r ? xcd * (q + 1) : r * (q + 1) + (xcd - r) * q) + off; }
        const int nig = WGM * nN, gid = wgid / nig, fm = gid * WGM, gsz = (nM - fm) < WGM ? (nM - fm) : WGM;
        u.pm = fm + ((wgid % nig) % gsz); u.pn = (wgid % nig) / gsz; return true;
    }
    __device__ __forceinline__ void a_ready(const Unit&) const {}
    __device__ __forceinline__ void done(const Unit&) const {}
};


__device__ __forceinline__ unsigned cvt_pk_bf16(float lo, float hi) { unsigned r; asm volatile("v_cvt_pk_bf16_f32 %0, %1, %2" : "=v"(r) : "v"(lo), "v"(hi)); return r; }

struct EpiPlain {
    static constexpr bool PERM = true, AFTER_DRAIN = false;
    bf16_t* O; int ldc;
    __device__ __forceinline__ void operator()(const f32x4 (&acc)[2][2][4][2], const Unit& u, int wr, int wc, int fr, int fq) const {
        const int row0 = u.pm * BM + wr * 64 + fr, col0 = u.pn * BM + wc * 32 + 8 * fq;
#pragma unroll
        for (int ai = 0; ai < 2; ++ai)
#pragma unroll
            for (int m = 0; m < 4; ++m) { bf16_t* rowp = O + (size_t)(row0 + ai * HALF + m * 16) * ldc + col0;
#pragma unroll
                for (int bj = 0; bj < 2; ++bj) { const f32x4 v0 = acc[ai][bj][m][0], v1 = acc[ai][bj][m][1];
                    u32x4 w; w.x = cvt_pk_bf16(v0[0], v0[1]); w.y = cvt_pk_bf16(v0[2], v0[3]); w.z = cvt_pk_bf16(v1[0], v1[1]); w.w = cvt_pk_bf16(v1[2], v1[3]);
                    *(u32x4*)(rowp + bj * HALF) = w; } }
    }
};
struct EpiProj {
    static constexpr bool PERM = true, AFTER_DRAIN = false;
    bf16_t* Q;
    __device__ __forceinline__ void operator()(const f32x4 (&acc)[2][2][4][2], const Unit& u, int wr, int wc, int fr, int fq) const {
        const int row0 = u.pm * BM + wr * 64 + fr; const int cat = u.pn >> 2, pnl = u.pn & 3;
        bf16_t* basep = Q + (size_t)cat * ((size_t)16 << 20);
        const bool headmajor = cat < 3, dogelu = cat == 4;
#pragma unroll
        for (int ai = 0; ai < 2; ++ai)
#pragma unroll
            for (int m = 0; m < 4; ++m) { const int row = row0 + ai * HALF + m * 16; const int b = row >> 12, s = row & 4095;
#pragma unroll
                for (int bj = 0; bj < 2; ++bj) { f32x4 v0 = acc[ai][bj][m][0], v1 = acc[ai][bj][m][1];
                    const int colt = pnl * BM + bj * HALF + wc * 32 + 8 * fq;
                    const int head = colt >> 7, d = colt & 127;
                    const size_t offA = ((size_t)((b * 8 + head) * 4096 + s)) * 128 + d, offB = (size_t)row * 1024 + colt;
                    bf16_t* dst = basep + (headmajor ? offA : offB);
                    if (dogelu) {
#pragma unroll
                        for (int e = 0; e < 4; ++e) { v0[e] = gelu_tanh(v0[e]); v1[e] = gelu_tanh(v1[e]); } }
                    u32x4 w; w.x = cvt_pk_bf16(v0[0], v0[1]); w.y = cvt_pk_bf16(v0[2], v0[3]); w.z = cvt_pk_bf16(v1[0], v1[1]); w.w = cvt_pk_bf16(v1[2], v1[3]);
                    *(u32x4*)dst = w; } }
    }
};
struct EpiRes {
    static constexpr bool PERM = false, AFTER_DRAIN = false;
    const float* base; float* out; int ldc; const float* gate; int gstride;
    __device__ __forceinline__ void operator()(const f32x4 (&acc)[2][2][4][2], const Unit& u, int wr, int wc, int fr, int fq) const {
        const int row0 = u.pm * BM + wr * 64 + fr, col0 = u.pn * BM + wc * 32 + 4 * fq;
        const int b = (u.pm * BM) >> 12;
        f32x4 gv[2][2];
#pragma unroll
        for (int bj = 0; bj < 2; ++bj)
#pragma unroll
            for (int n = 0; n < 2; ++n) gv[bj][n] = *(const f32x4*)(gate + (size_t)b * gstride + col0 + bj * HALF + n * 16);
#pragma unroll
        for (int ai = 0; ai < 2; ++ai)
#pragma unroll
            for (int m = 0; m < 4; ++m) { const size_t off = (size_t)(row0 + ai * HALF + m * 16) * ldc + col0;
#pragma unroll
                for (int bj = 0; bj < 2; ++bj)
#pragma unroll
                    for (int n = 0; n < 2; ++n) { const f32x4 bs = *(const f32x4*)(base + off + bj * HALF + n * 16);
                        *(f32x4*)(out + off + bj * HALF + n * 16) = bs + gv[bj][n] * acc[ai][bj][m][n]; } }
    }
};

template <class Epi, class Sched, bool ALIGN_EPI = false, bool SP2 = false>
__device__ __forceinline__ void gemm_phase(PG8_LAS unsigned char* lds, const Gemm g, const Sched& S, const Epi& E, const int kw) {
    const int tid = ktid(kw), wid = kw, lane = tid & 63, wr = wid >> 2, wc = wid & 3, fr = lane & 15, fq = lane >> 4;
    const int K = g.K, nt = K / BK;
    unsigned voffA[2], voffB[2];
#pragma unroll
    for (int i = 0; i < 2; ++i) { int R, C; stage_rc(tid * 16 + i * 8192, R, C); const int Rb = Epi::PERM ? ((R & ~31) + perm32(R & 31)) : R;
        voffA[i] = (unsigned)(R * K + C) * 2u; voffB[i] = (unsigned)(Rb * K + C) * 2u; }
    const size_t kstep = (size_t)(BK * 2);
    const size_t hstep = (size_t)HALF * K * 2;
    const size_t tstep = 2 * hstep;
    const unsigned ldsw = (unsigned)wid * 1024u;
    const int aoff = lds_byte(wr * 64 + fr, fq * 8), boff = lds_byte(wc * 32 + fr, fq * 8);
#define PG8_SA(b, h) (((b) * 2 + (h)) * HTB)
#define PG8_SB(b, h) ((4 + (b) * 2 + (h)) * HTB)
#define PG8_STAGE(bufoff, gbase, voff) do { _Pragma("unroll") for (int _i = 0; _i < 2; ++_i) \
        __builtin_amdgcn_global_load_lds((const unsigned*)((const char*)(gbase) + (voff)[_i]), (PG8_LAS unsigned*)(lds + (bufoff) + ldsw + _i * 8192), 16, 0, 0); } while (0)
#define PG8_LDA(dst, b, h) do { _Pragma("unroll") for (int m = 0; m < 4; ++m) _Pragma("unroll") for (int k = 0; k < 2; ++k) dst[m][k] = *(const PG8_LAS bf16x8*)(lds + PG8_SA(b, h) + aoff + m * 2048 + k * 1024); } while (0)
#define PG8_LDB(dst, b, h) do { _Pragma("unroll") for (int n = 0; n < 2; ++n) _Pragma("unroll") for (int k = 0; k < 2; ++k) dst[n][k] = *(const PG8_LAS bf16x8*)(lds + PG8_SB(b, h) + boff + n * 2048 + k * 1024); } while (0)
#define PG8_MMA(ai, bj, At, Bt) do { __builtin_amdgcn_s_setprio(1); _Pragma("unroll") for (int m = 0; m < 4; ++m) _Pragma("unroll") for (int n = 0; n < 2; ++n) _Pragma("unroll") for (int k = 0; k < 2; ++k) \
        acc[ai][bj][m][n] = __builtin_amdgcn_mfma_f32_16x16x32_bf16(Bt[n][k], At[m][k], acc[ai][bj][m][n], 0, 0, 0); __builtin_amdgcn_s_setprio(0); } while (0)
#define PG8_WAIT_V(n) asm volatile("s_waitcnt vmcnt(" #n ")" ::: "memory")
#define PG8_WAIT_L(n) asm volatile("s_waitcnt lgkmcnt(" #n ")" ::: "memory")
#define PG8_BAR __builtin_amdgcn_s_barrier()
#define PG8_SCHED __builtin_amdgcn_sched_barrier(0)
    Unit cur, nxt; int ui = 0;
    if (!S.next(0, cur)) return;
    f32x4 acc[2][2][4][2];
#pragma unroll
    for (int a = 0; a < 2; ++a)
#pragma unroll
        for (int b = 0; b < 2; ++b)
#pragma unroll
            for (int m = 0; m < 4; ++m)
#pragma unroll
                for (int n = 0; n < 2; ++n) acc[a][b][m][n] = (f32x4){0.f, 0.f, 0.f, 0.f};
    bf16x8 At[4][2], B0[2][2], B1[2][2];
    const char* cA = (const char*)g.A + (size_t)cur.pm * tstep; const char* cB = (const char*)g.Bt + (size_t)cur.pn * tstep;
    S.a_ready(cur);
    if constexpr (SP2) {
        PG8_STAGE(PG8_SB(0, 0), cB, voffB); PG8_STAGE(PG8_SB(0, 1), cB + hstep, voffB); PG8_STAGE(PG8_SA(0, 0), cA, voffA); PG8_STAGE(PG8_SA(0, 1), cA + hstep, voffA);
        if (wr == 1) PG8_BAR;
        PG8_WAIT_V(2); PG8_BAR;
        PG8_STAGE(PG8_SB(1, 0), cB + kstep, voffB); PG8_STAGE(PG8_SA(1, 0), cA + kstep, voffA); PG8_STAGE(PG8_SB(1, 1), cB + hstep + kstep, voffB);
        PG8_WAIT_V(6); PG8_BAR;
    } else {
        PG8_STAGE(PG8_SB(0, 0), cB, voffB); PG8_STAGE(PG8_SA(0, 0), cA, voffA); PG8_STAGE(PG8_SB(0, 1), cB + hstep, voffB); PG8_STAGE(PG8_SA(0, 1), cA + hstep, voffA);
        if (wr == 1) PG8_BAR;
        PG8_WAIT_V(4); PG8_BAR;
        PG8_STAGE(PG8_SB(1, 0), cB + kstep, voffB); PG8_STAGE(PG8_SA(1, 0), cA + kstep, voffA); PG8_STAGE(PG8_SB(1, 1), cB + hstep + kstep, voffB);
        PG8_WAIT_V(6); PG8_BAR;
    }
    for (;;) {
        const bool has_next = S.next(ui + 1, nxt);
        const char* nA = has_next ? (const char*)g.A + (size_t)nxt.pm * tstep : cA; const char* nB = has_next ? (const char*)g.Bt + (size_t)nxt.pn * tstep : cB;
        for (int t = 0; t < nt; t += 2) {
            const bool last = (t == nt - 2);
            const char* a1 = cA + (size_t)(t + 1) * kstep;
            const char* a2 = last ? nA : cA + (size_t)(t + 2) * kstep; const char* b2 = last ? nB : cB + (size_t)(t + 2) * kstep;
            const char* a3 = a2 + kstep; const char* b3 = b2 + kstep;
            if (last && has_next) S.a_ready(nxt);
            if constexpr (SP2) {
            PG8_LDB(B0, 0, 0); PG8_LDB(B1, 0, 1); PG8_SCHED; PG8_LDA(At, 0, 0); PG8_STAGE(PG8_SA(1, 1), a1 + hstep, voffA);
            PG8_WAIT_V(8); PG8_WAIT_L(0); PG8_BAR; PG8_MMA(0, 0, At, B0); PG8_MMA(0, 1, At, B1); PG8_BAR; PG8_SCHED;
            PG8_LDA(At, 0, 1); PG8_STAGE(PG8_SB(0, 0), b2, voffB); PG8_STAGE(PG8_SB(0, 1), b2 + hstep, voffB); PG8_STAGE(PG8_SA(0, 0), a2, voffA);
            PG8_WAIT_V(8); PG8_WAIT_L(0); PG8_BAR; PG8_MMA(1, 0, At, B0); PG8_MMA(1, 1, At, B1); PG8_BAR; PG8_SCHED;
            PG8_LDB(B0, 1, 0); PG8_LDB(B1, 1, 1); PG8_SCHED; PG8_LDA(At, 1, 0); PG8_STAGE(PG8_SA(0, 1), a2 + hstep, voffA);
            PG8_WAIT_V(8); PG8_WAIT_L(0); PG8_BAR; PG8_MMA(0, 0, At, B0); PG8_MMA(0, 1, At, B1); PG8_BAR; PG8_SCHED;
            PG8_LDA(At, 1, 1); PG8_STAGE(PG8_SB(1, 0), b3, voffB); PG8_STAGE(PG8_SB(1, 1), b3 + hstep, voffB); PG8_STAGE(PG8_SA(1, 0), a3, voffA);
            PG8_WAIT_V(8); PG8_WAIT_L(0); PG8_BAR; PG8_MMA(1, 0, At, B0); PG8_MMA(1, 1, At, B1); PG8_BAR; PG8_SCHED;
            } else {
            PG8_LDB(B0, 0, 0); PG8_SCHED; PG8_LDA(At, 0, 0); PG8_STAGE(PG8_SA(1, 1), a1 + hstep, voffA);
            PG8_WAIT_L(8); PG8_BAR; PG8_WAIT_L(0); PG8_MMA(0, 0, At, B0); PG8_BAR; PG8_SCHED;
            PG8_LDB(B1, 0, 1); PG8_STAGE(PG8_SB(0, 0), b2, voffB);
            PG8_BAR; PG8_WAIT_L(0); PG8_MMA(0, 1, At, B1); PG8_BAR;
            PG8_LDA(At, 0, 1); PG8_STAGE(PG8_SA(0, 0), a2, voffA);
            PG8_BAR; PG8_WAIT_L(0); PG8_MMA(1, 0, At, B0); PG8_BAR; PG8_SCHED;
            PG8_STAGE(PG8_SB(0, 1), b2 + hstep, voffB);
            PG8_WAIT_V(6); PG8_BAR; PG8_MMA(1, 1, At, B1); PG8_BAR;
            PG8_LDB(B0, 1, 0); PG8_SCHED; PG8_LDA(At, 1, 0); PG8_STAGE(PG8_SA(0, 1), a2 + hstep, voffA);
            PG8_WAIT_L(8); PG8_BAR; PG8_WAIT_L(0); PG8_MMA(0, 0, At, B0); PG8_BAR; PG8_SCHED;
            PG8_LDB(B1, 1, 1); PG8_STAGE(PG8_SB(1, 0), b3, voffB);
            PG8_BAR; PG8_WAIT_L(0); PG8_MMA(0, 1, At, B1); PG8_BAR;
            PG8_LDA(At, 1, 1); PG8_STAGE(PG8_SA(1, 0), a3, voffA);
            PG8_BAR; PG8_WAIT_L(0); PG8_MMA(1, 0, At, B0); PG8_BAR; PG8_SCHED;
            PG8_STAGE(PG8_SB(1, 1), b3 + hstep, voffB);
            PG8_WAIT_V(6); PG8_BAR; PG8_MMA(1, 1, At, B1); PG8_BAR;
            }
        }
        if constexpr (ALIGN_EPI) { if (wr == 0) PG8_BAR; }
        if constexpr (!Epi::AFTER_DRAIN) { E(acc, cur, wr, wc, fr, fq); S.done(cur); }
        if (!has_next) break;
#pragma unroll
        for (int a = 0; a < 2; ++a)
#pragma unroll
            for (int b = 0; b < 2; ++b)
#pragma unroll
                for (int m = 0; m < 4; ++m)
#pragma unroll
                    for (int n = 0; n < 2; ++n) acc[a][b][m][n] = (f32x4){0.f, 0.f, 0.f, 0.f};
        cur = nxt; cA = nA; cB = nB; ++ui;
        if constexpr (ALIGN_EPI) { if (wr == 1) PG8_BAR; }
    }
    PG8_WAIT_V(0);
    if constexpr (!ALIGN_EPI) { if (wr == 0) PG8_BAR; }
    PG8_BAR;
    if constexpr (Epi::AFTER_DRAIN) { E.fused(acc, cur, wr, wc, fr, fq, lds, wid, lane); S.done(cur); }
#undef PG8_SA
#undef PG8_SB
#undef PG8_STAGE
#undef PG8_LDA
#undef PG8_LDB
#undef PG8_MMA
#undef PG8_WAIT_V
#undef PG8_WAIT_L
#undef PG8_BAR
#undef PG8_SCHED
}
}

namespace att {
typedef unsigned short bf16;
typedef short bf16x8 __attribute__((ext_vector_type(8)));
typedef short s16x4 __attribute__((ext_vector_type(4)));
typedef float f32x16 __attribute__((ext_vector_type(16)));
typedef float f32x4 __attribute__((ext_vector_type(4)));
typedef unsigned u32x4 __attribute__((ext_vector_type(4)));
template <class A, class Bt> struct same_t { static constexpr bool v = false; };
template <class A> struct same_t<A, A> { static constexpr bool v = true; };
constexpr int D = 128;
constexpr float THR = 8.f;
constexpr bool WSKIP = false;
constexpr float SCALE = 0.08838834764831845f;
constexpr int NW = 8, QBLK = 32, KVBLK = 64, QB = NW * QBLK;
constexpr int SHM_V = KVBLK * D * 2, SHM_K = KVBLK * D * 2;
constexpr int LDS_BIAS = 2 * SHM_V + 2 * SHM_K + NW * 64 * 4;
constexpr int LDS_BYTES = LDS_BIAS + 4096 * 4;
constexpr int OP = 2048;
#define KSWZ(row, colB) ((row) * 256 + ((colB) ^ (((row) & 7) << 4)))
#define SBAR() __builtin_amdgcn_sched_barrier(0)
__device__ __forceinline__ int v_st(int k, int c) { const int kk = (k & ~0xC) | ((k & 4) << 1) | ((k & 8) >> 1); return ((kk >> 3) * 4 + (c >> 5)) * 512 + ((kk & 7) * 32 + (c & 31)) * 2; }
__device__ __forceinline__ int v_rd_base(int lane) { return ((lane & 3) << 3) | (((lane >> 2) & 3) << 6) | (((lane >> 4) & 1) << 5) | (((lane >> 5) & 1) << 8); }
constexpr int v_rd_off(int d0, int ks, int half) { return d0 * 512 + ks * 4096 + half * 2048; }
__device__ __forceinline__ int crow(int r, int hi) { return (r & 3) + 8 * (r >> 2) + 4 * hi; }
__device__ __forceinline__ unsigned cvtpk(float lo, float hi) {
    unsigned r; asm volatile("v_cvt_pk_bf16_f32 %0, %1, %2" : "=v"(r) : "v"(lo), "v"(hi)); return r;
}
__device__ __forceinline__ bf16x8 pack8(f32x4 a, f32x4 b) {
    u32x4 w = {cvtpk(a[0], a[1]), cvtpk(a[2], a[3]), cvtpk(b[0], b[1]), cvtpk(b[2], b[3])};
    return *reinterpret_cast<bf16x8*>(&w);
}
template <class T> __device__ __forceinline__ bf16x8 load8(const T* p) {
    if constexpr (same_t<T, float>::v) { return pack8(*(const f32x4*)p, *(const f32x4*)(p + 4)); }
    else { return *reinterpret_cast<const bf16x8*>(p); }
}
__device__ __forceinline__ void mask_tile(f32x16& p0, f32x16& p1, int dq, unsigned W) {
    const float NEG = -__builtin_inff();
#pragma unroll
    for (int r = 0; r < 16; ++r) {
        const int c = (r & 3) + 8 * (r >> 2);
        if ((unsigned)(dq - c) >= W) p0[r] = NEG;
        if ((unsigned)(dq - c - 32) >= W) p1[r] = NEG;
    }
}
__device__ __forceinline__ void partialSM(f32x16& p0, f32x16& p1, float& m_reg, float& mn, float& alpha) {
    float pmax = p0[0]; for (int r = 1; r < 16; ++r) pmax = fmaxf(pmax, p0[r]); for (int r = 0; r < 16; ++r) pmax = fmaxf(pmax, p1[r]);
    { auto rr = __builtin_amdgcn_permlane32_swap(__float_as_uint(pmax), __float_as_uint(pmax), false, false);
      pmax = fmaxf(__uint_as_float(rr[0]), __uint_as_float(rr[1])); }
    constexpr float C2 = 1.4426950408889634f * SCALE;
    if (__builtin_expect(__all((pmax - m_reg) * SCALE <= THR), 1)) { mn = m_reg; alpha = 1.f; }
    else { mn = fmaxf(m_reg, pmax); alpha = __builtin_amdgcn_exp2f((m_reg - mn) * C2); m_reg = mn; }
    const float mnL = -mn * C2;
    for (int r = 0; r < 16; ++r) p0[r] = fmaf(p0[r], C2, mnL); for (int r = 0; r < 16; ++r) p1[r] = fmaf(p1[r], C2, mnL);
    for (int r = 0; r < 16; ++r) p0[r] = __builtin_amdgcn_exp2f(p0[r]);
}
__device__ __forceinline__ void finishSM(f32x16& p0, f32x16& p1, float alpha, float& l_reg, bf16x8& pa0, bf16x8& pa1, bf16x8& pa2, bf16x8& pa3) {
    for (int r = 0; r < 16; ++r) p1[r] = __builtin_amdgcn_exp2f(p1[r]);
    float ps = 0; for (int r = 0; r < 16; ++r) ps += p0[r]; for (int r = 0; r < 16; ++r) ps += p1[r];
    { auto rr = __builtin_amdgcn_permlane32_swap(__float_as_uint(ps), __float_as_uint(ps), false, false);
      ps = __uint_as_float(rr[0]) + __uint_as_float(rr[1]); }
    l_reg = l_reg * alpha + ps;
#define PK4(P, B_, OUT) do { unsigned a0 = cvtpk(P[B_+0], P[B_+1]), a1 = cvtpk(P[B_+2], P[B_+3]);                          \
        unsigned b0 = cvtpk(P[B_+4], P[B_+5]), b1 = cvtpk(P[B_+6], P[B_+7]);                                             \
        auto r0 = __builtin_amdgcn_permlane32_swap(a0, b0, false, false); auto r1 = __builtin_amdgcn_permlane32_swap(a1, b1, false, false); \
        u32x4 w = {r0[0], r1[0], r0[1], r1[1]}; OUT = *reinterpret_cast<bf16x8*>(&w); } while (0)
    PK4(p0, 0, pa0); PK4(p0, 8, pa1); PK4(p1, 0, pa2); PK4(p1, 8, pa3);
#undef PK4
}
template <int KB, bool SK>
__device__ __forceinline__ void qkt(f32x16& p0, f32x16& p1, const char* K_lds, int r32, int hi, const bf16x8* qr, bool act, const float* bl) {
    if (SK && !act) { const float NEG = -__builtin_inff();
#pragma unroll
        for (int r = 0; r < 16; ++r) { p0[r] = NEG; p1[r] = NEG; } return; }
    { const f32x4 c0 = *(const f32x4*)(bl), c1 = *(const f32x4*)(bl + 8), c2 = *(const f32x4*)(bl + 16), c3 = *(const f32x4*)(bl + 24);
      const f32x4 e0 = *(const f32x4*)(bl + 32), e1 = *(const f32x4*)(bl + 40), e2 = *(const f32x4*)(bl + 48), e3 = *(const f32x4*)(bl + 56);
      p0 = (f32x16){c0[0], c0[1], c0[2], c0[3], c1[0], c1[1], c1[2], c1[3], c2[0], c2[1], c2[2], c2[3], c3[0], c3[1], c3[2], c3[3]};
      p1 = (f32x16){e0[0], e0[1], e0[2], e0[3], e1[0], e1[1], e1[2], e1[3], e2[0], e2[1], e2[2], e2[3], e3[0], e3[1], e3[2], e3[3]}; }
    const char* kb[4];
#pragma unroll
    for (int dd = 0; dd < 4; ++dd) kb[dd] = K_lds + KB * SHM_K + KSWZ(r32, (dd * 16 + hi * 8) * 2);
#pragma unroll
    for (int d0 = 0; d0 < 8; ++d0) { const char* a = kb[d0 & 3] + (d0 >> 2) * 128;
        bf16x8 b0 = *reinterpret_cast<const bf16x8*>(a);
        bf16x8 b1 = *reinterpret_cast<const bf16x8*>(a + 32 * 256);
        p0 = __builtin_amdgcn_mfma_f32_32x32x16_bf16(b0, qr[d0], p0, 0, 0, 0);
        p1 = __builtin_amdgcn_mfma_f32_32x32x16_bf16(b1, qr[d0], p1, 0, 0, 0); }
}
template <int VB, bool SK>
__device__ __forceinline__ void pv_tile(f32x16* o, int vb0, bf16x8 pa0, bf16x8 pa1, bf16x8 pa2, bf16x8 pa3, bool act) {
    if (SK && !act) return;
#define TRRD(dst, off) asm volatile("ds_read_b64_tr_b16 %0, %1 offset:%2" : "=&v"(dst) : "v"(vb0), "i"(off) : "memory")
#define PV_D0(d0) do { s16x4 l0, l1, l2, l3, h0, h1, h2, h3; constexpr int b_ = VB * SHM_V + v_rd_off(d0, 0, 0);     \
        TRRD(l0, b_); TRRD(h0, b_ + 2048); TRRD(l1, b_ + 4096); TRRD(h1, b_ + 6144); TRRD(l2, b_ + 8192); TRRD(h2, b_ + 10240); TRRD(l3, b_ + 12288); TRRD(h3, b_ + 14336); \
        asm volatile("s_waitcnt lgkmcnt(0)" ::: "memory"); SBAR();                 \
        o[d0] = __builtin_amdgcn_mfma_f32_32x32x16_bf16(pa0, (bf16x8){l0[0], l0[1], l0[2], l0[3], h0[0], h0[1], h0[2], h0[3]}, o[d0], 0, 0, 0);   \
        o[d0] = __builtin_amdgcn_mfma_f32_32x32x16_bf16(pa1, (bf16x8){l1[0], l1[1], l1[2], l1[3], h1[0], h1[1], h1[2], h1[3]}, o[d0], 0, 0, 0);   \
        o[d0] = __builtin_amdgcn_mfma_f32_32x32x16_bf16(pa2, (bf16x8){l2[0], l2[1], l2[2], l2[3], h2[0], h2[1], h2[2], h2[3]}, o[d0], 0, 0, 0);   \
        o[d0] = __builtin_amdgcn_mfma_f32_32x32x16_bf16(pa3, (bf16x8){l3[0], l3[1], l3[2], l3[3], h3[0], h3[1], h3[2], h3[3]}, o[d0], 0, 0, 0); } while (0)
    PV_D0(0); PV_D0(1); PV_D0(2); PV_D0(3);
#undef PV_D0
#undef TRRD
}


struct BlockRef { const bf16* Q; const bf16* K; const bf16* V; bf16* O; const float* KB; int P0; };
struct Seam { bf16x8 qr[8]; bf16x8 st_v0, st_v1, st_k0, st_k1; };
#define ROW(p, k0, rr) ((p) + (size_t)((k0) + (rr)) * D + sc)
#define VMW() asm volatile("s_waitcnt vmcnt(0)" ::: "memory")
#define VMWN(n) asm volatile("s_waitcnt vmcnt(%0)" :: "i"(n) : "memory")
#define SLOAD_H(Kp, Vp, k0) do { S.st_v0 = load8<bf16>(ROW(Vp, k0, sr)); S.st_v1 = load8<bf16>(ROW(Vp, k0, 32 + sr));              \
                         S.st_k0 = load8<bf16>(ROW(Kp, k0, sr)); S.st_k1 = load8<bf16>(ROW(Kp, k0, 32 + sr)); } while (0)
#define SWRITE_HK(bf) do { *(bf16x8*)(K_lds + (bf) * SHM_K + kws) = S.st_k0; *(bf16x8*)(K_lds + (bf) * SHM_K + kws + 32 * 256) = S.st_k1; } while (0)
#define SWRITE_HV(bf) do { *(bf16x8*)(V_lds + (bf) * SHM_V + vst0) = S.st_v0; *(bf16x8*)(V_lds + (bf) * SHM_V + vst1) = S.st_v1; } while (0)
#define SWRITE_H(bf) do { SWRITE_HV(bf); SWRITE_HK(bf); } while (0)
__device__ __forceinline__ void fox_prime(const BlockRef& cur, char* lds, Seam& S, int kw) {
    const int tid = ktid(kw), wid = kw, lane = tid & 63, r32 = lane & 31, hi = lane >> 5;
    const int sr = tid >> 4, sc = (tid & 15) * 8, kws = KSWZ(sr, sc * 2); char* K_lds = lds + 2 * SHM_V;
#pragma unroll
    for (int d0 = 0; d0 < 8; ++d0) S.qr[d0] = load8<bf16>(cur.Q + (size_t)(wid * QBLK + r32) * D + d0 * 16 + hi * 8);
    SLOAD_H(cur.K, cur.V, 0); VMW(); SWRITE_HK(0);
    __syncthreads();
}
__device__ __forceinline__ void fox_block(const BlockRef& cur, const BlockRef& nxt, char* lds, Seam& S, int kw) {
    constexpr bool SK = false; constexpr unsigned W = 0x7fffffffu;
    const int tid = ktid(kw), wid = kw, lane = tid & 63, r32 = lane & 31, hi = lane >> 5;
    const int NT = (cur.P0 + QB - 1) / KVBLK + 1;
    const int qlo = cur.P0 + wid * QBLK, qm = qlo + r32 - 4 * hi;
    char* V_lds = lds; char* K_lds = lds + 2 * SHM_V;
    float* ws = (float*)(lds + 2 * SHM_V + 2 * SHM_K) + wid * 64; float* li_l = ws, * al_l = ws + 32;
    float m_reg = -1e30f, l_reg = 0; f32x16 o[4] = {};
    const int sr = tid >> 4, sc = (tid & 15) * 8, vst0 = v_st(sr, sc), vst1 = v_st(32 + sr, sc), kws = KSWZ(sr, sc * 2);
    const int vb0 = (int)(uintptr_t)V_lds + v_rd_base(lane);
    const bf16* Kh = cur.K; const bf16* Vh = cur.V;
    float* bias_l = (float*)(lds + LDS_BIAS);
    { const int nb4 = (cur.P0 + QB) / 4; int i0 = ktid(kw); asm volatile("" : "+v"(i0));
      for (int i = i0; i < nb4; i += NW * 64) ((f32x4*)bias_l)[i] = ((const f32x4*)cur.KB)[i]; }
    __syncthreads();
    const float* KBh = bias_l + 4 * hi;
#define RESC(a) do { if (__any((a) < 1.f)) { if (hi == 0) al_l[r32] = (a); asm volatile("s_waitcnt lgkmcnt(0)" ::: "memory");              \
                     for (int d_ = 0; d_ < 4; ++d_) for (int r = 0; r < 16; ++r) o[d_][r] *= al_l[crow(r, hi)]; } } while (0)
#define KBASE(t) ((t) * KVBLK)
#define ACT(t) true
#define MASKT(P0_, P1_, t) do { const int kb_ = KBASE(t); if (kb_ + KVBLK - 1 > qlo) mask_tile(P0_, P1_, qm - kb_, W); } while (0)
    constexpr int NQL = 8;
#define SEAM_K0() do { VMWN(NQL); SWRITE_HK(0); SBAR(); } while (0)
    f32x16 pA0, pA1, pB0, pB1; float mnA, mnB, alA, alB; bf16x8 pa0, pa1, pa2, pa3;
    SWRITE_HV(0); SBAR();
    if (NT > 1) { SLOAD_H(Kh, Vh, KBASE(1)); }
    SBAR(); qkt<0, SK>(pA0, pA1, K_lds, r32, hi, S.qr, ACT(0), KBh);
    MASKT(pA0, pA1, 0); partialSM(pA0, pA1, m_reg, mnA, alA);
    if (NT > 1) { VMW(); SWRITE_H(1); }
    __syncthreads();
#define HALF_STEP(PX0, PX1, mnX, alX, PY0, PY1, alY, t, KB, VB, SB) do {                                                      \
        SBAR(); qkt<KB, SK>(PX0, PX1, K_lds, r32, hi, S.qr, ACT(t), KBh + KBASE(t));                                             \
        finishSM(PY0, PY1, alY, l_reg, pa0, pa1, pa2, pa3); SBAR();                                                           \
        if ((t) + 1 < NT) { SLOAD_H(Kh, Vh, KBASE((t) + 1)); SBAR(); }                                                        \
        pv_tile<VB, SK>(o, vb0, pa0, pa1, pa2, pa3, ACT((t) - 1)); MASKT(PX0, PX1, (t)); partialSM(PX0, PX1, m_reg, mnX, alX);  \
        __syncthreads();                                                                                                      \
        if ((t) + 1 < NT) { VMW(); SWRITE_H(SB); }                                                                            \
        RESC(alX); __syncthreads(); } while (0)
    for (int t = 1; t + 1 < NT; t += 2) {
        HALF_STEP(pB0, pB1, mnB, alB, pA0, pA1, alA, t, 1, 0, 0);
        HALF_STEP(pA0, pA1, mnA, alA, pB0, pB1, alB, t + 1, 0, 1, 1);
    }
    const bool even = (NT & 1) == 0;
    if (even) { SBAR(); qkt<1, SK>(pB0, pB1, K_lds, r32, hi, S.qr, ACT(NT - 1), KBh + KBASE(NT - 1)); SBAR(); }
    SLOAD_H(nxt.K, nxt.V, 0); SBAR();
#pragma unroll
    for (int d0 = 0; d0 < 8; ++d0) S.qr[d0] = load8<bf16>(nxt.Q + (size_t)(wid * QBLK + r32) * D + d0 * 16 + hi * 8);
    SBAR();
    finishSM(pA0, pA1, alA, l_reg, pa0, pa1, pa2, pa3); SBAR();
    pv_tile<0, SK>(o, vb0, pa0, pa1, pa2, pa3, true);
    if (even) { MASKT(pB0, pB1, NT - 1); partialSM(pB0, pB1, m_reg, mnB, alB); __syncthreads(); RESC(alB);
        finishSM(pB0, pB1, alB, l_reg, pa0, pa1, pa2, pa3); SBAR(); pv_tile<1, SK>(o, vb0, pa0, pa1, pa2, pa3, true); }
    SBAR(); SEAM_K0();
    if (hi == 0) li_l[r32] = l_reg; asm volatile("s_waitcnt lgkmcnt(0)" ::: "memory");
    float rli[16];
#pragma unroll
    for (int r = 0; r < 16; ++r) rli[r] = __builtin_amdgcn_rcpf(li_l[crow(r, hi)]);
    bf16* Ow = cur.O + (size_t)(wid * QBLK) * OP;
#pragma unroll
    for (int r = 0; r < 16; ++r) { const int orow = crow(r, hi);
#pragma unroll
        for (int d0 = 0; d0 < 4; ++d0) { const float v = o[d0][r] * rli[r];
            const float vn = __shfl_xor(v, 1);
            if ((r32 & 1) == 0) *(unsigned*)(Ow + (size_t)orow * OP + d0 * 32 + r32) = cvtpk(v, vn); } }
    __syncthreads();
#undef RESC
#undef KBASE
#undef ACT
#undef MASKT
#undef SEAM_K0
#undef HALF_STEP
}
#undef ROW
#undef VMW
#undef VMWN
#undef SLOAD_H
#undef SWRITE_HK
#undef SWRITE_HV
#undef SWRITE_H
#undef KSWZ
#undef SBAR
}

struct Frame {
    LAS unsigned char* lds;
    volatile LAS unsigned* MISC;
    gu32* ctl;
    int tid, lane, wave;
    int vcu, G, bx;
    const float *x, *c, *w_ada, *b_ada, *g_mix, *w_in, *b_f, *conv_w, *conv_b, *lru_w_a, *lru_b_a, *lru_w_x, *lru_b_x, *lru_lambda,
                *g_attn_out, *g_lru_out, *w_out, *g_ffn, *peer_w_q, *peer_k1, *peer_k2, *peer_u, *peer_v, *g_final;
    float* out;
    float *MOD, *LF, *KB, *SUMM, *EW, *USC, *VSC;
    int* EIDX;
    bf16_t *WLRU, *K1, *K2, *WIN, *WOUT, *WQ, *H, *Q, *K, *VV, *QP, *LX, *GLY, *MRG;
    unsigned char *U8, *V8;
};

struct Args { const float* in[24]; float* out; unsigned char* ws; int ph_lo, ph_hi, li, pad; };

__device__ __forceinline__ void p0_transpose_item(const float* W, int ldw, int K, bf16_t* WT, int kb, int scol, int drow, const float* gk, LAS float* scr, int lane) {
    const int k0 = 64 * kb;
#pragma unroll 8
    for (int i = 0; i < 32; ++i) { const int kk = 2 * i + (lane >> 5); float w = W[(size_t)(k0 + kk) * ldw + scol + (lane & 31)]; if (gk) w *= gk[k0 + kk]; scr[kk * 33 + (lane & 31)] = w; }
    LDS_WAIT(); asm volatile("" ::: "memory");
    const int c = lane & 7;
#pragma unroll
    for (int j = 0; j < 4; ++j) { const int n = (lane >> 3) + 8 * j; const LAS float* s = scr + (8 * c) * 33 + n;
        v4u o; o.x = pk2(s[0 * 33], s[1 * 33]); o.y = pk2(s[2 * 33], s[3 * 33]); o.z = pk2(s[4 * 33], s[5 * 33]); o.w = pk2(s[6 * 33], s[7 * 33]);
        *(GAS v4u*)(WT + (size_t)(drow + n) * K + k0 + 8 * c) = o; }
    LDS_WAIT(); asm volatile("" ::: "memory");
}
__device__ __forceinline__ void p0_convert(const float* src, bf16_t* dst, size_t n8, size_t gt, size_t ngt) {
#pragma unroll 4
    for (size_t i = gt; i < n8; i += ngt) { const f32x4 a = *(const GAS f32x4*)(src + i * 8), b = *(const GAS f32x4*)(src + i * 8 + 4);
        v4u o; o.x = pk2(a[0], a[1]); o.y = pk2(a[2], a[3]); o.z = pk2(b[0], b[1]); o.w = pk2(b[2], b[3]); *(GAS v4u*)(dst + i * 8) = o; }
}
__device__ __forceinline__ void p0_prologue(Frame& F) {
    {
        LAS float* scs = (LAS float*)F.lds;
        LAS float* red = scs + 4 * 2048;
        for (int i = F.tid; i < 4 * DM; i += NTHR) { const float cv = F.c[i]; scs[i] = cv * sigmoidf_(cv); }
        __syncthreads();
        for (int cb = F.bx; cb < 256; cb += F.G) {
            const int cq = F.tid % 12, rl = F.tid / 12;
            if (F.tid < 504) {
                float acc[4][4];
#pragma unroll
                for (int b = 0; b < 4; ++b)
#pragma unroll
                    for (int j = 0; j < 4; ++j) acc[b][j] = 0.f;
                const float* wp = F.w_ada + (size_t)rl * NADA + cb * 48 + cq * 4;
#pragma unroll 4
                for (int r = rl; r < DM; r += 42, wp += (size_t)42 * NADA) { const f32x4 w = *(const GAS f32x4*)wp;
#pragma unroll
                    for (int b = 0; b < 4; ++b) { const float s = scs[b * DM + r]; acc[b][0] += s * w[0]; acc[b][1] += s * w[1]; acc[b][2] += s * w[2]; acc[b][3] += s * w[3]; } }
#pragma unroll
                for (int b = 0; b < 4; ++b)
#pragma unroll
                    for (int j = 0; j < 4; ++j) red[rl * 192 + cq * 16 + b * 4 + j] = acc[b][j];
            }
            __syncthreads();
            if (F.tid < 192) { float s = 0.f;
                for (int r = 0; r < 42; ++r) s += red[r * 192 + F.tid];
                const int q = F.tid >> 4, b = (F.tid >> 2) & 3, j = F.tid & 3, col = cb * 48 + q * 4 + j;
                F.MOD[b * NADA + col] = s + F.b_ada[col]; }
            __syncthreads();
        }
    }
    {
        LAS float* scr = (LAS float*)(F.lds + F.wave * 16384);
        const int gw = F.vcu * NWAVES + F.wave, NGW = F.G * NWAVES;
        constexpr int I_IN1 = 32 * 96, I_IN2 = 32 * 64, I_SQ = 32 * 64, I_LRU = 16 * 8;
        constexpr int NITEMS = I_IN1 + I_IN2 + 2 * I_SQ + I_LRU;
        for (int it = gw; it < NITEMS; it += NGW) {
            int r = it;
            if (r < I_IN1) { const int kb = r / 96, nb = r % 96; p0_transpose_item(F.w_in, INC, DM, F.WIN, kb, 32 * nb, 32 * nb, nullptr, scr, F.lane); continue; } r -= I_IN1;
            if (r < I_IN2) { const int kb = r / 64, nb = r % 64; p0_transpose_item(F.w_in, INC, DM, F.WIN, kb, OFF_LX + 32 * nb, OFF_F + 32 * nb, nullptr, scr, F.lane); continue; } r -= I_IN2;
            if (r < I_SQ) { const int kb = r / 64, nb = r % 64; const float* gk = kb < 16 ? F.g_attn_out : F.g_lru_out - AW;
                p0_transpose_item(F.w_out, DM, DM, F.WOUT, kb, 32 * nb, 32 * nb, gk, scr, F.lane); continue; } r -= I_SQ;
            if (r < I_SQ) { const int kb = r / 64, nb = r % 64; p0_transpose_item(F.peer_w_q, DM, DM, F.WQ, kb, 32 * nb, 32 * nb, nullptr, scr, F.lane); continue; } r -= I_SQ;
            { const int mat = r >> 3, sub = r & 7, n = mat >> 1, which = mat & 1, kb = sub >> 2, nb = sub & 3;
              const float* src = (which ? F.lru_w_x : F.lru_w_a) + (size_t)n * LBD * LBD;
              p0_transpose_item(src, LBD, LBD, F.WLRU + (size_t)(n * 256 + which * 128) * LBD, kb, 32 * nb, 32 * nb, nullptr, scr, F.lane); }
        }
    }
    {
        const size_t gt = (size_t)F.vcu * NTHR + F.tid, ngt = (size_t)F.G * NTHR;
        p0_convert(F.peer_k1, F.K1, (size_t)PH * PNK * 128 / 8, gt, ngt);
        p0_convert(F.peer_k2, F.K2, (size_t)PH * PNK * 128 / 8, gt, ngt);
    }
    {
        const int gw = F.vcu * NWAVES + F.wave, NGW = F.G * NWAVES;
        for (int r = gw; r < 2 * NEXP; r += NGW) {
            const bool isv = r >= NEXP; const int rr = isv ? r - NEXP : r;
            const GAS f32x4* src = (const GAS f32x4*)((isv ? F.peer_v : F.peer_u) + (size_t)rr * DM) + F.lane;
            f32x4 v[8]; float am = 0.f;
#pragma unroll
            for (int j = 0; j < 8; ++j) { v[j] = src[64 * j]; am = fmaxf(am, fmaxf(fmaxf(fabsf(v[j][0]), fabsf(v[j][1])), fmaxf(fabsf(v[j][2]), fabsf(v[j][3])))); }
#pragma unroll
            for (int o = 1; o < 64; o <<= 1) am = fmaxf(am, __shfl_xor(am, o));
            const float sc = am > 0.f ? 416.f / am : 1.f;
            GAS unsigned* dst = (GAS unsigned*)((isv ? F.V8 : F.U8) + (size_t)rr * DM) + F.lane;
#pragma unroll
            for (int j = 0; j < 8; ++j) { int pk = 0; pk = __builtin_amdgcn_cvt_pk_fp8_f32(v[j][0] * sc, v[j][1] * sc, pk, false); pk = __builtin_amdgcn_cvt_pk_fp8_f32(v[j][2] * sc, v[j][3] * sc, pk, true); dst[64 * j] = (unsigned)pk; }
            if (F.lane == 0) (isv ? F.VSC : F.USC)[rr] = am > 0.f ? am / 416.f : 1.f;
        }
    }
}

template <bool WITH_F>
__device__ __forceinline__ void p_modnorm(Frame& F, const float* xin, const float* g, int off_sh, int off_sc) {
    LAS float* gsv = (LAS float*)F.lds;
    LAS float* shv = gsv + DM;
    LAS float* wfT = shv + DM;
    if (WITH_F) { for (int i = F.tid; i < 8 * DM; i += NTHR) { const int k = i >> 3, j = i & 7; wfT[j * DM + k] = F.w_in[(size_t)k * INC + OFF_F + j]; } }
    for (int rb = F.bx; rb < T / 64; rb += F.G) {
        const int b = rb >> 6;
        __syncthreads();
        for (int k = F.tid; k < DM; k += NTHR) { gsv[k] = g[k] * (1.f + F.MOD[b * NADA + off_sc + k]); shv[k] = F.MOD[b * NADA + off_sh + k]; }
        __syncthreads();
        for (int i = 0; i < 8; ++i) {
            const int row = rb * 64 + F.wave * 8 + i;
            const GAS f32x4* xr = (const GAS f32x4*)(xin + (size_t)row * DM) + F.lane;
            f32x4 v[8]; float ss = 0.f;
#pragma unroll
            for (int j = 0; j < 8; ++j) { v[j] = xr[64 * j]; ss += (v[j][0] * v[j][0] + v[j][1] * v[j][1]) + (v[j][2] * v[j][2] + v[j][3] * v[j][3]); }
            const float rstd = __builtin_amdgcn_rsqf(wave_sum(ss) * (1.f / DM) + EPS);
#pragma unroll
            for (int j = 0; j < 8; ++j) { const f32x4 gg = ((const LAS f32x4*)gsv)[F.lane + 64 * j], sh = ((const LAS f32x4*)shv)[F.lane + 64 * j]; v[j] = v[j] * rstd * gg + sh; }
            GAS v2u* o8 = (GAS v2u*)(F.H + (size_t)row * DM) + F.lane;
#pragma unroll
            for (int j = 0; j < 8; ++j) { v2u w; w.x = pk2(v[j][0], v[j][1]); w.y = pk2(v[j][2], v[j][3]); o8[64 * j] = w; }
            if (WITH_F) {
                float mine = 0.f;
#pragma unroll 1
                for (int jj = 0; jj < 8; ++jj) { float a = 0.f;
#pragma unroll
                    for (int j = 0; j < 8; ++j) { const f32x4 w = ((const LAS f32x4*)(wfT + jj * DM))[F.lane + 64 * j]; a += (v[j][0] * w[0] + v[j][1] * w[1]) + (v[j][2] * w[2] + v[j][3] * w[3]); }
                    a = wave_sum(a); mine = (F.lane == jj) ? a : mine; }
                if (F.lane < 8) { const float z = mine + F.b_f[F.lane]; const float lf = fminf(z, 0.f) - log1pf(fexp(-fabsf(z)));
                    F.LF[(size_t)(b * NH + F.lane) * SEQ + (row & (SEQ - 1))] = lf; }
            }
        }
    }
}

__device__ __forceinline__ void p2_cumsum(Frame& F) {
    LAS float* wt = (LAS float*)F.lds;
    for (int bh = F.bx; bh < BATCH * NH; bh += F.G) {
        const float* src = F.LF + (size_t)bh * SEQ + F.tid * 8;
        const f32x4 a = *(const GAS f32x4*)src, b = *(const GAS f32x4*)(src + 4);
        float p[8]; p[0] = a[0]; p[1] = p[0] + a[1]; p[2] = p[1] + a[2]; p[3] = p[2] + a[3]; p[4] = p[3] + b[0]; p[5] = p[4] + b[1]; p[6] = p[5] + b[2]; p[7] = p[6] + b[3];
        float incl = p[7];
#pragma unroll
        for (int o = 1; o < 64; o <<= 1) { const float n = __shfl_up(incl, o); if (F.lane >= o) incl += n; }
        __syncthreads();
        if (F.lane == 63) wt[F.wave] = incl;
        __syncthreads();
        float off = incl - p[7];
        for (int w = 0; w < F.wave; ++w) off += wt[w];
        constexpr float NIS = -1.0f / 0.08838834764831845f;
        f32x4 o0, o1;
        o0[0] = (off + p[0]) * NIS; o0[1] = (off + p[1]) * NIS; o0[2] = (off + p[2]) * NIS; o0[3] = (off + p[3]) * NIS;
        o1[0] = (off + p[4]) * NIS; o1[1] = (off + p[5]) * NIS; o1[2] = (off + p[6]) * NIS; o1[3] = (off + p[7]) * NIS;
        float* dst = F.KB + (size_t)bh * SEQ + F.tid * 8;
        *(GAS f32x4*)dst = o0; *(GAS f32x4*)(dst + 4) = o1;
    }
}

constexpr int L_LX = 0, L_A = 17408, L_XC = 34816, L_SA = 68608, L_SUM = 102400, L_HIN = 106496, L_END = 110592;
constexpr int XS = 132;
typedef float f32x4v __attribute__((ext_vector_type(4)));
template <bool FINAL>
__device__ __forceinline__ void lru_unit(Frame& F, int b, int chunk) {
    LAS unsigned char* L = F.lds;
    int tid_ = ktid(F.wave); asm volatile("" : "+v"(tid_));
    const int tid = tid_, lane = tid_ & 63, wave = F.wave;
    const int s0 = chunk * 64; const size_t row0 = (size_t)b * SEQ + s0;
    LAS float* hin = (LAS float*)(L + L_HIN);
    __syncthreads();
    if (FINAL) {
        for (int ch = tid; ch < LW; ch += NTHR) { float h = 0.f;
            const GAS f32x2* sp = (const GAS f32x2*)F.SUMM + (size_t)(b * 64) * LW + ch;
            for (int c = 0; c < chunk; ++c) { const f32x2 ph = sp[(size_t)c * LW]; h = ph[0] * h + ph[1]; }
            hin[ch] = h; }
    }
    float myssq = 0.f;
    for (int n = 0; n < NLB; ++n) {
        __syncthreads();
        for (int idx = tid; idx < 67 * 16; idx += NTHR) { const int r = idx >> 4, c8 = idx & 15; const int s = s0 - 3 + r;
            v4u val = {0u, 0u, 0u, 0u};
            if (s >= 0) val = *(const GAS v4u*)(F.LX + ((size_t)b * SEQ + s) * LW + n * LBD + c8 * 8);
            *(LAS v4u*)(L + L_LX + r * 256 + c8 * 16) = val; }
        __syncthreads();
        { const int tok = tid >> 3, c16 = tid & 7; const int chg = n * LBD + c16 * 16;
          float xc[16];
#pragma unroll
          for (int e = 0; e < 16; e += 4) { const f32x4 cb = *(const GAS f32x4*)(F.conv_b + chg + e); xc[e] = cb[0]; xc[e + 1] = cb[1]; xc[e + 2] = cb[2]; xc[e + 3] = cb[3]; }
#pragma unroll
          for (int k = 0; k < 4; ++k) {
              const v4u x0 = *(const LAS v4u*)(L + L_LX + (tok + k) * 256 + c16 * 32), x1 = *(const LAS v4u*)(L + L_LX + (tok + k) * 256 + c16 * 32 + 16);
              const unsigned xd[8] = {x0.x, x0.y, x0.z, x0.w, x1.x, x1.y, x1.z, x1.w};
#pragma unroll
              for (int e = 0; e < 16; e += 4) { const f32x4 w = *(const GAS f32x4*)(F.conv_w + k * LW + chg + e);
                  xc[e] += w[0] * bf_lo(xd[e / 2]); xc[e + 1] += w[1] * bf_hi(xd[e / 2]); xc[e + 2] += w[2] * bf_lo(xd[e / 2 + 1]); xc[e + 3] += w[3] * bf_hi(xd[e / 2 + 1]); } }
          v4u a0, a1; a0.x = pk2(xc[0], xc[1]); a0.y = pk2(xc[2], xc[3]); a0.z = pk2(xc[4], xc[5]); a0.w = pk2(xc[6], xc[7]);
          a1.x = pk2(xc[8], xc[9]); a1.y = pk2(xc[10], xc[11]); a1.z = pk2(xc[12], xc[13]); a1.w = pk2(xc[14], xc[15]);
          *(LAS v4u*)(L + L_A + tok * 272 + c16 * 32) = a0; *(LAS v4u*)(L + L_A + tok * 272 + c16 * 32 + 16) = a1;
          LAS float* xo = (LAS float*)(L + L_XC) + tok * XS + c16 * 16;
#pragma unroll
          for (int e = 0; e < 16; e += 4) *(LAS f32x4*)(xo + e) = (f32x4){xc[e], xc[e + 1], xc[e + 2], xc[e + 3]};
        }
        __syncthreads();
        const int r16 = lane & 15, g4 = lane >> 4;
        f32x4 acc_a[4], acc_x[4];
#pragma unroll
        for (int m = 0; m < 4; ++m) { acc_a[m] = (f32x4){0.f, 0.f, 0.f, 0.f}; acc_x[m] = (f32x4){0.f, 0.f, 0.f, 0.f}; }
        { const bf16_t* wa = F.WLRU + ((size_t)(n * 256 + 16 * wave + r16)) * LBD + 8 * g4; const bf16_t* wx = wa + (size_t)128 * LBD;
#pragma unroll
          for (int ks = 0; ks < 4; ++ks) {
              const bf16x8 ba = *(const GAS bf16x8*)(wa + 32 * ks), bx = *(const GAS bf16x8*)(wx + 32 * ks);
#pragma unroll
              for (int m = 0; m < 4; ++m) { const bf16x8 af = *(const LAS bf16x8*)(L + L_A + (16 * m + r16) * 272 + (32 * ks + 8 * g4) * 2);
                  acc_a[m] = __builtin_amdgcn_mfma_f32_16x16x32_bf16(af, ba, acc_a[m], 0, 0, 0);
                  acc_x[m] = __builtin_amdgcn_mfma_f32_16x16x32_bf16(af, bx, acc_x[m], 0, 0, 0); } } }
        { const int chl = 16 * wave + r16, chg = n * LBD + chl;
          const float ba_ = F.lru_b_a[chg], bx_ = F.lru_b_x[chg]; const float sp8 = 8.f * softplusf_(-F.lru_lambda[chg]);
          LAS float* xcp = (LAS float*)(L + L_XC) + chl; LAS float* sap = (LAS float*)(L + L_SA) + chl;
#pragma unroll
          for (int m = 0; m < 4; ++m)
#pragma unroll
              for (int i = 0; i < 4; ++i) { const int tt = 16 * m + 4 * g4 + i;
                  const float rg = sigmoidf_(acc_a[m][i] + ba_), ig = sigmoidf_(acc_x[m][i] + bx_);
                  const float la = -sp8 * rg; const float a = fexp(la); const float x2 = 2.f * la;
                  const float em1 = (x2 > -0.3f) ? x2 * (1.f + x2 * (0.5f + x2 * (0.16666667f + x2 * (0.041666668f + x2 * (0.008333334f + x2 * 0.0013888889f))))) : (fexp(x2) - 1.f);
                  const float bt = __builtin_sqrtf(fmaxf(-em1, 0.f)) * (ig * xcp[tt * XS]);
                  sap[tt * XS] = a; xcp[tt * XS] = bt; } }
        __syncthreads();
        { const int chl = tid & 127, sub = tid >> 7;
          const LAS float* sap = (const LAS float*)(L + L_SA) + (16 * sub) * XS + chl; const LAS float* sbp = (const LAS float*)(L + L_XC) + (16 * sub) * XS + chl;
          float av[16], bv[16];
#pragma unroll
          for (int j = 0; j < 16; ++j) { av[j] = sap[j * XS]; bv[j] = sbp[j * XS]; }
          float P = 1.f, Hh = 0.f;
#pragma unroll
          for (int j = 0; j < 16; ++j) { Hh = av[j] * Hh + bv[j]; P *= av[j]; }
          LAS f32x2* sm = (LAS f32x2*)(L + L_SUM);
          sm[sub * 128 + chl] = (f32x2){P, Hh};
          __syncthreads();
          if (!FINAL) {
              if (sub == 3) { float pp = 1.f, hh = 0.f;
#pragma unroll
                  for (int s = 0; s < 4; ++s) { const f32x2 ph = sm[s * 128 + chl]; hh = ph[0] * hh + ph[1]; pp *= ph[0]; }
                  *((GAS f32x2*)F.SUMM + ((size_t)(b * 64 + chunk)) * LW + n * LBD + chl) = (f32x2){pp, hh}; }
          } else {
              float h = hin[n * LBD + chl];
              for (int s = 0; s < sub; ++s) { const f32x2 ph = sm[s * 128 + chl]; h = ph[0] * h + ph[1]; }
              const bf16_t* gl = F.GLY + (row0 + 16 * sub) * LW + n * LBD + chl;
              bf16_t* op = F.MRG + (row0 + 16 * sub) * DM + AW + n * LBD + chl;
              float gv[16];
#pragma unroll
              for (int j = 0; j < 16; ++j) gv[j] = bf_lo((unsigned)gl[(size_t)j * LW]);
              LAS float* sq = (LAS float*)(L + L_SA) + (16 * sub) * XS + chl;
#pragma unroll
              for (int j = 0; j < 16; ++j) { h = av[j] * h + bv[j]; const float o = h * gv[j]; op[(size_t)j * DM] = (bf16_t)f2bf(o); sq[j * XS] = o * o; }
              __syncthreads();
              { const int tt = tid >> 3, part = tid & 7; const LAS float* q = (const LAS float*)(L + L_SA) + tt * XS + part * 16; float s = 0.f;
#pragma unroll
                for (int e = 0; e < 16; e += 4) { const f32x4 v = *(const LAS f32x4*)(q + e); s += (v[0] + v[1]) + (v[2] + v[3]); }
                s += __shfl_xor(s, 1); s += __shfl_xor(s, 2); s += __shfl_xor(s, 4); myssq += s; }
          }
        }
    }
    if (FINAL) {
        VM_WAIT(); __syncthreads();
        const int tt = tid >> 3, part = tid & 7;
        bf16_t* rowp = F.MRG + (row0 + tt) * DM;
        const float rl = __builtin_amdgcn_rsqf(myssq * (1.f / LW) + EPS);
        v4u la[16], aa[16];
#pragma unroll
        for (int e = 0; e < 16; ++e) { aa[e] = *(const GAS v4u*)(rowp + part * 128 + e * 8); }
        float sa = 0.f;
#pragma unroll
        for (int e = 0; e < 16; ++e) { const unsigned d[4] = {aa[e].x, aa[e].y, aa[e].z, aa[e].w};
#pragma unroll
            for (int q = 0; q < 4; ++q) { const float lo = bf_lo(d[q]), hi = bf_hi(d[q]); sa += lo * lo + hi * hi; } }
        sa += __shfl_xor(sa, 1); sa += __shfl_xor(sa, 2); sa += __shfl_xor(sa, 4);
        const float ra = __builtin_amdgcn_rsqf(sa * (1.f / AW) + EPS);
#pragma unroll
        for (int e = 0; e < 16; ++e) { v4u o; const unsigned d[4] = {aa[e].x, aa[e].y, aa[e].z, aa[e].w}; unsigned r[4];
#pragma unroll
            for (int q = 0; q < 4; ++q) r[q] = pk2(bf_lo(d[q]) * ra, bf_hi(d[q]) * ra);
            o.x = r[0]; o.y = r[1]; o.z = r[2]; o.w = r[3]; *(GAS v4u*)(rowp + part * 128 + e * 8) = o; }
#pragma unroll
        for (int e = 0; e < 16; ++e) { la[e] = *(const GAS v4u*)(rowp + AW + part * 128 + e * 8); }
#pragma unroll
        for (int e = 0; e < 16; ++e) { v4u o; const unsigned d[4] = {la[e].x, la[e].y, la[e].z, la[e].w}; unsigned r[4];
#pragma unroll
            for (int q = 0; q < 4; ++q) r[q] = pk2(bf_lo(d[q]) * rl, bf_hi(d[q]) * rl);
            o.x = r[0]; o.y = r[1]; o.z = r[2]; o.w = r[3]; *(GAS v4u*)(rowp + AW + part * 128 + e * 8) = o; }
    }
}

__device__ __forceinline__ att::BlockRef att_ref(Frame& F, int bh, int qb) {
    att::BlockRef r; const int b = bh >> 3, h = bh & 7;
    r.Q = F.Q + ((size_t)bh * SEQ + (size_t)qb * att::QB) * HD; r.K = F.K + (size_t)bh * SEQ * HD; r.V = F.VV + (size_t)bh * SEQ * HD;
    r.O = F.MRG + ((size_t)b * SEQ + (size_t)qb * att::QB) * DM + h * HD; r.KB = F.KB + (size_t)bh * SEQ; r.P0 = qb * att::QB;
    return r;
}
__device__ __forceinline__ void p3_attention(Frame& F, char* lds) {
    constexpr int NQB = SEQ / att::QB, NX = NQB / 2, TOTAL = BATCH * NH * NX;
    int L = F.vcu; if (L >= TOTAL) return;
    int pass = 0; int bh = L / NX, x = L % NX;
    att::BlockRef cur = att_ref(F, bh, x);
    att::Seam S;
    att::fox_prime(cur, lds, S, F.wave);
    for (;;) {
        const bool more_pass = pass == 0, more_item = L + F.G < TOTAL, last = !more_pass && !more_item;
        int passn = pass + 1, Ln = L;
        if (!more_pass) { passn = 0; Ln = more_item ? L + F.G : L; }
        const int bhn = Ln / NX, xn = Ln % NX;
        const att::BlockRef nxt = last ? cur : att_ref(F, bhn, passn ? NQB - 1 - xn : xn);
        att::fox_block(cur, nxt, lds, S, F.wave);
        if (last) break;
        cur = nxt; pass = passn; L = Ln;
    }
}

template <int N> __device__ __forceinline__ float row_ror(float v) { return __builtin_bit_cast(float, __builtin_amdgcn_update_dpp(0, __builtin_bit_cast(int, v), 0x120 + N, 0xf, 0xf, false)); }
__device__ __forceinline__ float fmax_s(float a, float b) { float r; asm("v_max_f32_e32 %0, %1, %2" : "=v"(r) : "v"(a), "v"(b)); return r; }
__device__ __forceinline__ float fmin_s(float a, float b) { float r; asm("v_min_f32_e32 %0, %1, %2" : "=v"(r) : "v"(a), "v"(b)); return r; }
__device__ __forceinline__ float row_allmax(float v) {
    asm volatile("s_nop 1\n\tv_max_f32_dpp %0, %0, %0 row_ror:8 row_mask:0xf bank_mask:0xf\n\t"
                 "s_nop 1\n\tv_max_f32_dpp %0, %0, %0 row_ror:4 row_mask:0xf bank_mask:0xf\n\t"
                 "s_nop 1\n\tv_max_f32_dpp %0, %0, %0 row_ror:2 row_mask:0xf bank_mask:0xf\n\t"
                 "s_nop 1\n\tv_max_f32_dpp %0, %0, %0 row_ror:1 row_mask:0xf bank_mask:0xf" : "+v"(v));
    return v;
}
__device__ __forceinline__ float row_allsum(float v) { v += row_ror<8>(v); v += row_ror<4>(v); v += row_ror<2>(v); v += row_ror<1>(v); return v; }
#define CE_DESC(a, b) do { const float hi_ = fmax_s(a, b), lo_ = fmin_s(a, b); a = hi_; b = lo_; } while (0)
__device__ __forceinline__ float row_top16(float (&Lv)[8], int r16) {
    CE_DESC(Lv[0], Lv[1]); CE_DESC(Lv[2], Lv[3]); CE_DESC(Lv[4], Lv[5]); CE_DESC(Lv[6], Lv[7]);
    CE_DESC(Lv[0], Lv[2]); CE_DESC(Lv[1], Lv[3]); CE_DESC(Lv[4], Lv[6]); CE_DESC(Lv[5], Lv[7]);
    CE_DESC(Lv[1], Lv[2]); CE_DESC(Lv[5], Lv[6]);
    CE_DESC(Lv[0], Lv[4]); CE_DESC(Lv[1], Lv[5]); CE_DESC(Lv[2], Lv[6]); CE_DESC(Lv[3], Lv[7]);
    CE_DESC(Lv[2], Lv[4]); CE_DESC(Lv[3], Lv[5]);
    CE_DESC(Lv[1], Lv[2]); CE_DESC(Lv[3], Lv[4]); CE_DESC(Lv[5], Lv[6]);
    float res = 0.f; const float NEG = -__builtin_inff();
#pragma unroll
    for (int k = 0; k < 16; ++k) {
        const float m = row_allmax(Lv[0]);
        res = (r16 == k) ? m : res;
        const bool win = (Lv[0] == m);
#pragma unroll
        for (int j = 0; j < 7; ++j) Lv[j] = win ? Lv[j + 1] : Lv[j];
        Lv[7] = win ? NEG : Lv[7];
    }
    return res;
}
__device__ __forceinline__ void p8_topk(Frame& F) {
    LAS unsigned char* L = F.lds;
    const int lane = F.lane, wave = F.wave, r16 = lane & 15, g4 = lane >> 4;
    for (int grp = F.bx; grp < 256; grp += F.G) {
        const int hd = grp & 7, widx = grp >> 3;
        __syncthreads();
        for (int idx = F.tid; idx < 2 * 128 * 16; idx += NTHR) { const int half = idx >> 11, row = (idx >> 4) & 127, c8 = idx & 15;
            const bf16_t* src = (half ? F.K2 : F.K1) + ((size_t)hd * PNK + row) * 128 + c8 * 8;
            *(LAS v4u*)(L + half * 34816 + row * 272 + c8 * 16) = *(const GAS v4u*)src; }
        __syncthreads();
        for (int it = wave; it < 32; it += NWAVES) {
            const int t0 = widx * 512 + it * 16;
            bf16x8 a1[4], a2[4];
            { const bf16_t* qp = F.QP + (size_t)(t0 + r16) * DM + hd * PQD + 8 * g4;
#pragma unroll
              for (int ks = 0; ks < 4; ++ks) { a1[ks] = *(const GAS bf16x8*)(qp + 32 * ks); a2[ks] = *(const GAS bf16x8*)(qp + 128 + 32 * ks); } }
            f32x4 s1[8], s2[8];
#pragma unroll
            for (int nt = 0; nt < 8; ++nt) { s1[nt] = (f32x4){0.f, 0.f, 0.f, 0.f}; s2[nt] = (f32x4){0.f, 0.f, 0.f, 0.f};
#pragma unroll
                for (int ks = 0; ks < 4; ++ks) {
                    const bf16x8 b1 = *(const LAS bf16x8*)(L + (16 * nt + r16) * 272 + (32 * ks + 8 * g4) * 2);
                    const bf16x8 b2 = *(const LAS bf16x8*)(L + 34816 + (16 * nt + r16) * 272 + (32 * ks + 8 * g4) * 2);
                    s1[nt] = __builtin_amdgcn_mfma_f32_16x16x32_bf16(a1[ks], b1, s1[nt], 0, 0, 0);
                    s2[nt] = __builtin_amdgcn_mfma_f32_16x16x32_bf16(a2[ks], b2, s2[nt], 0, 0, 0); } }
#pragma unroll
            for (int i = 0; i < 4; ++i) {
                float l1[8], l2[8];
#pragma unroll
                for (int nt = 0; nt < 8; ++nt) {
                    l1[nt] = bitsf((fbits(s1[nt][i]) & ~0x7Fu) | (unsigned)(16 * nt + r16));
                    l2[nt] = bitsf((fbits(s2[nt][i]) & ~0x7Fu) | (unsigned)(16 * nt + r16)); }
                __builtin_amdgcn_sched_barrier(0);
                const float v1 = row_top16(l1, r16); __builtin_amdgcn_sched_barrier(0);
                const float v2 = row_top16(l2, r16); __builtin_amdgcn_sched_barrier(0);
                float cnd[16];
#pragma unroll
                for (int bb = 0; bb < 16; ++bb) { const float w = __shfl(v2, bb, 16);
                    cnd[bb] = __builtin_bit_cast(float, (__builtin_bit_cast(unsigned, v1 + w) & ~0xFFu) | (unsigned)(r16 * 16 + bb)); }
                float fin = 0.f; const float NEG = -__builtin_inff();
#pragma unroll
                for (int k = 0; k < 16; ++k) {
                    const float m = row_allmax(cnd[0]);
                    fin = (r16 == k) ? m : fin;
                    const bool win = (cnd[0] == m);
#pragma unroll
                    for (int j = 0; j < 15; ++j) cnd[j] = win ? cnd[j + 1] : cnd[j];
                    cnd[15] = win ? NEG : cnd[15];
                }
                const unsigned fb = __builtin_bit_cast(unsigned, fin); const int ra = (fb >> 4) & 15, rb = fb & 15;
                const float pv1 = __shfl(v1, ra, 16), pv2 = __shfl(v2, rb, 16);
                const int i1 = __builtin_bit_cast(unsigned, pv1) & 0x7F, i2 = __builtin_bit_cast(unsigned, pv2) & 0x7F;
                const float vs = pv1 + pv2;
                const float mx = row_allmax(vs); const float ex = fexp(vs - mx); const float sm = row_allsum(ex);
                const size_t o = (size_t)(t0 + 4 * g4 + i) * NSEL + hd * PTOPK + r16;
                F.EIDX[o] = i1 * PNK + i2; F.EW[o] = ex / sm;
                __builtin_amdgcn_sched_barrier(0);
            }
        }
    }
}

#ifdef P8_NAIVE
__device__ __forceinline__ void p8_naive(Frame& F) {
    LAS float* base = (LAS float*)F.lds;
    if (F.tid < 64) {
        LAS float* sc = base + F.tid * 320; LAS int* ia = (LAS int*)(sc + 256); LAS int* ib = ia + 16;
        for (int pair = F.bx * 64 + F.tid; pair < T * PH; pair += F.G * 64) { const int t = pair >> 3, hd = pair & 7;
            for (int n = 0; n < 128; ++n) { float a = 0.f, b = 0.f;
                for (int d = 0; d < 128; ++d) { const float q1 = bf_lo((unsigned)F.QP[(size_t)t * DM + hd * 256 + d]), q2 = bf_lo((unsigned)F.QP[(size_t)t * DM + hd * 256 + 128 + d]);
                    a += q1 * F.peer_k1[((size_t)hd * 128 + n) * 128 + d]; b += q2 * F.peer_k2[((size_t)hd * 128 + n) * 128 + d]; }
                sc[n] = a; sc[128 + n] = b; }
            int na = 0, nb = 0;
            for (int n = 0; n < 128; ++n) { int c1 = 0, c2 = 0; for (int m = 0; m < 128; ++m) { c1 += (sc[m] > sc[n]) || (sc[m] == sc[n] && m < n); c2 += (sc[128 + m] > sc[128 + n]) || (sc[128 + m] == sc[128 + n] && m < n); }
                if (c1 < 16) ia[na++] = n; if (c2 < 16) ib[nb++] = n; }
            float bound = 1e30f; int pa = -1, pb = -1; float vs[16]; int ee[16];
            for (int r = 0; r < 16; ++r) { float mx = -1e30f; int ba = 0, bb = 0;
                for (int a = 0; a < 16; ++a) for (int b = 0; b < 16; ++b) { const float v = sc[ia[a]] + sc[128 + ib[b]];
                    const bool lt = v < bound || (v == bound && (ia[a] * 128 + ib[b]) > (pa * 128 + pb));
                    if (lt && (v > mx)) { mx = v; ba = ia[a]; bb = ib[b]; } }
                bound = mx; pa = ba; pb = bb; vs[r] = mx; ee[r] = ba * 128 + bb; }
            float sm = 0.f;
#pragma unroll
            for (int r = 0; r < 16; ++r) { vs[r] = expf(vs[r] - vs[0]); sm += vs[r]; }
#pragma unroll
            for (int r = 0; r < 16; ++r) { F.EIDX[(size_t)t * NSEL + hd * 16 + r] = ee[r]; F.EW[(size_t)t * NSEL + hd * 16 + r] = vs[r] / sm; }
        }
    }
}
#endif
__device__ __forceinline__ void p9_peer(Frame& F) {
    const int lane = F.lane; const int gw = F.vcu * NWAVES + F.wave, NGW = F.G * NWAVES;
    for (int t = gw; t < T; t += NGW) {
        const int b = t >> 12;
        float hf[32];
        { const GAS v4u* hp = (const GAS v4u*)(F.H + (size_t)t * DM) + 2 * lane;
#pragma unroll
          for (int j = 0; j < 2; ++j) { const v4u a = hp[128 * j], bq = hp[128 * j + 1]; const unsigned dd[8] = {a.x, a.y, a.z, a.w, bq.x, bq.y, bq.z, bq.w};
#pragma unroll
              for (int c = 0; c < 8; ++c) { hf[16 * j + 2 * c] = bf_lo(dd[c]); hf[16 * j + 2 * c + 1] = bf_hi(dd[c]); } } }
        float y[32];
#pragma unroll
        for (int e = 0; e < 32; ++e) y[e] = 0.f;
        const int* ei = F.EIDX + (size_t)t * NSEL; const float* ew = F.EW + (size_t)t * NSEL;
        for (int e0 = 0; e0 < NSEL; e0 += 4) {
            int ex[4]; float wt[4], us[4], vs[4];
#pragma unroll
            for (int q = 0; q < 4; ++q) { ex[q] = __builtin_amdgcn_readfirstlane(ei[e0 + q]); const float w_ = ew[e0 + q]; wt[q] = bitsf((unsigned)__builtin_amdgcn_readfirstlane((int)fbits(w_))); }
            v4u ur[4][2], vr[4][2];
#pragma unroll
            for (int q = 0; q < 4; ++q) { const GAS v4u* up = (const GAS v4u*)(F.U8 + (size_t)ex[q] * DM) + lane; ur[q][0] = up[0]; ur[q][1] = up[64]; }
#pragma unroll
            for (int q = 0; q < 4; ++q) { const GAS v4u* vp = (const GAS v4u*)(F.V8 + (size_t)ex[q] * DM) + lane; vr[q][0] = vp[0]; vr[q][1] = vp[64]; }
#pragma unroll
            for (int q = 0; q < 4; ++q) { us[q] = F.USC[ex[q]]; vs[q] = F.VSC[ex[q]]; }
            float d[4];
#pragma unroll
            for (int q = 0; q < 4; ++q) { float c0 = 0.f, c1 = 0.f;
#pragma unroll
                for (int j = 0; j < 2; ++j) { const unsigned dd[4] = {ur[q][j].x, ur[q][j].y, ur[q][j].z, ur[q][j].w};
#pragma unroll
                    for (int c = 0; c < 4; ++c) { const f32x2 lo = __builtin_amdgcn_cvt_pk_f32_fp8((int)dd[c], false), hi = __builtin_amdgcn_cvt_pk_f32_fp8((int)dd[c], true);
                        c0 = fmaf(lo[0], hf[16 * j + 4 * c], c0); c1 = fmaf(lo[1], hf[16 * j + 4 * c + 1], c1); c0 = fmaf(hi[0], hf[16 * j + 4 * c + 2], c0); c1 = fmaf(hi[1], hf[16 * j + 4 * c + 3], c1); } }
                d[q] = (c0 + c1) * us[q]; }
            const bool hi = lane >= 32, b4 = (lane & 16) != 0;
            float k0 = hi ? d[2] : d[0], k1 = hi ? d[3] : d[1]; const float x0 = hi ? d[0] : d[2], x1 = hi ? d[1] : d[3];
            k0 += __shfl_xor(x0, 32); k1 += __shfl_xor(x1, 32);
            float k = b4 ? k1 : k0; const float xs = b4 ? k0 : k1;
            k += __shfl_xor(xs, 16);
            k += __shfl_xor(k, 8); k += __shfl_xor(k, 4); k += __shfl_xor(k, 2); k += __shfl_xor(k, 1);
            const float g = gelu_tanh(k);
            float act[4];
            act[0] = bitsf((unsigned)__builtin_amdgcn_readlane((int)fbits(g), 0)) * (wt[0] * vs[0]);
            act[1] = bitsf((unsigned)__builtin_amdgcn_readlane((int)fbits(g), 16)) * (wt[1] * vs[1]);
            act[2] = bitsf((unsigned)__builtin_amdgcn_readlane((int)fbits(g), 32)) * (wt[2] * vs[2]);
            act[3] = bitsf((unsigned)__builtin_amdgcn_readlane((int)fbits(g), 48)) * (wt[3] * vs[3]);
#pragma unroll
            for (int q = 0; q < 4; ++q)
#pragma unroll
                for (int j = 0; j < 2; ++j) { const unsigned dd[4] = {vr[q][j].x, vr[q][j].y, vr[q][j].z, vr[q][j].w};
#pragma unroll
                    for (int c = 0; c < 4; ++c) { const f32x2 lo = __builtin_amdgcn_cvt_pk_f32_fp8((int)dd[c], false), hh = __builtin_amdgcn_cvt_pk_f32_fp8((int)dd[c], true);
                        y[16 * j + 4 * c] = fmaf(act[q], lo[0], y[16 * j + 4 * c]); y[16 * j + 4 * c + 1] = fmaf(act[q], lo[1], y[16 * j + 4 * c + 1]);
                        y[16 * j + 4 * c + 2] = fmaf(act[q], hh[0], y[16 * j + 4 * c + 2]); y[16 * j + 4 * c + 3] = fmaf(act[q], hh[1], y[16 * j + 4 * c + 3]); } }
        }
        float* op = F.out + (size_t)t * DM; const float* ga = F.MOD + (size_t)b * NADA + 5 * DM;
        float ss = 0.f;
#pragma unroll
        for (int j = 0; j < 2; ++j)
#pragma unroll
            for (int c = 0; c < 4; ++c) { const int col = 16 * (lane + 64 * j) + 4 * c;
                const f32x4 xa = *(const GAS f32x4*)(op + col), g4v = *(const GAS f32x4*)(ga + col);
#pragma unroll
                for (int i = 0; i < 4; ++i) { const float v = xa[i] + g4v[i] * y[16 * j + 4 * c + i]; y[16 * j + 4 * c + i] = v; ss += v * v; } }
        const float rstd = __builtin_amdgcn_rsqf(wave_sum(ss) * (1.f / DM) + EPS);
#pragma unroll
        for (int j = 0; j < 2; ++j)
#pragma unroll
            for (int c = 0; c < 4; ++c) { const int col = 16 * (lane + 64 * j) + 4 * c; const f32x4 gf = *(const GAS f32x4*)(F.g_final + col); f32x4 o;
#pragma unroll
                for (int i = 0; i < 4; ++i) o[i] = y[16 * j + 4 * c + i] * rstd * gf[i];
                *(GAS f32x4*)(op + col) = o; }
    }
}

#ifdef DBG_UPTO
__device__ __forceinline__ unsigned dhash(unsigned x) { x ^= x >> 16; x *= 0x7feb352du; x ^= x >> 15; x *= 0x846ca68bu; x ^= x >> 16; return x; }
__device__ __forceinline__ float dbf(const bf16_t* p, size_t i) { return __builtin_bit_cast(float, (unsigned)p[i] << 16); }
__device__ __forceinline__ float dsilu(float v) { return v / (1.f + expf(-v)); }
__device__ __forceinline__ float dgelu(float x) { return 0.5f * x * (1.f + tanhf(0.7978845608028654f * (x + 0.044715f * x * x * x))); }
__global__ void __launch_bounds__(512) dbg_check(Args args, int upto) {
    __shared__ unsigned emax[20];
    __shared__ float sbuf[8][4096 + 128];
    const int tid = threadIdx.x, lane = tid & 63, wave = tid >> 6;
    if (tid < 20) emax[tid] = 0u;
    __syncthreads();
    const float* x = args.in[0]; const float* c = args.in[1]; const float* w_ada = args.in[2]; const float* b_ada = args.in[3]; const float* g_mix = args.in[4];
    const float* w_in = args.in[5]; const float* b_f = args.in[6]; const float* conv_w = args.in[7]; const float* conv_b = args.in[8];
    const float* lru_w_a = args.in[9]; const float* lru_b_a = args.in[10]; const float* lru_w_x = args.in[11]; const float* lru_b_x = args.in[12]; const float* lru_lambda = args.in[13];
    const float* g_attn_out = args.in[14]; const float* g_lru_out = args.in[15]; const float* w_out = args.in[16];
    unsigned char* ws = args.ws; float* out = args.out;
    const float* MOD = (const float*)(ws + WS_MOD); const float* LF = (const float*)(ws + WS_LF); const float* KB = (const float*)(ws + WS_KB); const float* SUMM = (const float*)(ws + WS_SUMM);
    const bf16_t* H = (const bf16_t*)(ws + WS_H); const bf16_t* Q = (const bf16_t*)(ws + WS_Q); const bf16_t* K = (const bf16_t*)(ws + WS_K); const bf16_t* V = (const bf16_t*)(ws + WS_VV);
    const bf16_t* LX = (const bf16_t*)(ws + WS_LX); const bf16_t* GLY = (const bf16_t*)(ws + WS_GLY); const bf16_t* MRG = (const bf16_t*)(ws + WS_MRG);
#define REPORT(k, e) atomicMax(&emax[k], __float_as_uint(fminf(fmaxf((e), 0.f), 1e30f)))
    if (upto >= 1) { const int b = tid & 3, col = dhash(tid * 7 + 1) % NADA; float s = 0.f;
        for (int k = 0; k < DM; ++k) s += dsilu(c[b * DM + k]) * w_ada[(size_t)k * NADA + col];
        s += b_ada[col]; REPORT(1, fabsf(MOD[b * NADA + col] - s) / (2e-3f * (fabsf(s) + 0.05f))); }
    if (upto >= 2 && upto < 7) { const int row = dhash(tid * 13 + 5) % T, col = dhash(tid * 17 + 3) % DM, b = row >> 12; float ss = 0.f;
        for (int k = 0; k < DM; ++k) { const float v = x[(size_t)row * DM + k]; ss += v * v; }
        const float rstd = 1.f / sqrtf(ss / DM + EPS);
        const float h = x[(size_t)row * DM + col] * rstd * g_mix[col] * (1.f + MOD[b * NADA + DM + col]) + MOD[b * NADA + col];
        REPORT(2, fabsf(dbf(H, (size_t)row * DM + col) - h) / (1e-2f * (fabsf(h) + 0.1f)));
        const int j = tid & 7; float z = b_f[j];
        for (int k = 0; k < DM; ++k) z += dbf(H, (size_t)row * DM + k) * w_in[(size_t)k * INC + OFF_F + j];
        const float lf = fminf(z, 0.f) - log1pf(expf(-fabsf(z)));
        REPORT(3, fabsf(LF[(size_t)(b * NH + j) * SEQ + (row & (SEQ - 1))] - lf) / 2e-2f); }
    if (upto >= 3 && upto < 7) { const int row = dhash(tid * 19 + 11) % T, coln = dhash(tid * 23 + 7) % 5120, b = row >> 12, s = row & 4095;
        const int src = coln < 3072 ? coln : coln + 8; float v = 0.f;
        for (int k = 0; k < DM; ++k) v += dbf(H, (size_t)row * DM + k) * w_in[(size_t)k * INC + src];
        const int cat = coln >> 10, cc = coln & 1023; float got;
        if (cat < 3) { const bf16_t* base = cat == 0 ? Q : (cat == 1 ? K : V); got = dbf(base, ((size_t)((b * 8 + (cc >> 7)) * 4096 + s)) * 128 + (cc & 127)); }
        else if (cat == 3) got = dbf(LX, (size_t)row * 1024 + cc);
        else { got = dbf(GLY, (size_t)row * 1024 + cc); v = dgelu(v); }
        REPORT(4 + (cat == 4 ? 1 : 0) + (cat == 3 ? 2 : 0), fabsf(got - v) / (3e-2f * (fabsf(v) + 0.3f)));
        if (tid < 32) { float cum = 0.f, e = 0.f;
            for (int t = 0; t < SEQ; ++t) { cum += LF[(size_t)tid * SEQ + t]; e = fmaxf(e, fabsf(KB[(size_t)tid * SEQ + t] * (-0.08838834764831845f) - cum) / (1e-3f * (fabsf(cum) + 1.f))); }
            REPORT(7, e); } }
    if (upto >= 4) {
        for (int smp = 0; smp < 4; ++smp) { const unsigned hsh = dhash((wave * 4 + smp) * 31 + 17); const int bh = hsh & 31, t = (smp == 0) ? (int)((hsh >> 5) & 255) : (int)((hsh >> 5) & 4095); const int b = bh >> 3, h = bh & 7;
            float* lg = sbuf[wave]; float* qs = lg + 4096;
            qs[lane] = dbf(Q, ((size_t)bh * SEQ + t) * HD + lane); qs[64 + lane] = dbf(Q, ((size_t)bh * SEQ + t) * HD + 64 + lane);
            __builtin_amdgcn_wave_barrier();
            float mx = -1e30f;
            for (int s = lane; s <= t; s += 64) { float d = 0.f; for (int k = 0; k < HD; ++k) d += qs[k] * dbf(K, ((size_t)bh * SEQ + s) * HD + k);
                const float l = d * 0.08838834764831845f + KB[(size_t)bh * SEQ + s] * 0.08838834764831845f; lg[s] = l; mx = fmaxf(mx, l); }
            for (int o = 1; o < 64; o <<= 1) mx = fmaxf(mx, __shfl_xor(mx, o));
            float sm = 0.f;
            for (int s = lane; s <= t; s += 64) { const float p = expf(lg[s] - mx); lg[s] = p; sm += p; }
            for (int o = 1; o < 64; o <<= 1) sm += __shfl_xor(sm, o);
            __builtin_amdgcn_wave_barrier();
            float o0 = 0.f, o1 = 0.f;
            for (int s = 0; s <= t; ++s) { const float p = lg[s]; o0 += p * dbf(V, ((size_t)bh * SEQ + s) * HD + lane); o1 += p * dbf(V, ((size_t)bh * SEQ + s) * HD + 64 + lane); }
            o0 /= sm; o1 /= sm;
            if (upto == 4) {
                const float g0 = dbf(MRG, ((size_t)b * SEQ + t) * DM + h * HD + lane), g1 = dbf(MRG, ((size_t)b * SEQ + t) * DM + h * HD + 64 + lane);
                REPORT(8, fmaxf(fabsf(g0 - o0) / (3e-2f * (fabsf(o0) + 0.3f)), fabsf(g1 - o1) / (3e-2f * (fabsf(o1) + 0.3f)))); }
            __builtin_amdgcn_wave_barrier();
        }
        { const unsigned hsh = dhash(tid * 37 + 29); const int b = hsh & 3, chunk = (hsh >> 2) & 63, ch = (hsh >> 8) & 1023, n = ch >> 7, j = ch & 127;
          const float sp = log1pf(expf(-lru_lambda[ch])) ;
          float P = 1.f, Hh = 0.f;
          for (int tt = 0; tt < 64; ++tt) { const int s = chunk * 64 + tt; float ga = lru_b_a[ch], gx = lru_b_x[ch], xcj = 0.f;
              for (int i = 0; i < 128; ++i) { float xc = conv_b[n * 128 + i];
                  for (int k = 0; k < 4; ++k) { const int ss = s - 3 + k; if (ss >= 0) xc += conv_w[k * LW + n * 128 + i] * dbf(LX, ((size_t)b * SEQ + ss) * LW + n * 128 + i); }
                  ga += xc * lru_w_a[((size_t)n * 128 + i) * 128 + j]; gx += xc * lru_w_x[((size_t)n * 128 + i) * 128 + j]; if (i == j) xcj = xc; }
              const float r = 1.f / (1.f + expf(-ga)), ig = 1.f / (1.f + expf(-gx)); const float la = -8.f * r * sp; const float a = expf(la);
              const float bt = sqrtf(-expm1f(2.f * la)) * (ig * xcj); Hh = a * Hh + bt; P *= a; }
          const float gp = SUMM[(((size_t)(b * 64 + chunk)) * LW + ch) * 2], gh = SUMM[(((size_t)(b * 64 + chunk)) * LW + ch) * 2 + 1];
          REPORT(9, fmaxf(fabsf(gp - P) / (2e-2f * (fabsf(P) + 0.01f)), fabsf(gh - Hh) / (3e-2f * (fabsf(Hh) + 0.05f)))); }
    }
    if (upto >= 5) { const int row = dhash(tid * 41 + 3) % T; float sa = 0.f, sl = 0.f;
        for (int k = 0; k < 1024; ++k) { const float a = dbf(MRG, (size_t)row * DM + k), l = dbf(MRG, (size_t)row * DM + 1024 + k); sa += a * a; sl += l * l; }
        REPORT(10, fmaxf(fabsf(sa / 1024.f - 1.f), fabsf(sl / 1024.f - 1.f)) / 2e-2f);
        if (tid < 64) { const int pr = tid >> 1; const int b = pr & 3, ch = dhash(tid * 43 + 1) & 1023, n = ch >> 7, j = ch & 127, tend = 70 + (pr >> 2) * 8;
            const float sp = log1pf(expf(-lru_lambda[ch])); float hcur = 0.f;
            for (int s = 0; s <= tend; ++s) { float ga = lru_b_a[ch], gx = lru_b_x[ch], xcj = 0.f;
                for (int i = 0; i < 128; ++i) { float xc = conv_b[n * 128 + i];
                    for (int k = 0; k < 4; ++k) { const int ss = s - 3 + k; if (ss >= 0) xc += conv_w[k * LW + n * 128 + i] * dbf(LX, ((size_t)b * SEQ + ss) * LW + n * 128 + i); }
                    ga += xc * lru_w_a[((size_t)n * 128 + i) * 128 + j]; gx += xc * lru_w_x[((size_t)n * 128 + i) * 128 + j]; if (i == j) xcj = xc; }
                const float r = 1.f / (1.f + expf(-ga)), ig = 1.f / (1.f + expf(-gx)); const float la = -8.f * r * sp; const float a = expf(la);
                hcur = a * hcur + sqrtf(-expm1f(2.f * la)) * (ig * xcj); }
            sbuf[0][tid] = hcur * dbf(GLY, ((size_t)b * SEQ + tend) * LW + ch);
            sbuf[1][tid] = dbf(MRG, ((size_t)b * SEQ + tend) * DM + 1024 + ch); }
        __syncthreads();
        if (tid < 64 && (tid & 1) == 0) {
            const float r0 = sbuf[0][tid], r1 = sbuf[0][tid + 1], k0 = sbuf[1][tid], k1 = sbuf[1][tid + 1];
            REPORT(11, fabsf(r0 * k1 - r1 * k0) / (5e-2f * (fabsf(r0 * k1) + fabsf(r1 * k0) + 1e-3f))); }
    }
    if (upto >= 6 && upto < 10) { const int row = dhash(tid * 47 + 9) % T, col = dhash(tid * 53 + 13) % DM, b = row >> 12; float v = 0.f;
        for (int k = 0; k < DM; ++k) v += dbf(MRG, (size_t)row * DM + k) * w_out[(size_t)k * DM + col] * (k < 1024 ? g_attn_out[k] : g_lru_out[k - 1024]);
        const float x1 = x[(size_t)row * DM + col] + MOD[b * NADA + 2 * DM + col] * v;
        REPORT(12, fabsf(out[(size_t)row * DM + col] - x1) / (2e-2f * (fabsf(x1) + 0.2f))); }
    const float* g_ffn = args.in[17]; const float* w_q = args.in[18]; const float* pk1 = args.in[19]; const float* pk2 = args.in[20]; const float* pu = args.in[21]; const float* pv = args.in[22]; const float* g_final = args.in[23];
    const bf16_t* QP = (const bf16_t*)(ws + WS_QP); const int* EIDX = (const int*)(ws + WS_EIDX); const float* EW = (const float*)(ws + WS_EW);
    if (upto >= 7 && upto < 10) { const int row = dhash(tid * 59 + 5) % T, col = dhash(tid * 61 + 3) % DM, b = row >> 12; float ss = 0.f;
        for (int k = 0; k < DM; ++k) { const float v = out[(size_t)row * DM + k]; ss += v * v; }
        const float rstd = 1.f / sqrtf(ss / DM + EPS);
        const float h = out[(size_t)row * DM + col] * rstd * g_ffn[col] * (1.f + MOD[b * NADA + 4 * DM + col]) + MOD[b * NADA + 3 * DM + col];
        REPORT(13, fabsf(dbf(H, (size_t)row * DM + col) - h) / (1e-2f * (fabsf(h) + 0.1f))); }
    if (upto >= 8) { const int row = dhash(tid * 67 + 11) % T, col = dhash(tid * 71 + 7) % DM; float v = 0.f;
        for (int k = 0; k < DM; ++k) v += dbf(H, (size_t)row * DM + k) * w_q[(size_t)k * DM + col];
        REPORT(14, fabsf(dbf(QP, (size_t)row * DM + col) - v) / (3e-2f * (fabsf(v) + 0.3f))); }
    __syncthreads();
    if (upto >= 9 && tid < 64) { float* sc = &sbuf[0][0] + tid * 256; const unsigned hsh = dhash(tid * 73 + 19); const int t = hsh % T, hd = (hsh >> 16) & 7;
        for (int n = 0; n < 128; ++n) { float a = 0.f, bsum = 0.f;
            for (int d = 0; d < 128; ++d) { a += dbf(QP, (size_t)t * DM + hd * 256 + d) * dbf((const bf16_t*)(ws + WS_K1), ((size_t)hd * 128 + n) * 128 + d); bsum += dbf(QP, (size_t)t * DM + hd * 256 + 128 + d) * dbf((const bf16_t*)(ws + WS_K2), ((size_t)hd * 128 + n) * 128 + d); }
            sc[n] = a; sc[128 + n] = bsum; }
        float th1 = 0.f, th2 = 0.f;
        for (int n = 0; n < 128; ++n) { int c1 = 0, c2 = 0; for (int m = 0; m < 128; ++m) { c1 += sc[m] > sc[n]; c2 += sc[128 + m] > sc[128 + n]; } if (c1 == 15) th1 = sc[n]; if (c2 == 15) th2 = sc[128 + n]; }
        float best16 = -1e30f;
        {
          float bound = 1e30f;
          for (int r = 0; r < 16; ++r) { float mx = -1e30f;
              for (int a = 0; a < 128; ++a) if (sc[a] >= th1) for (int bq = 0; bq < 128; ++bq) if (sc[128 + bq] >= th2) { const float v = sc[a] + sc[128 + bq]; if (v < bound && v > mx) mx = v; }
              bound = mx; }
          best16 = bound; }
        float e = 0.f, e2 = 0.f, e3 = 0.f, mxs = -1e30f;
        for (int k = 0; k < 16; ++k) { const int ex = EIDX[(size_t)t * NSEL + hd * 16 + k]; const int i1 = ex >> 7, i2 = ex & 127;
            if (ex < 0 || ex >= NEXP) { e3 = 1e6f; continue; }
            const float v = sc[i1] + sc[128 + i2]; mxs = fmaxf(mxs, v);
            e = fmaxf(e, (best16 - v) / 3e-2f);
            for (int k2 = 0; k2 < k; ++k2) if (EIDX[(size_t)t * NSEL + hd * 16 + k2] == ex) e3 = 1e5f; }
        float sm = 0.f; for (int k = 0; k < 16; ++k) { const int ex = EIDX[(size_t)t * NSEL + hd * 16 + k] & (NEXP - 1); sm += expf(sc[ex >> 7] + sc[128 + (ex & 127)] - mxs); }
        for (int k = 0; k < 16; ++k) { const int ex = EIDX[(size_t)t * NSEL + hd * 16 + k] & (NEXP - 1); const float w = expf(sc[ex >> 7] + sc[128 + (ex & 127)] - mxs) / sm;
            e2 = fmaxf(e2, fabsf(EW[(size_t)t * NSEL + hd * 16 + k] - w) / (3e-2f * (w + 0.02f))); }
        REPORT(15, e); REPORT(17, e2); REPORT(18, e3); }
    __syncthreads();
    if (upto >= 10) {
        for (int smp = 0; smp < 2; ++smp) { const int row = dhash((wave * 2 + smp) * 79 + 23) % T, b = row >> 12;
            float x2[32]; float ss = 0.f;
#pragma unroll 1
            for (int j = 0; j < 32; ++j) { const int col = lane + 64 * j; float v = 0.f;
                for (int k = 0; k < DM; ++k) v += dbf(MRG, (size_t)row * DM + k) * w_out[(size_t)k * DM + col] * (k < 1024 ? g_attn_out[k] : g_lru_out[k - 1024]);
                sbuf[wave][col] = x[(size_t)row * DM + col] + MOD[b * NADA + 2 * DM + col] * v; }
            for (int j = 0; j < 32; ++j) sbuf[wave][2048 + lane + 64 * j] = 0.f;
            for (int e = 0; e < NSEL; ++e) { const int ex = EIDX[(size_t)row * NSEL + e] & (NEXP - 1); const float w = EW[(size_t)row * NSEL + e]; float d = 0.f;
                for (int j = 0; j < 32; ++j) { const int col = lane + 64 * j; d += dbf(H, (size_t)row * DM + col) * pu[(size_t)ex * DM + col]; }
                for (int o = 1; o < 64; o <<= 1) d += __shfl_xor(d, o);
                const float act = dgelu(d) * w;
                for (int j = 0; j < 32; ++j) { const int col = lane + 64 * j; sbuf[wave][2048 + col] += act * pv[(size_t)ex * DM + col]; } }
            for (int j = 0; j < 32; ++j) { const int col = lane + 64 * j; const float v = sbuf[wave][col] + MOD[b * NADA + 5 * DM + col] * sbuf[wave][2048 + col]; sbuf[wave][col] = v; ss += v * v; }
            for (int o = 1; o < 64; o <<= 1) ss += __shfl_xor(ss, o);
            const float rstd = 1.f / sqrtf(ss / DM + EPS); float e = 0.f;
            for (int j = 0; j < 32; ++j) { const int col = lane + 64 * j; const float r = sbuf[wave][col] * rstd * g_final[col]; e = fmaxf(e, fabsf(out[(size_t)row * DM + col] - r) / (3e-2f * (fabsf(r) + 0.3f))); }
            REPORT(16, e); (void)x2; }
    }
    __syncthreads();
    for (size_t i = tid; i < (size_t)T * DM; i += 512) out[i] = 0.f;
    __syncthreads();
    if (tid == 0) { float code = 0.f;
        for (int k = 18; k >= 1; --k) if (k != 16 && __uint_as_float(emax[k]) > 1.f) code = powf(10.f, (float)(k + 1)) * fminf(9.9f, 1.f + log10f(__uint_as_float(emax[k])));
        out[0] = code; }
}
#endif

__global__ void __launch_bounds__(NWAVES * 64, 2) hymba_fwd(Args args) {
    unsigned char* const lds = g_lds;
    Frame F;
    F.lds = (LAS unsigned char*)lds;
    F.MISC = (volatile LAS unsigned*)(F.lds + MISC_OFF);
    { const int t0_ = (int)__builtin_amdgcn_workitem_id_x();
      F.wave = __builtin_amdgcn_readfirstlane(t0_ >> 6); }
    F.tid = ktid(F.wave); F.lane = F.tid & 63;
    for (int u = F.tid; u < (LDS_BYTES - LDSCTL_OFF) / 4; u += NWAVES * 64) ((LAS unsigned*)(F.lds + LDSCTL_OFF))[u] = 0u;
    __syncthreads();
    F.G = gridDim.x; F.bx = blockIdx.x; { const int bx = blockIdx.x; F.vcu = (F.G % 8 == 0) ? (bx % 8) * (F.G / 8) + bx / 8 : bx; }
    unsigned char* ws0 = args.ws;
    F.ctl = (gu32*)(ws0 + WS_CTL);
#define FILL_PTRS(F) do { const __attribute__((address_space(4))) void* kp_ = (const __attribute__((address_space(4))) void*)__builtin_amdgcn_kernarg_segment_ptr(); asm volatile("" : "+s"(kp_)); \
    const float* const __attribute__((address_space(4)))* in_ = (const float* const __attribute__((address_space(4)))*)kp_; \
    unsigned char* ws = (unsigned char*)in_[25]; \
    { int t_ = ktid(F.wave); asm volatile("" : "+v"(t_)); F.tid = t_; F.lane = t_ & 63; } \
    F.x = in_[0]; F.c = in_[1]; F.w_ada = in_[2]; F.b_ada = in_[3]; F.g_mix = in_[4]; F.w_in = in_[5]; F.b_f = in_[6]; \
    F.conv_w = in_[7]; F.conv_b = in_[8]; F.lru_w_a = in_[9]; F.lru_b_a = in_[10]; F.lru_w_x = in_[11]; F.lru_b_x = in_[12]; \
    F.lru_lambda = in_[13]; F.g_attn_out = in_[14]; F.g_lru_out = in_[15]; F.w_out = in_[16]; F.g_ffn = in_[17]; \
    F.peer_w_q = in_[18]; F.peer_k1 = in_[19]; F.peer_k2 = in_[20]; F.peer_u = in_[21]; F.peer_v = in_[22]; F.g_final = in_[23]; \
    F.out = (float*)in_[24]; \
    F.MOD = (float*)(ws + WS_MOD); F.LF = (float*)(ws + WS_LF); F.KB = (float*)(ws + WS_KB); F.SUMM = (float*)(ws + WS_SUMM); \
    F.EW = (float*)(ws + WS_EW); F.EIDX = (int*)(ws + WS_EIDX); \
    F.WLRU = (bf16_t*)(ws + WS_WLRU); F.K1 = (bf16_t*)(ws + WS_K1); F.K2 = (bf16_t*)(ws + WS_K2); F.WIN = (bf16_t*)(ws + WS_WIN); \
    F.WOUT = (bf16_t*)(ws + WS_WOUT); F.WQ = (bf16_t*)(ws + WS_WQ); F.U8 = ws + WS_U; F.V8 = ws + WS_V; F.USC = (float*)(ws + WS_USC); F.VSC = (float*)(ws + WS_VSC); \
    F.H = (bf16_t*)(ws + WS_H); F.Q = (bf16_t*)(ws + WS_Q); F.K = (bf16_t*)(ws + WS_K); F.VV = (bf16_t*)(ws + WS_VV); F.QP = (bf16_t*)(ws + WS_QP); \
    F.LX = (bf16_t*)(ws + WS_LX); F.GLY = (bf16_t*)(ws + WS_GLY); F.MRG = (bf16_t*)(ws + WS_MRG); } while (0)
    XcdBarrier bar; bar.bar = (unsigned*)(F.ctl + CW_BAR); bar.x = 0; bar.st = nullptr;
    if (N_LAUNCHES == 1) bar = xcd_barrier_post((unsigned*)(F.ctl + CW_BAR), F.MISC + 8, F.wave);
#define GRID_BAR() do { if (N_LAUNCHES == 1) xcd_barrier(bar, F.wave); } while (0)
    const int lo = args.ph_lo, hi = args.ph_hi;
#ifndef PHASE_MASK
#define PHASE_MASK 0x3ff
#endif
#define IN(k) (((PHASE_MASK >> (k)) & 1) && lo <= (k) && (k) < hi)
#define BOTH(k) (IN(k) && IN((k) + 1))

    if (IN(0)) { FILL_PTRS(F); p0_prologue(F); if (BOTH(0)) GRID_BAR(); }
    if (IN(1)) { FILL_PTRS(F); p_modnorm<true>(F, F.x, F.g_mix, 0, DM); if (BOTH(1)) GRID_BAR(); }
    if (IN(2)) {
        FILL_PTRS(F); p2_cumsum(F); __syncthreads();
        pg8::Gemm g{F.H, F.WIN, T, 5120, DM}; pg8::StaticOrder S; S.init(T, 5120, F.G, (int)blockIdx.x);
        pg8::EpiProj E{F.Q};
        pg8::gemm_phase<pg8::EpiProj, pg8::StaticOrder, true, true>(F.lds + RING_OFF, g, S, E, F.wave);
        if (BOTH(2)) GRID_BAR();
    }
    if (IN(3)) {
        FILL_PTRS(F);
#ifndef NO_ATT
        p3_attention(F, (char*)lds + RING_OFF);
#endif
#ifndef NO_LRUA
        for (int u = F.vcu; u < BATCH * 64; u += F.G) lru_unit<false>(F, u >> 6, u & 63);
#endif
        if (BOTH(3)) GRID_BAR();
    }
    if (IN(4)) {
        FILL_PTRS(F);
        for (int u = F.vcu; u < BATCH * 64; u += F.G) lru_unit<true>(F, u >> 6, u & 63);
        if (BOTH(4)) GRID_BAR();
    }
    if (IN(5)) {
        FILL_PTRS(F);
        pg8::Gemm g{F.MRG, F.WOUT, T, DM, DM}; pg8::StaticOrder S; S.init(T, DM, F.G, (int)blockIdx.x);
        pg8::EpiRes E{F.x, F.out, DM, F.MOD + 2 * DM, NADA};
        pg8::gemm_phase<pg8::EpiRes, pg8::StaticOrder, true, true>(F.lds + RING_OFF, g, S, E, F.wave);
        if (BOTH(5)) GRID_BAR();
    }
    if (IN(6)) { FILL_PTRS(F); p_modnorm<false>(F, F.out, F.g_ffn, 3 * DM, 4 * DM); if (BOTH(6)) GRID_BAR(); }
    if (IN(7)) {
        FILL_PTRS(F);
        pg8::Gemm g{F.H, F.WQ, T, DM, DM}; pg8::StaticOrder S; S.init(T, DM, F.G, (int)blockIdx.x);
        pg8::EpiPlain E{F.QP, DM};
        pg8::gemm_phase<pg8::EpiPlain, pg8::StaticOrder, true, true>(F.lds + RING_OFF, g, S, E, F.wave);
        if (BOTH(7)) GRID_BAR();
    }
    #ifdef P8_NAIVE
    if (IN(8)) { FILL_PTRS(F); p8_naive(F); }
#else
    if (IN(8)) { FILL_PTRS(F); p8_topk(F); if (BOTH(8)) GRID_BAR(); }
#endif
    if (IN(9)) { FILL_PTRS(F); p9_peer(F); }
#undef IN
#undef BOTH
#undef GRID_BAR
}

extern "C" void kernel_launch(void* const* d_in, const int* in_sizes, int n_in, void* d_out, int out_size, void* d_ws, size_t ws_size, hipStream_t stream) {
    static int grid = 0;
    if (grid == 0) {
        if (n_in != 24 || in_sizes[0] != T * DM || out_size != T * DM || ws_size < WS_END) {
            fprintf(stderr, "kernel_launch: built for 24 inputs, x/out of %d floats, >= %zu bytes of workspace; got n_in %d, in0 %d, out %d, ws %zu; nothing launched\n", T * DM, (size_t)WS_END, n_in, n_in > 0 ? in_sizes[0] : -1, out_size, ws_size); grid = -1; return; }
        int dev = 0, cus = 0, per_cu = 0;
        if (hipGetDevice(&dev) != hipSuccess || hipDeviceGetAttribute(&cus, hipDeviceAttributeMultiprocessorCount, dev) != hipSuccess) { fprintf(stderr, "kernel_launch: device query failed\n"); grid = -1; return; }
        if (hipFuncSetAttribute((const void*)hymba_fwd, hipFuncAttributeMaxDynamicSharedMemorySize, LDS_BYTES) != hipSuccess) { fprintf(stderr, "kernel_launch: hipFuncSetAttribute failed\n"); grid = -1; return; }
        if (hipOccupancyMaxActiveBlocksPerMultiprocessor(&per_cu, (const void*)hymba_fwd, NWAVES * 64, LDS_BYTES) != hipSuccess || per_cu < 1)
            fprintf(stderr, "kernel_launch: note: occupancy query reports %d workgroups per CU\n", per_cu);
        (void)hipGetLastError();
        grid = cus;
    }
    if (grid < 0) return;
    if (hipMemsetAsync((char*)d_ws + WS_CTL, 0, CTL_ZERO_BYTES, stream) != hipSuccess) { fprintf(stderr, "kernel_launch: hipMemsetAsync failed\n"); return; }
    Args a{};
    for (int i = 0; i < 24; ++i) a.in[i] = (const float*)d_in[i];
    a.out = (float*)d_out; a.ws = (unsigned char*)d_ws;
#ifdef DBG_UPTO
    static_assert(N_LAUNCHES == N_PHASES, "probe builds launch one kernel per phase");
    for (int li = 0; li < DBG_UPTO; ++li) {
#else
    for (int li = 0; li < N_LAUNCHES; ++li) {
#endif
        a.ph_lo = (N_LAUNCHES == 1) ? 0 : li; a.ph_hi = (N_LAUNCHES == 1) ? N_PHASES : li + 1; a.li = li;
        hipLaunchKernelGGL(hymba_fwd, dim3(grid), dim3(NWAVES * 64), LDS_BYTES, stream, a);
        const hipError_t le = hipPeekAtLastError();
        if (le != hipSuccess) { fprintf(stderr, "kernel_launch: launch %d failed: %s\n", li, hipGetErrorName(le)); break; }
    }
#ifdef DBG_UPTO
    hipLaunchKernelGGL(dbg_check, dim3(1), dim3(512), 0, stream, a, (int)DBG_UPTO);
#endif
}
```

```cpp
#include <hip/hip_runtime.h>
#include <hip/hip_bf16.h>
#include <cstdio>
#include <cstdint>

constexpr int BATCH = 4, SEQ = 4096, DM = 2048, T = BATCH * SEQ;
constexpr int AW = 1024, NH = 8, HD = 128, LW = 1024, NLB = 8, LBD = 128;
constexpr int INC = 5128, OFF_F = 3072, OFF_LX = 3080;
constexpr int PH = 8, PNK = 128, PQD = 256, PTOPK = 16, NEXP = 16384, NSEL = PH * PTOPK;
constexpr int NADA = 6 * DM;
constexpr float EPS = 1e-6f;
constexpr int NWAVES = 8, NTHR = 512;

#ifndef MK_N_LAUNCHES
#define MK_N_LAUNCHES 1
#endif
constexpr int N_PHASES = 13;
constexpr int N_LAUNCHES = MK_N_LAUNCHES;

constexpr size_t MiB = 1u << 20;
constexpr size_t WS_CTL = 0, CTL_ZERO_BYTES = 1 * MiB;
constexpr size_t WS_MOD = 1 * MiB;
constexpr size_t WS_LF = WS_MOD + 256 * 1024;
constexpr size_t WS_KB = WS_LF + 512 * 1024;
constexpr size_t WS_SUMM = WS_KB + 512 * 1024;
constexpr size_t WS_WLRU = 5 * MiB;
constexpr size_t WS_K1 = WS_WLRU + 512 * 1024;
constexpr size_t WS_K2 = WS_K1 + 256 * 1024;
constexpr size_t WS_WIN = 6 * MiB;
constexpr size_t WS_WOUT = 26 * MiB;
constexpr size_t WS_WQ = 34 * MiB;
constexpr size_t WS_U = 42 * MiB, WS_V = 106 * MiB;
constexpr size_t WS_USC = WS_SUMM + 2 * MiB, WS_VSC = WS_USC + 64 * 1024;
constexpr size_t WS_H = 170 * MiB;
constexpr size_t WS_Q = 234 * MiB, WS_K = 266 * MiB, WS_VV = 298 * MiB;
constexpr size_t WS_QP = 234 * MiB;
constexpr size_t WS_EIDX = 298 * MiB, WS_EW = 306 * MiB;
constexpr size_t WS_LX = 330 * MiB, WS_GLY = 362 * MiB;
constexpr size_t WS_MRG = 394 * MiB;
constexpr size_t WS_PD = 330 * MiB;
constexpr size_t WS_Y = 170 * MiB;
constexpr size_t WS_ACT = 314 * MiB;
constexpr size_t WS_END = 458 * MiB;
static_assert(WS_K == WS_Q + 32 * MiB && WS_VV == WS_Q + 64 * MiB && WS_LX == WS_Q + 96 * MiB && WS_GLY == WS_Q + 128 * MiB, "EpiProj: destinations 32 MiB apart");
constexpr int CW_BAR = 4096;

constexpr int RING_OFF = 0, RING_BYTES = 131072;
constexpr int LDSCTL_OFF = RING_BYTES, MISC_OFF = LDSCTL_OFF + 320;
constexpr int LDS_BYTES = 147456;
static_assert(MISC_OFF + 128 <= LDS_BYTES, "LDS map");

#define GAS __attribute__((address_space(1)))
#define LAS __attribute__((address_space(3)))
typedef unsigned short bf16_t;
typedef unsigned v4u __attribute__((ext_vector_type(4)));
typedef unsigned v2u __attribute__((ext_vector_type(2)));
typedef float f32x4 __attribute__((ext_vector_type(4)));
typedef float f32x2 __attribute__((ext_vector_type(2)));
typedef short bf16x8 __attribute__((ext_vector_type(8)));
typedef __bf16 bf16x2_t __attribute__((ext_vector_type(2)));
typedef GAS unsigned gu32;
#define RLX_AGENT __ATOMIC_RELAXED, __HIP_MEMORY_SCOPE_AGENT
#define LDS_WAIT() asm volatile("s_waitcnt lgkmcnt(0)" ::: "memory")
#define VM_WAIT() asm volatile("s_waitcnt vmcnt(0)" ::: "memory")

extern __shared__ __attribute__((aligned(16))) unsigned char g_lds[];
__device__ __forceinline__ int ktid(int kw) { int l; asm volatile("v_mbcnt_lo_u32_b32 %0, -1, 0\n\tv_mbcnt_hi_u32_b32 %0, -1, %0" : "=v"(l)); return kw * 64 + l; }
__device__ __forceinline__ unsigned fbits(float x) { return __builtin_bit_cast(unsigned, x); }
__device__ __forceinline__ float bitsf(unsigned x) { return __builtin_bit_cast(float, x); }
__device__ __forceinline__ bf16x2_t asbf2(unsigned x) { return __builtin_bit_cast(bf16x2_t, x); }
__device__ __forceinline__ unsigned f2bf(float f) { unsigned u = __builtin_bit_cast(unsigned, f); return (u + 0x7fffu + ((u >> 16) & 1u)) >> 16; }
__device__ __forceinline__ unsigned pk2(float lo, float hi) { f32x2 v = {lo, hi}; bf16x2_t b = __builtin_convertvector(v, bf16x2_t); return __builtin_bit_cast(unsigned, b); }
__device__ __forceinline__ float bf_lo(unsigned d) { return __builtin_bit_cast(float, d << 16); }
__device__ __forceinline__ float bf_hi(unsigned d) { return __builtin_bit_cast(float, d & 0xffff0000u); }
__device__ __forceinline__ float fexp(float x) { return __builtin_amdgcn_exp2f(x * 1.4426950408889634f); }
__device__ __forceinline__ float sigmoidf_(float z) { return __builtin_amdgcn_rcpf(1.f + fexp(-z)); }
__device__ __forceinline__ float gelu_tanh(float x) { const float z = x * (1.5957691216057308f + 0.07135481627260025f * x * x); return x * __builtin_amdgcn_rcpf(1.f + fexp(-z)); }
__device__ __forceinline__ float softplusf_(float z) { return fmaxf(z, 0.f) + log1pf(fexp(-fabsf(z))); }
__device__ __forceinline__ float wave_sum(float v) {
#pragma unroll
    for (int o = 1; o < 64; o <<= 1) v += __shfl_xor(v, o);
    return v;
}
#define XB_TMO      128
#define XB_XCNT(j)  (256  + 64 * (j))
#define XB_XSUB(j)  (1280 + 64 * (j))
#define XB_XGEN(j)  (2304 + 64 * (j))
#define XB_TOP      3328
#define XB_TOPGEN   3392
#define XCD_BAR_WORDS 3456
#define XB_SPIN_CAP (1u << 18)

__device__ __forceinline__ unsigned xb_ld(unsigned* p)              { return __hip_atomic_load(p, __ATOMIC_RELAXED, __HIP_MEMORY_SCOPE_AGENT); }
__device__ __forceinline__ unsigned xb_add(unsigned* p, unsigned v) { return __hip_atomic_fetch_add(p, v, __ATOMIC_RELAXED, __HIP_MEMORY_SCOPE_AGENT); }
__device__ __forceinline__ unsigned xb_xcc_id() { return (unsigned)__builtin_amdgcn_s_getreg((3 << 11) | 20) & 0xFu; }
#define XB_SPIN(cond, bar) do { unsigned _sp = 0; while (cond) { __builtin_amdgcn_s_sleep(1); \
    if ((++_sp & 255u) == 0u) { if (xb_ld(&(bar)[XB_TMO])) break; if (_sp > XB_SPIN_CAP) { atomicAdd(&(bar)[XB_TMO], 1u); break; } } } } while (0)

struct XcdBarrier {
    unsigned* bar; unsigned x;
    volatile LAS unsigned* st;
};

__device__ __forceinline__ XcdBarrier xcd_barrier_post(unsigned* bar, volatile LAS unsigned* st, int kw) {
    XcdBarrier b; b.bar = bar; b.x = xb_xcc_id(); b.st = st;
    if (ktid(kw) == 0) (void)xb_add(&bar[XB_XCNT(b.x)], 1u);
    return b;
}
__device__ __forceinline__ void xcd_barrier_complete(unsigned* bar, unsigned x, unsigned& nloc, unsigned& nx) {
    const unsigned G = gridDim.x * gridDim.y * gridDim.z;
    unsigned sum, cnt, mine, sp = 0u;
    for (;;) {
        sum = 0u; cnt = 0u; mine = 0u;
#pragma unroll
        for (unsigned j = 0; j < 16; ++j) { const unsigned c = xb_ld(&bar[XB_XCNT(j)]); sum += c; cnt += (c > 0u) ? 1u : 0u; mine = (j == x) ? c : mine; }
        if (sum == G) break;
        __builtin_amdgcn_s_sleep(1);
        if ((++sp & 255u) == 0u) { if (xb_ld(&bar[XB_TMO])) break; if (sp > XB_SPIN_CAP) { atomicAdd(&bar[XB_TMO], 1u); break; } }
    }
    nloc = mine > 0u ? mine : 1u; nx = cnt > 0u ? cnt : 1u;
}

__device__ __forceinline__ void xcd_barrier(const XcdBarrier& b, int kw) {
    asm volatile("s_waitcnt vmcnt(0)" ::: "memory");
    __syncthreads();
    if (ktid(kw) == 0) {
        unsigned* bar = b.bar;
        __builtin_amdgcn_s_waitcnt(0);
        unsigned nloc = b.st[0], nx = b.st[1];
        if (nloc == 0u) { xcd_barrier_complete(bar, b.x, nloc, nx); b.st[0] = nloc; b.st[1] = nx; }
        const unsigned old = xb_add(&bar[XB_XSUB(b.x)], 1u);
        const unsigned gen = old / nloc;
        if (old + 1u == (gen + 1u) * nloc) {
            __builtin_amdgcn_fence(__ATOMIC_RELEASE, "agent");
            asm volatile("s_waitcnt vmcnt(0)" ::: "memory");
            const unsigned og = xb_add(&bar[XB_TOP], 1u);
            const unsigned tg = og / nx;
            if (og + 1u == (tg + 1u) * nx) xb_add(&bar[XB_TOPGEN], 1u);
            else XB_SPIN(xb_ld(&bar[XB_TOPGEN]) == tg, bar);
            __builtin_amdgcn_fence(__ATOMIC_ACQUIRE, "agent");
            xb_add(&bar[XB_XGEN(b.x)], 1u);
            asm volatile("s_waitcnt vmcnt(0)" ::: "memory");
        } else {
            XB_SPIN(xb_ld(&bar[XB_XGEN(b.x)]) == gen, bar);
            __builtin_amdgcn_fence(__ATOMIC_ACQUIRE, "agent");
            asm volatile("s_waitcnt vmcnt(0)" ::: "memory");
        }
    }
    __syncthreads();
}

namespace pg8 {
#define PG8_LAS __attribute__((address_space(3)))
typedef unsigned short bf16_t;
typedef short bf16x8 __attribute__((ext_vector_type(8)));
typedef float f32x4 __attribute__((ext_vector_type(4)));
typedef unsigned u32x4 __attribute__((ext_vector_type(4)));
constexpr int BM = 256, BK = 64, HALF = 128, HTB = HALF * BK * 2  , STAGE_BYTES = 8 * HTB, NXCD = 8, WGM = 8;

__host__ __device__ __forceinline__ int lds_byte(int r, int c) { const int st = (r >> 4) * 2 + (c >> 5), rr = r & 15, cc = c & 31, ob = rr * 64 + cc * 2; return st * 1024 + (ob ^ (((ob >> 9) & 1) << 5)); }
__host__ __device__ __forceinline__ void stage_rc(int b, int& R, int& C) { const int st = b / 1024, sb = b % 1024, swz = sb ^ (((sb >> 9) & 1) << 5); R = (st >> 1) * 16 + swz / 64; C = (st & 1) * 32 + (swz % 64) / 2; }
__host__ __device__ __forceinline__ int perm32(int rho) { const int n = rho >> 4, i = rho & 15; return 8 * (i >> 2) + 4 * n + (i & 3); }

struct Unit { int pm, pn; };
struct Gemm { const bf16_t* A; const bf16_t* Bt; int M, N, K; };

struct StaticOrder {
    int nM, nN, nwg, G, c;
    __host__ __device__ void init(int M, int N, int G_, int c_) { nM = M / BM; nN = N / BM; nwg = nM * nN; G = G_; c = c_; }
    __host__ __device__ bool next(int i, Unit& u) const {
        const long L = (long)i * G + c; if (L >= nwg) return false;
        int wgid = (int)L; { const int q = nwg / NXCD, r = nwg % NXCD, xcd = wgid % NXCD, off = wgid / NXCD; wgid = (xcd < r ? xcd * (q + 1) : r * (q + 1) + (xcd - r) * q) + off; }
        const int nig = WGM * nN, gid = wgid / nig, fm = gid * WGM, gsz = (nM - fm) < WGM ? (nM - fm) : WGM;
        u.pm = fm + ((wgid % nig) % gsz); u.pn = (wgid % nig) / gsz; return true;
    }
    __device__ __forceinline__ void a_ready(const Unit&) const {}
    __device__ __forceinline__ void done(const Unit&) const {}
};


__device__ __forceinline__ unsigned cvt_pk_bf16(float lo, float hi) { unsigned r; asm volatile("v_cvt_pk_bf16_f32 %0, %1, %2" : "=v"(r) : "v"(lo), "v"(hi)); return r; }

struct EpiPlain {
    static constexpr bool PERM = true, AFTER_DRAIN = false;
    bf16_t* O; int ldc;
    __device__ __forceinline__ void operator()(const f32x4 (&acc)[2][2][4][2], const Unit& u, int wr, int wc, int fr, int fq) const {
        const int row0 = u.pm * BM + wr * 64 + fr, col0 = u.pn * BM + wc * 32 + 8 * fq;
#pragma unroll
        for (int ai = 0; ai < 2; ++ai)
#pragma unroll
            for (int m = 0; m < 4; ++m) { bf16_t* rowp = O + (size_t)(row0 + ai * HALF + m * 16) * ldc + col0;
#pragma unroll
                for (int bj = 0; bj < 2; ++bj) { const f32x4 v0 = acc[ai][bj][m][0], v1 = acc[ai][bj][m][1];
                    u32x4 w; w.x = cvt_pk_bf16(v0[0], v0[1]); w.y = cvt_pk_bf16(v0[2], v0[3]); w.z = cvt_pk_bf16(v1[0], v1[1]); w.w = cvt_pk_bf16(v1[2], v1[3]);
                    *(u32x4*)(rowp + bj * HALF) = w; } }
    }
};
struct EpiProj {
    static constexpr bool PERM = true, AFTER_DRAIN = false;
    bf16_t* Q;
    __device__ __forceinline__ void operator()(const f32x4 (&acc)[2][2][4][2], const Unit& u, int wr, int wc, int fr, int fq) const {
        const int row0 = u.pm * BM + wr * 64 + fr; const int cat = u.pn >> 2, pnl = u.pn & 3;
        bf16_t* basep = Q + (size_t)cat * ((size_t)16 << 20);
        const bool headmajor = cat < 3, dogelu = cat == 4;
#pragma unroll
        for (int ai = 0; ai < 2; ++ai)
#pragma unroll
            for (int m = 0; m < 4; ++m) { const int row = row0 + ai * HALF + m * 16; const int b = row >> 12, s = row & 4095;
#pragma unroll
                for (int bj = 0; bj < 2; ++bj) { f32x4 v0 = acc[ai][bj][m][0], v1 = acc[ai][bj][m][1];
                    const int colt = pnl * BM + bj * HALF + wc * 32 + 8 * fq;
                    const int head = colt >> 7, d = colt & 127;
                    const size_t offA = ((size_t)((b * 8 + head) * 4096 + s)) * 128 + d, offB = (size_t)row * 1024 + colt;
                    bf16_t* dst = basep + (headmajor ? offA : offB);
                    if (dogelu) {
#pragma unroll
                        for (int e = 0; e < 4; ++e) { v0[e] = gelu_tanh(v0[e]); v1[e] = gelu_tanh(v1[e]); } }
                    u32x4 w; w.x = cvt_pk_bf16(v0[0], v0[1]); w.y = cvt_pk_bf16(v0[2], v0[3]); w.z = cvt_pk_bf16(v1[0], v1[1]); w.w = cvt_pk_bf16(v1[2], v1[3]);
                    *(u32x4*)dst = w; } }
    }
};
struct EpiRes {
    static constexpr bool PERM = false, AFTER_DRAIN = false;
    const float* base; float* out; int ldc; const float* gate; int gstride;
    __device__ __forceinline__ void operator()(const f32x4 (&acc)[2][2][4][2], const Unit& u, int wr, int wc, int fr, int fq) const {
        const int row0 = u.pm * BM + wr * 64 + fr, col0 = u.pn * BM + wc * 32 + 4 * fq;
        const int b = (u.pm * BM) >> 12;
        f32x4 gv[2][2];
#pragma unroll
        for (int bj = 0; bj < 2; ++bj)
#pragma unroll
            for (int n = 0; n < 2; ++n) gv[bj][n] = *(const f32x4*)(gate + (size_t)b * gstride + col0 + bj * HALF + n * 16);
#pragma unroll
        for (int ai = 0; ai < 2; ++ai)
#pragma unroll
            for (int m = 0; m < 4; ++m) { const size_t off = (size_t)(row0 + ai * HALF + m * 16) * ldc + col0;
#pragma unroll
                for (int bj = 0; bj < 2; ++bj)
#pragma unroll
                    for (int n = 0; n < 2; ++n) { const f32x4 bs = *(const f32x4*)(base + off + bj * HALF + n * 16);
                        *(f32x4*)(out + off + bj * HALF + n * 16) = bs + gv[bj][n] * acc[ai][bj][m][n]; } }
    }
};

template <class Epi, class Sched, bool ALIGN_EPI = false, bool SP2 = false>
__device__ __forceinline__ void gemm_phase(PG8_LAS unsigned char* lds, const Gemm g, const Sched& S, const Epi& E, const int kw) {
    const int tid = ktid(kw), wid = kw, lane = tid & 63, wr = wid >> 2, wc = wid & 3, fr = lane & 15, fq = lane >> 4;
    const int K = g.K, nt = K / BK;
    unsigned voffA[2], voffB[2];
#pragma unroll
    for (int i = 0; i < 2; ++i) { int R, C; stage_rc(tid * 16 + i * 8192, R, C); const int Rb = Epi::PERM ? ((R & ~31) + perm32(R & 31)) : R;
        voffA[i] = (unsigned)(R * K + C) * 2u; voffB[i] = (unsigned)(Rb * K + C) * 2u; }
    const size_t kstep = (size_t)(BK * 2);
    const size_t hstep = (size_t)HALF * K * 2;
    const size_t tstep = 2 * hstep;
    const unsigned ldsw = (unsigned)wid * 1024u;
    const int aoff = lds_byte(wr * 64 + fr, fq * 8), boff = lds_byte(wc * 32 + fr, fq * 8);
#define PG8_SA(b, h) (((b) * 2 + (h)) * HTB)
#define PG8_SB(b, h) ((4 + (b) * 2 + (h)) * HTB)
#define PG8_STAGE(bufoff, gbase, voff) do { _Pragma("unroll") for (int _i = 0; _i < 2; ++_i) \
        __builtin_amdgcn_global_load_lds((const unsigned*)((const char*)(gbase) + (voff)[_i]), (PG8_LAS unsigned*)(lds + (bufoff) + ldsw + _i * 8192), 16, 0, 0); } while (0)
#define PG8_LDA(dst, b, h) do { _Pragma("unroll") for (int m = 0; m < 4; ++m) _Pragma("unroll") for (int k = 0; k < 2; ++k) dst[m][k] = *(const PG8_LAS bf16x8*)(lds + PG8_SA(b, h) + aoff + m * 2048 + k * 1024); } while (0)
#define PG8_LDB(dst, b, h) do { _Pragma("unroll") for (int n = 0; n < 2; ++n) _Pragma("unroll") for (int k = 0; k < 2; ++k) dst[n][k] = *(const PG8_LAS bf16x8*)(lds + PG8_SB(b, h) + boff + n * 2048 + k * 1024); } while (0)
#define PG8_MMA(ai, bj, At, Bt) do { __builtin_amdgcn_s_setprio(1); _Pragma("unroll") for (int m = 0; m < 4; ++m) _Pragma("unroll") for (int n = 0; n < 2; ++n) _Pragma("unroll") for (int k = 0; k < 2; ++k) \
        acc[ai][bj][m][n] = __builtin_amdgcn_mfma_f32_16x16x32_bf16(Bt[n][k], At[m][k], acc[ai][bj][m][n], 0, 0, 0); __builtin_amdgcn_s_setprio(0); } while (0)
#define PG8_WAIT_V(n) asm volatile("s_waitcnt vmcnt(" #n ")" ::: "memory")
#define PG8_WAIT_L(n) asm volatile("s_waitcnt lgkmcnt(" #n ")" ::: "memory")
#define PG8_BAR __builtin_amdgcn_s_barrier()
#define PG8_SCHED __builtin_amdgcn_sched_barrier(0)
    Unit cur, nxt; int ui = 0;
    if (!S.next(0, cur)) return;
    f32x4 acc[2][2][4][2];
#pragma unroll
    for (int a = 0; a < 2; ++a)
#pragma unroll
        for (int b = 0; b < 2; ++b)
#pragma unroll
            for (int m = 0; m < 4; ++m)
#pragma unroll
                for (int n = 0; n < 2; ++n) acc[a][b][m][n] = (f32x4){0.f, 0.f, 0.f, 0.f};
    bf16x8 At[4][2], B0[2][2], B1[2][2];
    const char* cA = (const char*)g.A + (size_t)cur.pm * tstep; const char* cB = (const char*)g.Bt + (size_t)cur.pn * tstep;
    S.a_ready(cur);
    if constexpr (SP2) {
        PG8_STAGE(PG8_SB(0, 0), cB, voffB); PG8_STAGE(PG8_SB(0, 1), cB + hstep, voffB); PG8_STAGE(PG8_SA(0, 0), cA, voffA); PG8_STAGE(PG8_SA(0, 1), cA + hstep, voffA);
        if (wr == 1) PG8_BAR;
        PG8_WAIT_V(2); PG8_BAR;
        PG8_STAGE(PG8_SB(1, 0), cB + kstep, voffB); PG8_STAGE(PG8_SA(1, 0), cA + kstep, voffA); PG8_STAGE(PG8_SB(1, 1), cB + hstep + kstep, voffB);
        PG8_WAIT_V(6); PG8_BAR;
    } else {
        PG8_STAGE(PG8_SB(0, 0), cB, voffB); PG8_STAGE(PG8_SA(0, 0), cA, voffA); PG8_STAGE(PG8_SB(0, 1), cB + hstep, voffB); PG8_STAGE(PG8_SA(0, 1), cA + hstep, voffA);
        if (wr == 1) PG8_BAR;
        PG8_WAIT_V(4); PG8_BAR;
        PG8_STAGE(PG8_SB(1, 0), cB + kstep, voffB); PG8_STAGE(PG8_SA(1, 0), cA + kstep, voffA); PG8_STAGE(PG8_SB(1, 1), cB + hstep + kstep, voffB);
        PG8_WAIT_V(6); PG8_BAR;
    }
    for (;;) {
        const bool has_next = S.next(ui + 1, nxt);
        const char* nA = has_next ? (const char*)g.A + (size_t)nxt.pm * tstep : cA; const char* nB = has_next ? (const char*)g.Bt + (size_t)nxt.pn * tstep : cB;
        for (int t = 0; t < nt; t += 2) {
            const bool last = (t == nt - 2);
            const char* a1 = cA + (size_t)(t + 1) * kstep;
            const char* a2 = last ? nA : cA + (size_t)(t + 2) * kstep; const char* b2 = last ? nB : cB + (size_t)(t + 2) * kstep;
            const char* a3 = a2 + kstep; const char* b3 = b2 + kstep;
            if (last && has_next) S.a_ready(nxt);
            if constexpr (SP2) {
            PG8_LDB(B0, 0, 0); PG8_LDB(B1, 0, 1); PG8_SCHED; PG8_LDA(At, 0, 0); PG8_STAGE(PG8_SA(1, 1), a1 + hstep, voffA);
            PG8_WAIT_V(8); PG8_WAIT_L(0); PG8_BAR; PG8_MMA(0, 0, At, B0); PG8_MMA(0, 1, At, B1); PG8_BAR; PG8_SCHED;
            PG8_LDA(At, 0, 1); PG8_STAGE(PG8_SB(0, 0), b2, voffB); PG8_STAGE(PG8_SB(0, 1), b2 + hstep, voffB); PG8_STAGE(PG8_SA(0, 0), a2, voffA);
            PG8_WAIT_V(8); PG8_WAIT_L(0); PG8_BAR; PG8_MMA(1, 0, At, B0); PG8_MMA(1, 1, At, B1); PG8_BAR; PG8_SCHED;
            PG8_LDB(B0, 1, 0); PG8_LDB(B1, 1, 1); PG8_SCHED; PG8_LDA(At, 1, 0); PG8_STAGE(PG8_SA(0, 1), a2 + hstep, voffA);
            PG8_WAIT_V(8); PG8_WAIT_L(0); PG8_BAR; PG8_MMA(0, 0, At, B0); PG8_MMA(0, 1, At, B1); PG8_BAR; PG8_SCHED;
            PG8_LDA(At, 1, 1); PG8_STAGE(PG8_SB(1, 0), b3, voffB); PG8_STAGE(PG8_SB(1, 1), b3 + hstep, voffB); PG8_STAGE(PG8_SA(1, 0), a3, voffA);
            PG8_WAIT_V(8); PG8_WAIT_L(0); PG8_BAR; PG8_MMA(1, 0, At, B0); PG8_MMA(1, 1, At, B1); PG8_BAR; PG8_SCHED;
            } else {
            PG8_LDB(B0, 0, 0); PG8_SCHED; PG8_LDA(At, 0, 0); PG8_STAGE(PG8_SA(1, 1), a1 + hstep, voffA);
            PG8_WAIT_L(8); PG8_BAR; PG8_WAIT_L(0); PG8_MMA(0, 0, At, B0); PG8_BAR; PG8_SCHED;
            PG8_LDB(B1, 0, 1); PG8_STAGE(PG8_SB(0, 0), b2, voffB);
            PG8_BAR; PG8_WAIT_L(0); PG8_MMA(0, 1, At, B1); PG8_BAR;
            PG8_LDA(At, 0, 1); PG8_STAGE(PG8_SA(0, 0), a2, voffA);
            PG8_BAR; PG8_WAIT_L(0); PG8_MMA(1, 0, At, B0); PG8_BAR; PG8_SCHED;
            PG8_STAGE(PG8_SB(0, 1), b2 + hstep, voffB);
            PG8_WAIT_V(6); PG8_BAR; PG8_MMA(1, 1, At, B1); PG8_BAR;
            PG8_LDB(B0, 1, 0); PG8_SCHED; PG8_LDA(At, 1, 0); PG8_STAGE(PG8_SA(0, 1), a2 + hstep, voffA);
            PG8_WAIT_L(8); PG8_BAR; PG8_WAIT_L(0); PG8_MMA(0, 0, At, B0); PG8_BAR; PG8_SCHED;
            PG8_LDB(B1, 1, 1); PG8_STAGE(PG8_SB(1, 0), b3, voffB);
            PG8_BAR; PG8_WAIT_L(0); PG8_MMA(0, 1, At, B1); PG8_BAR;
            PG8_LDA(At, 1, 1); PG8_STAGE(PG8_SA(1, 0), a3, voffA);
            PG8_BAR; PG8_WAIT_L(0); PG8_MMA(1, 0, At, B0); PG8_BAR; PG8_SCHED;
            PG8_STAGE(PG8_SB(1, 1), b3 + hstep, voffB);
            PG8_WAIT_V(6); PG8_BAR; PG8_MMA(1, 1, At, B1); PG8_BAR;
            }
        }
        if constexpr (ALIGN_EPI) { if (wr == 0) PG8_BAR; }
        if constexpr (!Epi::AFTER_DRAIN) { E(acc, cur, wr, wc, fr, fq); S.done(cur); }
        if (!has_next) break;
#pragma unroll
        for (int a = 0; a < 2; ++a)
#pragma unroll
            for (int b = 0; b < 2; ++b)
#pragma unroll
                for (int m = 0; m < 4; ++m)
#pragma unroll
                    for (int n = 0; n < 2; ++n) acc[a][b][m][n] = (f32x4){0.f, 0.f, 0.f, 0.f};
        cur = nxt; cA = nA; cB = nB; ++ui;
        if constexpr (ALIGN_EPI) { if (wr == 1) PG8_BAR; }
    }
    PG8_WAIT_V(0);
    if constexpr (!ALIGN_EPI) { if (wr == 0) PG8_BAR; }
    PG8_BAR;
    if constexpr (Epi::AFTER_DRAIN) { E.fused(acc, cur, wr, wc, fr, fq, lds, wid, lane); S.done(cur); }
#undef PG8_SA
#undef PG8_SB
#undef PG8_STAGE
#undef PG8_LDA
#undef PG8_LDB
#undef PG8_MMA
#undef PG8_WAIT_V
#undef PG8_WAIT_L
#undef PG8_BAR
#undef PG8_SCHED
}
}

namespace att {
typedef unsigned short bf16;
typedef short bf16x8 __attribute__((ext_vector_type(8)));
typedef short s16x4 __attribute__((ext_vector_type(4)));
typedef float f32x16 __attribute__((ext_vector_type(16)));
typedef float f32x4 __attribute__((ext_vector_type(4)));
typedef unsigned u32x4 __attribute__((ext_vector_type(4)));
template <class A, class Bt> struct same_t { static constexpr bool v = false; };
template <class A> struct same_t<A, A> { static constexpr bool v = true; };
constexpr int D = 128;
constexpr float THR = 8.f;
constexpr bool WSKIP = false;
constexpr float SCALE = 0.08838834764831845f;
constexpr int NW = 8, QBLK = 32, KVBLK = 64, QB = NW * QBLK;
constexpr int SHM_V = KVBLK * D * 2, SHM_K = KVBLK * D * 2;
constexpr int LDS_BIAS = 2 * SHM_V + 2 * SHM_K + NW * 64 * 4;
constexpr int LDS_BYTES = LDS_BIAS + 4096 * 4;
constexpr int OP = 2048;
#define KSWZ(row, colB) ((row) * 256 + ((colB) ^ (((row) & 7) << 4)))
#define SBAR() __builtin_amdgcn_sched_barrier(0)
__device__ __forceinline__ int v_st(int k, int c) { const int kk = (k & ~0xC) | ((k & 4) << 1) | ((k & 8) >> 1); return ((kk >> 3) * 4 + (c >> 5)) * 512 + ((kk & 7) * 32 + (c & 31)) * 2; }
__device__ __forceinline__ int v_rd_base(int lane) { return ((lane & 3) << 3) | (((lane >> 2) & 3) << 6) | (((lane >> 4) & 1) << 5) | (((lane >> 5) & 1) << 8); }
constexpr int v_rd_off(int d0, int ks, int half) { return d0 * 512 + ks * 4096 + half * 2048; }
__device__ __forceinline__ int crow(int r, int hi) { return (r & 3) + 8 * (r >> 2) + 4 * hi; }
__device__ __forceinline__ unsigned cvtpk(float lo, float hi) {
    unsigned r; asm volatile("v_cvt_pk_bf16_f32 %0, %1, %2" : "=v"(r) : "v"(lo), "v"(hi)); return r;
}
__device__ __forceinline__ bf16x8 pack8(f32x4 a, f32x4 b) {
    u32x4 w = {cvtpk(a[0], a[1]), cvtpk(a[2], a[3]), cvtpk(b[0], b[1]), cvtpk(b[2], b[3])};
    return *reinterpret_cast<bf16x8*>(&w);
}
template <class T> __device__ __forceinline__ bf16x8 load8(const T* p) {
    if constexpr (same_t<T, float>::v) { return pack8(*(const f32x4*)p, *(const f32x4*)(p + 4)); }
    else { return *reinterpret_cast<const bf16x8*>(p); }
}
__device__ __forceinline__ void mask_tile(f32x16& p0, f32x16& p1, int dq, unsigned W) {
    const float NEG = -__builtin_inff();
#pragma unroll
    for (int r = 0; r < 16; ++r) {
        const int c = (r & 3) + 8 * (r >> 2);
        if ((unsigned)(dq - c) >= W) p0[r] = NEG;
        if ((unsigned)(dq - c - 32) >= W) p1[r] = NEG;
    }
}
__device__ __forceinline__ void partialSM(f32x16& p0, f32x16& p1, float& m_reg, float& mn, float& alpha) {
    float pmax = p0[0]; for (int r = 1; r < 16; ++r) pmax = fmaxf(pmax, p0[r]); for (int r = 0; r < 16; ++r) pmax = fmaxf(pmax, p1[r]);
    { auto rr = __builtin_amdgcn_permlane32_swap(__float_as_uint(pmax), __float_as_uint(pmax), false, false);
      pmax = fmaxf(__uint_as_float(rr[0]), __uint_as_float(rr[1])); }
    constexpr float C2 = 1.4426950408889634f * SCALE;
    if (__builtin_expect(__all((pmax - m_reg) * SCALE <= THR), 1)) { mn = m_reg; alpha = 1.f; }
    else { mn = fmaxf(m_reg, pmax); alpha = __builtin_amdgcn_exp2f((m_reg - mn) * C2); m_reg = mn; }
    const float mnL = -mn * C2;
    for (int r = 0; r < 16; ++r) p0[r] = fmaf(p0[r], C2, mnL); for (int r = 0; r < 16; ++r) p1[r] = fmaf(p1[r], C2, mnL);
    for (int r = 0; r < 16; ++r) p0[r] = __builtin_amdgcn_exp2f(p0[r]);
}
__device__ __forceinline__ void finishSM(f32x16& p0, f32x16& p1, float alpha, float& l_reg, bf16x8& pa0, bf16x8& pa1, bf16x8& pa2, bf16x8& pa3) {
    for (int r = 0; r < 16; ++r) p1[r] = __builtin_amdgcn_exp2f(p1[r]);
    float ps = 0; for (int r = 0; r < 16; ++r) ps += p0[r]; for (int r = 0; r < 16; ++r) ps += p1[r];
    { auto rr = __builtin_amdgcn_permlane32_swap(__float_as_uint(ps), __float_as_uint(ps), false, false);
      ps = __uint_as_float(rr[0]) + __uint_as_float(rr[1]); }
    l_reg = l_reg * alpha + ps;
#define PK4(P, B_, OUT) do { unsigned a0 = cvtpk(P[B_+0], P[B_+1]), a1 = cvtpk(P[B_+2], P[B_+3]);                          \
        unsigned b0 = cvtpk(P[B_+4], P[B_+5]), b1 = cvtpk(P[B_+6], P[B_+7]);                                             \
        auto r0 = __builtin_amdgcn_permlane32_swap(a0, b0, false, false); auto r1 = __builtin_amdgcn_permlane32_swap(a1, b1, false, false); \
        u32x4 w = {r0[0], r1[0], r0[1], r1[1]}; OUT = *reinterpret_cast<bf16x8*>(&w); } while (0)
    PK4(p0, 0, pa0); PK4(p0, 8, pa1); PK4(p1, 0, pa2); PK4(p1, 8, pa3);
#undef PK4
}
template <int KB, bool SK>
__device__ __forceinline__ void qkt(f32x16& p0, f32x16& p1, const char* K_lds, int r32, int hi, const bf16x8* qr, bool act, const float* bl) {
    if (SK && !act) { const float NEG = -__builtin_inff();
#pragma unroll
        for (int r = 0; r < 16; ++r) { p0[r] = NEG; p1[r] = NEG; } return; }
    { const f32x4 c0 = *(const f32x4*)(bl), c1 = *(const f32x4*)(bl + 8), c2 = *(const f32x4*)(bl + 16), c3 = *(const f32x4*)(bl + 24);
      const f32x4 e0 = *(const f32x4*)(bl + 32), e1 = *(const f32x4*)(bl + 40), e2 = *(const f32x4*)(bl + 48), e3 = *(const f32x4*)(bl + 56);
      p0 = (f32x16){c0[0], c0[1], c0[2], c0[3], c1[0], c1[1], c1[2], c1[3], c2[0], c2[1], c2[2], c2[3], c3[0], c3[1], c3[2], c3[3]};
      p1 = (f32x16){e0[0], e0[1], e0[2], e0[3], e1[0], e1[1], e1[2], e1[3], e2[0], e2[1], e2[2], e2[3], e3[0], e3[1], e3[2], e3[3]}; }
    const char* kb[4];
#pragma unroll
    for (int dd = 0; dd < 4; ++dd) kb[dd] = K_lds + KB * SHM_K + KSWZ(r32, (dd * 16 + hi * 8) * 2);
#pragma unroll
    for (int d0 = 0; d0 < 8; ++d0) { const char* a = kb[d0 & 3] + (d0 >> 2) * 128;
        bf16x8 b0 = *reinterpret_cast<const bf16x8*>(a);
        bf16x8 b1 = *reinterpret_cast<const bf16x8*>(a + 32 * 256);
        p0 = __builtin_amdgcn_mfma_f32_32x32x16_bf16(b0, qr[d0], p0, 0, 0, 0);
        p1 = __builtin_amdgcn_mfma_f32_32x32x16_bf16(b1, qr[d0], p1, 0, 0, 0); }
}
template <int VB, bool SK>
__device__ __forceinline__ void pv_tile(f32x16* o, int vb0, bf16x8 pa0, bf16x8 pa1, bf16x8 pa2, bf16x8 pa3, bool act) {
    if (SK && !act) return;
#define TRRD(dst, off) asm volatile("ds_read_b64_tr_b16 %0, %1 offset:%2" : "=&v"(dst) : "v"(vb0), "i"(off) : "memory")
#define PV_D0(d0) do { s16x4 l0, l1, l2, l3, h0, h1, h2, h3; constexpr int b_ = VB * SHM_V + v_rd_off(d0, 0, 0);     \
        TRRD(l0, b_); TRRD(h0, b_ + 2048); TRRD(l1, b_ + 4096); TRRD(h1, b_ + 6144); TRRD(l2, b_ + 8192); TRRD(h2, b_ + 10240); TRRD(l3, b_ + 12288); TRRD(h3, b_ + 14336); \
        asm volatile("s_waitcnt lgkmcnt(0)" ::: "memory"); SBAR();                 \
        o[d0] = __builtin_amdgcn_mfma_f32_32x32x16_bf16(pa0, (bf16x8){l0[0], l0[1], l0[2], l0[3], h0[0], h0[1], h0[2], h0[3]}, o[d0], 0, 0, 0);   \
        o[d0] = __builtin_amdgcn_mfma_f32_32x32x16_bf16(pa1, (bf16x8){l1[0], l1[1], l1[2], l1[3], h1[0], h1[1], h1[2], h1[3]}, o[d0], 0, 0, 0);   \
        o[d0] = __builtin_amdgcn_mfma_f32_32x32x16_bf16(pa2, (bf16x8){l2[0], l2[1], l2[2], l2[3], h2[0], h2[1], h2[2], h2[3]}, o[d0], 0, 0, 0);   \
        o[d0] = __builtin_amdgcn_mfma_f32_32x32x16_bf16(pa3, (bf16x8){l3[0], l3[1], l3[2], l3[3], h3[0], h3[1], h3[2], h3[3]}, o[d0], 0, 0, 0); } while (0)
    PV_D0(0); PV_D0(1); PV_D0(2); PV_D0(3);
#undef PV_D0
#undef TRRD
}


struct BlockRef { const bf16* Q; const bf16* K; const bf16* V; bf16* O; const float* KB; int P0; };
struct Seam { bf16x8 qr[8]; bf16x8 st_v0, st_v1, st_k0, st_k1; };
#define ROW(p, k0, rr) ((p) + (size_t)((k0) + (rr)) * D + sc)
#define VMW() asm volatile("s_waitcnt vmcnt(0)" ::: "memory")
#define VMWN(n) asm volatile("s_waitcnt vmcnt(%0)" :: "i"(n) : "memory")
#define SLOAD_H(Kp, Vp, k0) do { S.st_v0 = load8<bf16>(ROW(Vp, k0, sr)); S.st_v1 = load8<bf16>(ROW(Vp, k0, 32 + sr));              \
                         S.st_k0 = load8<bf16>(ROW(Kp, k0, sr)); S.st_k1 = load8<bf16>(ROW(Kp, k0, 32 + sr)); } while (0)
#define SWRITE_HK(bf) do { *(bf16x8*)(K_lds + (bf) * SHM_K + kws) = S.st_k0; *(bf16x8*)(K_lds + (bf) * SHM_K + kws + 32 * 256) = S.st_k1; } while (0)
#define SWRITE_HV(bf) do { *(bf16x8*)(V_lds + (bf) * SHM_V + vst0) = S.st_v0; *(bf16x8*)(V_lds + (bf) * SHM_V + vst1) = S.st_v1; } while (0)
#define SWRITE_H(bf) do { SWRITE_HV(bf); SWRITE_HK(bf); } while (0)
__device__ __forceinline__ void fox_prime(const BlockRef& cur, char* lds, Seam& S, int kw) {
    const int tid = ktid(kw), wid = kw, lane = tid & 63, r32 = lane & 31, hi = lane >> 5;
    const int sr = tid >> 4, sc = (tid & 15) * 8, kws = KSWZ(sr, sc * 2); char* K_lds = lds + 2 * SHM_V;
#pragma unroll
    for (int d0 = 0; d0 < 8; ++d0) S.qr[d0] = load8<bf16>(cur.Q + (size_t)(wid * QBLK + r32) * D + d0 * 16 + hi * 8);
    SLOAD_H(cur.K, cur.V, 0); VMW(); SWRITE_HK(0);
    __syncthreads();
}
__device__ __forceinline__ void fox_block(const BlockRef& cur, const BlockRef& nxt, char* lds, Seam& S, int kw) {
    constexpr bool SK = false; constexpr unsigned W = 0x7fffffffu;
    const int tid = ktid(kw), wid = kw, lane = tid & 63, r32 = lane & 31, hi = lane >> 5;
    const int NT = (cur.P0 + QB - 1) / KVBLK + 1;
    const int qlo = cur.P0 + wid * QBLK, qm = qlo + r32 - 4 * hi;
    char* V_lds = lds; char* K_lds = lds + 2 * SHM_V;
    float* ws = (float*)(lds + 2 * SHM_V + 2 * SHM_K) + wid * 64; float* li_l = ws, * al_l = ws + 32;
    float m_reg = -1e30f, l_reg = 0; f32x16 o[4] = {};
    const int sr = tid >> 4, sc = (tid & 15) * 8, vst0 = v_st(sr, sc), vst1 = v_st(32 + sr, sc), kws = KSWZ(sr, sc * 2);
    const int vb0 = (int)(uintptr_t)V_lds + v_rd_base(lane);
    const bf16* Kh = cur.K; const bf16* Vh = cur.V;
    float* bias_l = (float*)(lds + LDS_BIAS);
    { const int nb4 = (cur.P0 + QB) / 4; int i0 = ktid(kw); asm volatile("" : "+v"(i0));
      for (int i = i0; i < nb4; i += NW * 64) ((f32x4*)bias_l)[i] = ((const f32x4*)cur.KB)[i]; }
    __syncthreads();
    const float* KBh = bias_l + 4 * hi;
#define RESC(a) do { if (__any((a) < 1.f)) { if (hi == 0) al_l[r32] = (a); asm volatile("s_waitcnt lgkmcnt(0)" ::: "memory");              \
                     for (int d_ = 0; d_ < 4; ++d_) for (int r = 0; r < 16; ++r) o[d_][r] *= al_l[crow(r, hi)]; } } while (0)
#define KBASE(t) ((t) * KVBLK)
#define ACT(t) true
#define MASKT(P0_, P1_, t) do { const int kb_ = KBASE(t); if (kb_ + KVBLK - 1 > qlo) mask_tile(P0_, P1_, qm - kb_, W); } while (0)
    constexpr int NQL = 8;
#define SEAM_K0() do { VMWN(NQL); SWRITE_HK(0); SBAR(); } while (0)
    f32x16 pA0, pA1, pB0, pB1; float mnA, mnB, alA, alB; bf16x8 pa0, pa1, pa2, pa3;
    SWRITE_HV(0); SBAR();
    if (NT > 1) { SLOAD_H(Kh, Vh, KBASE(1)); }
    SBAR(); qkt<0, SK>(pA0, pA1, K_lds, r32, hi, S.qr, ACT(0), KBh);
    MASKT(pA0, pA1, 0); partialSM(pA0, pA1, m_reg, mnA, alA);
    if (NT > 1) { VMW(); SWRITE_H(1); }
    __syncthreads();
#define HALF_STEP(PX0, PX1, mnX, alX, PY0, PY1, alY, t, KB, VB, SB) do {                                                      \
        SBAR(); qkt<KB, SK>(PX0, PX1, K_lds, r32, hi, S.qr, ACT(t), KBh + KBASE(t));                                             \
        finishSM(PY0, PY1, alY, l_reg, pa0, pa1, pa2, pa3); SBAR();                                                           \
        if ((t) + 1 < NT) { SLOAD_H(Kh, Vh, KBASE((t) + 1)); SBAR(); }                                                        \
        pv_tile<VB, SK>(o, vb0, pa0, pa1, pa2, pa3, ACT((t) - 1)); MASKT(PX0, PX1, (t)); partialSM(PX0, PX1, m_reg, mnX, alX);  \
        __syncthreads();                                                                                                      \
        if ((t) + 1 < NT) { VMW(); SWRITE_H(SB); }                                                                            \
        RESC(alX); __syncthreads(); } while (0)
    for (int t = 1; t + 1 < NT; t += 2) {
        HALF_STEP(pB0, pB1, mnB, alB, pA0, pA1, alA, t, 1, 0, 0);
        HALF_STEP(pA0, pA1, mnA, alA, pB0, pB1, alB, t + 1, 0, 1, 1);
    }
    const bool even = (NT & 1) == 0;
    if (even) { SBAR(); qkt<1, SK>(pB0, pB1, K_lds, r32, hi, S.qr, ACT(NT - 1), KBh + KBASE(NT - 1)); SBAR(); }
    SLOAD_H(nxt.K, nxt.V, 0); SBAR();
#pragma unroll
    for (int d0 = 0; d0 < 8; ++d0) S.qr[d0] = load8<bf16>(nxt.Q + (size_t)(wid * QBLK + r32) * D + d0 * 16 + hi * 8);
    SBAR();
    finishSM(pA0, pA1, alA, l_reg, pa0, pa1, pa2, pa3); SBAR();
    pv_tile<0, SK>(o, vb0, pa0, pa1, pa2, pa3, true);
    if (even) { MASKT(pB0, pB1, NT - 1); partialSM(pB0, pB1, m_reg, mnB, alB); __syncthreads(); RESC(alB);
        finishSM(pB0, pB1, alB, l_reg, pa0, pa1, pa2, pa3); SBAR(); pv_tile<1, SK>(o, vb0, pa0, pa1, pa2, pa3, true); }
    SBAR(); SEAM_K0();
    if (hi == 0) li_l[r32] = l_reg; asm volatile("s_waitcnt lgkmcnt(0)" ::: "memory");
    float rli[16];
#pragma unroll
    for (int r = 0; r < 16; ++r) rli[r] = __builtin_amdgcn_rcpf(li_l[crow(r, hi)]);
    bf16* Ow = cur.O + (size_t)(wid * QBLK) * OP;
#pragma unroll
    for (int r = 0; r < 16; ++r) { const int orow = crow(r, hi);
#pragma unroll
        for (int d0 = 0; d0 < 4; ++d0) { const float v = o[d0][r] * rli[r];
            const float vn = __shfl_xor(v, 1);
            if ((r32 & 1) == 0) *(unsigned*)(Ow + (size_t)orow * OP + d0 * 32 + r32) = cvtpk(v, vn); } }
    __syncthreads();
#undef RESC
#undef KBASE
#undef ACT
#undef MASKT
#undef SEAM_K0
#undef HALF_STEP
}
#undef ROW
#undef VMW
#undef VMWN
#undef SLOAD_H
#undef SWRITE_HK
#undef SWRITE_HV
#undef SWRITE_H
#undef KSWZ
#undef SBAR
}

struct Frame {
    LAS unsigned char* lds;
    volatile LAS unsigned* MISC;
    gu32* ctl;
    int tid, lane, wave;
    int vcu, G, bx;
    const float *x, *c, *w_ada, *b_ada, *g_mix, *w_in, *b_f, *conv_w, *conv_b, *lru_w_a, *lru_b_a, *lru_w_x, *lru_b_x, *lru_lambda,
                *g_attn_out, *g_lru_out, *w_out, *g_ffn, *peer_w_q, *peer_k1, *peer_k2, *peer_u, *peer_v, *g_final;
    float* out;
    float *MOD, *LF, *KB, *SUMM, *EW, *USC, *VSC, *PD, *Y, *ACT;
    int* EIDX;
    bf16_t *WLRU, *K1, *K2, *WIN, *WOUT, *WQ, *H, *Q, *K, *VV, *QP, *LX, *GLY, *MRG;
    unsigned char *U8, *V8;
};

struct Args { const float* in[24]; float* out; unsigned char* ws; int ph_lo, ph_hi, li, pad; };

__device__ __forceinline__ void p0_transpose_item(const float* W, int ldw, int K, bf16_t* WT, int kb, int scol, int drow, const float* gk, LAS float* scr, int lane) {
    const int k0 = 64 * kb;
#pragma unroll 8
    for (int i = 0; i < 32; ++i) { const int kk = 2 * i + (lane >> 5); float w = W[(size_t)(k0 + kk) * ldw + scol + (lane & 31)]; if (gk) w *= gk[k0 + kk]; scr[kk * 33 + (lane & 31)] = w; }
    LDS_WAIT(); asm volatile("" ::: "memory");
    const int c = lane & 7;
#pragma unroll
    for (int j = 0; j < 4; ++j) { const int n = (lane >> 3) + 8 * j; const LAS float* s = scr + (8 * c) * 33 + n;
        v4u o; o.x = pk2(s[0 * 33], s[1 * 33]); o.y = pk2(s[2 * 33], s[3 * 33]); o.z = pk2(s[4 * 33], s[5 * 33]); o.w = pk2(s[6 * 33], s[7 * 33]);
        *(GAS v4u*)(WT + (size_t)(drow + n) * K + k0 + 8 * c) = o; }
    LDS_WAIT(); asm volatile("" ::: "memory");
}
__device__ __forceinline__ void p0_convert(const float* src, bf16_t* dst, size_t n8, size_t gt, size_t ngt) {
#pragma unroll 4
    for (size_t i = gt; i < n8; i += ngt) { const f32x4 a = *(const GAS f32x4*)(src + i * 8), b = *(const GAS f32x4*)(src + i * 8 + 4);
        v4u o; o.x = pk2(a[0], a[1]); o.y = pk2(a[2], a[3]); o.z = pk2(b[0], b[1]); o.w = pk2(b[2], b[3]); *(GAS v4u*)(dst + i * 8) = o; }
}
__device__ __forceinline__ void p0_prologue(Frame& F) {
    {
        LAS float* scs = (LAS float*)F.lds;
        LAS float* red = scs + 4 * 2048;
        for (int i = F.tid; i < 4 * DM; i += NTHR) { const float cv = F.c[i]; scs[i] = cv * sigmoidf_(cv); }
        __syncthreads();
        for (int cb = F.bx; cb < 256; cb += F.G) {
            const int cq = F.tid % 12, rl = F.tid / 12;
            if (F.tid < 504) {
                float acc[4][4];
#pragma unroll
                for (int b = 0; b < 4; ++b)
#pragma unroll
                    for (int j = 0; j < 4; ++j) acc[b][j] = 0.f;
                const float* wp = F.w_ada + (size_t)rl * NADA + cb * 48 + cq * 4;
#pragma unroll 4
                for (int r = rl; r < DM; r += 42, wp += (size_t)42 * NADA) { const f32x4 w = *(const GAS f32x4*)wp;
#pragma unroll
                    for (int b = 0; b < 4; ++b) { const float s = scs[b * DM + r]; acc[b][0] += s * w[0]; acc[b][1] += s * w[1]; acc[b][2] += s * w[2]; acc[b][3] += s * w[3]; } }
#pragma unroll
                for (int b = 0; b < 4; ++b)
#pragma unroll
                    for (int j = 0; j < 4; ++j) red[rl * 192 + cq * 16 + b * 4 + j] = acc[b][j];
            }
            __syncthreads();
            if (F.tid < 192) { float s = 0.f;
                for (int r = 0; r < 42; ++r) s += red[r * 192 + F.tid];
                const int q = F.tid >> 4, b = (F.tid >> 2) & 3, j = F.tid & 3, col = cb * 48 + q * 4 + j;
                F.MOD[b * NADA + col] = s + F.b_ada[col]; }
            __syncthreads();
        }
    }
    {
        LAS float* scr = (LAS float*)(F.lds + F.wave * 16384);
        const int gw = F.vcu * NWAVES + F.wave, NGW = F.G * NWAVES;
        constexpr int I_IN1 = 32 * 96, I_IN2 = 32 * 64, I_SQ = 32 * 64, I_LRU = 16 * 8;
        constexpr int NITEMS = I_IN1 + I_IN2 + 2 * I_SQ + I_LRU;
        for (int it = gw; it < NITEMS; it += NGW) {
            int r = it;
            if (r < I_IN1) { const int kb = r / 96, nb = r % 96; p0_transpose_item(F.w_in, INC, DM, F.WIN, kb, 32 * nb, 32 * nb, nullptr, scr, F.lane); continue; } r -= I_IN1;
            if (r < I_IN2) { const int kb = r / 64, nb = r % 64; p0_transpose_item(F.w_in, INC, DM, F.WIN, kb, OFF_LX + 32 * nb, OFF_F + 32 * nb, nullptr, scr, F.lane); continue; } r -= I_IN2;
            if (r < I_SQ) { const int kb = r / 64, nb = r % 64; const float* gk = kb < 16 ? F.g_attn_out : F.g_lru_out - AW;
                p0_transpose_item(F.w_out, DM, DM, F.WOUT, kb, 32 * nb, 32 * nb, gk, scr, F.lane); continue; } r -= I_SQ;
            if (r < I_SQ) { const int kb = r / 64, nb = r % 64; p0_transpose_item(F.peer_w_q, DM, DM, F.WQ, kb, 32 * nb, 32 * nb, nullptr, scr, F.lane); continue; } r -= I_SQ;
            { const int mat = r >> 3, sub = r & 7, n = mat >> 1, which = mat & 1, kb = sub >> 2, nb = sub & 3;
              const float* src = (which ? F.lru_w_x : F.lru_w_a) + (size_t)n * LBD * LBD;
              p0_transpose_item(src, LBD, LBD, F.WLRU + (size_t)(n * 256 + which * 128) * LBD, kb, 32 * nb, 32 * nb, nullptr, scr, F.lane); }
        }
    }
    {
        const size_t gt = (size_t)F.vcu * NTHR + F.tid, ngt = (size_t)F.G * NTHR;
        p0_convert(F.peer_k1, F.K1, (size_t)PH * PNK * 128 / 8, gt, ngt);
        p0_convert(F.peer_k2, F.K2, (size_t)PH * PNK * 128 / 8, gt, ngt);
    }
    {
        const int gw = F.vcu * NWAVES + F.wave, NGW = F.G * NWAVES;
        for (int r = gw; r < 2 * NEXP; r += NGW) {
            const bool isv = r >= NEXP; const int rr = isv ? r - NEXP : r;
            const GAS f32x4* src = (const GAS f32x4*)((isv ? F.peer_v : F.peer_u) + (size_t)rr * DM) + F.lane;
            f32x4 v[8]; float am = 0.f;
#pragma unroll
            for (int j = 0; j < 8; ++j) { v[j] = src[64 * j]; am = fmaxf(am, fmaxf(fmaxf(fabsf(v[j][0]), fabsf(v[j][1])), fmaxf(fabsf(v[j][2]), fabsf(v[j][3])))); }
#pragma unroll
            for (int o = 1; o < 64; o <<= 1) am = fmaxf(am, __shfl_xor(am, o));
            const float sc = am > 0.f ? 416.f / am : 1.f;
            GAS unsigned char* dstb = (GAS unsigned char*)(isv ? F.V8 : F.U8) + (size_t)(F.lane >> 5) * ((size_t)NEXP * 128) + (size_t)rr * 128 + (F.lane & 31) * 4;
#pragma unroll
            for (int j = 0; j < 8; ++j) { int pk = 0; pk = __builtin_amdgcn_cvt_pk_fp8_f32(v[j][0] * sc, v[j][1] * sc, pk, false); pk = __builtin_amdgcn_cvt_pk_fp8_f32(v[j][2] * sc, v[j][3] * sc, pk, true);
                *(GAS unsigned*)(dstb + (size_t)(2 * j) * ((size_t)NEXP * 128)) = (unsigned)pk; }
            if (F.lane == 0) (isv ? F.VSC : F.USC)[rr] = am > 0.f ? am / 416.f : 1.f;
        }
    }
}

template <bool WITH_F>
__device__ __forceinline__ void p_modnorm(Frame& F, const float* xin, const float* g, int off_sh, int off_sc) {
    LAS float* gsv = (LAS float*)F.lds;
    LAS float* shv = gsv + DM;
    LAS float* wfT = shv + DM;
    if (WITH_F) { for (int i = F.tid; i < 8 * DM; i += NTHR) { const int k = i >> 3, j = i & 7; wfT[j * DM + k] = F.w_in[(size_t)k * INC + OFF_F + j]; } }
    for (int rb = F.bx; rb < T / 64; rb += F.G) {
        const int b = rb >> 6;
        __syncthreads();
        for (int k = F.tid; k < DM; k += NTHR) { gsv[k] = g[k] * (1.f + F.MOD[b * NADA + off_sc + k]); shv[k] = F.MOD[b * NADA + off_sh + k]; }
        __syncthreads();
        for (int i = 0; i < 8; ++i) {
            const int row = rb * 64 + F.wave * 8 + i;
            const GAS f32x4* xr = (const GAS f32x4*)(xin + (size_t)row * DM) + F.lane;
            f32x4 v[8]; float ss = 0.f;
#pragma unroll
            for (int j = 0; j < 8; ++j) { v[j] = xr[64 * j]; ss += (v[j][0] * v[j][0] + v[j][1] * v[j][1]) + (v[j][2] * v[j][2] + v[j][3] * v[j][3]); }
            const float rstd = __builtin_amdgcn_rsqf(wave_sum(ss) * (1.f / DM) + EPS);
#pragma unroll
            for (int j = 0; j < 8; ++j) { const f32x4 gg = ((const LAS f32x4*)gsv)[F.lane + 64 * j], sh = ((const LAS f32x4*)shv)[F.lane + 64 * j]; v[j] = v[j] * rstd * gg + sh; }
            GAS v2u* o8 = (GAS v2u*)(F.H + (size_t)row * DM) + F.lane;
#pragma unroll
            for (int j = 0; j < 8; ++j) { v2u w; w.x = pk2(v[j][0], v[j][1]); w.y = pk2(v[j][2], v[j][3]); o8[64 * j] = w; }
            if (WITH_F) {
                float mine = 0.f;
#pragma unroll 1
                for (int jj = 0; jj < 8; ++jj) { float a = 0.f;
#pragma unroll
                    for (int j = 0; j < 8; ++j) { const f32x4 w = ((const LAS f32x4*)(wfT + jj * DM))[F.lane + 64 * j]; a += (v[j][0] * w[0] + v[j][1] * w[1]) + (v[j][2] * w[2] + v[j][3] * w[3]); }
                    a = wave_sum(a); mine = (F.lane == jj) ? a : mine; }
                if (F.lane < 8) { const float z = mine + F.b_f[F.lane]; const float lf = fminf(z, 0.f) - log1pf(fexp(-fabsf(z)));
                    F.LF[(size_t)(b * NH + F.lane) * SEQ + (row & (SEQ - 1))] = lf; }
            }
        }
    }
}

__device__ __forceinline__ void p2_cumsum(Frame& F) {
    LAS float* wt = (LAS float*)F.lds;
    for (int bh = F.bx; bh < BATCH * NH; bh += F.G) {
        const float* src = F.LF + (size_t)bh * SEQ + F.tid * 8;
        const f32x4 a = *(const GAS f32x4*)src, b = *(const GAS f32x4*)(src + 4);
        float p[8]; p[0] = a[0]; p[1] = p[0] + a[1]; p[2] = p[1] + a[2]; p[3] = p[2] + a[3]; p[4] = p[3] + b[0]; p[5] = p[4] + b[1]; p[6] = p[5] + b[2]; p[7] = p[6] + b[3];
        float incl = p[7];
#pragma unroll
        for (int o = 1; o < 64; o <<= 1) { const float n = __shfl_up(incl, o); if (F.lane >= o) incl += n; }
        __syncthreads();
        if (F.lane == 63) wt[F.wave] = incl;
        __syncthreads();
        float off = incl - p[7];
        for (int w = 0; w < F.wave; ++w) off += wt[w];
        constexpr float NIS = -1.0f / 0.08838834764831845f;
        f32x4 o0, o1;
        o0[0] = (off + p[0]) * NIS; o0[1] = (off + p[1]) * NIS; o0[2] = (off + p[2]) * NIS; o0[3] = (off + p[3]) * NIS;
        o1[0] = (off + p[4]) * NIS; o1[1] = (off + p[5]) * NIS; o1[2] = (off + p[6]) * NIS; o1[3] = (off + p[7]) * NIS;
        float* dst = F.KB + (size_t)bh * SEQ + F.tid * 8;
        *(GAS f32x4*)dst = o0; *(GAS f32x4*)(dst + 4) = o1;
    }
}

constexpr int L_LX = 0, L_A = 17408, L_XC = 34816, L_SA = 68608, L_SUM = 102400, L_HIN = 106496, L_END = 110592;
constexpr int XS = 132;
typedef float f32x4v __attribute__((ext_vector_type(4)));
template <bool FINAL>
__device__ __forceinline__ void lru_unit(Frame& F, int b, int chunk) {
    LAS unsigned char* L = F.lds;
    int tid_ = ktid(F.wave); asm volatile("" : "+v"(tid_));
    const int tid = tid_, lane = tid_ & 63, wave = F.wave;
    const int s0 = chunk * 64; const size_t row0 = (size_t)b * SEQ + s0;
    LAS float* hin = (LAS float*)(L + L_HIN);
    __syncthreads();
    if (FINAL) {
        for (int ch = tid; ch < LW; ch += NTHR) { float h = 0.f;
            const GAS f32x2* sp = (const GAS f32x2*)F.SUMM + (size_t)(b * 64) * LW + ch;
            for (int c = 0; c < chunk; ++c) { const f32x2 ph = sp[(size_t)c * LW]; h = ph[0] * h + ph[1]; }
            hin[ch] = h; }
    }
    float myssq = 0.f;
    for (int n = 0; n < NLB; ++n) {
        __syncthreads();
        for (int idx = tid; idx < 67 * 16; idx += NTHR) { const int r = idx >> 4, c8 = idx & 15; const int s = s0 - 3 + r;
            v4u val = {0u, 0u, 0u, 0u};
            if (s >= 0) val = *(const GAS v4u*)(F.LX + ((size_t)b * SEQ + s) * LW + n * LBD + c8 * 8);
            *(LAS v4u*)(L + L_LX + r * 256 + c8 * 16) = val; }
        __syncthreads();
        { const int tok = tid >> 3, c16 = tid & 7; const int chg = n * LBD + c16 * 16;
          float xc[16];
#pragma unroll
          for (int e = 0; e < 16; e += 4) { const f32x4 cb = *(const GAS f32x4*)(F.conv_b + chg + e); xc[e] = cb[0]; xc[e + 1] = cb[1]; xc[e + 2] = cb[2]; xc[e + 3] = cb[3]; }
#pragma unroll
          for (int k = 0; k < 4; ++k) {
              const v4u x0 = *(const LAS v4u*)(L + L_LX + (tok + k) * 256 + c16 * 32), x1 = *(const LAS v4u*)(L + L_LX + (tok + k) * 256 + c16 * 32 + 16);
              const unsigned xd[8] = {x0.x, x0.y, x0.z, x0.w, x1.x, x1.y, x1.z, x1.w};
#pragma unroll
              for (int e = 0; e < 16; e += 4) { const f32x4 w = *(const GAS f32x4*)(F.conv_w + k * LW + chg + e);
                  xc[e] += w[0] * bf_lo(xd[e / 2]); xc[e + 1] += w[1] * bf_hi(xd[e / 2]); xc[e + 2] += w[2] * bf_lo(xd[e / 2 + 1]); xc[e + 3] += w[3] * bf_hi(xd[e / 2 + 1]); } }
          v4u a0, a1; a0.x = pk2(xc[0], xc[1]); a0.y = pk2(xc[2], xc[3]); a0.z = pk2(xc[4], xc[5]); a0.w = pk2(xc[6], xc[7]);
          a1.x = pk2(xc[8], xc[9]); a1.y = pk2(xc[10], xc[11]); a1.z = pk2(xc[12], xc[13]); a1.w = pk2(xc[14], xc[15]);
          *(LAS v4u*)(L + L_A + tok * 272 + c16 * 32) = a0; *(LAS v4u*)(L + L_A + tok * 272 + c16 * 32 + 16) = a1;
          LAS float* xo = (LAS float*)(L + L_XC) + tok * XS + c16 * 16;
#pragma unroll
          for (int e = 0; e < 16; e += 4) *(LAS f32x4*)(xo + e) = (f32x4){xc[e], xc[e + 1], xc[e + 2], xc[e + 3]};
        }
        __syncthreads();
        const int r16 = lane & 15, g4 = lane >> 4;
        f32x4 acc_a[4], acc_x[4];
#pragma unroll
        for (int m = 0; m < 4; ++m) { acc_a[m] = (f32x4){0.f, 0.f, 0.f, 0.f}; acc_x[m] = (f32x4){0.f, 0.f, 0.f, 0.f}; }
        { const bf16_t* wa = F.WLRU + ((size_t)(n * 256 + 16 * wave + r16)) * LBD + 8 * g4; const bf16_t* wx = wa + (size_t)128 * LBD;
#pragma unroll
          for (int ks = 0; ks < 4; ++ks) {
              const bf16x8 ba = *(const GAS bf16x8*)(wa + 32 * ks), bx = *(const GAS bf16x8*)(wx + 32 * ks);
#pragma unroll
              for (int m = 0; m < 4; ++m) { const bf16x8 af = *(const LAS bf16x8*)(L + L_A + (16 * m + r16) * 272 + (32 * ks + 8 * g4) * 2);
                  acc_a[m] = __builtin_amdgcn_mfma_f32_16x16x32_bf16(af, ba, acc_a[m], 0, 0, 0);
                  acc_x[m] = __builtin_amdgcn_mfma_f32_16x16x32_bf16(af, bx, acc_x[m], 0, 0, 0); } } }
        { const int chl = 16 * wave + r16, chg = n * LBD + chl;
          const float ba_ = F.lru_b_a[chg], bx_ = F.lru_b_x[chg]; const float sp8 = 8.f * softplusf_(-F.lru_lambda[chg]);
          LAS float* xcp = (LAS float*)(L + L_XC) + chl; LAS float* sap = (LAS float*)(L + L_SA) + chl;
#pragma unroll
          for (int m = 0; m < 4; ++m)
#pragma unroll
              for (int i = 0; i < 4; ++i) { const int tt = 16 * m + 4 * g4 + i;
                  const float rg = sigmoidf_(acc_a[m][i] + ba_), ig = sigmoidf_(acc_x[m][i] + bx_);
                  const float la = -sp8 * rg; const float a = fexp(la); const float x2 = 2.f * la;
                  const float em1 = (x2 > -0.3f) ? x2 * (1.f + x2 * (0.5f + x2 * (0.16666667f + x2 * (0.041666668f + x2 * (0.008333334f + x2 * 0.0013888889f))))) : (fexp(x2) - 1.f);
                  const float bt = __builtin_sqrtf(fmaxf(-em1, 0.f)) * (ig * xcp[tt * XS]);
                  sap[tt * XS] = a; xcp[tt * XS] = bt; } }
        __syncthreads();
        { const int chl = tid & 127, sub = tid >> 7;
          const LAS float* sap = (const LAS float*)(L + L_SA) + (16 * sub) * XS + chl; const LAS float* sbp = (const LAS float*)(L + L_XC) + (16 * sub) * XS + chl;
          float av[16], bv[16];
#pragma unroll
          for (int j = 0; j < 16; ++j) { av[j] = sap[j * XS]; bv[j] = sbp[j * XS]; }
          float P = 1.f, Hh = 0.f;
#pragma unroll
          for (int j = 0; j < 16; ++j) { Hh = av[j] * Hh + bv[j]; P *= av[j]; }
          LAS f32x2* sm = (LAS f32x2*)(L + L_SUM);
          sm[sub * 128 + chl] = (f32x2){P, Hh};
          __syncthreads();
          if (!FINAL) {
              if (sub == 3) { float pp = 1.f, hh = 0.f;
#pragma unroll
                  for (int s = 0; s < 4; ++s) { const f32x2 ph = sm[s * 128 + chl]; hh = ph[0] * hh + ph[1]; pp *= ph[0]; }
                  *((GAS f32x2*)F.SUMM + ((size_t)(b * 64 + chunk)) * LW + n * LBD + chl) = (f32x2){pp, hh}; }
          } else {
              float h = hin[n * LBD + chl];
              for (int s = 0; s < sub; ++s) { const f32x2 ph = sm[s * 128 + chl]; h = ph[0] * h + ph[1]; }
              const bf16_t* gl = F.GLY + (row0 + 16 * sub) * LW + n * LBD + chl;
              bf16_t* op = F.MRG + (row0 + 16 * sub) * DM + AW + n * LBD + chl;
              float gv[16];
#pragma unroll
              for (int j = 0; j < 16; ++j) gv[j] = bf_lo((unsigned)gl[(size_t)j * LW]);
              LAS float* sq = (LAS float*)(L + L_SA) + (16 * sub) * XS + chl;
#pragma unroll
              for (int j = 0; j < 16; ++j) { h = av[j] * h + bv[j]; const float o = h * gv[j]; op[(size_t)j * DM] = (bf16_t)f2bf(o); sq[j * XS] = o * o; }
              __syncthreads();
              { const int tt = tid >> 3, part = tid & 7; const LAS float* q = (const LAS float*)(L + L_SA) + tt * XS + part * 16; float s = 0.f;
#pragma unroll
                for (int e = 0; e < 16; e += 4) { const f32x4 v = *(const LAS f32x4*)(q + e); s += (v[0] + v[1]) + (v[2] + v[3]); }
                s += __shfl_xor(s, 1); s += __shfl_xor(s, 2); s += __shfl_xor(s, 4); myssq += s; }
          }
        }
    }
    if (FINAL) {
        VM_WAIT(); __syncthreads();
        const int tt = tid >> 3, part = tid & 7;
        bf16_t* rowp = F.MRG + (row0 + tt) * DM;
        const float rl = __builtin_amdgcn_rsqf(myssq * (1.f / LW) + EPS);
        v4u la[16], aa[16];
#pragma unroll
        for (int e = 0; e < 16; ++e) { aa[e] = *(const GAS v4u*)(rowp + part * 128 + e * 8); }
        float sa = 0.f;
#pragma unroll
        for (int e = 0; e < 16; ++e) { const unsigned d[4] = {aa[e].x, aa[e].y, aa[e].z, aa[e].w};
#pragma unroll
            for (int q = 0; q < 4; ++q) { const float lo = bf_lo(d[q]), hi = bf_hi(d[q]); sa += lo * lo + hi * hi; } }
        sa += __shfl_xor(sa, 1); sa += __shfl_xor(sa, 2); sa += __shfl_xor(sa, 4);
        const float ra = __builtin_amdgcn_rsqf(sa * (1.f / AW) + EPS);
#pragma unroll
        for (int e = 0; e < 16; ++e) { v4u o; const unsigned d[4] = {aa[e].x, aa[e].y, aa[e].z, aa[e].w}; unsigned r[4];
#pragma unroll
            for (int q = 0; q < 4; ++q) r[q] = pk2(bf_lo(d[q]) * ra, bf_hi(d[q]) * ra);
            o.x = r[0]; o.y = r[1]; o.z = r[2]; o.w = r[3]; *(GAS v4u*)(rowp + part * 128 + e * 8) = o; }
#pragma unroll
        for (int e = 0; e < 16; ++e) { la[e] = *(const GAS v4u*)(rowp + AW + part * 128 + e * 8); }
#pragma unroll
        for (int e = 0; e < 16; ++e) { v4u o; const unsigned d[4] = {la[e].x, la[e].y, la[e].z, la[e].w}; unsigned r[4];
#pragma unroll
            for (int q = 0; q < 4; ++q) r[q] = pk2(bf_lo(d[q]) * rl, bf_hi(d[q]) * rl);
            o.x = r[0]; o.y = r[1]; o.z = r[2]; o.w = r[3]; *(GAS v4u*)(rowp + AW + part * 128 + e * 8) = o; }
    }
}

__device__ __forceinline__ att::BlockRef att_ref(Frame& F, int bh, int qb) {
    att::BlockRef r; const int b = bh >> 3, h = bh & 7;
    r.Q = F.Q + ((size_t)bh * SEQ + (size_t)qb * att::QB) * HD; r.K = F.K + (size_t)bh * SEQ * HD; r.V = F.VV + (size_t)bh * SEQ * HD;
    r.O = F.MRG + ((size_t)b * SEQ + (size_t)qb * att::QB) * DM + h * HD; r.KB = F.KB + (size_t)bh * SEQ; r.P0 = qb * att::QB;
    return r;
}
__device__ __forceinline__ void p3_attention(Frame& F, char* lds) {
    constexpr int NQB = SEQ / att::QB, NX = NQB / 2, TOTAL = BATCH * NH * NX;
    int L = F.vcu; if (L >= TOTAL) return;
    int pass = 0; int bh = L / NX, x = L % NX;
    att::BlockRef cur = att_ref(F, bh, x);
    att::Seam S;
    att::fox_prime(cur, lds, S, F.wave);
    for (;;) {
        const bool more_pass = pass == 0, more_item = L + F.G < TOTAL, last = !more_pass && !more_item;
        int passn = pass + 1, Ln = L;
        if (!more_pass) { passn = 0; Ln = more_item ? L + F.G : L; }
        const int bhn = Ln / NX, xn = Ln % NX;
        const att::BlockRef nxt = last ? cur : att_ref(F, bhn, passn ? NQB - 1 - xn : xn);
        att::fox_block(cur, nxt, lds, S, F.wave);
        if (last) break;
        cur = nxt; pass = passn; L = Ln;
    }
}

template <int N> __device__ __forceinline__ float row_ror(float v) { return __builtin_bit_cast(float, __builtin_amdgcn_update_dpp(0, __builtin_bit_cast(int, v), 0x120 + N, 0xf, 0xf, false)); }
__device__ __forceinline__ float fmax_s(float a, float b) { float r; asm("v_max_f32_e32 %0, %1, %2" : "=v"(r) : "v"(a), "v"(b)); return r; }
__device__ __forceinline__ float fmin_s(float a, float b) { float r; asm("v_min_f32_e32 %0, %1, %2" : "=v"(r) : "v"(a), "v"(b)); return r; }
__device__ __forceinline__ float row_allmax(float v) {
    asm volatile("s_nop 1\n\tv_max_f32_dpp %0, %0, %0 row_ror:8 row_mask:0xf bank_mask:0xf\n\t"
                 "s_nop 1\n\tv_max_f32_dpp %0, %0, %0 row_ror:4 row_mask:0xf bank_mask:0xf\n\t"
                 "s_nop 1\n\tv_max_f32_dpp %0, %0, %0 row_ror:2 row_mask:0xf bank_mask:0xf\n\t"
                 "s_nop 1\n\tv_max_f32_dpp %0, %0, %0 row_ror:1 row_mask:0xf bank_mask:0xf" : "+v"(v));
    return v;
}
__device__ __forceinline__ float row_allsum(float v) { v += row_ror<8>(v); v += row_ror<4>(v); v += row_ror<2>(v); v += row_ror<1>(v); return v; }
#define CE_DESC(a, b) do { const float hi_ = fmax_s(a, b), lo_ = fmin_s(a, b); a = hi_; b = lo_; } while (0)
__device__ __forceinline__ float row_top16(float (&Lv)[8], int r16) {
    CE_DESC(Lv[0], Lv[1]); CE_DESC(Lv[2], Lv[3]); CE_DESC(Lv[4], Lv[5]); CE_DESC(Lv[6], Lv[7]);
    CE_DESC(Lv[0], Lv[2]); CE_DESC(Lv[1], Lv[3]); CE_DESC(Lv[4], Lv[6]); CE_DESC(Lv[5], Lv[7]);
    CE_DESC(Lv[1], Lv[2]); CE_DESC(Lv[5], Lv[6]);
    CE_DESC(Lv[0], Lv[4]); CE_DESC(Lv[1], Lv[5]); CE_DESC(Lv[2], Lv[6]); CE_DESC(Lv[3], Lv[7]);
    CE_DESC(Lv[2], Lv[4]); CE_DESC(Lv[3], Lv[5]);
    CE_DESC(Lv[1], Lv[2]); CE_DESC(Lv[3], Lv[4]); CE_DESC(Lv[5], Lv[6]);
    float res = 0.f; const float NEG = -__builtin_inff();
#pragma unroll
    for (int k = 0; k < 16; ++k) {
        const float m = row_allmax(Lv[0]);
        res = (r16 == k) ? m : res;
        const bool win = (Lv[0] == m);
#pragma unroll
        for (int j = 0; j < 7; ++j) Lv[j] = win ? Lv[j + 1] : Lv[j];
        Lv[7] = win ? NEG : Lv[7];
    }
    return res;
}
__device__ __forceinline__ void p8_topk(Frame& F) {
    LAS unsigned char* L = F.lds;
    const int lane = F.lane, wave = F.wave, r16 = lane & 15, g4 = lane >> 4;
    for (int grp = F.bx; grp < 256; grp += F.G) {
        const int hd = grp & 7, widx = grp >> 3;
        __syncthreads();
        for (int idx = F.tid; idx < 2 * 128 * 16; idx += NTHR) { const int half = idx >> 11, row = (idx >> 4) & 127, c8 = idx & 15;
            const bf16_t* src = (half ? F.K2 : F.K1) + ((size_t)hd * PNK + row) * 128 + c8 * 8;
            *(LAS v4u*)(L + half * 34816 + row * 272 + c8 * 16) = *(const GAS v4u*)src; }
        __syncthreads();
        for (int it = wave; it < 32; it += NWAVES) {
            const int t0 = widx * 512 + it * 16;
            bf16x8 a1[4], a2[4];
            { const bf16_t* qp = F.QP + (size_t)(t0 + r16) * DM + hd * PQD + 8 * g4;
#pragma unroll
              for (int ks = 0; ks < 4; ++ks) { a1[ks] = *(const GAS bf16x8*)(qp + 32 * ks); a2[ks] = *(const GAS bf16x8*)(qp + 128 + 32 * ks); } }
            f32x4 s1[8], s2[8];
#pragma unroll
            for (int nt = 0; nt < 8; ++nt) { s1[nt] = (f32x4){0.f, 0.f, 0.f, 0.f}; s2[nt] = (f32x4){0.f, 0.f, 0.f, 0.f};
#pragma unroll
                for (int ks = 0; ks < 4; ++ks) {
                    const bf16x8 b1 = *(const LAS bf16x8*)(L + (16 * nt + r16) * 272 + (32 * ks + 8 * g4) * 2);
                    const bf16x8 b2 = *(const LAS bf16x8*)(L + 34816 + (16 * nt + r16) * 272 + (32 * ks + 8 * g4) * 2);
                    s1[nt] = __builtin_amdgcn_mfma_f32_16x16x32_bf16(a1[ks], b1, s1[nt], 0, 0, 0);
                    s2[nt] = __builtin_amdgcn_mfma_f32_16x16x32_bf16(a2[ks], b2, s2[nt], 0, 0, 0); } }
#pragma unroll
            for (int i = 0; i < 4; ++i) {
                float l1[8], l2[8];
#pragma unroll
                for (int nt = 0; nt < 8; ++nt) {
                    l1[nt] = bitsf((fbits(s1[nt][i]) & ~0x7Fu) | (unsigned)(16 * nt + r16));
                    l2[nt] = bitsf((fbits(s2[nt][i]) & ~0x7Fu) | (unsigned)(16 * nt + r16)); }
                __builtin_amdgcn_sched_barrier(0);
                const float v1 = row_top16(l1, r16); __builtin_amdgcn_sched_barrier(0);
                const float v2 = row_top16(l2, r16); __builtin_amdgcn_sched_barrier(0);
                float cnd[16];
#pragma unroll
                for (int bb = 0; bb < 16; ++bb) { const float w = __shfl(v2, bb, 16);
                    cnd[bb] = __builtin_bit_cast(float, (__builtin_bit_cast(unsigned, v1 + w) & ~0xFFu) | (unsigned)(r16 * 16 + bb)); }
                float fin = 0.f; const float NEG = -__builtin_inff();
#pragma unroll
                for (int k = 0; k < 16; ++k) {
                    const float m = row_allmax(cnd[0]);
                    fin = (r16 == k) ? m : fin;
                    const bool win = (cnd[0] == m);
#pragma unroll
                    for (int j = 0; j < 15; ++j) cnd[j] = win ? cnd[j + 1] : cnd[j];
                    cnd[15] = win ? NEG : cnd[15];
                }
                const unsigned fb = __builtin_bit_cast(unsigned, fin); const int ra = (fb >> 4) & 15, rb = fb & 15;
                const float pv1 = __shfl(v1, ra, 16), pv2 = __shfl(v2, rb, 16);
                const int i1 = __builtin_bit_cast(unsigned, pv1) & 0x7F, i2 = __builtin_bit_cast(unsigned, pv2) & 0x7F;
                const float vs = pv1 + pv2;
                const float mx = row_allmax(vs); const float ex = fexp(vs - mx); const float sm = row_allsum(ex);
                const size_t o = (size_t)(t0 + 4 * g4 + i) * NSEL + hd * PTOPK + r16;
                F.EIDX[o] = i1 * PNK + i2; F.EW[o] = ex / sm;
                __builtin_amdgcn_sched_barrier(0);
            }
        }
    }
}

#ifdef P8_NAIVE
__device__ __forceinline__ void p8_naive(Frame& F) {
    LAS float* base = (LAS float*)F.lds;
    if (F.tid < 64) {
        LAS float* sc = base + F.tid * 320; LAS int* ia = (LAS int*)(sc + 256); LAS int* ib = ia + 16;
        for (int pair = F.bx * 64 + F.tid; pair < T * PH; pair += F.G * 64) { const int t = pair >> 3, hd = pair & 7;
            for (int n = 0; n < 128; ++n) { float a = 0.f, b = 0.f;
                for (int d = 0; d < 128; ++d) { const float q1 = bf_lo((unsigned)F.QP[(size_t)t * DM + hd * 256 + d]), q2 = bf_lo((unsigned)F.QP[(size_t)t * DM + hd * 256 + 128 + d]);
                    a += q1 * F.peer_k1[((size_t)hd * 128 + n) * 128 + d]; b += q2 * F.peer_k2[((size_t)hd * 128 + n) * 128 + d]; }
                sc[n] = a; sc[128 + n] = b; }
            int na = 0, nb = 0;
            for (int n = 0; n < 128; ++n) { int c1 = 0, c2 = 0; for (int m = 0; m < 128; ++m) { c1 += (sc[m] > sc[n]) || (sc[m] == sc[n] && m < n); c2 += (sc[128 + m] > sc[128 + n]) || (sc[128 + m] == sc[128 + n] && m < n); }
                if (c1 < 16) ia[na++] = n; if (c2 < 16) ib[nb++] = n; }
            float bound = 1e30f; int pa = -1, pb = -1; float vs[16]; int ee[16];
            for (int r = 0; r < 16; ++r) { float mx = -1e30f; int ba = 0, bb = 0;
                for (int a = 0; a < 16; ++a) for (int b = 0; b < 16; ++b) { const float v = sc[ia[a]] + sc[128 + ib[b]];
                    const bool lt = v < bound || (v == bound && (ia[a] * 128 + ib[b]) > (pa * 128 + pb));
                    if (lt && (v > mx)) { mx = v; ba = ia[a]; bb = ib[b]; } }
                bound = mx; pa = ba; pb = bb; vs[r] = mx; ee[r] = ba * 128 + bb; }
            float sm = 0.f;
#pragma unroll
            for (int r = 0; r < 16; ++r) { vs[r] = expf(vs[r] - vs[0]); sm += vs[r]; }
#pragma unroll
            for (int r = 0; r < 16; ++r) { F.EIDX[(size_t)t * NSEL + hd * 16 + r] = ee[r]; F.EW[(size_t)t * NSEL + hd * 16 + r] = vs[r] / sm; }
        }
    }
}
#endif
__device__ __forceinline__ void cvt16(const v4u& r, float (&f)[16]) {
    const unsigned dd[4] = {r.x, r.y, r.z, r.w};
#pragma unroll
    for (int c = 0; c < 4; ++c) { const f32x2 lo = __builtin_amdgcn_cvt_pk_f32_fp8((int)dd[c], false), hi = __builtin_amdgcn_cvt_pk_f32_fp8((int)dd[c], true);
        f[4 * c] = lo[0]; f[4 * c + 1] = lo[1]; f[4 * c + 2] = hi[0]; f[4 * c + 3] = hi[1]; }
}
__device__ __forceinline__ void p9a_udots(Frame& F) {
    const int lane = F.lane, sub = lane & 7, g = lane >> 3;
    const bool b2 = (lane & 4) != 0, b1 = (lane & 2) != 0, b0 = (lane & 1) != 0;
    for (int vid = F.bx; vid < 256; vid += F.G) { const int x = vid & 7, c = vid >> 3;
        for (int si = 0; si < 2; ++si) { const int s = x + 8 * si;
            const unsigned char* tab = F.U8 + (size_t)s * ((size_t)NEXP * 128) + 16 * sub;
            const int tb = c * 512 + F.wave;
            int idn[8]; v4u rc[8]; v4u hc0, hc1;
            { const int* ei = F.EIDX + (size_t)tb * NSEL + g;
#pragma unroll
              for (int i = 0; i < 8; ++i) idn[i] = ei[8 * i];
              const GAS v4u* hp = (const GAS v4u*)(F.H + (size_t)tb * DM + 128 * s + 16 * sub); hc0 = hp[0]; hc1 = hp[1];
#pragma unroll
              for (int i = 0; i < 8; ++i) rc[i] = *(const GAS v4u*)(tab + (size_t)idn[i] * 128);
#pragma unroll
              for (int i = 0; i < 8; ++i) idn[i] = ei[64 + 8 * i]; }
#pragma unroll 1
            for (int k = 0; k < 64; ++k) { const int t = tb + 8 * k; const int t1 = tb + 8 * (k + 1 < 64 ? k + 1 : 63);
                float hf[16];
                { const unsigned dd[8] = {hc0.x, hc0.y, hc0.z, hc0.w, hc1.x, hc1.y, hc1.z, hc1.w};
#pragma unroll
                  for (int q = 0; q < 8; ++q) { hf[2 * q] = bf_lo(dd[q]); hf[2 * q + 1] = bf_hi(dd[q]); } }
                { const GAS v4u* hp = (const GAS v4u*)(F.H + (size_t)t1 * DM + 128 * s + 16 * sub); hc0 = hp[0]; hc1 = hp[1]; }
                const int* ei1 = F.EIDX + (size_t)t1 * NSEL + g;
                float p[16];
#pragma unroll
                for (int it = 0; it < 16; ++it) { const int i = it & 7; float f[16]; cvt16(rc[i], f);
                    rc[i] = *(const GAS v4u*)(tab + (size_t)idn[i] * 128);
                    idn[i] = ei1[(it < 8 ? 0 : 64) + 8 * i];
                    float p0 = 0.f, p1 = 0.f;
#pragma unroll
                    for (int q = 0; q < 16; q += 2) { p0 = fmaf(f[q], hf[q], p0); p1 = fmaf(f[q + 1], hf[q + 1], p1); }
                    p[it] = p0 + p1; }
                float q8[8], q4[4], q2[2];
#pragma unroll
                for (int i = 0; i < 8; ++i) { const float keep = b2 ? p[8 + i] : p[i], send = b2 ? p[i] : p[8 + i]; q8[i] = keep + __shfl_xor(send, 4); }
#pragma unroll
                for (int i = 0; i < 4; ++i) { const float keep = b1 ? q8[4 + i] : q8[i], send = b1 ? q8[i] : q8[4 + i]; q4[i] = keep + __shfl_xor(send, 2); }
#pragma unroll
                for (int i = 0; i < 2; ++i) { const float keep = b0 ? q4[2 + i] : q4[i], send = b0 ? q4[i] : q4[2 + i]; q2[i] = keep + __shfl_xor(send, 1); }
                float* pd = F.PD + ((size_t)s * T + t) * NSEL + 16 * sub + g;
                pd[0] = q2[0]; pd[8] = q2[1];
            }
        }
    }
}
__device__ __forceinline__ void p9b_act(Frame& F) {
    const size_t gt = (size_t)F.vcu * NTHR + F.tid, ngt = (size_t)F.G * NTHR;
    for (size_t idx = gt; idx < (size_t)T * NSEL; idx += ngt) {
        const int ex = F.EIDX[idx]; float sum = 0.f;
#pragma unroll
        for (int s = 0; s < 16; ++s) sum += F.PD[(size_t)s * T * NSEL + idx];
        F.ACT[idx] = gelu_tanh(sum * F.USC[ex]) * F.EW[idx] * F.VSC[ex];
    }
}
__device__ __forceinline__ void p9c_vacc(Frame& F) {
    const int lane = F.lane, sub = lane & 7, g = lane >> 3;
    const bool b5 = (lane & 32) != 0, b4 = (lane & 16) != 0, b3 = (lane & 8) != 0;
    for (int vid = F.bx; vid < 256; vid += F.G) { const int x = vid & 7, c = vid >> 3;
        for (int si = 0; si < 2; ++si) { const int s = x + 8 * si;
            const unsigned char* tab = F.V8 + (size_t)s * ((size_t)NEXP * 128) + 16 * sub;
            const int tb = c * 512 + F.wave;
            int idn[8]; v4u rc[8]; float ac[8];
            { const int* ei = F.EIDX + (size_t)tb * NSEL + g; const float* ap = F.ACT + (size_t)tb * NSEL + g;
#pragma unroll
              for (int i = 0; i < 8; ++i) { idn[i] = ei[8 * i]; ac[i] = ap[8 * i]; }
#pragma unroll
              for (int i = 0; i < 8; ++i) rc[i] = *(const GAS v4u*)(tab + (size_t)idn[i] * 128);
#pragma unroll
              for (int i = 0; i < 8; ++i) idn[i] = ei[64 + 8 * i]; }
#pragma unroll 1
            for (int k = 0; k < 64; ++k) { const int t = tb + 8 * k; const int t1 = tb + 8 * (k + 1 < 64 ? k + 1 : 63);
                const int* ei1 = F.EIDX + (size_t)t1 * NSEL + g; const float* ap0 = F.ACT + (size_t)t * NSEL + g; const float* ap1 = F.ACT + (size_t)t1 * NSEL + g;
                float ya[16];
#pragma unroll
                for (int i = 0; i < 16; ++i) ya[i] = 0.f;
#pragma unroll
                for (int it = 0; it < 16; ++it) { const int i = it & 7; float f[16]; cvt16(rc[i], f); const float a = ac[i];
                    rc[i] = *(const GAS v4u*)(tab + (size_t)idn[i] * 128);
                    ac[i] = (it < 8) ? ap0[64 + 8 * i] : ap1[8 * i];
                    idn[i] = ei1[(it < 8 ? 0 : 64) + 8 * i];
#pragma unroll
                    for (int q = 0; q < 16; ++q) ya[q] = fmaf(a, f[q], ya[q]); }
                float y8[8], y4[4], y2[2];
#pragma unroll
                for (int i = 0; i < 8; ++i) { const float keep = b5 ? ya[8 + i] : ya[i], send = b5 ? ya[i] : ya[8 + i]; y8[i] = keep + __shfl_xor(send, 32); }
#pragma unroll
                for (int i = 0; i < 4; ++i) { const float keep = b4 ? y8[4 + i] : y8[i], send = b4 ? y8[i] : y8[4 + i]; y4[i] = keep + __shfl_xor(send, 16); }
#pragma unroll
                for (int i = 0; i < 2; ++i) { const float keep = b3 ? y4[2 + i] : y4[i], send = b3 ? y4[i] : y4[2 + i]; y2[i] = keep + __shfl_xor(send, 8); }
                float* yp = F.Y + (size_t)t * DM + 128 * s + 16 * sub + 2 * g;
                *(GAS f32x2*)yp = (f32x2){y2[0], y2[1]};
            }
        }
    }
}
__device__ __forceinline__ void p9d_final(Frame& F) {
    const int lane = F.lane; const int gw = F.vcu * NWAVES + F.wave, NGW = F.G * NWAVES;
    for (int t = gw; t < T; t += NGW) {
        const int b = t >> 12;
        float* op = F.out + (size_t)t * DM; const float* ga = F.MOD + (size_t)b * NADA + 5 * DM; const float* yp = F.Y + (size_t)t * DM;
        f32x4 v[8]; float ss = 0.f;
#pragma unroll
        for (int j = 0; j < 8; ++j) { const int col = 4 * (lane + 64 * j); const f32x4 xa = *(const GAS f32x4*)(op + col), g4v = *(const GAS f32x4*)(ga + col), yv = *(const GAS f32x4*)(yp + col);
            v[j] = xa + g4v * yv; ss += (v[j][0] * v[j][0] + v[j][1] * v[j][1]) + (v[j][2] * v[j][2] + v[j][3] * v[j][3]); }
        const float rstd = __builtin_amdgcn_rsqf(wave_sum(ss) * (1.f / DM) + EPS);
#pragma unroll
        for (int j = 0; j < 8; ++j) { const int col = 4 * (lane + 64 * j); const f32x4 gf = *(const GAS f32x4*)(F.g_final + col); *(GAS f32x4*)(op + col) = v[j] * rstd * gf; }
    }
}

#ifdef DBG_UPTO
__device__ __forceinline__ unsigned dhash(unsigned x) { x ^= x >> 16; x *= 0x7feb352du; x ^= x >> 15; x *= 0x846ca68bu; x ^= x >> 16; return x; }
__device__ __forceinline__ float dbf(const bf16_t* p, size_t i) { return __builtin_bit_cast(float, (unsigned)p[i] << 16); }
__device__ __forceinline__ float dsilu(float v) { return v / (1.f + expf(-v)); }
__device__ __forceinline__ float dgelu(float x) { return 0.5f * x * (1.f + tanhf(0.7978845608028654f * (x + 0.044715f * x * x * x))); }
__global__ void __launch_bounds__(512) dbg_check(Args args, int upto) {
    __shared__ unsigned emax[20];
    __shared__ float sbuf[8][4096 + 128];
    const int tid = threadIdx.x, lane = tid & 63, wave = tid >> 6;
    if (tid < 20) emax[tid] = 0u;
    __syncthreads();
    const float* x = args.in[0]; const float* c = args.in[1]; const float* w_ada = args.in[2]; const float* b_ada = args.in[3]; const float* g_mix = args.in[4];
    const float* w_in = args.in[5]; const float* b_f = args.in[6]; const float* conv_w = args.in[7]; const float* conv_b = args.in[8];
    const float* lru_w_a = args.in[9]; const float* lru_b_a = args.in[10]; const float* lru_w_x = args.in[11]; const float* lru_b_x = args.in[12]; const float* lru_lambda = args.in[13];
    const float* g_attn_out = args.in[14]; const float* g_lru_out = args.in[15]; const float* w_out = args.in[16];
    unsigned char* ws = args.ws; float* out = args.out;
    const float* MOD = (const float*)(ws + WS_MOD); const float* LF = (const float*)(ws + WS_LF); const float* KB = (const float*)(ws + WS_KB); const float* SUMM = (const float*)(ws + WS_SUMM);
    const bf16_t* H = (const bf16_t*)(ws + WS_H); const bf16_t* Q = (const bf16_t*)(ws + WS_Q); const bf16_t* K = (const bf16_t*)(ws + WS_K); const bf16_t* V = (const bf16_t*)(ws + WS_VV);
    const bf16_t* LX = (const bf16_t*)(ws + WS_LX); const bf16_t* GLY = (const bf16_t*)(ws + WS_GLY); const bf16_t* MRG = (const bf16_t*)(ws + WS_MRG);
#define REPORT(k, e) atomicMax(&emax[k], __float_as_uint(fminf(fmaxf((e), 0.f), 1e30f)))
    if (upto >= 1) { const int b = tid & 3, col = dhash(tid * 7 + 1) % NADA; float s = 0.f;
        for (int k = 0; k < DM; ++k) s += dsilu(c[b * DM + k]) * w_ada[(size_t)k * NADA + col];
        s += b_ada[col]; REPORT(1, fabsf(MOD[b * NADA + col] - s) / (2e-3f * (fabsf(s) + 0.05f))); }
    if (upto >= 2 && upto < 7) { const int row = dhash(tid * 13 + 5) % T, col = dhash(tid * 17 + 3) % DM, b = row >> 12; float ss = 0.f;
        for (int k = 0; k < DM; ++k) { const float v = x[(size_t)row * DM + k]; ss += v * v; }
        const float rstd = 1.f / sqrtf(ss / DM + EPS);
        const float h = x[(size_t)row * DM + col] * rstd * g_mix[col] * (1.f + MOD[b * NADA + DM + col]) + MOD[b * NADA + col];
        REPORT(2, fabsf(dbf(H, (size_t)row * DM + col) - h) / (1e-2f * (fabsf(h) + 0.1f)));
        const int j = tid & 7; float z = b_f[j];
        for (int k = 0; k < DM; ++k) z += dbf(H, (size_t)row * DM + k) * w_in[(size_t)k * INC + OFF_F + j];
        const float lf = fminf(z, 0.f) - log1pf(expf(-fabsf(z)));
        REPORT(3, fabsf(LF[(size_t)(b * NH + j) * SEQ + (row & (SEQ - 1))] - lf) / 2e-2f); }
    if (upto >= 3 && upto < 7) { const int row = dhash(tid * 19 + 11) % T, coln = dhash(tid * 23 + 7) % 5120, b = row >> 12, s = row & 4095;
        const int src = coln < 3072 ? coln : coln + 8; float v = 0.f;
        for (int k = 0; k < DM; ++k) v += dbf(H, (size_t)row * DM + k) * w_in[(size_t)k * INC + src];
        const int cat = coln >> 10, cc = coln & 1023; float got;
        if (cat < 3) { const bf16_t* base = cat == 0 ? Q : (cat == 1 ? K : V); got = dbf(base, ((size_t)((b * 8 + (cc >> 7)) * 4096 + s)) * 128 + (cc & 127)); }
        else if (cat == 3) got = dbf(LX, (size_t)row * 1024 + cc);
        else { got = dbf(GLY, (size_t)row * 1024 + cc); v = dgelu(v); }
        REPORT(4 + (cat == 4 ? 1 : 0) + (cat == 3 ? 2 : 0), fabsf(got - v) / (3e-2f * (fabsf(v) + 0.3f)));
        if (tid < 32) { float cum = 0.f, e = 0.f;
            for (int t = 0; t < SEQ; ++t) { cum += LF[(size_t)tid * SEQ + t]; e = fmaxf(e, fabsf(KB[(size_t)tid * SEQ + t] * (-0.08838834764831845f) - cum) / (1e-3f * (fabsf(cum) + 1.f))); }
            REPORT(7, e); } }
    if (upto >= 4) {
        for (int smp = 0; smp < 4; ++smp) { const unsigned hsh = dhash((wave * 4 + smp) * 31 + 17); const int bh = hsh & 31, t = (smp == 0) ? (int)((hsh >> 5) & 255) : (int)((hsh >> 5) & 4095); const int b = bh >> 3, h = bh & 7;
            float* lg = sbuf[wave]; float* qs = lg + 4096;
            qs[lane] = dbf(Q, ((size_t)bh * SEQ + t) * HD + lane); qs[64 + lane] = dbf(Q, ((size_t)bh * SEQ + t) * HD + 64 + lane);
            __builtin_amdgcn_wave_barrier();
            float mx = -1e30f;
            for (int s = lane; s <= t; s += 64) { float d = 0.f; for (int k = 0; k < HD; ++k) d += qs[k] * dbf(K, ((size_t)bh * SEQ + s) * HD + k);
                const float l = d * 0.08838834764831845f + KB[(size_t)bh * SEQ + s] * 0.08838834764831845f; lg[s] = l; mx = fmaxf(mx, l); }
            for (int o = 1; o < 64; o <<= 1) mx = fmaxf(mx, __shfl_xor(mx, o));
            float sm = 0.f;
            for (int s = lane; s <= t; s += 64) { const float p = expf(lg[s] - mx); lg[s] = p; sm += p; }
            for (int o = 1; o < 64; o <<= 1) sm += __shfl_xor(sm, o);
            __builtin_amdgcn_wave_barrier();
            float o0 = 0.f, o1 = 0.f;
            for (int s = 0; s <= t; ++s) { const float p = lg[s]; o0 += p * dbf(V, ((size_t)bh * SEQ + s) * HD + lane); o1 += p * dbf(V, ((size_t)bh * SEQ + s) * HD + 64 + lane); }
            o0 /= sm; o1 /= sm;
            if (upto == 4) {
                const float g0 = dbf(MRG, ((size_t)b * SEQ + t) * DM + h * HD + lane), g1 = dbf(MRG, ((size_t)b * SEQ + t) * DM + h * HD + 64 + lane);
                REPORT(8, fmaxf(fabsf(g0 - o0) / (3e-2f * (fabsf(o0) + 0.3f)), fabsf(g1 - o1) / (3e-2f * (fabsf(o1) + 0.3f)))); }
            __builtin_amdgcn_wave_barrier();
        }
        { const unsigned hsh = dhash(tid * 37 + 29); const int b = hsh & 3, chunk = (hsh >> 2) & 63, ch = (hsh >> 8) & 1023, n = ch >> 7, j = ch & 127;
          const float sp = log1pf(expf(-lru_lambda[ch])) ;
          float P = 1.f, Hh = 0.f;
          for (int tt = 0; tt < 64; ++tt) { const int s = chunk * 64 + tt; float ga = lru_b_a[ch], gx = lru_b_x[ch], xcj = 0.f;
              for (int i = 0; i < 128; ++i) { float xc = conv_b[n * 128 + i];
                  for (int k = 0; k < 4; ++k) { const int ss = s - 3 + k; if (ss >= 0) xc += conv_w[k * LW + n * 128 + i] * dbf(LX, ((size_t)b * SEQ + ss) * LW + n * 128 + i); }
                  ga += xc * lru_w_a[((size_t)n * 128 + i) * 128 + j]; gx += xc * lru_w_x[((size_t)n * 128 + i) * 128 + j]; if (i == j) xcj = xc; }
              const float r = 1.f / (1.f + expf(-ga)), ig = 1.f / (1.f + expf(-gx)); const float la = -8.f * r * sp; const float a = expf(la);
              const float bt = sqrtf(-expm1f(2.f * la)) * (ig * xcj); Hh = a * Hh + bt; P *= a; }
          const float gp = SUMM[(((size_t)(b * 64 + chunk)) * LW + ch) * 2], gh = SUMM[(((size_t)(b * 64 + chunk)) * LW + ch) * 2 + 1];
          REPORT(9, fmaxf(fabsf(gp - P) / (2e-2f * (fabsf(P) + 0.01f)), fabsf(gh - Hh) / (3e-2f * (fabsf(Hh) + 0.05f)))); }
    }
    if (upto >= 5) { const int row = dhash(tid * 41 + 3) % T; float sa = 0.f, sl = 0.f;
        for (int k = 0; k < 1024; ++k) { const float a = dbf(MRG, (size_t)row * DM + k), l = dbf(MRG, (size_t)row * DM + 1024 + k); sa += a * a; sl += l * l; }
        REPORT(10, fmaxf(fabsf(sa / 1024.f - 1.f), fabsf(sl / 1024.f - 1.f)) / 2e-2f);
        if (tid < 64) { const int pr = tid >> 1; const int b = pr & 3, ch = dhash(tid * 43 + 1) & 1023, n = ch >> 7, j = ch & 127, tend = 70 + (pr >> 2) * 8;
            const float sp = log1pf(expf(-lru_lambda[ch])); float hcur = 0.f;
            for (int s = 0; s <= tend; ++s) { float ga = lru_b_a[ch], gx = lru_b_x[ch], xcj = 0.f;
                for (int i = 0; i < 128; ++i) { float xc = conv_b[n * 128 + i];
                    for (int k = 0; k < 4; ++k) { const int ss = s - 3 + k; if (ss >= 0) xc += conv_w[k * LW + n * 128 + i] * dbf(LX, ((size_t)b * SEQ + ss) * LW + n * 128 + i); }
                    ga += xc * lru_w_a[((size_t)n * 128 + i) * 128 + j]; gx += xc * lru_w_x[((size_t)n * 128 + i) * 128 + j]; if (i == j) xcj = xc; }
                const float r = 1.f / (1.f + expf(-ga)), ig = 1.f / (1.f + expf(-gx)); const float la = -8.f * r * sp; const float a = expf(la);
                hcur = a * hcur + sqrtf(-expm1f(2.f * la)) * (ig * xcj); }
            sbuf[0][tid] = hcur * dbf(GLY, ((size_t)b * SEQ + tend) * LW + ch);
            sbuf[1][tid] = dbf(MRG, ((size_t)b * SEQ + tend) * DM + 1024 + ch); }
        __syncthreads();
        if (tid < 64 && (tid & 1) == 0) {
            const float r0 = sbuf[0][tid], r1 = sbuf[0][tid + 1], k0 = sbuf[1][tid], k1 = sbuf[1][tid + 1];
            REPORT(11, fabsf(r0 * k1 - r1 * k0) / (5e-2f * (fabsf(r0 * k1) + fabsf(r1 * k0) + 1e-3f))); }
    }
    if (upto >= 6 && upto < 10) { const int row = dhash(tid * 47 + 9) % T, col = dhash(tid * 53 + 13) % DM, b = row >> 12; float v = 0.f;
        for (int k = 0; k < DM; ++k) v += dbf(MRG, (size_t)row * DM + k) * w_out[(size_t)k * DM + col] * (k < 1024 ? g_attn_out[k] : g_lru_out[k - 1024]);
        const float x1 = x[(size_t)row * DM + col] + MOD[b * NADA + 2 * DM + col] * v;
        REPORT(12, fabsf(out[(size_t)row * DM + col] - x1) / (2e-2f * (fabsf(x1) + 0.2f))); }
    const float* g_ffn = args.in[17]; const float* w_q = args.in[18]; const float* pk1 = args.in[19]; const float* pk2 = args.in[20]; const float* pu = args.in[21]; const float* pv = args.in[22]; const float* g_final = args.in[23];
    const bf16_t* QP = (const bf16_t*)(ws + WS_QP); const int* EIDX = (const int*)(ws + WS_EIDX); const float* EW = (const float*)(ws + WS_EW);
    if (upto >= 7 && upto < 10) { const int row = dhash(tid * 59 + 5) % T, col = dhash(tid * 61 + 3) % DM, b = row >> 12; float ss = 0.f;
        for (int k = 0; k < DM; ++k) { const float v = out[(size_t)row * DM + k]; ss += v * v; }
        const float rstd = 1.f / sqrtf(ss / DM + EPS);
        const float h = out[(size_t)row * DM + col] * rstd * g_ffn[col] * (1.f + MOD[b * NADA + 4 * DM + col]) + MOD[b * NADA + 3 * DM + col];
        REPORT(13, fabsf(dbf(H, (size_t)row * DM + col) - h) / (1e-2f * (fabsf(h) + 0.1f))); }
    if (upto >= 8) { const int row = dhash(tid * 67 + 11) % T, col = dhash(tid * 71 + 7) % DM; float v = 0.f;
        for (int k = 0; k < DM; ++k) v += dbf(H, (size_t)row * DM + k) * w_q[(size_t)k * DM + col];
        REPORT(14, fabsf(dbf(QP, (size_t)row * DM + col) - v) / (3e-2f * (fabsf(v) + 0.3f))); }
    __syncthreads();
    if (upto >= 9 && tid < 64) { float* sc = &sbuf[0][0] + tid * 256; const unsigned hsh = dhash(tid * 73 + 19); const int t = hsh % T, hd = (hsh >> 16) & 7;
        for (int n = 0; n < 128; ++n) { float a = 0.f, bsum = 0.f;
            for (int d = 0; d < 128; ++d) { a += dbf(QP, (size_t)t * DM + hd * 256 + d) * dbf((const bf16_t*)(ws + WS_K1), ((size_t)hd * 128 + n) * 128 + d); bsum += dbf(QP, (size_t)t * DM + hd * 256 + 128 + d) * dbf((const bf16_t*)(ws + WS_K2), ((size_t)hd * 128 + n) * 128 + d); }
            sc[n] = a; sc[128 + n] = bsum; }
        float th1 = 0.f, th2 = 0.f;
        for (int n = 0; n < 128; ++n) { int c1 = 0, c2 = 0; for (int m = 0; m < 128; ++m) { c1 += sc[m] > sc[n]; c2 += sc[128 + m] > sc[128 + n]; } if (c1 == 15) th1 = sc[n]; if (c2 == 15) th2 = sc[128 + n]; }
        float best16 = -1e30f;
        {
          float bound = 1e30f;
          for (int r = 0; r < 16; ++r) { float mx = -1e30f;
              for (int a = 0; a < 128; ++a) if (sc[a] >= th1) for (int bq = 0; bq < 128; ++bq) if (sc[128 + bq] >= th2) { const float v = sc[a] + sc[128 + bq]; if (v < bound && v > mx) mx = v; }
              bound = mx; }
          best16 = bound; }
        float e = 0.f, e2 = 0.f, e3 = 0.f, mxs = -1e30f;
        for (int k = 0; k < 16; ++k) { const int ex = EIDX[(size_t)t * NSEL + hd * 16 + k]; const int i1 = ex >> 7, i2 = ex & 127;
            if (ex < 0 || ex >= NEXP) { e3 = 1e6f; continue; }
            const float v = sc[i1] + sc[128 + i2]; mxs = fmaxf(mxs, v);
            e = fmaxf(e, (best16 - v) / 3e-2f);
            for (int k2 = 0; k2 < k; ++k2) if (EIDX[(size_t)t * NSEL + hd * 16 + k2] == ex) e3 = 1e5f; }
        float sm = 0.f; for (int k = 0; k < 16; ++k) { const int ex = EIDX[(size_t)t * NSEL + hd * 16 + k] & (NEXP - 1); sm += expf(sc[ex >> 7] + sc[128 + (ex & 127)] - mxs); }
        for (int k = 0; k < 16; ++k) { const int ex = EIDX[(size_t)t * NSEL + hd * 16 + k] & (NEXP - 1); const float w = expf(sc[ex >> 7] + sc[128 + (ex & 127)] - mxs) / sm;
            e2 = fmaxf(e2, fabsf(EW[(size_t)t * NSEL + hd * 16 + k] - w) / (3e-2f * (w + 0.02f))); }
        REPORT(15, e); REPORT(17, e2); REPORT(18, e3); }
    __syncthreads();
    if (upto >= 10) {
        for (int smp = 0; smp < 2; ++smp) { const int row = dhash((wave * 2 + smp) * 79 + 23) % T, b = row >> 12;
            float x2[32]; float ss = 0.f;
#pragma unroll 1
            for (int j = 0; j < 32; ++j) { const int col = lane + 64 * j; float v = 0.f;
                for (int k = 0; k < DM; ++k) v += dbf(MRG, (size_t)row * DM + k) * w_out[(size_t)k * DM + col] * (k < 1024 ? g_attn_out[k] : g_lru_out[k - 1024]);
                sbuf[wave][col] = x[(size_t)row * DM + col] + MOD[b * NADA + 2 * DM + col] * v; }
            for (int j = 0; j < 32; ++j) sbuf[wave][2048 + lane + 64 * j] = 0.f;
            for (int e = 0; e < NSEL; ++e) { const int ex = EIDX[(size_t)row * NSEL + e] & (NEXP - 1); const float w = EW[(size_t)row * NSEL + e]; float d = 0.f;
                for (int j = 0; j < 32; ++j) { const int col = lane + 64 * j; d += dbf(H, (size_t)row * DM + col) * pu[(size_t)ex * DM + col]; }
                for (int o = 1; o < 64; o <<= 1) d += __shfl_xor(d, o);
                const float act = dgelu(d) * w;
                for (int j = 0; j < 32; ++j) { const int col = lane + 64 * j; sbuf[wave][2048 + col] += act * pv[(size_t)ex * DM + col]; } }
            for (int j = 0; j < 32; ++j) { const int col = lane + 64 * j; const float v = sbuf[wave][col] + MOD[b * NADA + 5 * DM + col] * sbuf[wave][2048 + col]; sbuf[wave][col] = v; ss += v * v; }
            for (int o = 1; o < 64; o <<= 1) ss += __shfl_xor(ss, o);
            const float rstd = 1.f / sqrtf(ss / DM + EPS); float e = 0.f;
            for (int j = 0; j < 32; ++j) { const int col = lane + 64 * j; const float r = sbuf[wave][col] * rstd * g_final[col]; e = fmaxf(e, fabsf(out[(size_t)row * DM + col] - r) / (3e-2f * (fabsf(r) + 0.3f))); }
            REPORT(16, e); (void)x2; }
    }
    __syncthreads();
    for (size_t i = tid; i < (size_t)T * DM; i += 512) out[i] = 0.f;
    __syncthreads();
    if (tid == 0) { float code = 0.f;
        for (int k = 18; k >= 1; --k) if (k != 16 && __uint_as_float(emax[k]) > 1.f) code = powf(10.f, (float)(k + 1)) * fminf(9.9f, 1.f + log10f(__uint_as_float(emax[k])));
        out[0] = code; }
}
#endif

__global__ void __launch_bounds__(NWAVES * 64, 2) hymba_fwd(Args args) {
    unsigned char* const lds = g_lds;
    Frame F;
    F.lds = (LAS unsigned char*)lds;
    F.MISC = (volatile LAS unsigned*)(F.lds + MISC_OFF);
    { const int t0_ = (int)__builtin_amdgcn_workitem_id_x();
      F.wave = __builtin_amdgcn_readfirstlane(t0_ >> 6); }
    F.tid = ktid(F.wave); F.lane = F.tid & 63;
    for (int u = F.tid; u < (LDS_BYTES - LDSCTL_OFF) / 4; u += NWAVES * 64) ((LAS unsigned*)(F.lds + LDSCTL_OFF))[u] = 0u;
    __syncthreads();
    F.G = gridDim.x; F.bx = blockIdx.x; { const int bx = blockIdx.x; F.vcu = (F.G % 8 == 0) ? (bx % 8) * (F.G / 8) + bx / 8 : bx; }
    unsigned char* ws0 = args.ws;
    F.ctl = (gu32*)(ws0 + WS_CTL);
#define FILL_PTRS(F) do { const __attribute__((address_space(4))) void* kp_ = (const __attribute__((address_space(4))) void*)__builtin_amdgcn_kernarg_segment_ptr(); asm volatile("" : "+s"(kp_)); \
    const float* const __attribute__((address_space(4)))* in_ = (const float* const __attribute__((address_space(4)))*)kp_; \
    unsigned char* ws = (unsigned char*)in_[25]; \
    { int t_ = ktid(F.wave); asm volatile("" : "+v"(t_)); F.tid = t_; F.lane = t_ & 63; } \
    F.x = in_[0]; F.c = in_[1]; F.w_ada = in_[2]; F.b_ada = in_[3]; F.g_mix = in_[4]; F.w_in = in_[5]; F.b_f = in_[6]; \
    F.conv_w = in_[7]; F.conv_b = in_[8]; F.lru_w_a = in_[9]; F.lru_b_a = in_[10]; F.lru_w_x = in_[11]; F.lru_b_x = in_[12]; \
    F.lru_lambda = in_[13]; F.g_attn_out = in_[14]; F.g_lru_out = in_[15]; F.w_out = in_[16]; F.g_ffn = in_[17]; \
    F.peer_w_q = in_[18]; F.peer_k1 = in_[19]; F.peer_k2 = in_[20]; F.peer_u = in_[21]; F.peer_v = in_[22]; F.g_final = in_[23]; \
    F.out = (float*)in_[24]; \
    F.MOD = (float*)(ws + WS_MOD); F.LF = (float*)(ws + WS_LF); F.KB = (float*)(ws + WS_KB); F.SUMM = (float*)(ws + WS_SUMM); \
    F.EW = (float*)(ws + WS_EW); F.EIDX = (int*)(ws + WS_EIDX); \
    F.WLRU = (bf16_t*)(ws + WS_WLRU); F.K1 = (bf16_t*)(ws + WS_K1); F.K2 = (bf16_t*)(ws + WS_K2); F.WIN = (bf16_t*)(ws + WS_WIN); \
    F.WOUT = (bf16_t*)(ws + WS_WOUT); F.WQ = (bf16_t*)(ws + WS_WQ); F.U8 = ws + WS_U; F.V8 = ws + WS_V; F.USC = (float*)(ws + WS_USC); F.VSC = (float*)(ws + WS_VSC); F.PD = (float*)(ws + WS_PD); F.Y = (float*)(ws + WS_Y); F.ACT = (float*)(ws + WS_ACT); \
    F.H = (bf16_t*)(ws + WS_H); F.Q = (bf16_t*)(ws + WS_Q); F.K = (bf16_t*)(ws + WS_K); F.VV = (bf16_t*)(ws + WS_VV); F.QP = (bf16_t*)(ws + WS_QP); \
    F.LX = (bf16_t*)(ws + WS_LX); F.GLY = (bf16_t*)(ws + WS_GLY); F.MRG = (bf16_t*)(ws + WS_MRG); } while (0)
    XcdBarrier bar; bar.bar = (unsigned*)(F.ctl + CW_BAR); bar.x = 0; bar.st = nullptr;
    if (N_LAUNCHES == 1) bar = xcd_barrier_post((unsigned*)(F.ctl + CW_BAR), F.MISC + 8, F.wave);
#define GRID_BAR() do { if (N_LAUNCHES == 1) xcd_barrier(bar, F.wave); } while (0)
    const int lo = args.ph_lo, hi = args.ph_hi;
#ifndef PHASE_MASK
#define PHASE_MASK 0xffff
#endif
#define IN(k) (((PHASE_MASK >> (k)) & 1) && lo <= (k) && (k) < hi)
#define BOTH(k) (IN(k) && IN((k) + 1))
#ifndef REPEAT_PHASE
#define REPEAT_PHASE -1
#endif
#define REP(k)
#define REPBAR(k)

    if (IN(0)) { FILL_PTRS(F); p0_prologue(F);
#if REPEAT_PHASE == 0
        GRID_BAR(); FILL_PTRS(F); p0_prologue(F);
#endif
        if (BOTH(0)) GRID_BAR(); }
    if (IN(1)) { FILL_PTRS(F); p_modnorm<true>(F, F.x, F.g_mix, 0, DM);
#if REPEAT_PHASE == 1
        GRID_BAR(); FILL_PTRS(F); p_modnorm<true>(F, F.x, F.g_mix, 0, DM);
#endif
        if (BOTH(1)) GRID_BAR(); }
    if (IN(2)) {
        FILL_PTRS(F); p2_cumsum(F); __syncthreads();
        { pg8::Gemm g{F.H, F.WIN, T, 5120, DM}; pg8::StaticOrder S; S.init(T, 5120, F.G, (int)blockIdx.x);
        pg8::EpiProj E{F.Q};
        pg8::gemm_phase<pg8::EpiProj, pg8::StaticOrder, true, true>(F.lds + RING_OFF, g, S, E, F.wave); }
#if REPEAT_PHASE == 2
        GRID_BAR(); FILL_PTRS(F);
        { pg8::Gemm g{F.H, F.WIN, T, 5120, DM}; pg8::StaticOrder S; S.init(T, 5120, F.G, (int)blockIdx.x);
        pg8::EpiProj E{F.Q};
        pg8::gemm_phase<pg8::EpiProj, pg8::StaticOrder, true, true>(F.lds + RING_OFF, g, S, E, F.wave); }
#endif
        if (BOTH(2)) GRID_BAR();
    }
    if (IN(3)) {
        FILL_PTRS(F);
        p3_attention(F, (char*)lds + RING_OFF);
        for (int u = F.vcu; u < BATCH * 64; u += F.G) lru_unit<false>(F, u >> 6, u & 63);
#if REPEAT_PHASE == 3
        GRID_BAR(); FILL_PTRS(F);
        p3_attention(F, (char*)lds + RING_OFF);
        for (int u = F.vcu; u < BATCH * 64; u += F.G) lru_unit<false>(F, u >> 6, u & 63);
#endif
#if REPEAT_PHASE == 30
        GRID_BAR(); FILL_PTRS(F);
        p3_attention(F, (char*)lds + RING_OFF);
#endif
#if REPEAT_PHASE == 31
        GRID_BAR(); FILL_PTRS(F);
        for (int u = F.vcu; u < BATCH * 64; u += F.G) lru_unit<false>(F, u >> 6, u & 63);
#endif
        if (BOTH(3)) GRID_BAR();
    }
    if (IN(4)) {
        FILL_PTRS(F);
        for (int u = F.vcu; u < BATCH * 64; u += F.G) lru_unit<true>(F, u >> 6, u & 63);
#if REPEAT_PHASE == 4
        GRID_BAR(); FILL_PTRS(F);
        for (int u = F.vcu; u < BATCH * 64; u += F.G) lru_unit<true>(F, u >> 6, u & 63);
#endif
        if (BOTH(4)) GRID_BAR();
    }
    if (IN(5)) {
        FILL_PTRS(F);
        pg8::Gemm g{F.MRG, F.WOUT, T, DM, DM}; pg8::StaticOrder S; S.init(T, DM, F.G, (int)blockIdx.x);
        pg8::EpiRes E{F.x, F.out, DM, F.MOD + 2 * DM, NADA};
        pg8::gemm_phase<pg8::EpiRes, pg8::StaticOrder, true, true>(F.lds + RING_OFF, g, S, E, F.wave);
        if (BOTH(5)) GRID_BAR();
    }
    if (IN(6)) { FILL_PTRS(F); p_modnorm<false>(F, F.out, F.g_ffn, 3 * DM, 4 * DM); if (BOTH(6)) GRID_BAR(); }
    if (IN(7)) {
        FILL_PTRS(F);
        pg8::Gemm g{F.H, F.WQ, T, DM, DM}; pg8::StaticOrder S; S.init(T, DM, F.G, (int)blockIdx.x);
        pg8::EpiPlain E{F.QP, DM};
        pg8::gemm_phase<pg8::EpiPlain, pg8::StaticOrder, true, true>(F.lds + RING_OFF, g, S, E, F.wave);
        if (BOTH(7)) GRID_BAR();
    }
    #ifdef P8_NAIVE
    if (IN(8)) { FILL_PTRS(F); p8_naive(F); }
#else
    if (IN(8)) { FILL_PTRS(F); p8_topk(F);
#if REPEAT_PHASE == 8
        GRID_BAR(); FILL_PTRS(F); p8_topk(F);
#endif
        if (BOTH(8)) GRID_BAR(); }
#endif
    if (IN(9)) { FILL_PTRS(F); p9a_udots(F);
#if REPEAT_PHASE == 9
        GRID_BAR(); FILL_PTRS(F); p9a_udots(F);
#endif
        if (BOTH(9)) GRID_BAR(); }
    if (IN(10)) { FILL_PTRS(F); p9b_act(F);
#if REPEAT_PHASE == 10
        GRID_BAR(); FILL_PTRS(F); p9b_act(F);
#endif
        if (BOTH(10)) GRID_BAR(); }
    if (IN(11)) { FILL_PTRS(F); p9c_vacc(F);
#if REPEAT_PHASE == 11
        GRID_BAR(); FILL_PTRS(F); p9c_vacc(F);
#endif
        if (BOTH(11)) GRID_BAR(); }
    if (IN(12)) { FILL_PTRS(F); p9d_final(F); }
#undef IN
#undef BOTH
#undef GRID_BAR
}

extern "C" void kernel_launch(void* const* d_in, const int* in_sizes, int n_in, void* d_out, int out_size, void* d_ws, size_t ws_size, hipStream_t stream) {
    static int grid = 0;
    if (grid == 0) {
        if (n_in != 24 || in_sizes[0] != T * DM || out_size != T * DM || ws_size < WS_END) {
            fprintf(stderr, "kernel_launch: built for 24 inputs, x/out of %d floats, >= %zu bytes of workspace; got n_in %d, in0 %d, out %d, ws %zu; nothing launched\n", T * DM, (size_t)WS_END, n_in, n_in > 0 ? in_sizes[0] : -1, out_size, ws_size); grid = -1; return; }
        int dev = 0, cus = 0, per_cu = 0;
        if (hipGetDevice(&dev) != hipSuccess || hipDeviceGetAttribute(&cus, hipDeviceAttributeMultiprocessorCount, dev) != hipSuccess) { fprintf(stderr, "kernel_launch: device query failed\n"); grid = -1; return; }
        if (hipFuncSetAttribute((const void*)hymba_fwd, hipFuncAttributeMaxDynamicSharedMemorySize, LDS_BYTES) != hipSuccess) { fprintf(stderr, "kernel_launch: hipFuncSetAttribute failed\n"); grid = -1; return; }
        if (hipOccupancyMaxActiveBlocksPerMultiprocessor(&per_cu, (const void*)hymba_fwd, NWAVES * 64, LDS_BYTES) != hipSuccess || per_cu < 1)
            fprintf(stderr, "kernel_launch: note: occupancy query reports %d workgroups per CU\n", per_cu);
        (void)hipGetLastError();
        grid = cus;
    }
    if (grid < 0) return;
    if (hipMemsetAsync((char*)d_ws + WS_CTL, 0, CTL_ZERO_BYTES, stream) != hipSuccess) { fprintf(stderr, "kernel_launch: hipMemsetAsync failed\n"); return; }
    Args a{};
    for (int i = 0; i < 24; ++i) a.in[i] = (const float*)d_in[i];
    a.out = (float*)d_out; a.ws = (unsigned char*)d_ws;
#ifdef DBG_UPTO
    static_assert(N_LAUNCHES == N_PHASES, "probe builds launch one kernel per phase");
    for (int li = 0; li < DBG_UPTO; ++li) {
#else
    for (int li = 0; li < N_LAUNCHES; ++li) {
#endif
        a.ph_lo = (N_LAUNCHES == 1) ? 0 : li; a.ph_hi = (N_LAUNCHES == 1) ? N_PHASES : li + 1; a.li = li;
        hipLaunchKernelGGL(hymba_fwd, dim3(grid), dim3(NWAVES * 64), LDS_BYTES, stream, a);
        const hipError_t le = hipPeekAtLastError();
        if (le != hipSuccess) { fprintf(stderr, "kernel_launch: launch %d failed: %s\n", li, hipGetErrorName(le)); break; }
    }
#ifdef DBG_UPTO
    hipLaunchKernelGGL(dbg_check, dim3(1), dim3(512), 0, stream, a, (int)DBG_UPTO);
#endif
}
```

```cpp
#include <hip/hip_runtime.h>
#include <hip/hip_bf16.h>
#include <cstdio>
#include <cstdint>

constexpr int BATCH = 4, SEQ = 4096, DM = 2048, T = BATCH * SEQ;
constexpr int AW = 1024, NH = 8, HD = 128, LW = 1024, NLB = 8, LBD = 128;
constexpr int INC = 5128, OFF_F = 3072, OFF_LX = 3080;
constexpr int PH = 8, PNK = 128, PQD = 256, PTOPK = 16, NEXP = 16384, NSEL = PH * PTOPK;
constexpr int NADA = 6 * DM;
constexpr float EPS = 1e-6f;
constexpr int NWAVES = 8, NTHR = 512;

#ifndef MK_N_LAUNCHES
#define MK_N_LAUNCHES 1
#endif
constexpr int N_PHASES = 13;
constexpr int N_LAUNCHES = MK_N_LAUNCHES;

constexpr size_t MiB = 1u << 20;
constexpr size_t WS_CTL = 0, CTL_ZERO_BYTES = 1 * MiB;
constexpr size_t WS_MOD = 1 * MiB;
constexpr size_t WS_LF = WS_MOD + 256 * 1024;
constexpr size_t WS_KB = WS_LF + 512 * 1024;
constexpr size_t WS_SUMM = WS_KB + 512 * 1024;
constexpr size_t WS_WLRU = 5 * MiB;
constexpr size_t WS_K1 = WS_WLRU + 512 * 1024;
constexpr size_t WS_K2 = WS_K1 + 256 * 1024;
constexpr size_t WS_WIN = 6 * MiB;
constexpr size_t WS_WOUT = 26 * MiB;
constexpr size_t WS_WQ = 34 * MiB;
constexpr size_t WS_U = 42 * MiB, WS_V = 106 * MiB;
constexpr size_t WS_USC = WS_SUMM + 2 * MiB, WS_VSC = WS_USC + 64 * 1024;
constexpr size_t WS_H = 170 * MiB;
constexpr size_t WS_Q = 234 * MiB, WS_K = 266 * MiB, WS_VV = 298 * MiB;
constexpr size_t WS_QP = 234 * MiB;
constexpr size_t WS_EIDX = 298 * MiB, WS_EW = 306 * MiB;
constexpr size_t WS_LX = 330 * MiB, WS_GLY = 362 * MiB;
constexpr size_t WS_MRG = 394 * MiB;
constexpr size_t WS_HL = 170 * MiB, WS_AC = 202 * MiB;
constexpr size_t WS_PD = 330 * MiB;
constexpr size_t WS_Y = 170 * MiB;
constexpr size_t WS_ACT = 314 * MiB;
constexpr size_t WS_END = 458 * MiB;
static_assert(WS_K == WS_Q + 32 * MiB && WS_VV == WS_Q + 64 * MiB && WS_LX == WS_Q + 96 * MiB && WS_GLY == WS_Q + 128 * MiB, "EpiProj: destinations 32 MiB apart");
constexpr int CW_BAR = 4096;

constexpr int RING_OFF = 0, RING_BYTES = 131072;
constexpr int LDSCTL_OFF = RING_BYTES, MISC_OFF = LDSCTL_OFF + 320;
constexpr int LDS_BYTES = 147456;
static_assert(MISC_OFF + 128 <= LDS_BYTES, "LDS map");

#define GAS __attribute__((address_space(1)))
#define LAS __attribute__((address_space(3)))
typedef unsigned short bf16_t;
typedef unsigned v4u __attribute__((ext_vector_type(4)));
typedef unsigned v2u __attribute__((ext_vector_type(2)));
typedef float f32x4 __attribute__((ext_vector_type(4)));
typedef float f32x2 __attribute__((ext_vector_type(2)));
typedef short bf16x8 __attribute__((ext_vector_type(8)));
typedef __bf16 bf16x2_t __attribute__((ext_vector_type(2)));
typedef GAS unsigned gu32;
#define RLX_AGENT __ATOMIC_RELAXED, __HIP_MEMORY_SCOPE_AGENT
#define LDS_WAIT() asm volatile("s_waitcnt lgkmcnt(0)" ::: "memory")
#define VM_WAIT() asm volatile("s_waitcnt vmcnt(0)" ::: "memory")

extern __shared__ __attribute__((aligned(16))) unsigned char g_lds[];
__device__ __forceinline__ int ktid(int kw) { int l; asm volatile("v_mbcnt_lo_u32_b32 %0, -1, 0\n\tv_mbcnt_hi_u32_b32 %0, -1, %0" : "=v"(l)); return kw * 64 + l; }
__device__ __forceinline__ unsigned fbits(float x) { return __builtin_bit_cast(unsigned, x); }
__device__ __forceinline__ float bitsf(unsigned x) { return __builtin_bit_cast(float, x); }
__device__ __forceinline__ bf16x2_t asbf2(unsigned x) { return __builtin_bit_cast(bf16x2_t, x); }
__device__ __forceinline__ unsigned f2bf(float f) { unsigned u = __builtin_bit_cast(unsigned, f); return (u + 0x7fffu + ((u >> 16) & 1u)) >> 16; }
__device__ __forceinline__ unsigned pk2(float lo, float hi) { f32x2 v = {lo, hi}; bf16x2_t b = __builtin_convertvector(v, bf16x2_t); return __builtin_bit_cast(unsigned, b); }
__device__ __forceinline__ float bf_lo(unsigned d) { return __builtin_bit_cast(float, d << 16); }
__device__ __forceinline__ float bf_hi(unsigned d) { return __builtin_bit_cast(float, d & 0xffff0000u); }
__device__ __forceinline__ float fexp(float x) { return __builtin_amdgcn_exp2f(x * 1.4426950408889634f); }
__device__ __forceinline__ float sigmoidf_(float z) { return __builtin_amdgcn_rcpf(1.f + fexp(-z)); }
__device__ __forceinline__ float gelu_tanh(float x) { const float z = x * (1.5957691216057308f + 0.07135481627260025f * x * x); return x * __builtin_amdgcn_rcpf(1.f + fexp(-z)); }
__device__ __forceinline__ float softplusf_(float z) { return fmaxf(z, 0.f) + log1pf(fexp(-fabsf(z))); }
__device__ __forceinline__ float wave_sum(float v) {
#pragma unroll
    for (int o = 1; o < 64; o <<= 1) v += __shfl_xor(v, o);
    return v;
}
#define XB_TMO      128
#define XB_XCNT(j)  (256  + 64 * (j))
#define XB_XSUB(j)  (1280 + 64 * (j))
#define XB_XGEN(j)  (2304 + 64 * (j))
#define XB_TOP      3328
#define XB_TOPGEN   3392
#define XCD_BAR_WORDS 3456
#define XB_SPIN_CAP (1u << 18)

__device__ __forceinline__ unsigned xb_ld(unsigned* p)              { return __hip_atomic_load(p, __ATOMIC_RELAXED, __HIP_MEMORY_SCOPE_AGENT); }
__device__ __forceinline__ unsigned xb_add(unsigned* p, unsigned v) { return __hip_atomic_fetch_add(p, v, __ATOMIC_RELAXED, __HIP_MEMORY_SCOPE_AGENT); }
__device__ __forceinline__ unsigned xb_xcc_id() { return (unsigned)__builtin_amdgcn_s_getreg((3 << 11) | 20) & 0xFu; }
#define XB_SPIN(cond, bar) do { unsigned _sp = 0; while (cond) { __builtin_amdgcn_s_sleep(1); \
    if ((++_sp & 255u) == 0u) { if (xb_ld(&(bar)[XB_TMO])) break; if (_sp > XB_SPIN_CAP) { atomicAdd(&(bar)[XB_TMO], 1u); break; } } } } while (0)

struct XcdBarrier {
    unsigned* bar; unsigned x;
    volatile LAS unsigned* st;
};

__device__ __forceinline__ XcdBarrier xcd_barrier_post(unsigned* bar, volatile LAS unsigned* st, int kw) {
    XcdBarrier b; b.bar = bar; b.x = xb_xcc_id(); b.st = st;
    if (ktid(kw) == 0) (void)xb_add(&bar[XB_XCNT(b.x)], 1u);
    return b;
}
__device__ __forceinline__ void xcd_barrier_complete(unsigned* bar, unsigned x, unsigned& nloc, unsigned& nx) {
    const unsigned G = gridDim.x * gridDim.y * gridDim.z;
    unsigned sum, cnt, mine, sp = 0u;
    for (;;) {
        sum = 0u; cnt = 0u; mine = 0u;
#pragma unroll
        for (unsigned j = 0; j < 16; ++j) { const unsigned c = xb_ld(&bar[XB_XCNT(j)]); sum += c; cnt += (c > 0u) ? 1u : 0u; mine = (j == x) ? c : mine; }
        if (sum == G) break;
        __builtin_amdgcn_s_sleep(1);
        if ((++sp & 255u) == 0u) { if (xb_ld(&bar[XB_TMO])) break; if (sp > XB_SPIN_CAP) { atomicAdd(&bar[XB_TMO], 1u); break; } }
    }
    nloc = mine > 0u ? mine : 1u; nx = cnt > 0u ? cnt : 1u;
}

__device__ __forceinline__ void xcd_barrier(const XcdBarrier& b, int kw) {
    asm volatile("s_waitcnt vmcnt(0)" ::: "memory");
    __syncthreads();
    if (ktid(kw) == 0) {
        unsigned* bar = b.bar;
        __builtin_amdgcn_s_waitcnt(0);
        unsigned nloc = b.st[0], nx = b.st[1];
        if (nloc == 0u) { xcd_barrier_complete(bar, b.x, nloc, nx); b.st[0] = nloc; b.st[1] = nx; }
        const unsigned old = xb_add(&bar[XB_XSUB(b.x)], 1u);
        const unsigned gen = old / nloc;
        if (old + 1u == (gen + 1u) * nloc) {
            __builtin_amdgcn_fence(__ATOMIC_RELEASE, "agent");
            asm volatile("s_waitcnt vmcnt(0)" ::: "memory");
            const unsigned og = xb_add(&bar[XB_TOP], 1u);
            const unsigned tg = og / nx;
            if (og + 1u == (tg + 1u) * nx) xb_add(&bar[XB_TOPGEN], 1u);
            else XB_SPIN(xb_ld(&bar[XB_TOPGEN]) == tg, bar);
            __builtin_amdgcn_fence(__ATOMIC_ACQUIRE, "agent");
            xb_add(&bar[XB_XGEN(b.x)], 1u);
            asm volatile("s_waitcnt vmcnt(0)" ::: "memory");
        } else {
            XB_SPIN(xb_ld(&bar[XB_XGEN(b.x)]) == gen, bar);
            __builtin_amdgcn_fence(__ATOMIC_ACQUIRE, "agent");
            asm volatile("s_waitcnt vmcnt(0)" ::: "memory");
        }
    }
    __syncthreads();
}

namespace pg8 {
#define PG8_LAS __attribute__((address_space(3)))
typedef unsigned short bf16_t;
typedef short bf16x8 __attribute__((ext_vector_type(8)));
typedef float f32x4 __attribute__((ext_vector_type(4)));
typedef unsigned u32x4 __attribute__((ext_vector_type(4)));
constexpr int BM = 256, BK = 64, HALF = 128, HTB = HALF * BK * 2  , STAGE_BYTES = 8 * HTB, NXCD = 8, WGM = 8;

__host__ __device__ __forceinline__ int lds_byte(int r, int c) { const int st = (r >> 4) * 2 + (c >> 5), rr = r & 15, cc = c & 31, ob = rr * 64 + cc * 2; return st * 1024 + (ob ^ (((ob >> 9) & 1) << 5)); }
__host__ __device__ __forceinline__ void stage_rc(int b, int& R, int& C) { const int st = b / 1024, sb = b % 1024, swz = sb ^ (((sb >> 9) & 1) << 5); R = (st >> 1) * 16 + swz / 64; C = (st & 1) * 32 + (swz % 64) / 2; }
__host__ __device__ __forceinline__ int perm32(int rho) { const int n = rho >> 4, i = rho & 15; return 8 * (i >> 2) + 4 * n + (i & 3); }

struct Unit { int pm, pn; };
struct Gemm { const bf16_t* A; const bf16_t* Bt; int M, N, K; };

struct StaticOrder {
    int nM, nN, nwg, G, c;
    __host__ __device__ void init(int M, int N, int G_, int c_) { nM = M / BM; nN = N / BM; nwg = nM * nN; G = G_; c = c_; }
    __host__ __device__ bool next(int i, Unit& u) const {
        const long L = (long)i * G + c; if (L >= nwg) return false;
        int wgid = (int)L; { const int q = nwg / NXCD, r = nwg % NXCD, xcd = wgid % NXCD, off = wgid / NXCD; wgid = (xcd < r ? xcd * (q + 1) : r * (q + 1) + (xcd - r) * q) + off; }
        const int nig = WGM * nN, gid = wgid / nig, fm = gid * WGM, gsz = (nM - fm) < WGM ? (nM - fm) : WGM;
        u.pm = fm + ((wgid % nig) % gsz); u.pn = (wgid % nig) / gsz; return true;
    }
    __device__ __forceinline__ void a_ready(const Unit&) const {}
    __device__ __forceinline__ void done(const Unit&) const {}
};


__device__ __forceinline__ unsigned cvt_pk_bf16(float lo, float hi) { unsigned r; asm volatile("v_cvt_pk_bf16_f32 %0, %1, %2" : "=v"(r) : "v"(lo), "v"(hi)); return r; }

struct EpiPlain {
    static constexpr bool PERM = true, AFTER_DRAIN = false;
    bf16_t* O; int ldc;
    __device__ __forceinline__ void operator()(const f32x4 (&acc)[2][2][4][2], const Unit& u, int wr, int wc, int fr, int fq) const {
        const int row0 = u.pm * BM + wr * 64 + fr, col0 = u.pn * BM + wc * 32 + 8 * fq;
#pragma unroll
        for (int ai = 0; ai < 2; ++ai)
#pragma unroll
            for (int m = 0; m < 4; ++m) { bf16_t* rowp = O + (size_t)(row0 + ai * HALF + m * 16) * ldc + col0;
#pragma unroll
                for (int bj = 0; bj < 2; ++bj) { const f32x4 v0 = acc[ai][bj][m][0], v1 = acc[ai][bj][m][1];
                    u32x4 w; w.x = cvt_pk_bf16(v0[0], v0[1]); w.y = cvt_pk_bf16(v0[2], v0[3]); w.z = cvt_pk_bf16(v1[0], v1[1]); w.w = cvt_pk_bf16(v1[2], v1[3]);
                    *(u32x4*)(rowp + bj * HALF) = w; } }
    }
};
struct EpiProj {
    static constexpr bool PERM = true, AFTER_DRAIN = false;
    bf16_t* Q;
    __device__ __forceinline__ void operator()(const f32x4 (&acc)[2][2][4][2], const Unit& u, int wr, int wc, int fr, int fq) const {
        const int row0 = u.pm * BM + wr * 64 + fr; const int cat = u.pn >> 2, pnl = u.pn & 3;
        bf16_t* basep = Q + (size_t)cat * ((size_t)16 << 20);
        const bool headmajor = cat < 3, dogelu = cat == 4;
#pragma unroll
        for (int ai = 0; ai < 2; ++ai)
#pragma unroll
            for (int m = 0; m < 4; ++m) { const int row = row0 + ai * HALF + m * 16; const int b = row >> 12, s = row & 4095;
#pragma unroll
                for (int bj = 0; bj < 2; ++bj) { f32x4 v0 = acc[ai][bj][m][0], v1 = acc[ai][bj][m][1];
                    const int colt = pnl * BM + bj * HALF + wc * 32 + 8 * fq;
                    const int head = colt >> 7, d = colt & 127;
                    const size_t offA = ((size_t)((b * 8 + head) * 4096 + s)) * 128 + d, offB = (size_t)row * 1024 + colt;
                    bf16_t* dst = basep + (headmajor ? offA : offB);
                    if (dogelu) {
#pragma unroll
                        for (int e = 0; e < 4; ++e) { v0[e] = gelu_tanh(v0[e]); v1[e] = gelu_tanh(v1[e]); } }
                    u32x4 w; w.x = cvt_pk_bf16(v0[0], v0[1]); w.y = cvt_pk_bf16(v0[2], v0[3]); w.z = cvt_pk_bf16(v1[0], v1[1]); w.w = cvt_pk_bf16(v1[2], v1[3]);
                    *(u32x4*)dst = w; } }
    }
};
struct EpiRes {
    static constexpr bool PERM = false, AFTER_DRAIN = false;
    const float* base; float* out; int ldc; const float* gate; int gstride;
    __device__ __forceinline__ void operator()(const f32x4 (&acc)[2][2][4][2], const Unit& u, int wr, int wc, int fr, int fq) const {
        const int row0 = u.pm * BM + wr * 64 + fr, col0 = u.pn * BM + wc * 32 + 4 * fq;
        const int b = (u.pm * BM) >> 12;
        f32x4 gv[2][2];
#pragma unroll
        for (int bj = 0; bj < 2; ++bj)
#pragma unroll
            for (int n = 0; n < 2; ++n) gv[bj][n] = *(const f32x4*)(gate + (size_t)b * gstride + col0 + bj * HALF + n * 16);
#pragma unroll
        for (int ai = 0; ai < 2; ++ai)
#pragma unroll
            for (int m = 0; m < 4; ++m) { const size_t off = (size_t)(row0 + ai * HALF + m * 16) * ldc + col0;
#pragma unroll
                for (int bj = 0; bj < 2; ++bj)
#pragma unroll
                    for (int n = 0; n < 2; ++n) { const f32x4 bs = *(const f32x4*)(base + off + bj * HALF + n * 16);
                        *(f32x4*)(out + off + bj * HALF + n * 16) = bs + gv[bj][n] * acc[ai][bj][m][n]; } }
    }
};

template <class Epi, class Sched, bool ALIGN_EPI = false, bool SP2 = false>
__device__ __forceinline__ void gemm_phase(PG8_LAS unsigned char* lds, const Gemm g, const Sched& S, const Epi& E, const int kw) {
    const int tid = ktid(kw), wid = kw, lane = tid & 63, wr = wid >> 2, wc = wid & 3, fr = lane & 15, fq = lane >> 4;
    const int K = g.K, nt = K / BK;
    unsigned voffA[2], voffB[2];
#pragma unroll
    for (int i = 0; i < 2; ++i) { int R, C; stage_rc(tid * 16 + i * 8192, R, C); const int Rb = Epi::PERM ? ((R & ~31) + perm32(R & 31)) : R;
        voffA[i] = (unsigned)(R * K + C) * 2u; voffB[i] = (unsigned)(Rb * K + C) * 2u; }
    const size_t kstep = (size_t)(BK * 2);
    const size_t hstep = (size_t)HALF * K * 2;
    const size_t tstep = 2 * hstep;
    const unsigned ldsw = (unsigned)wid * 1024u;
    const int aoff = lds_byte(wr * 64 + fr, fq * 8), boff = lds_byte(wc * 32 + fr, fq * 8);
#define PG8_SA(b, h) (((b) * 2 + (h)) * HTB)
#define PG8_SB(b, h) ((4 + (b) * 2 + (h)) * HTB)
#define PG8_STAGE(bufoff, gbase, voff) do { _Pragma("unroll") for (int _i = 0; _i < 2; ++_i) \
        __builtin_amdgcn_global_load_lds((const unsigned*)((const char*)(gbase) + (voff)[_i]), (PG8_LAS unsigned*)(lds + (bufoff) + ldsw + _i * 8192), 16, 0, 0); } while (0)
#define PG8_LDA(dst, b, h) do { _Pragma("unroll") for (int m = 0; m < 4; ++m) _Pragma("unroll") for (int k = 0; k < 2; ++k) dst[m][k] = *(const PG8_LAS bf16x8*)(lds + PG8_SA(b, h) + aoff + m * 2048 + k * 1024); } while (0)
#define PG8_LDB(dst, b, h) do { _Pragma("unroll") for (int n = 0; n < 2; ++n) _Pragma("unroll") for (int k = 0; k < 2; ++k) dst[n][k] = *(const PG8_LAS bf16x8*)(lds + PG8_SB(b, h) + boff + n * 2048 + k * 1024); } while (0)
#define PG8_MMA(ai, bj, At, Bt) do { __builtin_amdgcn_s_setprio(1); _Pragma("unroll") for (int m = 0; m < 4; ++m) _Pragma("unroll") for (int n = 0; n < 2; ++n) _Pragma("unroll") for (int k = 0; k < 2; ++k) \
        acc[ai][bj][m][n] = __builtin_amdgcn_mfma_f32_16x16x32_bf16(Bt[n][k], At[m][k], acc[ai][bj][m][n], 0, 0, 0); __builtin_amdgcn_s_setprio(0); } while (0)
#define PG8_WAIT_V(n) asm volatile("s_waitcnt vmcnt(" #n ")" ::: "memory")
#define PG8_WAIT_L(n) asm volatile("s_waitcnt lgkmcnt(" #n ")" ::: "memory")
#define PG8_BAR __builtin_amdgcn_s_barrier()
#define PG8_SCHED __builtin_amdgcn_sched_barrier(0)
    Unit cur, nxt; int ui = 0;
    if (!S.next(0, cur)) return;
    f32x4 acc[2][2][4][2];
#pragma unroll
    for (int a = 0; a < 2; ++a)
#pragma unroll
        for (int b = 0; b < 2; ++b)
#pragma unroll
            for (int m = 0; m < 4; ++m)
#pragma unroll
                for (int n = 0; n < 2; ++n) acc[a][b][m][n] = (f32x4){0.f, 0.f, 0.f, 0.f};
    bf16x8 At[4][2], B0[2][2], B1[2][2];
    const char* cA = (const char*)g.A + (size_t)cur.pm * tstep; const char* cB = (const char*)g.Bt + (size_t)cur.pn * tstep;
    S.a_ready(cur);
    if constexpr (SP2) {
        PG8_STAGE(PG8_SB(0, 0), cB, voffB); PG8_STAGE(PG8_SB(0, 1), cB + hstep, voffB); PG8_STAGE(PG8_SA(0, 0), cA, voffA); PG8_STAGE(PG8_SA(0, 1), cA + hstep, voffA);
        if (wr == 1) PG8_BAR;
        PG8_WAIT_V(2); PG8_BAR;
        PG8_STAGE(PG8_SB(1, 0), cB + kstep, voffB); PG8_STAGE(PG8_SA(1, 0), cA + kstep, voffA); PG8_STAGE(PG8_SB(1, 1), cB + hstep + kstep, voffB);
        PG8_WAIT_V(6); PG8_BAR;
    } else {
        PG8_STAGE(PG8_SB(0, 0), cB, voffB); PG8_STAGE(PG8_SA(0, 0), cA, voffA); PG8_STAGE(PG8_SB(0, 1), cB + hstep, voffB); PG8_STAGE(PG8_SA(0, 1), cA + hstep, voffA);
        if (wr == 1) PG8_BAR;
        PG8_WAIT_V(4); PG8_BAR;
        PG8_STAGE(PG8_SB(1, 0), cB + kstep, voffB); PG8_STAGE(PG8_SA(1, 0), cA + kstep, voffA); PG8_STAGE(PG8_SB(1, 1), cB + hstep + kstep, voffB);
        PG8_WAIT_V(6); PG8_BAR;
    }
    for (;;) {
        const bool has_next = S.next(ui + 1, nxt);
        const char* nA = has_next ? (const char*)g.A + (size_t)nxt.pm * tstep : cA; const char* nB = has_next ? (const char*)g.Bt + (size_t)nxt.pn * tstep : cB;
        for (int t = 0; t < nt; t += 2) {
            const bool last = (t == nt - 2);
            const char* a1 = cA + (size_t)(t + 1) * kstep;
            const char* a2 = last ? nA : cA + (size_t)(t + 2) * kstep; const char* b2 = last ? nB : cB + (size_t)(t + 2) * kstep;
            const char* a3 = a2 + kstep; const char* b3 = b2 + kstep;
            if (last && has_next) S.a_ready(nxt);
            if constexpr (SP2) {
            PG8_LDB(B0, 0, 0); PG8_LDB(B1, 0, 1); PG8_SCHED; PG8_LDA(At, 0, 0); PG8_STAGE(PG8_SA(1, 1), a1 + hstep, voffA);
            PG8_WAIT_V(8); PG8_WAIT_L(0); PG8_BAR; PG8_MMA(0, 0, At, B0); PG8_MMA(0, 1, At, B1); PG8_BAR; PG8_SCHED;
            PG8_LDA(At, 0, 1); PG8_STAGE(PG8_SB(0, 0), b2, voffB); PG8_STAGE(PG8_SB(0, 1), b2 + hstep, voffB); PG8_STAGE(PG8_SA(0, 0), a2, voffA);
            PG8_WAIT_V(8); PG8_WAIT_L(0); PG8_BAR; PG8_MMA(1, 0, At, B0); PG8_MMA(1, 1, At, B1); PG8_BAR; PG8_SCHED;
            PG8_LDB(B0, 1, 0); PG8_LDB(B1, 1, 1); PG8_SCHED; PG8_LDA(At, 1, 0); PG8_STAGE(PG8_SA(0, 1), a2 + hstep, voffA);
            PG8_WAIT_V(8); PG8_WAIT_L(0); PG8_BAR; PG8_MMA(0, 0, At, B0); PG8_MMA(0, 1, At, B1); PG8_BAR; PG8_SCHED;
            PG8_LDA(At, 1, 1); PG8_STAGE(PG8_SB(1, 0), b3, voffB); PG8_STAGE(PG8_SB(1, 1), b3 + hstep, voffB); PG8_STAGE(PG8_SA(1, 0), a3, voffA);
            PG8_WAIT_V(8); PG8_WAIT_L(0); PG8_BAR; PG8_MMA(1, 0, At, B0); PG8_MMA(1, 1, At, B1); PG8_BAR; PG8_SCHED;
            } else {
            PG8_LDB(B0, 0, 0); PG8_SCHED; PG8_LDA(At, 0, 0); PG8_STAGE(PG8_SA(1, 1), a1 + hstep, voffA);
            PG8_WAIT_L(8); PG8_BAR; PG8_WAIT_L(0); PG8_MMA(0, 0, At, B0); PG8_BAR; PG8_SCHED;
            PG8_LDB(B1, 0, 1); PG8_STAGE(PG8_SB(0, 0), b2, voffB);
            PG8_BAR; PG8_WAIT_L(0); PG8_MMA(0, 1, At, B1); PG8_BAR;
            PG8_LDA(At, 0, 1); PG8_STAGE(PG8_SA(0, 0), a2, voffA);
            PG8_BAR; PG8_WAIT_L(0); PG8_MMA(1, 0, At, B0); PG8_BAR; PG8_SCHED;
            PG8_STAGE(PG8_SB(0, 1), b2 + hstep, voffB);
            PG8_WAIT_V(6); PG8_BAR; PG8_MMA(1, 1, At, B1); PG8_BAR;
            PG8_LDB(B0, 1, 0); PG8_SCHED; PG8_LDA(At, 1, 0); PG8_STAGE(PG8_SA(0, 1), a2 + hstep, voffA);
            PG8_WAIT_L(8); PG8_BAR; PG8_WAIT_L(0); PG8_MMA(0, 0, At, B0); PG8_BAR; PG8_SCHED;
            PG8_LDB(B1, 1, 1); PG8_STAGE(PG8_SB(1, 0), b3, voffB);
            PG8_BAR; PG8_WAIT_L(0); PG8_MMA(0, 1, At, B1); PG8_BAR;
            PG8_LDA(At, 1, 1); PG8_STAGE(PG8_SA(1, 0), a3, voffA);
            PG8_BAR; PG8_WAIT_L(0); PG8_MMA(1, 0, At, B0); PG8_BAR; PG8_SCHED;
            PG8_STAGE(PG8_SB(1, 1), b3 + hstep, voffB);
            PG8_WAIT_V(6); PG8_BAR; PG8_MMA(1, 1, At, B1); PG8_BAR;
            }
        }
        if constexpr (ALIGN_EPI) { if (wr == 0) PG8_BAR; }
        if constexpr (!Epi::AFTER_DRAIN) { E(acc, cur, wr, wc, fr, fq); S.done(cur); }
        if (!has_next) break;
#pragma unroll
        for (int a = 0; a < 2; ++a)
#pragma unroll
            for (int b = 0; b < 2; ++b)
#pragma unroll
                for (int m = 0; m < 4; ++m)
#pragma unroll
                    for (int n = 0; n < 2; ++n) acc[a][b][m][n] = (f32x4){0.f, 0.f, 0.f, 0.f};
        cur = nxt; cA = nA; cB = nB; ++ui;
        if constexpr (ALIGN_EPI) { if (wr == 1) PG8_BAR; }
    }
    PG8_WAIT_V(0);
    if constexpr (!ALIGN_EPI) { if (wr == 0) PG8_BAR; }
    PG8_BAR;
    if constexpr (Epi::AFTER_DRAIN) { E.fused(acc, cur, wr, wc, fr, fq, lds, wid, lane); S.done(cur); }
#undef PG8_SA
#undef PG8_SB
#undef PG8_STAGE
#undef PG8_LDA
#undef PG8_LDB
#undef PG8_MMA
#undef PG8_WAIT_V
#undef PG8_WAIT_L
#undef PG8_BAR
#undef PG8_SCHED
}
}

namespace att {
typedef unsigned short bf16;
typedef short bf16x8 __attribute__((ext_vector_type(8)));
typedef short s16x4 __attribute__((ext_vector_type(4)));
typedef float f32x16 __attribute__((ext_vector_type(16)));
typedef float f32x4 __attribute__((ext_vector_type(4)));
typedef unsigned u32x4 __attribute__((ext_vector_type(4)));
template <class A, class Bt> struct same_t { static constexpr bool v = false; };
template <class A> struct same_t<A, A> { static constexpr bool v = true; };
constexpr int D = 128;
constexpr float THR = 8.f;
constexpr bool WSKIP = false;
constexpr float SCALE = 0.08838834764831845f;
constexpr int NW = 8, QBLK = 32, KVBLK = 64, QB = NW * QBLK;
constexpr int SHM_V = KVBLK * D * 2, SHM_K = KVBLK * D * 2;
constexpr int LDS_BIAS = 2 * SHM_V + 2 * SHM_K + NW * 64 * 4;
constexpr int LDS_BYTES = LDS_BIAS + 4096 * 4;
constexpr int OP = 2048;
#define KSWZ(row, colB) ((row) * 256 + ((colB) ^ (((row) & 7) << 4)))
#define SBAR() __builtin_amdgcn_sched_barrier(0)
__device__ __forceinline__ int v_st(int k, int c) { const int kk = (k & ~0xC) | ((k & 4) << 1) | ((k & 8) >> 1); return ((kk >> 3) * 4 + (c >> 5)) * 512 + ((kk & 7) * 32 + (c & 31)) * 2; }
__device__ __forceinline__ int v_rd_base(int lane) { return ((lane & 3) << 3) | (((lane >> 2) & 3) << 6) | (((lane >> 4) & 1) << 5) | (((lane >> 5) & 1) << 8); }
constexpr int v_rd_off(int d0, int ks, int half) { return d0 * 512 + ks * 4096 + half * 2048; }
__device__ __forceinline__ int crow(int r, int hi) { return (r & 3) + 8 * (r >> 2) + 4 * hi; }
__device__ __forceinline__ unsigned cvtpk(float lo, float hi) {
    unsigned r; asm volatile("v_cvt_pk_bf16_f32 %0, %1, %2" : "=v"(r) : "v"(lo), "v"(hi)); return r;
}
__device__ __forceinline__ bf16x8 pack8(f32x4 a, f32x4 b) {
    u32x4 w = {cvtpk(a[0], a[1]), cvtpk(a[2], a[3]), cvtpk(b[0], b[1]), cvtpk(b[2], b[3])};
    return *reinterpret_cast<bf16x8*>(&w);
}
template <class T> __device__ __forceinline__ bf16x8 load8(const T* p) {
    if constexpr (same_t<T, float>::v) { return pack8(*(const f32x4*)p, *(const f32x4*)(p + 4)); }
    else { return *reinterpret_cast<const bf16x8*>(p); }
}
__device__ __forceinline__ void mask_tile(f32x16& p0, f32x16& p1, int dq, unsigned W) {
    const float NEG = -__builtin_inff();
#pragma unroll
    for (int r = 0; r < 16; ++r) {
        const int c = (r & 3) + 8 * (r >> 2);
        if ((unsigned)(dq - c) >= W) p0[r] = NEG;
        if ((unsigned)(dq - c - 32) >= W) p1[r] = NEG;
    }
}
__device__ __forceinline__ void partialSM(f32x16& p0, f32x16& p1, float& m_reg, float& mn, float& alpha) {
    float pmax = p0[0]; for (int r = 1; r < 16; ++r) pmax = fmaxf(pmax, p0[r]); for (int r = 0; r < 16; ++r) pmax = fmaxf(pmax, p1[r]);
    { auto rr = __builtin_amdgcn_permlane32_swap(__float_as_uint(pmax), __float_as_uint(pmax), false, false);
      pmax = fmaxf(__uint_as_float(rr[0]), __uint_as_float(rr[1])); }
    constexpr float C2 = 1.4426950408889634f * SCALE;
    if (__builtin_expect(__all((pmax - m_reg) * SCALE <= THR), 1)) { mn = m_reg; alpha = 1.f; }
    else { mn = fmaxf(m_reg, pmax); alpha = __builtin_amdgcn_exp2f((m_reg - mn) * C2); m_reg = mn; }
    const float mnL = -mn * C2;
    for (int r = 0; r < 16; ++r) p0[r] = fmaf(p0[r], C2, mnL); for (int r = 0; r < 16; ++r) p1[r] = fmaf(p1[r], C2, mnL);
    for (int r = 0; r < 16; ++r) p0[r] = __builtin_amdgcn_exp2f(p0[r]);
}
__device__ __forceinline__ void finishSM(f32x16& p0, f32x16& p1, float alpha, float& l_reg, bf16x8& pa0, bf16x8& pa1, bf16x8& pa2, bf16x8& pa3) {
    for (int r = 0; r < 16; ++r) p1[r] = __builtin_amdgcn_exp2f(p1[r]);
    float ps = 0; for (int r = 0; r < 16; ++r) ps += p0[r]; for (int r = 0; r < 16; ++r) ps += p1[r];
    { auto rr = __builtin_amdgcn_permlane32_swap(__float_as_uint(ps), __float_as_uint(ps), false, false);
      ps = __uint_as_float(rr[0]) + __uint_as_float(rr[1]); }
    l_reg = l_reg * alpha + ps;
#define PK4(P, B_, OUT) do { unsigned a0 = cvtpk(P[B_+0], P[B_+1]), a1 = cvtpk(P[B_+2], P[B_+3]);                          \
        unsigned b0 = cvtpk(P[B_+4], P[B_+5]), b1 = cvtpk(P[B_+6], P[B_+7]);                                             \
        auto r0 = __builtin_amdgcn_permlane32_swap(a0, b0, false, false); auto r1 = __builtin_amdgcn_permlane32_swap(a1, b1, false, false); \
        u32x4 w = {r0[0], r1[0], r0[1], r1[1]}; OUT = *reinterpret_cast<bf16x8*>(&w); } while (0)
    PK4(p0, 0, pa0); PK4(p0, 8, pa1); PK4(p1, 0, pa2); PK4(p1, 8, pa3);
#undef PK4
}
template <int KB, bool SK>
__device__ __forceinline__ void qkt(f32x16& p0, f32x16& p1, const char* K_lds, int r32, int hi, const bf16x8* qr, bool act, const float* bl) {
    if (SK && !act) { const float NEG = -__builtin_inff();
#pragma unroll
        for (int r = 0; r < 16; ++r) { p0[r] = NEG; p1[r] = NEG; } return; }
    { const f32x4 c0 = *(const f32x4*)(bl), c1 = *(const f32x4*)(bl + 8), c2 = *(const f32x4*)(bl + 16), c3 = *(const f32x4*)(bl + 24);
      const f32x4 e0 = *(const f32x4*)(bl + 32), e1 = *(const f32x4*)(bl + 40), e2 = *(const f32x4*)(bl + 48), e3 = *(const f32x4*)(bl + 56);
      p0 = (f32x16){c0[0], c0[1], c0[2], c0[3], c1[0], c1[1], c1[2], c1[3], c2[0], c2[1], c2[2], c2[3], c3[0], c3[1], c3[2], c3[3]};
      p1 = (f32x16){e0[0], e0[1], e0[2], e0[3], e1[0], e1[1], e1[2], e1[3], e2[0], e2[1], e2[2], e2[3], e3[0], e3[1], e3[2], e3[3]}; }
    const char* kb[4];
#pragma unroll
    for (int dd = 0; dd < 4; ++dd) kb[dd] = K_lds + KB * SHM_K + KSWZ(r32, (dd * 16 + hi * 8) * 2);
#pragma unroll
    for (int d0 = 0; d0 < 8; ++d0) { const char* a = kb[d0 & 3] + (d0 >> 2) * 128;
        bf16x8 b0 = *reinterpret_cast<const bf16x8*>(a);
        bf16x8 b1 = *reinterpret_cast<const bf16x8*>(a + 32 * 256);
        p0 = __builtin_amdgcn_mfma_f32_32x32x16_bf16(b0, qr[d0], p0, 0, 0, 0);
        p1 = __builtin_amdgcn_mfma_f32_32x32x16_bf16(b1, qr[d0], p1, 0, 0, 0); }
}
template <int VB, bool SK>
__device__ __forceinline__ void pv_tile(f32x16* o, int vb0, bf16x8 pa0, bf16x8 pa1, bf16x8 pa2, bf16x8 pa3, bool act) {
    if (SK && !act) return;
#define TRRD(dst, off) asm volatile("ds_read_b64_tr_b16 %0, %1 offset:%2" : "=&v"(dst) : "v"(vb0), "i"(off) : "memory")
#define PV_D0(d0) do { s16x4 l0, l1, l2, l3, h0, h1, h2, h3; constexpr int b_ = VB * SHM_V + v_rd_off(d0, 0, 0);     \
        TRRD(l0, b_); TRRD(h0, b_ + 2048); TRRD(l1, b_ + 4096); TRRD(h1, b_ + 6144); TRRD(l2, b_ + 8192); TRRD(h2, b_ + 10240); TRRD(l3, b_ + 12288); TRRD(h3, b_ + 14336); \
        asm volatile("s_waitcnt lgkmcnt(0)" ::: "memory"); SBAR();                 \
        o[d0] = __builtin_amdgcn_mfma_f32_32x32x16_bf16(pa0, (bf16x8){l0[0], l0[1], l0[2], l0[3], h0[0], h0[1], h0[2], h0[3]}, o[d0], 0, 0, 0);   \
        o[d0] = __builtin_amdgcn_mfma_f32_32x32x16_bf16(pa1, (bf16x8){l1[0], l1[1], l1[2], l1[3], h1[0], h1[1], h1[2], h1[3]}, o[d0], 0, 0, 0);   \
        o[d0] = __builtin_amdgcn_mfma_f32_32x32x16_bf16(pa2, (bf16x8){l2[0], l2[1], l2[2], l2[3], h2[0], h2[1], h2[2], h2[3]}, o[d0], 0, 0, 0);   \
        o[d0] = __builtin_amdgcn_mfma_f32_32x32x16_bf16(pa3, (bf16x8){l3[0], l3[1], l3[2], l3[3], h3[0], h3[1], h3[2], h3[3]}, o[d0], 0, 0, 0); } while (0)
    PV_D0(0); PV_D0(1); PV_D0(2); PV_D0(3);
#undef PV_D0
#undef TRRD
}


struct BlockRef { const bf16* Q; const bf16* K; const bf16* V; bf16* O; const float* KB; int P0; };
struct Seam { bf16x8 qr[8]; bf16x8 st_v0, st_v1, st_k0, st_k1; };
#define ROW(p, k0, rr) ((p) + (size_t)((k0) + (rr)) * D + sc)
#define VMW() asm volatile("s_waitcnt vmcnt(0)" ::: "memory")
#define VMWN(n) asm volatile("s_waitcnt vmcnt(%0)" :: "i"(n) : "memory")
#define SLOAD_H(Kp, Vp, k0) do { S.st_v0 = load8<bf16>(ROW(Vp, k0, sr)); S.st_v1 = load8<bf16>(ROW(Vp, k0, 32 + sr));              \
                         S.st_k0 = load8<bf16>(ROW(Kp, k0, sr)); S.st_k1 = load8<bf16>(ROW(Kp, k0, 32 + sr)); } while (0)
#define SWRITE_HK(bf) do { *(bf16x8*)(K_lds + (bf) * SHM_K + kws) = S.st_k0; *(bf16x8*)(K_lds + (bf) * SHM_K + kws + 32 * 256) = S.st_k1; } while (0)
#define SWRITE_HV(bf) do { *(bf16x8*)(V_lds + (bf) * SHM_V + vst0) = S.st_v0; *(bf16x8*)(V_lds + (bf) * SHM_V + vst1) = S.st_v1; } while (0)
#define SWRITE_H(bf) do { SWRITE_HV(bf); SWRITE_HK(bf); } while (0)
__device__ __forceinline__ void fox_prime(const BlockRef& cur, char* lds, Seam& S, int kw) {
    const int tid = ktid(kw), wid = kw, lane = tid & 63, r32 = lane & 31, hi = lane >> 5;
    const int sr = tid >> 4, sc = (tid & 15) * 8, kws = KSWZ(sr, sc * 2); char* K_lds = lds + 2 * SHM_V;
#pragma unroll
    for (int d0 = 0; d0 < 8; ++d0) S.qr[d0] = load8<bf16>(cur.Q + (size_t)(wid * QBLK + r32) * D + d0 * 16 + hi * 8);
    SLOAD_H(cur.K, cur.V, 0); VMW(); SWRITE_HK(0);
    __syncthreads();
}
__device__ __forceinline__ void fox_block(const BlockRef& cur, const BlockRef& nxt, char* lds, Seam& S, int kw) {
    constexpr bool SK = false; constexpr unsigned W = 0x7fffffffu;
    const int tid = ktid(kw), wid = kw, lane = tid & 63, r32 = lane & 31, hi = lane >> 5;
    const int NT = (cur.P0 + QB - 1) / KVBLK + 1;
    const int qlo = cur.P0 + wid * QBLK, qm = qlo + r32 - 4 * hi;
    char* V_lds = lds; char* K_lds = lds + 2 * SHM_V;
    float* ws = (float*)(lds + 2 * SHM_V + 2 * SHM_K) + wid * 64; float* li_l = ws, * al_l = ws + 32;
    float m_reg = -1e30f, l_reg = 0; f32x16 o[4] = {};
    const int sr = tid >> 4, sc = (tid & 15) * 8, vst0 = v_st(sr, sc), vst1 = v_st(32 + sr, sc), kws = KSWZ(sr, sc * 2);
    const int vb0 = (int)(uintptr_t)V_lds + v_rd_base(lane);
    const bf16* Kh = cur.K; const bf16* Vh = cur.V;
    float* bias_l = (float*)(lds + LDS_BIAS);
    { const int nb4 = (cur.P0 + QB) / 4; int i0 = ktid(kw); asm volatile("" : "+v"(i0));
      for (int i = i0; i < nb4; i += NW * 64) ((f32x4*)bias_l)[i] = ((const f32x4*)cur.KB)[i]; }
    __syncthreads();
    const float* KBh = bias_l + 4 * hi;
#define RESC(a) do { if (__any((a) < 1.f)) { if (hi == 0) al_l[r32] = (a); asm volatile("s_waitcnt lgkmcnt(0)" ::: "memory");              \
                     for (int d_ = 0; d_ < 4; ++d_) for (int r = 0; r < 16; ++r) o[d_][r] *= al_l[crow(r, hi)]; } } while (0)
#define KBASE(t) ((t) * KVBLK)
#define ACT(t) true
#define MASKT(P0_, P1_, t) do { const int kb_ = KBASE(t); if (kb_ + KVBLK - 1 > qlo) mask_tile(P0_, P1_, qm - kb_, W); } while (0)
    constexpr int NQL = 8;
#define SEAM_K0() do { VMWN(NQL); SWRITE_HK(0); SBAR(); } while (0)
    f32x16 pA0, pA1, pB0, pB1; float mnA, mnB, alA, alB; bf16x8 pa0, pa1, pa2, pa3;
    SWRITE_HV(0); SBAR();
    if (NT > 1) { SLOAD_H(Kh, Vh, KBASE(1)); }
    SBAR(); qkt<0, SK>(pA0, pA1, K_lds, r32, hi, S.qr, ACT(0), KBh);
    MASKT(pA0, pA1, 0); partialSM(pA0, pA1, m_reg, mnA, alA);
    if (NT > 1) { VMW(); SWRITE_H(1); }
    __syncthreads();
#define HALF_STEP(PX0, PX1, mnX, alX, PY0, PY1, alY, t, KB, VB, SB) do {                                                      \
        SBAR(); qkt<KB, SK>(PX0, PX1, K_lds, r32, hi, S.qr, ACT(t), KBh + KBASE(t));                                             \
        finishSM(PY0, PY1, alY, l_reg, pa0, pa1, pa2, pa3); SBAR();                                                           \
        if ((t) + 1 < NT) { SLOAD_H(Kh, Vh, KBASE((t) + 1)); SBAR(); }                                                        \
        pv_tile<VB, SK>(o, vb0, pa0, pa1, pa2, pa3, ACT((t) - 1)); MASKT(PX0, PX1, (t)); partialSM(PX0, PX1, m_reg, mnX, alX);  \
        __syncthreads();                                                                                                      \
        if ((t) + 1 < NT) { VMW(); SWRITE_H(SB); }                                                                            \
        RESC(alX); __syncthreads(); } while (0)
    for (int t = 1; t + 1 < NT; t += 2) {
        HALF_STEP(pB0, pB1, mnB, alB, pA0, pA1, alA, t, 1, 0, 0);
        HALF_STEP(pA0, pA1, mnA, alA, pB0, pB1, alB, t + 1, 0, 1, 1);
    }
    const bool even = (NT & 1) == 0;
    if (even) { SBAR(); qkt<1, SK>(pB0, pB1, K_lds, r32, hi, S.qr, ACT(NT - 1), KBh + KBASE(NT - 1)); SBAR(); }
    SLOAD_H(nxt.K, nxt.V, 0); SBAR();
#pragma unroll
    for (int d0 = 0; d0 < 8; ++d0) S.qr[d0] = load8<bf16>(nxt.Q + (size_t)(wid * QBLK + r32) * D + d0 * 16 + hi * 8);
    SBAR();
    finishSM(pA0, pA1, alA, l_reg, pa0, pa1, pa2, pa3); SBAR();
    pv_tile<0, SK>(o, vb0, pa0, pa1, pa2, pa3, true);
    if (even) { MASKT(pB0, pB1, NT - 1); partialSM(pB0, pB1, m_reg, mnB, alB); __syncthreads(); RESC(alB);
        finishSM(pB0, pB1, alB, l_reg, pa0, pa1, pa2, pa3); SBAR(); pv_tile<1, SK>(o, vb0, pa0, pa1, pa2, pa3, true); }
    SBAR(); SEAM_K0();
    if (hi == 0) li_l[r32] = l_reg; asm volatile("s_waitcnt lgkmcnt(0)" ::: "memory");
    float rli[16];
#pragma unroll
    for (int r = 0; r < 16; ++r) rli[r] = __builtin_amdgcn_rcpf(li_l[crow(r, hi)]);
    bf16* Ow = cur.O + (size_t)(wid * QBLK) * OP;
#pragma unroll
    for (int r = 0; r < 16; ++r) { const int orow = crow(r, hi);
#pragma unroll
        for (int d0 = 0; d0 < 4; ++d0) { const float v = o[d0][r] * rli[r];
            const float vn = __shfl_xor(v, 1);
            if ((r32 & 1) == 0) *(unsigned*)(Ow + (size_t)orow * OP + d0 * 32 + r32) = cvtpk(v, vn); } }
    __syncthreads();
#undef RESC
#undef KBASE
#undef ACT
#undef MASKT
#undef SEAM_K0
#undef HALF_STEP
}
#undef ROW
#undef VMW
#undef VMWN
#undef SLOAD_H
#undef SWRITE_HK
#undef SWRITE_HV
#undef SWRITE_H
#undef KSWZ
#undef SBAR
}

struct Frame {
    LAS unsigned char* lds;
    volatile LAS unsigned* MISC;
    gu32* ctl;
    int tid, lane, wave;
    int vcu, G, bx;
    const float *x, *c, *w_ada, *b_ada, *g_mix, *w_in, *b_f, *conv_w, *conv_b, *lru_w_a, *lru_b_a, *lru_w_x, *lru_b_x, *lru_lambda,
                *g_attn_out, *g_lru_out, *w_out, *g_ffn, *peer_w_q, *peer_k1, *peer_k2, *peer_u, *peer_v, *g_final;
    float* out;
    float *MOD, *LF, *KB, *SUMM, *EW, *USC, *VSC, *PD, *Y, *ACT;
    int* EIDX;
    bf16_t *WLRU, *K1, *K2, *WIN, *WOUT, *WQ, *H, *Q, *K, *VV, *QP, *LX, *GLY, *MRG, *HL, *AC;
    unsigned char *U8, *V8;
};

struct Args { const float* in[24]; float* out; unsigned char* ws; int ph_lo, ph_hi, li, pad; };

__device__ __forceinline__ void p0_transpose_item(const float* W, int ldw, int K, bf16_t* WT, int kb, int scol, int drow, const float* gk, LAS float* scr, int lane) {
    const int k0 = 64 * kb;
#pragma unroll 8
    for (int i = 0; i < 32; ++i) { const int kk = 2 * i + (lane >> 5); float w = W[(size_t)(k0 + kk) * ldw + scol + (lane & 31)]; if (gk) w *= gk[k0 + kk]; scr[kk * 33 + (lane & 31)] = w; }
    LDS_WAIT(); asm volatile("" ::: "memory");
    const int c = lane & 7;
#pragma unroll
    for (int j = 0; j < 4; ++j) { const int n = (lane >> 3) + 8 * j; const LAS float* s = scr + (8 * c) * 33 + n;
        v4u o; o.x = pk2(s[0 * 33], s[1 * 33]); o.y = pk2(s[2 * 33], s[3 * 33]); o.z = pk2(s[4 * 33], s[5 * 33]); o.w = pk2(s[6 * 33], s[7 * 33]);
        *(GAS v4u*)(WT + (size_t)(drow + n) * K + k0 + 8 * c) = o; }
    LDS_WAIT(); asm volatile("" ::: "memory");
}
__device__ __forceinline__ void p0_convert(const float* src, bf16_t* dst, size_t n8, size_t gt, size_t ngt) {
#pragma unroll 4
    for (size_t i = gt; i < n8; i += ngt) { const f32x4 a = *(const GAS f32x4*)(src + i * 8), b = *(const GAS f32x4*)(src + i * 8 + 4);
        v4u o; o.x = pk2(a[0], a[1]); o.y = pk2(a[2], a[3]); o.z = pk2(b[0], b[1]); o.w = pk2(b[2], b[3]); *(GAS v4u*)(dst + i * 8) = o; }
}
__device__ __forceinline__ void p0_prologue(Frame& F) {
    {
        LAS float* scs = (LAS float*)F.lds;
        LAS float* red = scs + 4 * 2048;
        for (int i = F.tid; i < 4 * DM; i += NTHR) { const float cv = F.c[i]; scs[i] = cv * sigmoidf_(cv); }
        __syncthreads();
        for (int cb = F.bx; cb < 256; cb += F.G) {
            const int cq = F.tid % 12, rl = F.tid / 12;
            if (F.tid < 504) {
                float acc[4][4];
#pragma unroll
                for (int b = 0; b < 4; ++b)
#pragma unroll
                    for (int j = 0; j < 4; ++j) acc[b][j] = 0.f;
                const float* wp = F.w_ada + (size_t)rl * NADA + cb * 48 + cq * 4;
#pragma unroll 4
                for (int r = rl; r < DM; r += 42, wp += (size_t)42 * NADA) { const f32x4 w = *(const GAS f32x4*)wp;
#pragma unroll
                    for (int b = 0; b < 4; ++b) { const float s = scs[b * DM + r]; acc[b][0] += s * w[0]; acc[b][1] += s * w[1]; acc[b][2] += s * w[2]; acc[b][3] += s * w[3]; } }
#pragma unroll
                for (int b = 0; b < 4; ++b)
#pragma unroll
                    for (int j = 0; j < 4; ++j) red[rl * 192 + cq * 16 + b * 4 + j] = acc[b][j];
            }
            __syncthreads();
            if (F.tid < 192) { float s = 0.f;
                for (int r = 0; r < 42; ++r) s += red[r * 192 + F.tid];
                const int q = F.tid >> 4, b = (F.tid >> 2) & 3, j = F.tid & 3, col = cb * 48 + q * 4 + j;
                F.MOD[b * NADA + col] = s + F.b_ada[col]; }
            __syncthreads();
        }
    }
    {
        LAS float* scr = (LAS float*)(F.lds + F.wave * 16384);
        const int gw = F.vcu * NWAVES + F.wave, NGW = F.G * NWAVES;
        constexpr int I_IN1 = 32 * 96, I_IN2 = 32 * 64, I_SQ = 32 * 64, I_LRU = 16 * 8;
        constexpr int NITEMS = I_IN1 + I_IN2 + 2 * I_SQ + I_LRU;
        for (int it = gw; it < NITEMS; it += NGW) {
            int r = it;
            if (r < I_IN1) { const int kb = r / 96, nb = r % 96; p0_transpose_item(F.w_in, INC, DM, F.WIN, kb, 32 * nb, 32 * nb, nullptr, scr, F.lane); continue; } r -= I_IN1;
            if (r < I_IN2) { const int kb = r / 64, nb = r % 64; p0_transpose_item(F.w_in, INC, DM, F.WIN, kb, OFF_LX + 32 * nb, OFF_F + 32 * nb, nullptr, scr, F.lane); continue; } r -= I_IN2;
            if (r < I_SQ) { const int kb = r / 64, nb = r % 64; const float* gk = kb < 16 ? F.g_attn_out : F.g_lru_out - AW;
                p0_transpose_item(F.w_out, DM, DM, F.WOUT, kb, 32 * nb, 32 * nb, gk, scr, F.lane); continue; } r -= I_SQ;
            if (r < I_SQ) { const int kb = r / 64, nb = r % 64; p0_transpose_item(F.peer_w_q, DM, DM, F.WQ, kb, 32 * nb, 32 * nb, nullptr, scr, F.lane); continue; } r -= I_SQ;
            { const int mat = r >> 3, sub = r & 7, n = mat >> 1, which = mat & 1, kb = sub >> 2, nb = sub & 3;
              const float* src = (which ? F.lru_w_x : F.lru_w_a) + (size_t)n * LBD * LBD;
              p0_transpose_item(src, LBD, LBD, F.WLRU + (size_t)(n * 256 + which * 128) * LBD, kb, 32 * nb, 32 * nb, nullptr, scr, F.lane); }
        }
    }
    {
        const size_t gt = (size_t)F.vcu * NTHR + F.tid, ngt = (size_t)F.G * NTHR;
        p0_convert(F.peer_k1, F.K1, (size_t)PH * PNK * 128 / 8, gt, ngt);
        p0_convert(F.peer_k2, F.K2, (size_t)PH * PNK * 128 / 8, gt, ngt);
    }
    {
        const int gw = F.vcu * NWAVES + F.wave, NGW = F.G * NWAVES;
        for (int r = gw; r < 2 * NEXP; r += NGW) {
            const bool isv = r >= NEXP; const int rr = isv ? r - NEXP : r;
            const GAS f32x4* src = (const GAS f32x4*)((isv ? F.peer_v : F.peer_u) + (size_t)rr * DM) + F.lane;
            f32x4 v[8]; float am = 0.f;
#pragma unroll
            for (int j = 0; j < 8; ++j) { v[j] = src[64 * j]; am = fmaxf(am, fmaxf(fmaxf(fabsf(v[j][0]), fabsf(v[j][1])), fmaxf(fabsf(v[j][2]), fabsf(v[j][3])))); }
#pragma unroll
            for (int o = 1; o < 64; o <<= 1) am = fmaxf(am, __shfl_xor(am, o));
            const float sc = am > 0.f ? 416.f / am : 1.f;
            GAS unsigned char* dstb = (GAS unsigned char*)(isv ? F.V8 : F.U8) + (size_t)(F.lane >> 5) * ((size_t)NEXP * 128) + (size_t)rr * 128 + (F.lane & 31) * 4;
#pragma unroll
            for (int j = 0; j < 8; ++j) { int pk = 0; pk = __builtin_amdgcn_cvt_pk_fp8_f32(v[j][0] * sc, v[j][1] * sc, pk, false); pk = __builtin_amdgcn_cvt_pk_fp8_f32(v[j][2] * sc, v[j][3] * sc, pk, true);
                *(GAS unsigned*)(dstb + (size_t)(2 * j) * ((size_t)NEXP * 128)) = (unsigned)pk; }
            if (F.lane == 0) (isv ? F.VSC : F.USC)[rr] = am > 0.f ? am / 416.f : 1.f;
        }
    }
}

template <bool WITH_F>
__device__ __forceinline__ void p_modnorm(Frame& F, const float* xin, const float* g, int off_sh, int off_sc) {
    LAS float* gsv = (LAS float*)F.lds;
    LAS float* shv = gsv + DM;
    LAS float* wfT = shv + DM;
    if (WITH_F) { for (int i = F.tid; i < 8 * DM; i += NTHR) { const int k = i >> 3, j = i & 7; wfT[j * DM + k] = F.w_in[(size_t)k * INC + OFF_F + j]; } }
    for (int rb = F.bx; rb < T / 64; rb += F.G) {
        const int b = rb >> 6;
        __syncthreads();
        for (int k = F.tid; k < DM; k += NTHR) { gsv[k] = g[k] * (1.f + F.MOD[b * NADA + off_sc + k]); shv[k] = F.MOD[b * NADA + off_sh + k]; }
        __syncthreads();
        for (int i = 0; i < 8; ++i) {
            const int row = rb * 64 + F.wave * 8 + i;
            const GAS f32x4* xr = (const GAS f32x4*)(xin + (size_t)row * DM) + F.lane;
            f32x4 v[8]; float ss = 0.f;
#pragma unroll
            for (int j = 0; j < 8; ++j) { v[j] = xr[64 * j]; ss += (v[j][0] * v[j][0] + v[j][1] * v[j][1]) + (v[j][2] * v[j][2] + v[j][3] * v[j][3]); }
            const float rstd = __builtin_amdgcn_rsqf(wave_sum(ss) * (1.f / DM) + EPS);
#pragma unroll
            for (int j = 0; j < 8; ++j) { const f32x4 gg = ((const LAS f32x4*)gsv)[F.lane + 64 * j], sh = ((const LAS f32x4*)shv)[F.lane + 64 * j]; v[j] = v[j] * rstd * gg + sh; }
            GAS v2u* o8 = (GAS v2u*)(F.H + (size_t)row * DM) + F.lane;
#pragma unroll
            for (int j = 0; j < 8; ++j) { v2u w; w.x = pk2(v[j][0], v[j][1]); w.y = pk2(v[j][2], v[j][3]); o8[64 * j] = w; }
            if (WITH_F) {
                float mine = 0.f;
#pragma unroll 1
                for (int jj = 0; jj < 8; ++jj) { float a = 0.f;
#pragma unroll
                    for (int j = 0; j < 8; ++j) { const f32x4 w = ((const LAS f32x4*)(wfT + jj * DM))[F.lane + 64 * j]; a += (v[j][0] * w[0] + v[j][1] * w[1]) + (v[j][2] * w[2] + v[j][3] * w[3]); }
                    a = wave_sum(a); mine = (F.lane == jj) ? a : mine; }
                if (F.lane < 8) { const float z = mine + F.b_f[F.lane]; const float lf = fminf(z, 0.f) - log1pf(fexp(-fabsf(z)));
                    F.LF[(size_t)(b * NH + F.lane) * SEQ + (row & (SEQ - 1))] = lf; }
            }
        }
    }
}

__device__ __forceinline__ void p2_cumsum(Frame& F) {
    LAS float* wt = (LAS float*)F.lds;
    for (int bh = F.bx; bh < BATCH * NH; bh += F.G) {
        const float* src = F.LF + (size_t)bh * SEQ + F.tid * 8;
        const f32x4 a = *(const GAS f32x4*)src, b = *(const GAS f32x4*)(src + 4);
        float p[8]; p[0] = a[0]; p[1] = p[0] + a[1]; p[2] = p[1] + a[2]; p[3] = p[2] + a[3]; p[4] = p[3] + b[0]; p[5] = p[4] + b[1]; p[6] = p[5] + b[2]; p[7] = p[6] + b[3];
        float incl = p[7];
#pragma unroll
        for (int o = 1; o < 64; o <<= 1) { const float n = __shfl_up(incl, o); if (F.lane >= o) incl += n; }
        __syncthreads();
        if (F.lane == 63) wt[F.wave] = incl;
        __syncthreads();
        float off = incl - p[7];
        for (int w = 0; w < F.wave; ++w) off += wt[w];
        constexpr float NIS = -1.0f / 0.08838834764831845f;
        f32x4 o0, o1;
        o0[0] = (off + p[0]) * NIS; o0[1] = (off + p[1]) * NIS; o0[2] = (off + p[2]) * NIS; o0[3] = (off + p[3]) * NIS;
        o1[0] = (off + p[4]) * NIS; o1[1] = (off + p[5]) * NIS; o1[2] = (off + p[6]) * NIS; o1[3] = (off + p[7]) * NIS;
        float* dst = F.KB + (size_t)bh * SEQ + F.tid * 8;
        *(GAS f32x4*)dst = o0; *(GAS f32x4*)(dst + 4) = o1;
    }
}

constexpr int L_LX = 0, L_A = 17408, L_XC = 34816, L_SA = 68608, L_SUM = 102400, L_HIN = 106496, L_END = 110592;
constexpr int XS = 132;
typedef float f32x4v __attribute__((ext_vector_type(4)));
__device__ __forceinline__ void lru_unit(Frame& F, int b, int chunk) {
    LAS unsigned char* L = F.lds;
    int tid_ = ktid(F.wave); asm volatile("" : "+v"(tid_));
    const int tid = tid_, lane = tid_ & 63, wave = F.wave;
    const int s0 = chunk * 64; const size_t row0 = (size_t)b * SEQ + s0;
    LAS float* hin = (LAS float*)(L + L_HIN);
    __syncthreads();
    for (int n = 0; n < NLB; ++n) {
        __syncthreads();
        for (int idx = tid; idx < 67 * 16; idx += NTHR) { const int r = idx >> 4, c8 = idx & 15; const int s = s0 - 3 + r;
            v4u val = {0u, 0u, 0u, 0u};
            if (s >= 0) val = *(const GAS v4u*)(F.LX + ((size_t)b * SEQ + s) * LW + n * LBD + c8 * 8);
            *(LAS v4u*)(L + L_LX + r * 256 + c8 * 16) = val; }
        __syncthreads();
        { const int tok = tid >> 3, c16 = tid & 7; const int chg = n * LBD + c16 * 16;
          float xc[16];
#pragma unroll
          for (int e = 0; e < 16; e += 4) { const f32x4 cb = *(const GAS f32x4*)(F.conv_b + chg + e); xc[e] = cb[0]; xc[e + 1] = cb[1]; xc[e + 2] = cb[2]; xc[e + 3] = cb[3]; }
#pragma unroll
          for (int k = 0; k < 4; ++k) {
              const v4u x0 = *(const LAS v4u*)(L + L_LX + (tok + k) * 256 + c16 * 32), x1 = *(const LAS v4u*)(L + L_LX + (tok + k) * 256 + c16 * 32 + 16);
              const unsigned xd[8] = {x0.x, x0.y, x0.z, x0.w, x1.x, x1.y, x1.z, x1.w};
#pragma unroll
              for (int e = 0; e < 16; e += 4) { const f32x4 w = *(const GAS f32x4*)(F.conv_w + k * LW + chg + e);
                  xc[e] += w[0] * bf_lo(xd[e / 2]); xc[e + 1] += w[1] * bf_hi(xd[e / 2]); xc[e + 2] += w[2] * bf_lo(xd[e / 2 + 1]); xc[e + 3] += w[3] * bf_hi(xd[e / 2 + 1]); } }
          v4u a0, a1; a0.x = pk2(xc[0], xc[1]); a0.y = pk2(xc[2], xc[3]); a0.z = pk2(xc[4], xc[5]); a0.w = pk2(xc[6], xc[7]);
          a1.x = pk2(xc[8], xc[9]); a1.y = pk2(xc[10], xc[11]); a1.z = pk2(xc[12], xc[13]); a1.w = pk2(xc[14], xc[15]);
          *(LAS v4u*)(L + L_A + tok * 272 + c16 * 32) = a0; *(LAS v4u*)(L + L_A + tok * 272 + c16 * 32 + 16) = a1;
          LAS float* xo = (LAS float*)(L + L_XC) + tok * XS + c16 * 16;
#pragma unroll
          for (int e = 0; e < 16; e += 4) *(LAS f32x4*)(xo + e) = (f32x4){xc[e], xc[e + 1], xc[e + 2], xc[e + 3]};
        }
        __syncthreads();
        const int r16 = lane & 15, g4 = lane >> 4;
        f32x4 acc_a[4], acc_x[4];
#pragma unroll
        for (int m = 0; m < 4; ++m) { acc_a[m] = (f32x4){0.f, 0.f, 0.f, 0.f}; acc_x[m] = (f32x4){0.f, 0.f, 0.f, 0.f}; }
        { const bf16_t* wa = F.WLRU + ((size_t)(n * 256 + 16 * wave + r16)) * LBD + 8 * g4; const bf16_t* wx = wa + (size_t)128 * LBD;
#pragma unroll
          for (int ks = 0; ks < 4; ++ks) {
              const bf16x8 ba = *(const GAS bf16x8*)(wa + 32 * ks), bx = *(const GAS bf16x8*)(wx + 32 * ks);
#pragma unroll
              for (int m = 0; m < 4; ++m) { const bf16x8 af = *(const LAS bf16x8*)(L + L_A + (16 * m + r16) * 272 + (32 * ks + 8 * g4) * 2);
                  acc_a[m] = __builtin_amdgcn_mfma_f32_16x16x32_bf16(af, ba, acc_a[m], 0, 0, 0);
                  acc_x[m] = __builtin_amdgcn_mfma_f32_16x16x32_bf16(af, bx, acc_x[m], 0, 0, 0); } } }
        { const int chl = 16 * wave + r16, chg = n * LBD + chl;
          const float ba_ = F.lru_b_a[chg], bx_ = F.lru_b_x[chg]; const float sp8 = 8.f * softplusf_(-F.lru_lambda[chg]);
          LAS float* xcp = (LAS float*)(L + L_XC) + chl; LAS float* sap = (LAS float*)(L + L_SA) + chl;
#pragma unroll
          for (int m = 0; m < 4; ++m)
#pragma unroll
              for (int i = 0; i < 4; ++i) { const int tt = 16 * m + 4 * g4 + i;
                  const float rg = sigmoidf_(acc_a[m][i] + ba_), ig = sigmoidf_(acc_x[m][i] + bx_);
                  const float la = -sp8 * rg; const float a = fexp(la); const float x2 = 2.f * la;
                  const float em1 = (x2 > -0.3f) ? x2 * (1.f + x2 * (0.5f + x2 * (0.16666667f + x2 * (0.041666668f + x2 * (0.008333334f + x2 * 0.0013888889f))))) : (fexp(x2) - 1.f);
                  const float bt = __builtin_sqrtf(fmaxf(-em1, 0.f)) * (ig * xcp[tt * XS]);
                  sap[tt * XS] = a; xcp[tt * XS] = bt; } }
        __syncthreads();
        { const int chl = tid & 127, sub = tid >> 7;
          const LAS float* sap = (const LAS float*)(L + L_SA) + (16 * sub) * XS + chl; const LAS float* sbp = (const LAS float*)(L + L_XC) + (16 * sub) * XS + chl;
          float av[16], bv[16];
#pragma unroll
          for (int j = 0; j < 16; ++j) { av[j] = sap[j * XS]; bv[j] = sbp[j * XS]; }
          float P = 1.f, Hh = 0.f;
#pragma unroll
          for (int j = 0; j < 16; ++j) { Hh = av[j] * Hh + bv[j]; P *= av[j]; }
          LAS f32x2* sm = (LAS f32x2*)(L + L_SUM);
          sm[sub * 128 + chl] = (f32x2){P, Hh};
          __syncthreads();
          float h = 0.f, cp = 1.f;
          for (int s = 0; s < sub; ++s) { const f32x2 ph = sm[s * 128 + chl]; h = ph[0] * h + ph[1]; cp *= ph[0]; }
          bf16_t* hl = F.HL + (row0 + 16 * sub) * LW + n * LBD + chl; bf16_t* ac = F.AC + (row0 + 16 * sub) * LW + n * LBD + chl;
#pragma unroll
          for (int j = 0; j < 16; ++j) { h = av[j] * h + bv[j]; cp *= av[j]; hl[(size_t)j * LW] = (bf16_t)f2bf(h); ac[(size_t)j * LW] = (bf16_t)f2bf(cp); }
          if (sub == 3) *((GAS f32x2*)F.SUMM + ((size_t)(b * 64 + chunk)) * LW + n * LBD + chl) = (f32x2){cp, h};
        }
    }
}

__device__ __forceinline__ void lru_final(Frame& F, int b, int chunk) {
    LAS float* hin = (LAS float*)F.lds;
    int tid_ = ktid(F.wave); asm volatile("" : "+v"(tid_));
    const int tid = tid_;
    const size_t row0 = (size_t)b * SEQ + chunk * 64;
    __syncthreads();
    for (int ch = tid; ch < LW; ch += NTHR) { float h = 0.f;
        const GAS f32x2* sp = (const GAS f32x2*)F.SUMM + (size_t)(b * 64) * LW + ch;
        for (int c0 = 0; c0 < chunk; c0 += 8) { f32x2 ph[8];
#pragma unroll
            for (int q = 0; q < 8; ++q) ph[q] = sp[(size_t)(c0 + q < chunk ? c0 + q : chunk - 1) * LW];
#pragma unroll
            for (int q = 0; q < 8; ++q) if (c0 + q < chunk) h = ph[q][0] * h + ph[q][1]; }
        hin[ch] = h; }
    __syncthreads();
    const int tt = tid >> 3, part = tid & 7;
    const bf16_t* hlp = F.HL + (row0 + tt) * LW; const bf16_t* acp = F.AC + (row0 + tt) * LW; const bf16_t* glp = F.GLY + (row0 + tt) * LW;
    bf16_t* rowp = F.MRG + (row0 + tt) * DM;
    v4u ov[16]; float ssq = 0.f;
#pragma unroll
    for (int e = 0; e < 16; ++e) { const int c0 = (e * 8 + part) * 8;
        const v4u hv = *(const GAS v4u*)(hlp + c0), av = *(const GAS v4u*)(acp + c0), gv = *(const GAS v4u*)(glp + c0);
        const f32x4 c4a = *(const LAS f32x4*)(hin + c0), c4b = *(const LAS f32x4*)(hin + c0 + 4);
        const unsigned hd[4] = {hv.x, hv.y, hv.z, hv.w}, ad[4] = {av.x, av.y, av.z, av.w}, gd[4] = {gv.x, gv.y, gv.z, gv.w};
        const float ci[8] = {c4a[0], c4a[1], c4a[2], c4a[3], c4b[0], c4b[1], c4b[2], c4b[3]}; unsigned r[4];
#pragma unroll
        for (int q = 0; q < 4; ++q) { const float o0 = (bf_lo(hd[q]) + bf_lo(ad[q]) * ci[2 * q]) * bf_lo(gd[q]), o1 = (bf_hi(hd[q]) + bf_hi(ad[q]) * ci[2 * q + 1]) * bf_hi(gd[q]);
            ssq += o0 * o0 + o1 * o1; r[q] = pk2(o0, o1); }
        ov[e].x = r[0]; ov[e].y = r[1]; ov[e].z = r[2]; ov[e].w = r[3]; }
    ssq += __shfl_xor(ssq, 1); ssq += __shfl_xor(ssq, 2); ssq += __shfl_xor(ssq, 4);
    const float rl = __builtin_amdgcn_rsqf(ssq * (1.f / LW) + EPS);
#pragma unroll
    for (int e = 0; e < 16; ++e) { const int c0 = (e * 8 + part) * 8; const unsigned d[4] = {ov[e].x, ov[e].y, ov[e].z, ov[e].w}; v4u o;
        o.x = pk2(bf_lo(d[0]) * rl, bf_hi(d[0]) * rl); o.y = pk2(bf_lo(d[1]) * rl, bf_hi(d[1]) * rl); o.z = pk2(bf_lo(d[2]) * rl, bf_hi(d[2]) * rl); o.w = pk2(bf_lo(d[3]) * rl, bf_hi(d[3]) * rl);
        *(GAS v4u*)(rowp + AW + c0) = o; }
    float sa = 0.f;
#pragma unroll
    for (int e = 0; e < 16; ++e) { const int c0 = (e * 8 + part) * 8; ov[e] = *(const GAS v4u*)(rowp + c0); const unsigned d[4] = {ov[e].x, ov[e].y, ov[e].z, ov[e].w};
#pragma unroll
        for (int q = 0; q < 4; ++q) { const float lo = bf_lo(d[q]), hi = bf_hi(d[q]); sa += lo * lo + hi * hi; } }
    sa += __shfl_xor(sa, 1); sa += __shfl_xor(sa, 2); sa += __shfl_xor(sa, 4);
    const float ra = __builtin_amdgcn_rsqf(sa * (1.f / AW) + EPS);
#pragma unroll
    for (int e = 0; e < 16; ++e) { const int c0 = (e * 8 + part) * 8; const unsigned d[4] = {ov[e].x, ov[e].y, ov[e].z, ov[e].w}; v4u o;
        o.x = pk2(bf_lo(d[0]) * ra, bf_hi(d[0]) * ra); o.y = pk2(bf_lo(d[1]) * ra, bf_hi(d[1]) * ra); o.z = pk2(bf_lo(d[2]) * ra, bf_hi(d[2]) * ra); o.w = pk2(bf_lo(d[3]) * ra, bf_hi(d[3]) * ra);
        *(GAS v4u*)(rowp + c0) = o; }
}

__device__ __forceinline__ att::BlockRef att_ref(Frame& F, int bh, int qb) {
    att::BlockRef r; const int b = bh >> 3, h = bh & 7;
    r.Q = F.Q + ((size_t)bh * SEQ + (size_t)qb * att::QB) * HD; r.K = F.K + (size_t)bh * SEQ * HD; r.V = F.VV + (size_t)bh * SEQ * HD;
    r.O = F.MRG + ((size_t)b * SEQ + (size_t)qb * att::QB) * DM + h * HD; r.KB = F.KB + (size_t)bh * SEQ; r.P0 = qb * att::QB;
    return r;
}
__device__ __forceinline__ void p3_attention(Frame& F, char* lds) {
    constexpr int NQB = SEQ / att::QB, NX = NQB / 2, TOTAL = BATCH * NH * NX;
    int L = F.vcu; if (L >= TOTAL) return;
    int pass = 0; int bh = L / NX, x = L % NX;
    att::BlockRef cur = att_ref(F, bh, x);
    att::Seam S;
    att::fox_prime(cur, lds, S, F.wave);
    for (;;) {
        const bool more_pass = pass == 0, more_item = L + F.G < TOTAL, last = !more_pass && !more_item;
        int passn = pass + 1, Ln = L;
        if (!more_pass) { passn = 0; Ln = more_item ? L + F.G : L; }
        const int bhn = Ln / NX, xn = Ln % NX;
        const att::BlockRef nxt = last ? cur : att_ref(F, bhn, passn ? NQB - 1 - xn : xn);
        att::fox_block(cur, nxt, lds, S, F.wave);
        if (last) break;
        cur = nxt; pass = passn; L = Ln;
    }
}

template <int N> __device__ __forceinline__ float row_ror(float v) { return __builtin_bit_cast(float, __builtin_amdgcn_update_dpp(0, __builtin_bit_cast(int, v), 0x120 + N, 0xf, 0xf, false)); }
__device__ __forceinline__ float fmax_s(float a, float b) { float r; asm("v_max_f32_e32 %0, %1, %2" : "=v"(r) : "v"(a), "v"(b)); return r; }
__device__ __forceinline__ float fmin_s(float a, float b) { float r; asm("v_min_f32_e32 %0, %1, %2" : "=v"(r) : "v"(a), "v"(b)); return r; }
__device__ __forceinline__ float row_allmax(float v) {
    asm volatile("s_nop 1\n\tv_max_f32_dpp %0, %0, %0 row_ror:8 row_mask:0xf bank_mask:0xf\n\t"
                 "s_nop 1\n\tv_max_f32_dpp %0, %0, %0 row_ror:4 row_mask:0xf bank_mask:0xf\n\t"
                 "s_nop 1\n\tv_max_f32_dpp %0, %0, %0 row_ror:2 row_mask:0xf bank_mask:0xf\n\t"
                 "s_nop 1\n\tv_max_f32_dpp %0, %0, %0 row_ror:1 row_mask:0xf bank_mask:0xf" : "+v"(v));
    return v;
}
__device__ __forceinline__ float row_allsum(float v) { v += row_ror<8>(v); v += row_ror<4>(v); v += row_ror<2>(v); v += row_ror<1>(v); return v; }
#define CE_DESC(a, b) do { const float hi_ = fmax_s(a, b), lo_ = fmin_s(a, b); a = hi_; b = lo_; } while (0)
__device__ __forceinline__ float row_top16(float (&Lv)[8], int r16) {
    CE_DESC(Lv[0], Lv[1]); CE_DESC(Lv[2], Lv[3]); CE_DESC(Lv[4], Lv[5]); CE_DESC(Lv[6], Lv[7]);
    CE_DESC(Lv[0], Lv[2]); CE_DESC(Lv[1], Lv[3]); CE_DESC(Lv[4], Lv[6]); CE_DESC(Lv[5], Lv[7]);
    CE_DESC(Lv[1], Lv[2]); CE_DESC(Lv[5], Lv[6]);
    CE_DESC(Lv[0], Lv[4]); CE_DESC(Lv[1], Lv[5]); CE_DESC(Lv[2], Lv[6]); CE_DESC(Lv[3], Lv[7]);
    CE_DESC(Lv[2], Lv[4]); CE_DESC(Lv[3], Lv[5]);
    CE_DESC(Lv[1], Lv[2]); CE_DESC(Lv[3], Lv[4]); CE_DESC(Lv[5], Lv[6]);
    float res = 0.f; const float NEG = -__builtin_inff();
#pragma unroll
    for (int k = 0; k < 16; ++k) {
        const float m = row_allmax(Lv[0]);
        res = (r16 == k) ? m : res;
        const bool win = (Lv[0] == m);
#pragma unroll
        for (int j = 0; j < 7; ++j) Lv[j] = win ? Lv[j + 1] : Lv[j];
        Lv[7] = win ? NEG : Lv[7];
    }
    return res;
}
__device__ __forceinline__ void p8_topk(Frame& F) {
    LAS unsigned char* L = F.lds;
    const int lane = F.lane, wave = F.wave, r16 = lane & 15, g4 = lane >> 4;
    for (int grp = F.bx; grp < 256; grp += F.G) {
        const int hd = grp & 7, widx = grp >> 3;
        __syncthreads();
        for (int idx = F.tid; idx < 2 * 128 * 16; idx += NTHR) { const int half = idx >> 11, row = (idx >> 4) & 127, c8 = idx & 15;
            const bf16_t* src = (half ? F.K2 : F.K1) + ((size_t)hd * PNK + row) * 128 + c8 * 8;
            *(LAS v4u*)(L + half * 34816 + row * 272 + c8 * 16) = *(const GAS v4u*)src; }
        __syncthreads();
        for (int it = wave; it < 32; it += NWAVES) {
            const int t0 = widx * 512 + it * 16;
            bf16x8 a1[4], a2[4];
            { const bf16_t* qp = F.QP + (size_t)(t0 + r16) * DM + hd * PQD + 8 * g4;
#pragma unroll
              for (int ks = 0; ks < 4; ++ks) { a1[ks] = *(const GAS bf16x8*)(qp + 32 * ks); a2[ks] = *(const GAS bf16x8*)(qp + 128 + 32 * ks); } }
            f32x4 s1[8], s2[8];
#pragma unroll
            for (int nt = 0; nt < 8; ++nt) { s1[nt] = (f32x4){0.f, 0.f, 0.f, 0.f}; s2[nt] = (f32x4){0.f, 0.f, 0.f, 0.f};
#pragma unroll
                for (int ks = 0; ks < 4; ++ks) {
                    const bf16x8 b1 = *(const LAS bf16x8*)(L + (16 * nt + r16) * 272 + (32 * ks + 8 * g4) * 2);
                    const bf16x8 b2 = *(const LAS bf16x8*)(L + 34816 + (16 * nt + r16) * 272 + (32 * ks + 8 * g4) * 2);
                    s1[nt] = __builtin_amdgcn_mfma_f32_16x16x32_bf16(a1[ks], b1, s1[nt], 0, 0, 0);
                    s2[nt] = __builtin_amdgcn_mfma_f32_16x16x32_bf16(a2[ks], b2, s2[nt], 0, 0, 0); } }
#pragma unroll
            for (int i = 0; i < 4; ++i) {
                float l1[8], l2[8];
#pragma unroll
                for (int nt = 0; nt < 8; ++nt) {
                    l1[nt] = bitsf((fbits(s1[nt][i]) & ~0x7Fu) | (unsigned)(16 * nt + r16));
                    l2[nt] = bitsf((fbits(s2[nt][i]) & ~0x7Fu) | (unsigned)(16 * nt + r16)); }
                __builtin_amdgcn_sched_barrier(0);
                const float v1 = row_top16(l1, r16); __builtin_amdgcn_sched_barrier(0);
                const float v2 = row_top16(l2, r16); __builtin_amdgcn_sched_barrier(0);
                float cnd[16];
#pragma unroll
                for (int bb = 0; bb < 16; ++bb) { const float w = __shfl(v2, bb, 16);
                    cnd[bb] = __builtin_bit_cast(float, (__builtin_bit_cast(unsigned, v1 + w) & ~0xFFu) | (unsigned)(r16 * 16 + bb)); }
                float fin = 0.f; const float NEG = -__builtin_inff();
#pragma unroll
                for (int k = 0; k < 16; ++k) {
                    const float m = row_allmax(cnd[0]);
                    fin = (r16 == k) ? m : fin;
                    const bool win = (cnd[0] == m);
#pragma unroll
                    for (int j = 0; j < 15; ++j) cnd[j] = win ? cnd[j + 1] : cnd[j];
                    cnd[15] = win ? NEG : cnd[15];
                }
                const unsigned fb = __builtin_bit_cast(unsigned, fin); const int ra = (fb >> 4) & 15, rb = fb & 15;
                const float pv1 = __shfl(v1, ra, 16), pv2 = __shfl(v2, rb, 16);
                const int i1 = __builtin_bit_cast(unsigned, pv1) & 0x7F, i2 = __builtin_bit_cast(unsigned, pv2) & 0x7F;
                const float vs = pv1 + pv2;
                const float mx = row_allmax(vs); const float ex = fexp(vs - mx); const float sm = row_allsum(ex);
                const size_t o = (size_t)(t0 + 4 * g4 + i) * NSEL + hd * PTOPK + r16;
                F.EIDX[o] = i1 * PNK + i2; F.EW[o] = ex / sm;
                __builtin_amdgcn_sched_barrier(0);
            }
        }
    }
}

#ifdef P8_NAIVE
__device__ __forceinline__ void p8_naive(Frame& F) {
    LAS float* base = (LAS float*)F.lds;
    if (F.tid < 64) {
        LAS float* sc = base + F.tid * 320; LAS int* ia = (LAS int*)(sc + 256); LAS int* ib = ia + 16;
        for (int pair = F.bx * 64 + F.tid; pair < T * PH; pair += F.G * 64) { const int t = pair >> 3, hd = pair & 7;
            for (int n = 0; n < 128; ++n) { float a = 0.f, b = 0.f;
                for (int d = 0; d < 128; ++d) { const float q1 = bf_lo((unsigned)F.QP[(size_t)t * DM + hd * 256 + d]), q2 = bf_lo((unsigned)F.QP[(size_t)t * DM + hd * 256 + 128 + d]);
                    a += q1 * F.peer_k1[((size_t)hd * 128 + n) * 128 + d]; b += q2 * F.peer_k2[((size_t)hd * 128 + n) * 128 + d]; }
                sc[n] = a; sc[128 + n] = b; }
            int na = 0, nb = 0;
            for (int n = 0; n < 128; ++n) { int c1 = 0, c2 = 0; for (int m = 0; m < 128; ++m) { c1 += (sc[m] > sc[n]) || (sc[m] == sc[n] && m < n); c2 += (sc[128 + m] > sc[128 + n]) || (sc[128 + m] == sc[128 + n] && m < n); }
                if (c1 < 16) ia[na++] = n; if (c2 < 16) ib[nb++] = n; }
            float bound = 1e30f; int pa = -1, pb = -1; float vs[16]; int ee[16];
            for (int r = 0; r < 16; ++r) { float mx = -1e30f; int ba = 0, bb = 0;
                for (int a = 0; a < 16; ++a) for (int b = 0; b < 16; ++b) { const float v = sc[ia[a]] + sc[128 + ib[b]];
                    const bool lt = v < bound || (v == bound && (ia[a] * 128 + ib[b]) > (pa * 128 + pb));
                    if (lt && (v > mx)) { mx = v; ba = ia[a]; bb = ib[b]; } }
                bound = mx; pa = ba; pb = bb; vs[r] = mx; ee[r] = ba * 128 + bb; }
            float sm = 0.f;
#pragma unroll
            for (int r = 0; r < 16; ++r) { vs[r] = expf(vs[r] - vs[0]); sm += vs[r]; }
#pragma unroll
            for (int r = 0; r < 16; ++r) { F.EIDX[(size_t)t * NSEL + hd * 16 + r] = ee[r]; F.EW[(size_t)t * NSEL + hd * 16 + r] = vs[r] / sm; }
        }
    }
}
#endif
__device__ __forceinline__ void cvt16(const v4u& r, float (&f)[16]) {
    const unsigned dd[4] = {r.x, r.y, r.z, r.w};
#pragma unroll
    for (int c = 0; c < 4; ++c) { const f32x2 lo = __builtin_amdgcn_cvt_pk_f32_fp8((int)dd[c], false), hi = __builtin_amdgcn_cvt_pk_f32_fp8((int)dd[c], true);
        f[4 * c] = lo[0]; f[4 * c + 1] = lo[1]; f[4 * c + 2] = hi[0]; f[4 * c + 3] = hi[1]; }
}
__device__ __forceinline__ void p9a_udots(Frame& F) {
    const int lane = F.lane, sub = lane & 7, g = lane >> 3;
    const bool b2 = (lane & 4) != 0, b1 = (lane & 2) != 0, b0 = (lane & 1) != 0;
    for (int vid = F.bx; vid < 256; vid += F.G) { const int x = vid & 7, c = vid >> 3;
        for (int si = 0; si < 2; ++si) { const int s = x + 8 * si;
            const unsigned char* tab = F.U8 + (size_t)s * ((size_t)NEXP * 128) + 16 * sub;
            const int tb = c * 512 + F.wave;
            int idn[8]; v4u rc[8]; v4u hc0, hc1;
            { const int* ei = F.EIDX + (size_t)tb * NSEL + g;
#pragma unroll
              for (int i = 0; i < 8; ++i) idn[i] = ei[8 * i];
              const GAS v4u* hp = (const GAS v4u*)(F.H + (size_t)tb * DM + 128 * s + 16 * sub); hc0 = hp[0]; hc1 = hp[1];
#pragma unroll
              for (int i = 0; i < 8; ++i) rc[i] = *(const GAS v4u*)(tab + (size_t)idn[i] * 128);
#pragma unroll
              for (int i = 0; i < 8; ++i) idn[i] = ei[64 + 8 * i]; }
#pragma unroll 1
            for (int k = 0; k < 64; ++k) { const int t = tb + 8 * k; const int t1 = tb + 8 * (k + 1 < 64 ? k + 1 : 63);
                float hf[16];
                { const unsigned dd[8] = {hc0.x, hc0.y, hc0.z, hc0.w, hc1.x, hc1.y, hc1.z, hc1.w};
#pragma unroll
                  for (int q = 0; q < 8; ++q) { hf[2 * q] = bf_lo(dd[q]); hf[2 * q + 1] = bf_hi(dd[q]); } }
                { const GAS v4u* hp = (const GAS v4u*)(F.H + (size_t)t1 * DM + 128 * s + 16 * sub); hc0 = hp[0]; hc1 = hp[1]; }
                const int* ei1 = F.EIDX + (size_t)t1 * NSEL + g;
                float p[16];
#pragma unroll
                for (int it = 0; it < 16; ++it) { const int i = it & 7; float f[16]; cvt16(rc[i], f);
                    rc[i] = *(const GAS v4u*)(tab + (size_t)idn[i] * 128);
                    idn[i] = ei1[(it < 8 ? 0 : 64) + 8 * i];
                    float p0 = 0.f, p1 = 0.f;
#pragma unroll
                    for (int q = 0; q < 16; q += 2) { p0 = fmaf(f[q], hf[q], p0); p1 = fmaf(f[q + 1], hf[q + 1], p1); }
                    p[it] = p0 + p1; }
                float q8[8], q4[4], q2[2];
#pragma unroll
                for (int i = 0; i < 8; ++i) { const float keep = b2 ? p[8 + i] : p[i], send = b2 ? p[i] : p[8 + i]; q8[i] = keep + __shfl_xor(send, 4); }
#pragma unroll
                for (int i = 0; i < 4; ++i) { const float keep = b1 ? q8[4 + i] : q8[i], send = b1 ? q8[i] : q8[4 + i]; q4[i] = keep + __shfl_xor(send, 2); }
#pragma unroll
                for (int i = 0; i < 2; ++i) { const float keep = b0 ? q4[2 + i] : q4[i], send = b0 ? q4[i] : q4[2 + i]; q2[i] = keep + __shfl_xor(send, 1); }
                float* pd = F.PD + ((size_t)s * T + t) * NSEL + 16 * sub + g;
                pd[0] = q2[0]; pd[8] = q2[1];
            }
        }
    }
}
__device__ __forceinline__ void p9b_act(Frame& F) {
    const size_t gt = (size_t)F.vcu * NTHR + F.tid, ngt = (size_t)F.G * NTHR;
    for (size_t idx = gt; idx < (size_t)T * NSEL; idx += ngt) {
        const int ex = F.EIDX[idx]; float sum = 0.f;
#pragma unroll
        for (int s = 0; s < 16; ++s) sum += F.PD[(size_t)s * T * NSEL + idx];
        F.ACT[idx] = gelu_tanh(sum * F.USC[ex]) * F.EW[idx] * F.VSC[ex];
    }
}
__device__ __forceinline__ void p9c_vacc(Frame& F) {
    const int lane = F.lane, sub = lane & 7, g = lane >> 3;
    const bool b5 = (lane & 32) != 0, b4 = (lane & 16) != 0, b3 = (lane & 8) != 0;
    for (int vid = F.bx; vid < 256; vid += F.G) { const int x = vid & 7, c = vid >> 3;
        for (int si = 0; si < 2; ++si) { const int s = x + 8 * si;
            const unsigned char* tab = F.V8 + (size_t)s * ((size_t)NEXP * 128) + 16 * sub;
            const int tb = c * 512 + F.wave;
            int idn[8]; v4u rc[8]; float ac[8];
            { const int* ei = F.EIDX + (size_t)tb * NSEL + g; const float* ap = F.ACT + (size_t)tb * NSEL + g;
#pragma unroll
              for (int i = 0; i < 8; ++i) { idn[i] = ei[8 * i]; ac[i] = ap[8 * i]; }
#pragma unroll
              for (int i = 0; i < 8; ++i) rc[i] = *(const GAS v4u*)(tab + (size_t)idn[i] * 128);
#pragma unroll
              for (int i = 0; i < 8; ++i) idn[i] = ei[64 + 8 * i]; }
#pragma unroll 1
            for (int k = 0; k < 64; ++k) { const int t = tb + 8 * k; const int t1 = tb + 8 * (k + 1 < 64 ? k + 1 : 63);
                const int* ei1 = F.EIDX + (size_t)t1 * NSEL + g; const float* ap0 = F.ACT + (size_t)t * NSEL + g; const float* ap1 = F.ACT + (size_t)t1 * NSEL + g;
                float ya[16];
#pragma unroll
                for (int i = 0; i < 16; ++i) ya[i] = 0.f;
#pragma unroll
                for (int it = 0; it < 16; ++it) { const int i = it & 7; float f[16]; cvt16(rc[i], f); const float a = ac[i];
                    rc[i] = *(const GAS v4u*)(tab + (size_t)idn[i] * 128);
                    ac[i] = (it < 8) ? ap0[64 + 8 * i] : ap1[8 * i];
                    idn[i] = ei1[(it < 8 ? 0 : 64) + 8 * i];
#pragma unroll
                    for (int q = 0; q < 16; ++q) ya[q] = fmaf(a, f[q], ya[q]); }
                float y8[8], y4[4], y2[2];
#pragma unroll
                for (int i = 0; i < 8; ++i) { const float keep = b5 ? ya[8 + i] : ya[i], send = b5 ? ya[i] : ya[8 + i]; y8[i] = keep + __shfl_xor(send, 32); }
#pragma unroll
                for (int i = 0; i < 4; ++i) { const float keep = b4 ? y8[4 + i] : y8[i], send = b4 ? y8[i] : y8[4 + i]; y4[i] = keep + __shfl_xor(send, 16); }
#pragma unroll
                for (int i = 0; i < 2; ++i) { const float keep = b3 ? y4[2 + i] : y4[i], send = b3 ? y4[i] : y4[2 + i]; y2[i] = keep + __shfl_xor(send, 8); }
                float* yp = F.Y + (size_t)t * DM + 128 * s + 16 * sub + 2 * g;
                *(GAS f32x2*)yp = (f32x2){y2[0], y2[1]};
            }
        }
    }
}
__device__ __forceinline__ void p9d_final(Frame& F) {
    const int lane = F.lane; const int gw = F.vcu * NWAVES + F.wave, NGW = F.G * NWAVES;
    for (int t = gw; t < T; t += NGW) {
        const int b = t >> 12;
        float* op = F.out + (size_t)t * DM; const float* ga = F.MOD + (size_t)b * NADA + 5 * DM; const float* yp = F.Y + (size_t)t * DM;
        f32x4 v[8]; float ss = 0.f;
#pragma unroll
        for (int j = 0; j < 8; ++j) { const int col = 4 * (lane + 64 * j); const f32x4 xa = *(const GAS f32x4*)(op + col), g4v = *(const GAS f32x4*)(ga + col), yv = *(const GAS f32x4*)(yp + col);
            v[j] = xa + g4v * yv; ss += (v[j][0] * v[j][0] + v[j][1] * v[j][1]) + (v[j][2] * v[j][2] + v[j][3] * v[j][3]); }
        const float rstd = __builtin_amdgcn_rsqf(wave_sum(ss) * (1.f / DM) + EPS);
#pragma unroll
        for (int j = 0; j < 8; ++j) { const int col = 4 * (lane + 64 * j); const f32x4 gf = *(const GAS f32x4*)(F.g_final + col); *(GAS f32x4*)(op + col) = v[j] * rstd * gf; }
    }
}

#ifdef DBG_UPTO
__device__ __forceinline__ unsigned dhash(unsigned x) { x ^= x >> 16; x *= 0x7feb352du; x ^= x >> 15; x *= 0x846ca68bu; x ^= x >> 16; return x; }
__device__ __forceinline__ float dbf(const bf16_t* p, size_t i) { return __builtin_bit_cast(float, (unsigned)p[i] << 16); }
__device__ __forceinline__ float dsilu(float v) { return v / (1.f + expf(-v)); }
__device__ __forceinline__ float dgelu(float x) { return 0.5f * x * (1.f + tanhf(0.7978845608028654f * (x + 0.044715f * x * x * x))); }
__global__ void __launch_bounds__(512) dbg_check(Args args, int upto) {
    __shared__ unsigned emax[20];
    __shared__ float sbuf[8][4096 + 128];
    const int tid = threadIdx.x, lane = tid & 63, wave = tid >> 6;
    if (tid < 20) emax[tid] = 0u;
    __syncthreads();
    const float* x = args.in[0]; const float* c = args.in[1]; const float* w_ada = args.in[2]; const float* b_ada = args.in[3]; const float* g_mix = args.in[4];
    const float* w_in = args.in[5]; const float* b_f = args.in[6]; const float* conv_w = args.in[7]; const float* conv_b = args.in[8];
    const float* lru_w_a = args.in[9]; const float* lru_b_a = args.in[10]; const float* lru_w_x = args.in[11]; const float* lru_b_x = args.in[12]; const float* lru_lambda = args.in[13];
    const float* g_attn_out = args.in[14]; const float* g_lru_out = args.in[15]; const float* w_out = args.in[16];
    unsigned char* ws = args.ws; float* out = args.out;
    const float* MOD = (const float*)(ws + WS_MOD); const float* LF = (const float*)(ws + WS_LF); const float* KB = (const float*)(ws + WS_KB); const float* SUMM = (const float*)(ws + WS_SUMM);
    const bf16_t* H = (const bf16_t*)(ws + WS_H); const bf16_t* Q = (const bf16_t*)(ws + WS_Q); const bf16_t* K = (const bf16_t*)(ws + WS_K); const bf16_t* V = (const bf16_t*)(ws + WS_VV);
    const bf16_t* LX = (const bf16_t*)(ws + WS_LX); const bf16_t* GLY = (const bf16_t*)(ws + WS_GLY); const bf16_t* MRG = (const bf16_t*)(ws + WS_MRG);
#define REPORT(k, e) atomicMax(&emax[k], __float_as_uint(fminf(fmaxf((e), 0.f), 1e30f)))
    if (upto >= 1) { const int b = tid & 3, col = dhash(tid * 7 + 1) % NADA; float s = 0.f;
        for (int k = 0; k < DM; ++k) s += dsilu(c[b * DM + k]) * w_ada[(size_t)k * NADA + col];
        s += b_ada[col]; REPORT(1, fabsf(MOD[b * NADA + col] - s) / (2e-3f * (fabsf(s) + 0.05f))); }
    if (upto >= 2 && upto < 7) { const int row = dhash(tid * 13 + 5) % T, col = dhash(tid * 17 + 3) % DM, b = row >> 12; float ss = 0.f;
        for (int k = 0; k < DM; ++k) { const float v = x[(size_t)row * DM + k]; ss += v * v; }
        const float rstd = 1.f / sqrtf(ss / DM + EPS);
        const float h = x[(size_t)row * DM + col] * rstd * g_mix[col] * (1.f + MOD[b * NADA + DM + col]) + MOD[b * NADA + col];
        REPORT(2, fabsf(dbf(H, (size_t)row * DM + col) - h) / (1e-2f * (fabsf(h) + 0.1f)));
        const int j = tid & 7; float z = b_f[j];
        for (int k = 0; k < DM; ++k) z += dbf(H, (size_t)row * DM + k) * w_in[(size_t)k * INC + OFF_F + j];
        const float lf = fminf(z, 0.f) - log1pf(expf(-fabsf(z)));
        REPORT(3, fabsf(LF[(size_t)(b * NH + j) * SEQ + (row & (SEQ - 1))] - lf) / 2e-2f); }
    if (upto >= 3 && upto < 7) { const int row = dhash(tid * 19 + 11) % T, coln = dhash(tid * 23 + 7) % 5120, b = row >> 12, s = row & 4095;
        const int src = coln < 3072 ? coln : coln + 8; float v = 0.f;
        for (int k = 0; k < DM; ++k) v += dbf(H, (size_t)row * DM + k) * w_in[(size_t)k * INC + src];
        const int cat = coln >> 10, cc = coln & 1023; float got;
        if (cat < 3) { const bf16_t* base = cat == 0 ? Q : (cat == 1 ? K : V); got = dbf(base, ((size_t)((b * 8 + (cc >> 7)) * 4096 + s)) * 128 + (cc & 127)); }
        else if (cat == 3) got = dbf(LX, (size_t)row * 1024 + cc);
        else { got = dbf(GLY, (size_t)row * 1024 + cc); v = dgelu(v); }
        REPORT(4 + (cat == 4 ? 1 : 0) + (cat == 3 ? 2 : 0), fabsf(got - v) / (3e-2f * (fabsf(v) + 0.3f)));
        if (tid < 32) { float cum = 0.f, e = 0.f;
            for (int t = 0; t < SEQ; ++t) { cum += LF[(size_t)tid * SEQ + t]; e = fmaxf(e, fabsf(KB[(size_t)tid * SEQ + t] * (-0.08838834764831845f) - cum) / (1e-3f * (fabsf(cum) + 1.f))); }
            REPORT(7, e); } }
    if (upto >= 4) {
        for (int smp = 0; smp < 4; ++smp) { const unsigned hsh = dhash((wave * 4 + smp) * 31 + 17); const int bh = hsh & 31, t = (smp == 0) ? (int)((hsh >> 5) & 255) : (int)((hsh >> 5) & 4095); const int b = bh >> 3, h = bh & 7;
            float* lg = sbuf[wave]; float* qs = lg + 4096;
            qs[lane] = dbf(Q, ((size_t)bh * SEQ + t) * HD + lane); qs[64 + lane] = dbf(Q, ((size_t)bh * SEQ + t) * HD + 64 + lane);
            __builtin_amdgcn_wave_barrier();
            float mx = -1e30f;
            for (int s = lane; s <= t; s += 64) { float d = 0.f; for (int k = 0; k < HD; ++k) d += qs[k] * dbf(K, ((size_t)bh * SEQ + s) * HD + k);
                const float l = d * 0.08838834764831845f + KB[(size_t)bh * SEQ + s] * 0.08838834764831845f; lg[s] = l; mx = fmaxf(mx, l); }
            for (int o = 1; o < 64; o <<= 1) mx = fmaxf(mx, __shfl_xor(mx, o));
            float sm = 0.f;
            for (int s = lane; s <= t; s += 64) { const float p = expf(lg[s] - mx); lg[s] = p; sm += p; }
            for (int o = 1; o < 64; o <<= 1) sm += __shfl_xor(sm, o);
            __builtin_amdgcn_wave_barrier();
            float o0 = 0.f, o1 = 0.f;
            for (int s = 0; s <= t; ++s) { const float p = lg[s]; o0 += p * dbf(V, ((size_t)bh * SEQ + s) * HD + lane); o1 += p * dbf(V, ((size_t)bh * SEQ + s) * HD + 64 + lane); }
            o0 /= sm; o1 /= sm;
            if (upto == 4) {
                const float g0 = dbf(MRG, ((size_t)b * SEQ + t) * DM + h * HD + lane), g1 = dbf(MRG, ((size_t)b * SEQ + t) * DM + h * HD + 64 + lane);
                REPORT(8, fmaxf(fabsf(g0 - o0) / (3e-2f * (fabsf(o0) + 0.3f)), fabsf(g1 - o1) / (3e-2f * (fabsf(o1) + 0.3f)))); }
            __builtin_amdgcn_wave_barrier();
        }
        { const unsigned hsh = dhash(tid * 37 + 29); const int b = hsh & 3, chunk = (hsh >> 2) & 63, ch = (hsh >> 8) & 1023, n = ch >> 7, j = ch & 127;
          const float sp = log1pf(expf(-lru_lambda[ch])) ;
          float P = 1.f, Hh = 0.f;
          for (int tt = 0; tt < 64; ++tt) { const int s = chunk * 64 + tt; float ga = lru_b_a[ch], gx = lru_b_x[ch], xcj = 0.f;
              for (int i = 0; i < 128; ++i) { float xc = conv_b[n * 128 + i];
                  for (int k = 0; k < 4; ++k) { const int ss = s - 3 + k; if (ss >= 0) xc += conv_w[k * LW + n * 128 + i] * dbf(LX, ((size_t)b * SEQ + ss) * LW + n * 128 + i); }
                  ga += xc * lru_w_a[((size_t)n * 128 + i) * 128 + j]; gx += xc * lru_w_x[((size_t)n * 128 + i) * 128 + j]; if (i == j) xcj = xc; }
              const float r = 1.f / (1.f + expf(-ga)), ig = 1.f / (1.f + expf(-gx)); const float la = -8.f * r * sp; const float a = expf(la);
              const float bt = sqrtf(-expm1f(2.f * la)) * (ig * xcj); Hh = a * Hh + bt; P *= a; }
          const float gp = SUMM[(((size_t)(b * 64 + chunk)) * LW + ch) * 2], gh = SUMM[(((size_t)(b * 64 + chunk)) * LW + ch) * 2 + 1];
          REPORT(9, fmaxf(fabsf(gp - P) / (2e-2f * (fabsf(P) + 0.01f)), fabsf(gh - Hh) / (3e-2f * (fabsf(Hh) + 0.05f)))); }
    }
    if (upto >= 5) { const int row = dhash(tid * 41 + 3) % T; float sa = 0.f, sl = 0.f;
        for (int k = 0; k < 1024; ++k) { const float a = dbf(MRG, (size_t)row * DM + k), l = dbf(MRG, (size_t)row * DM + 1024 + k); sa += a * a; sl += l * l; }
        REPORT(10, fmaxf(fabsf(sa / 1024.f - 1.f), fabsf(sl / 1024.f - 1.f)) / 2e-2f);
        if (tid < 64) { const int pr = tid >> 1; const int b = pr & 3, ch = dhash(tid * 43 + 1) & 1023, n = ch >> 7, j = ch & 127, tend = 70 + (pr >> 2) * 8;
            const float sp = log1pf(expf(-lru_lambda[ch])); float hcur = 0.f;
            for (int s = 0; s <= tend; ++s) { float ga = lru_b_a[ch], gx = lru_b_x[ch], xcj = 0.f;
                for (int i = 0; i < 128; ++i) { float xc = conv_b[n * 128 + i];
                    for (int k = 0; k < 4; ++k) { const int ss = s - 3 + k; if (ss >= 0) xc += conv_w[k * LW + n * 128 + i] * dbf(LX, ((size_t)b * SEQ + ss) * LW + n * 128 + i); }
                    ga += xc * lru_w_a[((size_t)n * 128 + i) * 128 + j]; gx += xc * lru_w_x[((size_t)n * 128 + i) * 128 + j]; if (i == j) xcj = xc; }
                const float r = 1.f / (1.f + expf(-ga)), ig = 1.f / (1.f + expf(-gx)); const float la = -8.f * r * sp; const float a = expf(la);
                hcur = a * hcur + sqrtf(-expm1f(2.f * la)) * (ig * xcj); }
            sbuf[0][tid] = hcur * dbf(GLY, ((size_t)b * SEQ + tend) * LW + ch);
            sbuf[1][tid] = dbf(MRG, ((size_t)b * SEQ + tend) * DM + 1024 + ch); }
        __syncthreads();
        if (tid < 64 && (tid & 1) == 0) {
            const float r0 = sbuf[0][tid], r1 = sbuf[0][tid + 1], k0 = sbuf[1][tid], k1 = sbuf[1][tid + 1];
            REPORT(11, fabsf(r0 * k1 - r1 * k0) / (5e-2f * (fabsf(r0 * k1) + fabsf(r1 * k0) + 1e-3f))); }
    }
    if (upto >= 6 && upto < 10) { const int row = dhash(tid * 47 + 9) % T, col = dhash(tid * 53 + 13) % DM, b = row >> 12; float v = 0.f;
        for (int k = 0; k < DM; ++k) v += dbf(MRG, (size_t)row * DM + k) * w_out[(size_t)k * DM + col] * (k < 1024 ? g_attn_out[k] : g_lru_out[k - 1024]);
        const float x1 = x[(size_t)row * DM + col] + MOD[b * NADA + 2 * DM + col] * v;
        REPORT(12, fabsf(out[(size_t)row * DM + col] - x1) / (2e-2f * (fabsf(x1) + 0.2f))); }
    const float* g_ffn = args.in[17]; const float* w_q = args.in[18]; const float* pk1 = args.in[19]; const float* pk2 = args.in[20]; const float* pu = args.in[21]; const float* pv = args.in[22]; const float* g_final = args.in[23];
    const bf16_t* QP = (const bf16_t*)(ws + WS_QP); const int* EIDX = (const int*)(ws + WS_EIDX); const float* EW = (const float*)(ws + WS_EW);
    if (upto >= 7 && upto < 10) { const int row = dhash(tid * 59 + 5) % T, col = dhash(tid * 61 + 3) % DM, b = row >> 12; float ss = 0.f;
        for (int k = 0; k < DM; ++k) { const float v = out[(size_t)row * DM + k]; ss += v * v; }
        const float rstd = 1.f / sqrtf(ss / DM + EPS);
        const float h = out[(size_t)row * DM + col] * rstd * g_ffn[col] * (1.f + MOD[b * NADA + 4 * DM + col]) + MOD[b * NADA + 3 * DM + col];
        REPORT(13, fabsf(dbf(H, (size_t)row * DM + col) - h) / (1e-2f * (fabsf(h) + 0.1f))); }
    if (upto >= 8) { const int row = dhash(tid * 67 + 11) % T, col = dhash(tid * 71 + 7) % DM; float v = 0.f;
        for (int k = 0; k < DM; ++k) v += dbf(H, (size_t)row * DM + k) * w_q[(size_t)k * DM + col];
        REPORT(14, fabsf(dbf(QP, (size_t)row * DM + col) - v) / (3e-2f * (fabsf(v) + 0.3f))); }
    __syncthreads();
    if (upto >= 9 && tid < 64) { float* sc = &sbuf[0][0] + tid * 256; const unsigned hsh = dhash(tid * 73 + 19); const int t = hsh % T, hd = (hsh >> 16) & 7;
        for (int n = 0; n < 128; ++n) { float a = 0.f, bsum = 0.f;
            for (int d = 0; d < 128; ++d) { a += dbf(QP, (size_t)t * DM + hd * 256 + d) * dbf((const bf16_t*)(ws + WS_K1), ((size_t)hd * 128 + n) * 128 + d); bsum += dbf(QP, (size_t)t * DM + hd * 256 + 128 + d) * dbf((const bf16_t*)(ws + WS_K2), ((size_t)hd * 128 + n) * 128 + d); }
            sc[n] = a; sc[128 + n] = bsum; }
        float th1 = 0.f, th2 = 0.f;
        for (int n = 0; n < 128; ++n) { int c1 = 0, c2 = 0; for (int m = 0; m < 128; ++m) { c1 += sc[m] > sc[n]; c2 += sc[128 + m] > sc[128 + n]; } if (c1 == 15) th1 = sc[n]; if (c2 == 15) th2 = sc[128 + n]; }
        float best16 = -1e30f;
        {
          float bound = 1e30f;
          for (int r = 0; r < 16; ++r) { float mx = -1e30f;
              for (int a = 0; a < 128; ++a) if (sc[a] >= th1) for (int bq = 0; bq < 128; ++bq) if (sc[128 + bq] >= th2) { const float v = sc[a] + sc[128 + bq]; if (v < bound && v > mx) mx = v; }
              bound = mx; }
          best16 = bound; }
        float e = 0.f, e2 = 0.f, e3 = 0.f, mxs = -1e30f;
        for (int k = 0; k < 16; ++k) { const int ex = EIDX[(size_t)t * NSEL + hd * 16 + k]; const int i1 = ex >> 7, i2 = ex & 127;
            if (ex < 0 || ex >= NEXP) { e3 = 1e6f; continue; }
            const float v = sc[i1] + sc[128 + i2]; mxs = fmaxf(mxs, v);
            e = fmaxf(e, (best16 - v) / 3e-2f);
            for (int k2 = 0; k2 < k; ++k2) if (EIDX[(size_t)t * NSEL + hd * 16 + k2] == ex) e3 = 1e5f; }
        float sm = 0.f; for (int k = 0; k < 16; ++k) { const int ex = EIDX[(size_t)t * NSEL + hd * 16 + k] & (NEXP - 1); sm += expf(sc[ex >> 7] + sc[128 + (ex & 127)] - mxs); }
        for (int k = 0; k < 16; ++k) { const int ex = EIDX[(size_t)t * NSEL + hd * 16 + k] & (NEXP - 1); const float w = expf(sc[ex >> 7] + sc[128 + (ex & 127)] - mxs) / sm;
            e2 = fmaxf(e2, fabsf(EW[(size_t)t * NSEL + hd * 16 + k] - w) / (3e-2f * (w + 0.02f))); }
        REPORT(15, e); REPORT(17, e2); REPORT(18, e3); }
    __syncthreads();
    if (upto >= 10) {
        for (int smp = 0; smp < 2; ++smp) { const int row = dhash((wave * 2 + smp) * 79 + 23) % T, b = row >> 12;
            float x2[32]; float ss = 0.f;
#pragma unroll 1
            for (int j = 0; j < 32; ++j) { const int col = lane + 64 * j; float v = 0.f;
                for (int k = 0; k < DM; ++k) v += dbf(MRG, (size_t)row * DM + k) * w_out[(size_t)k * DM + col] * (k < 1024 ? g_attn_out[k] : g_lru_out[k - 1024]);
                sbuf[wave][col] = x[(size_t)row * DM + col] + MOD[b * NADA + 2 * DM + col] * v; }
            for (int j = 0; j < 32; ++j) sbuf[wave][2048 + lane + 64 * j] = 0.f;
            for (int e = 0; e < NSEL; ++e) { const int ex = EIDX[(size_t)row * NSEL + e] & (NEXP - 1); const float w = EW[(size_t)row * NSEL + e]; float d = 0.f;
                for (int j = 0; j < 32; ++j) { const int col = lane + 64 * j; d += dbf(H, (size_t)row * DM + col) * pu[(size_t)ex * DM + col]; }
                for (int o = 1; o < 64; o <<= 1) d += __shfl_xor(d, o);
                const float act = dgelu(d) * w;
                for (int j = 0; j < 32; ++j) { const int col = lane + 64 * j; sbuf[wave][2048 + col] += act * pv[(size_t)ex * DM + col]; } }
            for (int j = 0; j < 32; ++j) { const int col = lane + 64 * j; const float v = sbuf[wave][col] + MOD[b * NADA + 5 * DM + col] * sbuf[wave][2048 + col]; sbuf[wave][col] = v; ss += v * v; }
            for (int o = 1; o < 64; o <<= 1) ss += __shfl_xor(ss, o);
            const float rstd = 1.f / sqrtf(ss / DM + EPS); float e = 0.f;
            for (int j = 0; j < 32; ++j) { const int col = lane + 64 * j; const float r = sbuf[wave][col] * rstd * g_final[col]; e = fmaxf(e, fabsf(out[(size_t)row * DM + col] - r) / (3e-2f * (fabsf(r) + 0.3f))); }
            REPORT(16, e); (void)x2; }
    }
    __syncthreads();
    for (size_t i = tid; i < (size_t)T * DM; i += 512) out[i] = 0.f;
    __syncthreads();
    if (tid == 0) { float code = 0.f;
        for (int k = 18; k >= 1; --k) if (k != 16 && __uint_as_float(emax[k]) > 1.f) code = powf(10.f, (float)(k + 1)) * fminf(9.9f, 1.f + log10f(__uint_as_float(emax[k])));
        out[0] = code; }
}
#endif

__global__ void __launch_bounds__(NWAVES * 64, 2) hymba_fwd(Args args) {
    unsigned char* const lds = g_lds;
    Frame F;
    F.lds = (LAS unsigned char*)lds;
    F.MISC = (volatile LAS unsigned*)(F.lds + MISC_OFF);
    { const int t0_ = (int)__builtin_amdgcn_workitem_id_x();
      F.wave = __builtin_amdgcn_readfirstlane(t0_ >> 6); }
    F.tid = ktid(F.wave); F.lane = F.tid & 63;
    for (int u = F.tid; u < (LDS_BYTES - LDSCTL_OFF) / 4; u += NWAVES * 64) ((LAS unsigned*)(F.lds + LDSCTL_OFF))[u] = 0u;
    __syncthreads();
    F.G = gridDim.x; F.bx = blockIdx.x; { const int bx = blockIdx.x; F.vcu = (F.G % 8 == 0) ? (bx % 8) * (F.G / 8) + bx / 8 : bx; }
    unsigned char* ws0 = args.ws;
    F.ctl = (gu32*)(ws0 + WS_CTL);
#define FILL_PTRS(F) do { const __attribute__((address_space(4))) void* kp_ = (const __attribute__((address_space(4))) void*)__builtin_amdgcn_kernarg_segment_ptr(); asm volatile("" : "+s"(kp_)); \
    const float* const __attribute__((address_space(4)))* in_ = (const float* const __attribute__((address_space(4)))*)kp_; \
    unsigned char* ws = (unsigned char*)in_[25]; \
    { int t_ = ktid(F.wave); asm volatile("" : "+v"(t_)); F.tid = t_; F.lane = t_ & 63; } \
    F.x = in_[0]; F.c = in_[1]; F.w_ada = in_[2]; F.b_ada = in_[3]; F.g_mix = in_[4]; F.w_in = in_[5]; F.b_f = in_[6]; \
    F.conv_w = in_[7]; F.conv_b = in_[8]; F.lru_w_a = in_[9]; F.lru_b_a = in_[10]; F.lru_w_x = in_[11]; F.lru_b_x = in_[12]; \
    F.lru_lambda = in_[13]; F.g_attn_out = in_[14]; F.g_lru_out = in_[15]; F.w_out = in_[16]; F.g_ffn = in_[17]; \
    F.peer_w_q = in_[18]; F.peer_k1 = in_[19]; F.peer_k2 = in_[20]; F.peer_u = in_[21]; F.peer_v = in_[22]; F.g_final = in_[23]; \
    F.out = (float*)in_[24]; \
    F.MOD = (float*)(ws + WS_MOD); F.LF = (float*)(ws + WS_LF); F.KB = (float*)(ws + WS_KB); F.SUMM = (float*)(ws + WS_SUMM); \
    F.EW = (float*)(ws + WS_EW); F.EIDX = (int*)(ws + WS_EIDX); \
    F.WLRU = (bf16_t*)(ws + WS_WLRU); F.K1 = (bf16_t*)(ws + WS_K1); F.K2 = (bf16_t*)(ws + WS_K2); F.WIN = (bf16_t*)(ws + WS_WIN); \
    F.WOUT = (bf16_t*)(ws + WS_WOUT); F.WQ = (bf16_t*)(ws + WS_WQ); F.U8 = ws + WS_U; F.V8 = ws + WS_V; F.USC = (float*)(ws + WS_USC); F.VSC = (float*)(ws + WS_VSC); F.PD = (float*)(ws + WS_PD); F.Y = (float*)(ws + WS_Y); F.ACT = (float*)(ws + WS_ACT); \
    F.H = (bf16_t*)(ws + WS_H); F.Q = (bf16_t*)(ws + WS_Q); F.K = (bf16_t*)(ws + WS_K); F.VV = (bf16_t*)(ws + WS_VV); F.QP = (bf16_t*)(ws + WS_QP); \
    F.LX = (bf16_t*)(ws + WS_LX); F.GLY = (bf16_t*)(ws + WS_GLY); F.MRG = (bf16_t*)(ws + WS_MRG); F.HL = (bf16_t*)(ws + WS_HL); F.AC = (bf16_t*)(ws + WS_AC); } while (0)
    XcdBarrier bar; bar.bar = (unsigned*)(F.ctl + CW_BAR); bar.x = 0; bar.st = nullptr;
    if (N_LAUNCHES == 1) bar = xcd_barrier_post((unsigned*)(F.ctl + CW_BAR), F.MISC + 8, F.wave);
#define GRID_BAR() do { if (N_LAUNCHES == 1) xcd_barrier(bar, F.wave); } while (0)
    const int lo = args.ph_lo, hi = args.ph_hi;
#ifndef PHASE_MASK
#define PHASE_MASK 0xffff
#endif
#define IN(k) (((PHASE_MASK >> (k)) & 1) && lo <= (k) && (k) < hi)
#define BOTH(k) (IN(k) && IN((k) + 1))
#ifndef REPEAT_PHASE
#define REPEAT_PHASE -1
#endif
#define REP(k)
#define REPBAR(k)

    if (IN(0)) { FILL_PTRS(F); p0_prologue(F);
#if REPEAT_PHASE == 0
        GRID_BAR(); FILL_PTRS(F); p0_prologue(F);
#endif
        if (BOTH(0)) GRID_BAR(); }
    if (IN(1)) { FILL_PTRS(F); p_modnorm<true>(F, F.x, F.g_mix, 0, DM);
#if REPEAT_PHASE == 1
        GRID_BAR(); FILL_PTRS(F); p_modnorm<true>(F, F.x, F.g_mix, 0, DM);
#endif
        if (BOTH(1)) GRID_BAR(); }
    if (IN(2)) {
        FILL_PTRS(F); p2_cumsum(F); __syncthreads();
        { pg8::Gemm g{F.H, F.WIN, T, 5120, DM}; pg8::StaticOrder S; S.init(T, 5120, F.G, (int)blockIdx.x);
        pg8::EpiProj E{F.Q};
        pg8::gemm_phase<pg8::EpiProj, pg8::StaticOrder, true, true>(F.lds + RING_OFF, g, S, E, F.wave); }
#if REPEAT_PHASE == 2
        GRID_BAR(); FILL_PTRS(F);
        { pg8::Gemm g{F.H, F.WIN, T, 5120, DM}; pg8::StaticOrder S; S.init(T, 5120, F.G, (int)blockIdx.x);
        pg8::EpiProj E{F.Q};
        pg8::gemm_phase<pg8::EpiProj, pg8::StaticOrder, true, true>(F.lds + RING_OFF, g, S, E, F.wave); }
#endif
        if (BOTH(2)) GRID_BAR();
    }
    if (IN(3)) {
        FILL_PTRS(F);
        p3_attention(F, (char*)lds + RING_OFF);
        for (int u = F.vcu; u < BATCH * 64; u += F.G) lru_unit(F, u >> 6, u & 63);
#if REPEAT_PHASE == 3
        GRID_BAR(); FILL_PTRS(F);
        p3_attention(F, (char*)lds + RING_OFF);
        for (int u = F.vcu; u < BATCH * 64; u += F.G) lru_unit(F, u >> 6, u & 63);
#endif
#if REPEAT_PHASE == 30
        GRID_BAR(); FILL_PTRS(F);
        p3_attention(F, (char*)lds + RING_OFF);
#endif
#if REPEAT_PHASE == 31
        GRID_BAR(); FILL_PTRS(F);
        for (int u = F.vcu; u < BATCH * 64; u += F.G) lru_unit(F, u >> 6, u & 63);
#endif
        if (BOTH(3)) GRID_BAR();
    }
    if (IN(4)) {
        FILL_PTRS(F);
        for (int u = F.vcu; u < BATCH * 64; u += F.G) lru_final(F, u >> 6, u & 63);
#if REPEAT_PHASE == 4
        GRID_BAR(); FILL_PTRS(F);
        for (int u = F.vcu; u < BATCH * 64; u += F.G) lru_final(F, u >> 6, u & 63);
#endif
        if (BOTH(4)) GRID_BAR();
    }
    if (IN(5)) {
        FILL_PTRS(F);
        pg8::Gemm g{F.MRG, F.WOUT, T, DM, DM}; pg8::StaticOrder S; S.init(T, DM, F.G, (int)blockIdx.x);
        pg8::EpiRes E{F.x, F.out, DM, F.MOD + 2 * DM, NADA};
        pg8::gemm_phase<pg8::EpiRes, pg8::StaticOrder, true, true>(F.lds + RING_OFF, g, S, E, F.wave);
        if (BOTH(5)) GRID_BAR();
    }
    if (IN(6)) { FILL_PTRS(F); p_modnorm<false>(F, F.out, F.g_ffn, 3 * DM, 4 * DM); if (BOTH(6)) GRID_BAR(); }
    if (IN(7)) {
        FILL_PTRS(F);
        pg8::Gemm g{F.H, F.WQ, T, DM, DM}; pg8::StaticOrder S; S.init(T, DM, F.G, (int)blockIdx.x);
        pg8::EpiPlain E{F.QP, DM};
        pg8::gemm_phase<pg8::EpiPlain, pg8::StaticOrder, true, true>(F.lds + RING_OFF, g, S, E, F.wave);
        if (BOTH(7)) GRID_BAR();
    }
    #ifdef P8_NAIVE
    if (IN(8)) { FILL_PTRS(F); p8_naive(F); }
#else
    if (IN(8)) { FILL_PTRS(F); p8_topk(F);
#if REPEAT_PHASE == 8
        GRID_BAR(); FILL_PTRS(F); p8_topk(F);
#endif
        if (BOTH(8)) GRID_BAR(); }
#endif
    if (IN(9)) { FILL_PTRS(F); p9a_udots(F);
#if REPEAT_PHASE == 9
        GRID_BAR(); FILL_PTRS(F); p9a_udots(F);
#endif
        if (BOTH(9)) GRID_BAR(); }
    if (IN(10)) { FILL_PTRS(F); p9b_act(F);
#if REPEAT_PHASE == 10
        GRID_BAR(); FILL_PTRS(F); p9b_act(F);
#endif
        if (BOTH(10)) GRID_BAR(); }
    if (IN(11)) { FILL_PTRS(F); p9c_vacc(F);
#if REPEAT_PHASE == 11
        GRID_BAR(); FILL_PTRS(F); p9c_vacc(F);
#endif
        if (BOTH(11)) GRID_BAR(); }
    if (IN(12)) { FILL_PTRS(F); p9d_final(F); }
#undef IN
#undef BOTH
#undef GRID_BAR
}

extern "C" void kernel_launch(void* const* d_in, const int* in_sizes, int n_in, void* d_out, int out_size, void* d_ws, size_t ws_size, hipStream_t stream) {
    static int grid = 0;
    if (grid == 0) {
        if (n_in != 24 || in_sizes[0] != T * DM || out_size != T * DM || ws_size < WS_END) {
            fprintf(stderr, "kernel_launch: built for 24 inputs, x/out of %d floats, >= %zu bytes of workspace; got n_in %d, in0 %d, out %d, ws %zu; nothing launched\n", T * DM, (size_t)WS_END, n_in, n_in > 0 ? in_sizes[0] : -1, out_size, ws_size); grid = -1; return; }
        int dev = 0, cus = 0, per_cu = 0;
        if (hipGetDevice(&dev) != hipSuccess || hipDeviceGetAttribute(&cus, hipDeviceAttributeMultiprocessorCount, dev) != hipSuccess) { fprintf(stderr, "kernel_launch: device query failed\n"); grid = -1; return; }
        if (hipFuncSetAttribute((const void*)hymba_fwd, hipFuncAttributeMaxDynamicSharedMemorySize, LDS_BYTES) != hipSuccess) { fprintf(stderr, "kernel_launch: hipFuncSetAttribute failed\n"); grid = -1; return; }
        if (hipOccupancyMaxActiveBlocksPerMultiprocessor(&per_cu, (const void*)hymba_fwd, NWAVES * 64, LDS_BYTES) != hipSuccess || per_cu < 1)
            fprintf(stderr, "kernel_launch: note: occupancy query reports %d workgroups per CU\n", per_cu);
        (void)hipGetLastError();
        grid = cus;
    }
    if (grid < 0) return;
    if (hipMemsetAsync((char*)d_ws + WS_CTL, 0, CTL_ZERO_BYTES, stream) != hipSuccess) { fprintf(stderr, "kernel_launch: hipMemsetAsync failed\n"); return; }
    Args a{};
    for (int i = 0; i < 24; ++i) a.in[i] = (const float*)d_in[i];
    a.out = (float*)d_out; a.ws = (unsigned char*)d_ws;
#ifdef DBG_UPTO
    static_assert(N_LAUNCHES == N_PHASES, "probe builds launch one kernel per phase");
    for (int li = 0; li < DBG_UPTO; ++li) {
#else
    for (int li = 0; li < N_LAUNCHES; ++li) {
#endif
        a.ph_lo = (N_LAUNCHES == 1) ? 0 : li; a.ph_hi = (N_LAUNCHES == 1) ? N_PHASES : li + 1; a.li = li;
        hipLaunchKernelGGL(hymba_fwd, dim3(grid), dim3(NWAVES * 64), LDS_BYTES, stream, a);
        const hipError_t le = hipPeekAtLastError();
        if (le != hipSuccess) { fprintf(stderr, "kernel_launch: launch %d failed: %s\n", li, hipGetErrorName(le)); break; }
    }
#ifdef DBG_UPTO
    hipLaunchKernelGGL(dbg_check, dim3(1), dim3(512), 0, stream, a, (int)DBG_UPTO);
#endif
}
```

```cpp
#include <hip/hip_runtime.h>
#include <hip/hip_bf16.h>
#include <cstdio>
#include <cstdint>

constexpr int BATCH = 4, SEQ = 4096, DM = 2048, T = BATCH * SEQ;
constexpr int AW = 1024, NH = 8, HD = 128, LW = 1024, NLB = 8, LBD = 128;
constexpr int INC = 5128, OFF_F = 3072, OFF_LX = 3080;
constexpr int PH = 8, PNK = 128, PQD = 256, PTOPK = 16, NEXP = 16384, NSEL = PH * PTOPK;
constexpr int NADA = 6 * DM;
constexpr float EPS = 1e-6f;
constexpr int NWAVES = 8, NTHR = 512;

#ifndef MK_N_LAUNCHES
#define MK_N_LAUNCHES 1
#endif
constexpr int N_PHASES = 13;
constexpr int N_LAUNCHES = MK_N_LAUNCHES;

constexpr size_t MiB = 1u << 20;
constexpr size_t WS_CTL = 0, CTL_ZERO_BYTES = 1 * MiB;
constexpr size_t WS_MOD = 1 * MiB;
constexpr size_t WS_LF = WS_MOD + 256 * 1024;
constexpr size_t WS_KB = WS_LF + 512 * 1024;
constexpr size_t WS_SUMM = WS_KB + 512 * 1024;
constexpr size_t WS_WLRU = 5 * MiB;
constexpr size_t WS_K1 = WS_WLRU + 512 * 1024;
constexpr size_t WS_K2 = WS_K1 + 256 * 1024;
constexpr size_t WS_WIN = 6 * MiB;
constexpr size_t WS_WOUT = 26 * MiB;
constexpr size_t WS_WQ = 34 * MiB;
constexpr size_t WS_U = 42 * MiB, WS_V = 106 * MiB;
constexpr size_t WS_USC = WS_SUMM + 2 * MiB, WS_VSC = WS_USC + 64 * 1024;
constexpr size_t WS_H = 170 * MiB;
constexpr size_t WS_Q = 234 * MiB, WS_K = 266 * MiB, WS_VV = 298 * MiB;
constexpr size_t WS_QP = 234 * MiB;
constexpr size_t WS_EIDX = 298 * MiB, WS_EW = 306 * MiB;
constexpr size_t WS_LX = 330 * MiB, WS_GLY = 362 * MiB;
constexpr size_t WS_MRG = 394 * MiB;
constexpr size_t WS_PART = 458 * MiB;
constexpr size_t WS_HL = 170 * MiB, WS_AC = 202 * MiB;
constexpr size_t WS_PD = 330 * MiB;
constexpr size_t WS_Y = 170 * MiB;
constexpr size_t WS_ACT = 314 * MiB;
constexpr size_t WS_END = 464 * MiB;
static_assert(WS_K == WS_Q + 32 * MiB && WS_VV == WS_Q + 64 * MiB && WS_LX == WS_Q + 96 * MiB && WS_GLY == WS_Q + 128 * MiB, "EpiProj: destinations 32 MiB apart");
constexpr int CW_BAR = 4096;

constexpr int RING_OFF = 0, RING_BYTES = 131072;
constexpr int LDSCTL_OFF = RING_BYTES, MISC_OFF = LDSCTL_OFF + 320;
constexpr int LDS_BYTES = 147456;
static_assert(MISC_OFF + 128 <= LDS_BYTES, "LDS map");

#define GAS __attribute__((address_space(1)))
#define LAS __attribute__((address_space(3)))
typedef unsigned short bf16_t;
typedef unsigned v4u __attribute__((ext_vector_type(4)));
typedef unsigned v2u __attribute__((ext_vector_type(2)));
typedef float f32x4 __attribute__((ext_vector_type(4)));
typedef float f32x2 __attribute__((ext_vector_type(2)));
typedef short bf16x8 __attribute__((ext_vector_type(8)));
typedef __bf16 bf16x2_t __attribute__((ext_vector_type(2)));
typedef GAS unsigned gu32;
#define RLX_AGENT __ATOMIC_RELAXED, __HIP_MEMORY_SCOPE_AGENT
#define LDS_WAIT() asm volatile("s_waitcnt lgkmcnt(0)" ::: "memory")
#define VM_WAIT() asm volatile("s_waitcnt vmcnt(0)" ::: "memory")

extern __shared__ __attribute__((aligned(16))) unsigned char g_lds[];
__device__ __forceinline__ int ktid(int kw) { int l; asm volatile("v_mbcnt_lo_u32_b32 %0, -1, 0\n\tv_mbcnt_hi_u32_b32 %0, -1, %0" : "=v"(l)); return kw * 64 + l; }
__device__ __forceinline__ unsigned fbits(float x) { return __builtin_bit_cast(unsigned, x); }
__device__ __forceinline__ float bitsf(unsigned x) { return __builtin_bit_cast(float, x); }
__device__ __forceinline__ bf16x2_t asbf2(unsigned x) { return __builtin_bit_cast(bf16x2_t, x); }
__device__ __forceinline__ unsigned f2bf(float f) { unsigned u = __builtin_bit_cast(unsigned, f); return (u + 0x7fffu + ((u >> 16) & 1u)) >> 16; }
__device__ __forceinline__ unsigned pk2(float lo, float hi) { f32x2 v = {lo, hi}; bf16x2_t b = __builtin_convertvector(v, bf16x2_t); return __builtin_bit_cast(unsigned, b); }
__device__ __forceinline__ float bf_lo(unsigned d) { return __builtin_bit_cast(float, d << 16); }
__device__ __forceinline__ float bf_hi(unsigned d) { return __builtin_bit_cast(float, d & 0xffff0000u); }
__device__ __forceinline__ float fexp(float x) { return __builtin_amdgcn_exp2f(x * 1.4426950408889634f); }
__device__ __forceinline__ float sigmoidf_(float z) { return __builtin_amdgcn_rcpf(1.f + fexp(-z)); }
__device__ __forceinline__ float gelu_tanh(float x) { const float z = x * (1.5957691216057308f + 0.07135481627260025f * x * x); return x * __builtin_amdgcn_rcpf(1.f + fexp(-z)); }
__device__ __forceinline__ float softplusf_(float z) { return fmaxf(z, 0.f) + log1pf(fexp(-fabsf(z))); }
__device__ __forceinline__ float wave_sum(float v) {
#pragma unroll
    for (int o = 1; o < 64; o <<= 1) v += __shfl_xor(v, o);
    return v;
}
#define XB_TMO      128
#define XB_XCNT(j)  (256  + 64 * (j))
#define XB_XSUB(j)  (1280 + 64 * (j))
#define XB_XGEN(j)  (2304 + 64 * (j))
#define XB_TOP      3328
#define XB_TOPGEN   3392
#define XCD_BAR_WORDS 3456
#define XB_SPIN_CAP (1u << 18)

__device__ __forceinline__ unsigned xb_ld(unsigned* p)              { return __hip_atomic_load(p, __ATOMIC_RELAXED, __HIP_MEMORY_SCOPE_AGENT); }
__device__ __forceinline__ unsigned xb_add(unsigned* p, unsigned v) { return __hip_atomic_fetch_add(p, v, __ATOMIC_RELAXED, __HIP_MEMORY_SCOPE_AGENT); }
__device__ __forceinline__ unsigned xb_xcc_id() { return (unsigned)__builtin_amdgcn_s_getreg((3 << 11) | 20) & 0xFu; }
#define XB_SPIN(cond, bar) do { unsigned _sp = 0; while (cond) { __builtin_amdgcn_s_sleep(1); \
    if ((++_sp & 255u) == 0u) { if (xb_ld(&(bar)[XB_TMO])) break; if (_sp > XB_SPIN_CAP) { atomicAdd(&(bar)[XB_TMO], 1u); break; } } } } while (0)

struct XcdBarrier {
    unsigned* bar; unsigned x;
    volatile LAS unsigned* st;
};

__device__ __forceinline__ XcdBarrier xcd_barrier_post(unsigned* bar, volatile LAS unsigned* st, int kw) {
    XcdBarrier b; b.bar = bar; b.x = xb_xcc_id(); b.st = st;
    if (ktid(kw) == 0) (void)xb_add(&bar[XB_XCNT(b.x)], 1u);
    return b;
}
__device__ __forceinline__ void xcd_barrier_complete(unsigned* bar, unsigned x, unsigned& nloc, unsigned& nx) {
    const unsigned G = gridDim.x * gridDim.y * gridDim.z;
    unsigned sum, cnt, mine, sp = 0u;
    for (;;) {
        sum = 0u; cnt = 0u; mine = 0u;
#pragma unroll
        for (unsigned j = 0; j < 16; ++j) { const unsigned c = xb_ld(&bar[XB_XCNT(j)]); sum += c; cnt += (c > 0u) ? 1u : 0u; mine = (j == x) ? c : mine; }
        if (sum == G) break;
        __builtin_amdgcn_s_sleep(1);
        if ((++sp & 255u) == 0u) { if (xb_ld(&bar[XB_TMO])) break; if (sp > XB_SPIN_CAP) { atomicAdd(&bar[XB_TMO], 1u); break; } }
    }
    nloc = mine > 0u ? mine : 1u; nx = cnt > 0u ? cnt : 1u;
}

__device__ __forceinline__ void xcd_barrier(const XcdBarrier& b, int kw) {
    asm volatile("s_waitcnt vmcnt(0)" ::: "memory");
    __syncthreads();
    if (ktid(kw) == 0) {
        unsigned* bar = b.bar;
        __builtin_amdgcn_s_waitcnt(0);
        unsigned nloc = b.st[0], nx = b.st[1];
        if (nloc == 0u) { xcd_barrier_complete(bar, b.x, nloc, nx); b.st[0] = nloc; b.st[1] = nx; }
        const unsigned old = xb_add(&bar[XB_XSUB(b.x)], 1u);
        const unsigned gen = old / nloc;
        if (old + 1u == (gen + 1u) * nloc) {
            __builtin_amdgcn_fence(__ATOMIC_RELEASE, "agent");
            asm volatile("s_waitcnt vmcnt(0)" ::: "memory");
            const unsigned og = xb_add(&bar[XB_TOP], 1u);
            const unsigned tg = og / nx;
            if (og + 1u == (tg + 1u) * nx) xb_add(&bar[XB_TOPGEN], 1u);
            else XB_SPIN(xb_ld(&bar[XB_TOPGEN]) == tg, bar);
            __builtin_amdgcn_fence(__ATOMIC_ACQUIRE, "agent");
            xb_add(&bar[XB_XGEN(b.x)], 1u);
            asm volatile("s_waitcnt vmcnt(0)" ::: "memory");
        } else {
            XB_SPIN(xb_ld(&bar[XB_XGEN(b.x)]) == gen, bar);
            __builtin_amdgcn_fence(__ATOMIC_ACQUIRE, "agent");
            asm volatile("s_waitcnt vmcnt(0)" ::: "memory");
        }
    }
    __syncthreads();
}

namespace pg8 {
#define PG8_LAS __attribute__((address_space(3)))
typedef unsigned short bf16_t;
typedef short bf16x8 __attribute__((ext_vector_type(8)));
typedef float f32x4 __attribute__((ext_vector_type(4)));
typedef unsigned u32x4 __attribute__((ext_vector_type(4)));
constexpr int BM = 256, BK = 64, HALF = 128, HTB = HALF * BK * 2  , STAGE_BYTES = 8 * HTB, NXCD = 8, WGM = 8;

__host__ __device__ __forceinline__ int lds_byte(int r, int c) { const int st = (r >> 4) * 2 + (c >> 5), rr = r & 15, cc = c & 31, ob = rr * 64 + cc * 2; return st * 1024 + (ob ^ (((ob >> 9) & 1) << 5)); }
__host__ __device__ __forceinline__ void stage_rc(int b, int& R, int& C) { const int st = b / 1024, sb = b % 1024, swz = sb ^ (((sb >> 9) & 1) << 5); R = (st >> 1) * 16 + swz / 64; C = (st & 1) * 32 + (swz % 64) / 2; }
__host__ __device__ __forceinline__ int perm32(int rho) { const int n = rho >> 4, i = rho & 15; return 8 * (i >> 2) + 4 * n + (i & 3); }

struct Unit { int pm, pn; };
struct Gemm { const bf16_t* A; const bf16_t* Bt; int M, N, K; };

struct StaticOrder {
    int nM, nN, nwg, G, c;
    __host__ __device__ void init(int M, int N, int G_, int c_) { nM = M / BM; nN = N / BM; nwg = nM * nN; G = G_; c = c_; }
    __host__ __device__ bool next(int i, Unit& u) const {
        const long L = (long)i * G + c; if (L >= nwg) return false;
        int wgid = (int)L; { const int q = nwg / NXCD, r = nwg % NXCD, xcd = wgid % NXCD, off = wgid / NXCD; wgid = (xcd < r ? xcd * (q + 1) : r * (q + 1) + (xcd - r) * q) + off; }
        const int nig = WGM * nN, gid = wgid / nig, fm = gid * WGM, gsz = (nM - fm) < WGM ? (nM - fm) : WGM;
        u.pm = fm + ((wgid % nig) % gsz); u.pn = (wgid % nig) / gsz; return true;
    }
    __device__ __forceinline__ void a_ready(const Unit&) const {}
    __device__ __forceinline__ void done(const Unit&) const {}
};


__device__ __forceinline__ unsigned cvt_pk_bf16(float lo, float hi) { unsigned r; asm volatile("v_cvt_pk_bf16_f32 %0, %1, %2" : "=v"(r) : "v"(lo), "v"(hi)); return r; }

struct EpiPlain {
    static constexpr bool PERM = true, AFTER_DRAIN = false;
    bf16_t* O; int ldc;
    __device__ __forceinline__ void operator()(const f32x4 (&acc)[2][2][4][2], const Unit& u, int wr, int wc, int fr, int fq) const {
        const int row0 = u.pm * BM + wr * 64 + fr, col0 = u.pn * BM + wc * 32 + 8 * fq;
#pragma unroll
        for (int ai = 0; ai < 2; ++ai)
#pragma unroll
            for (int m = 0; m < 4; ++m) { bf16_t* rowp = O + (size_t)(row0 + ai * HALF + m * 16) * ldc + col0;
#pragma unroll
                for (int bj = 0; bj < 2; ++bj) { const f32x4 v0 = acc[ai][bj][m][0], v1 = acc[ai][bj][m][1];
                    u32x4 w; w.x = cvt_pk_bf16(v0[0], v0[1]); w.y = cvt_pk_bf16(v0[2], v0[3]); w.z = cvt_pk_bf16(v1[0], v1[1]); w.w = cvt_pk_bf16(v1[2], v1[3]);
                    *(u32x4*)(rowp + bj * HALF) = w; } }
    }
};
struct EpiProj {
    static constexpr bool PERM = true, AFTER_DRAIN = false;
    bf16_t* Q;
    __device__ __forceinline__ void operator()(const f32x4 (&acc)[2][2][4][2], const Unit& u, int wr, int wc, int fr, int fq) const {
        const int row0 = u.pm * BM + wr * 64 + fr; const int cat = u.pn >> 2, pnl = u.pn & 3;
        bf16_t* basep = Q + (size_t)cat * ((size_t)16 << 20);
        const bool headmajor = cat < 3, dogelu = cat == 4;
#pragma unroll
        for (int ai = 0; ai < 2; ++ai)
#pragma unroll
            for (int m = 0; m < 4; ++m) { const int row = row0 + ai * HALF + m * 16; const int b = row >> 12, s = row & 4095;
#pragma unroll
                for (int bj = 0; bj < 2; ++bj) { f32x4 v0 = acc[ai][bj][m][0], v1 = acc[ai][bj][m][1];
                    const int colt = pnl * BM + bj * HALF + wc * 32 + 8 * fq;
                    const int head = colt >> 7, d = colt & 127;
                    const size_t offA = ((size_t)((b * 8 + head) * 4096 + s)) * 128 + d, offB = (size_t)row * 1024 + colt;
                    bf16_t* dst = basep + (headmajor ? offA : offB);
                    if (dogelu) {
#pragma unroll
                        for (int e = 0; e < 4; ++e) { v0[e] = gelu_tanh(v0[e]); v1[e] = gelu_tanh(v1[e]); } }
                    u32x4 w; w.x = cvt_pk_bf16(v0[0], v0[1]); w.y = cvt_pk_bf16(v0[2], v0[3]); w.z = cvt_pk_bf16(v1[0], v1[1]); w.w = cvt_pk_bf16(v1[2], v1[3]);
                    *(u32x4*)dst = w; } }
    }
};
struct EpiRes {
    static constexpr bool PERM = false, AFTER_DRAIN = false;
    const float* base; float* out; int ldc; const float* gate; int gstride;
    __device__ __forceinline__ void operator()(const f32x4 (&acc)[2][2][4][2], const Unit& u, int wr, int wc, int fr, int fq) const {
        const int row0 = u.pm * BM + wr * 64 + fr, col0 = u.pn * BM + wc * 32 + 4 * fq;
        const int b = (u.pm * BM) >> 12;
        f32x4 gv[2][2];
#pragma unroll
        for (int bj = 0; bj < 2; ++bj)
#pragma unroll
            for (int n = 0; n < 2; ++n) gv[bj][n] = *(const f32x4*)(gate + (size_t)b * gstride + col0 + bj * HALF + n * 16);
#pragma unroll
        for (int ai = 0; ai < 2; ++ai)
#pragma unroll
            for (int m = 0; m < 4; ++m) { const size_t off = (size_t)(row0 + ai * HALF + m * 16) * ldc + col0;
#pragma unroll
                for (int bj = 0; bj < 2; ++bj)
#pragma unroll
                    for (int n = 0; n < 2; ++n) { const f32x4 bs = *(const f32x4*)(base + off + bj * HALF + n * 16);
                        *(f32x4*)(out + off + bj * HALF + n * 16) = bs + gv[bj][n] * acc[ai][bj][m][n]; } }
    }
};

template <class Epi, class Sched, bool ALIGN_EPI = false, bool SP2 = false>
__device__ __forceinline__ void gemm_phase(PG8_LAS unsigned char* lds, const Gemm g, const Sched& S, const Epi& E, const int kw) {
    const int tid = ktid(kw), wid = kw, lane = tid & 63, wr = wid >> 2, wc = wid & 3, fr = lane & 15, fq = lane >> 4;
    const int K = g.K, nt = K / BK;
    unsigned voffA[2], voffB[2];
#pragma unroll
    for (int i = 0; i < 2; ++i) { int R, C; stage_rc(tid * 16 + i * 8192, R, C); const int Rb = Epi::PERM ? ((R & ~31) + perm32(R & 31)) : R;
        voffA[i] = (unsigned)(R * K + C) * 2u; voffB[i] = (unsigned)(Rb * K + C) * 2u; }
    const size_t kstep = (size_t)(BK * 2);
    const size_t hstep = (size_t)HALF * K * 2;
    const size_t tstep = 2 * hstep;
    const unsigned ldsw = (unsigned)wid * 1024u;
    const int aoff = lds_byte(wr * 64 + fr, fq * 8), boff = lds_byte(wc * 32 + fr, fq * 8);
#define PG8_SA(b, h) (((b) * 2 + (h)) * HTB)
#define PG8_SB(b, h) ((4 + (b) * 2 + (h)) * HTB)
#define PG8_STAGE(bufoff, gbase, voff) do { _Pragma("unroll") for (int _i = 0; _i < 2; ++_i) \
        __builtin_amdgcn_global_load_lds((const unsigned*)((const char*)(gbase) + (voff)[_i]), (PG8_LAS unsigned*)(lds + (bufoff) + ldsw + _i * 8192), 16, 0, 0); } while (0)
#define PG8_LDA(dst, b, h) do { _Pragma("unroll") for (int m = 0; m < 4; ++m) _Pragma("unroll") for (int k = 0; k < 2; ++k) dst[m][k] = *(const PG8_LAS bf16x8*)(lds + PG8_SA(b, h) + aoff + m * 2048 + k * 1024); } while (0)
#define PG8_LDB(dst, b, h) do { _Pragma("unroll") for (int n = 0; n < 2; ++n) _Pragma("unroll") for (int k = 0; k < 2; ++k) dst[n][k] = *(const PG8_LAS bf16x8*)(lds + PG8_SB(b, h) + boff + n * 2048 + k * 1024); } while (0)
#define PG8_MMA(ai, bj, At, Bt) do { __builtin_amdgcn_s_setprio(1); _Pragma("unroll") for (int m = 0; m < 4; ++m) _Pragma("unroll") for (int n = 0; n < 2; ++n) _Pragma("unroll") for (int k = 0; k < 2; ++k) \
        acc[ai][bj][m][n] = __builtin_amdgcn_mfma_f32_16x16x32_bf16(Bt[n][k], At[m][k], acc[ai][bj][m][n], 0, 0, 0); __builtin_amdgcn_s_setprio(0); } while (0)
#define PG8_WAIT_V(n) asm volatile("s_waitcnt vmcnt(" #n ")" ::: "memory")
#define PG8_WAIT_L(n) asm volatile("s_waitcnt lgkmcnt(" #n ")" ::: "memory")
#define PG8_BAR __builtin_amdgcn_s_barrier()
#define PG8_SCHED __builtin_amdgcn_sched_barrier(0)
    Unit cur, nxt; int ui = 0;
    if (!S.next(0, cur)) return;
    f32x4 acc[2][2][4][2];
#pragma unroll
    for (int a = 0; a < 2; ++a)
#pragma unroll
        for (int b = 0; b < 2; ++b)
#pragma unroll
            for (int m = 0; m < 4; ++m)
#pragma unroll
                for (int n = 0; n < 2; ++n) acc[a][b][m][n] = (f32x4){0.f, 0.f, 0.f, 0.f};
    bf16x8 At[4][2], B0[2][2], B1[2][2];
    const char* cA = (const char*)g.A + (size_t)cur.pm * tstep; const char* cB = (const char*)g.Bt + (size_t)cur.pn * tstep;
    S.a_ready(cur);
    if constexpr (SP2) {
        PG8_STAGE(PG8_SB(0, 0), cB, voffB); PG8_STAGE(PG8_SB(0, 1), cB + hstep, voffB); PG8_STAGE(PG8_SA(0, 0), cA, voffA); PG8_STAGE(PG8_SA(0, 1), cA + hstep, voffA);
        if (wr == 1) PG8_BAR;
        PG8_WAIT_V(2); PG8_BAR;
        PG8_STAGE(PG8_SB(1, 0), cB + kstep, voffB); PG8_STAGE(PG8_SA(1, 0), cA + kstep, voffA); PG8_STAGE(PG8_SB(1, 1), cB + hstep + kstep, voffB);
        PG8_WAIT_V(6); PG8_BAR;
    } else {
        PG8_STAGE(PG8_SB(0, 0), cB, voffB); PG8_STAGE(PG8_SA(0, 0), cA, voffA); PG8_STAGE(PG8_SB(0, 1), cB + hstep, voffB); PG8_STAGE(PG8_SA(0, 1), cA + hstep, voffA);
        if (wr == 1) PG8_BAR;
        PG8_WAIT_V(4); PG8_BAR;
        PG8_STAGE(PG8_SB(1, 0), cB + kstep, voffB); PG8_STAGE(PG8_SA(1, 0), cA + kstep, voffA); PG8_STAGE(PG8_SB(1, 1), cB + hstep + kstep, voffB);
        PG8_WAIT_V(6); PG8_BAR;
    }
    for (;;) {
        const bool has_next = S.next(ui + 1, nxt);
        const char* nA = has_next ? (const char*)g.A + (size_t)nxt.pm * tstep : cA; const char* nB = has_next ? (const char*)g.Bt + (size_t)nxt.pn * tstep : cB;
        for (int t = 0; t < nt; t += 2) {
            const bool last = (t == nt - 2);
            const char* a1 = cA + (size_t)(t + 1) * kstep;
            const char* a2 = last ? nA : cA + (size_t)(t + 2) * kstep; const char* b2 = last ? nB : cB + (size_t)(t + 2) * kstep;
            const char* a3 = a2 + kstep; const char* b3 = b2 + kstep;
            if (last && has_next) S.a_ready(nxt);
            if constexpr (SP2) {
            PG8_LDB(B0, 0, 0); PG8_LDB(B1, 0, 1); PG8_SCHED; PG8_LDA(At, 0, 0); PG8_STAGE(PG8_SA(1, 1), a1 + hstep, voffA);
            PG8_WAIT_V(8); PG8_WAIT_L(0); PG8_BAR; PG8_MMA(0, 0, At, B0); PG8_MMA(0, 1, At, B1); PG8_BAR; PG8_SCHED;
            PG8_LDA(At, 0, 1); PG8_STAGE(PG8_SB(0, 0), b2, voffB); PG8_STAGE(PG8_SB(0, 1), b2 + hstep, voffB); PG8_STAGE(PG8_SA(0, 0), a2, voffA);
            PG8_WAIT_V(8); PG8_WAIT_L(0); PG8_BAR; PG8_MMA(1, 0, At, B0); PG8_MMA(1, 1, At, B1); PG8_BAR; PG8_SCHED;
            PG8_LDB(B0, 1, 0); PG8_LDB(B1, 1, 1); PG8_SCHED; PG8_LDA(At, 1, 0); PG8_STAGE(PG8_SA(0, 1), a2 + hstep, voffA);
            PG8_WAIT_V(8); PG8_WAIT_L(0); PG8_BAR; PG8_MMA(0, 0, At, B0); PG8_MMA(0, 1, At, B1); PG8_BAR; PG8_SCHED;
            PG8_LDA(At, 1, 1); PG8_STAGE(PG8_SB(1, 0), b3, voffB); PG8_STAGE(PG8_SB(1, 1), b3 + hstep, voffB); PG8_STAGE(PG8_SA(1, 0), a3, voffA);
            PG8_WAIT_V(8); PG8_WAIT_L(0); PG8_BAR; PG8_MMA(1, 0, At, B0); PG8_MMA(1, 1, At, B1); PG8_BAR; PG8_SCHED;
            } else {
            PG8_LDB(B0, 0, 0); PG8_SCHED; PG8_LDA(At, 0, 0); PG8_STAGE(PG8_SA(1, 1), a1 + hstep, voffA);
            PG8_WAIT_L(8); PG8_BAR; PG8_WAIT_L(0); PG8_MMA(0, 0, At, B0); PG8_BAR; PG8_SCHED;
            PG8_LDB(B1, 0, 1); PG8_STAGE(PG8_SB(0, 0), b2, voffB);
            PG8_BAR; PG8_WAIT_L(0); PG8_MMA(0, 1, At, B1); PG8_BAR;
            PG8_LDA(At, 0, 1); PG8_STAGE(PG8_SA(0, 0), a2, voffA);
            PG8_BAR; PG8_WAIT_L(0); PG8_MMA(1, 0, At, B0); PG8_BAR; PG8_SCHED;
            PG8_STAGE(PG8_SB(0, 1), b2 + hstep, voffB);
            PG8_WAIT_V(6); PG8_BAR; PG8_MMA(1, 1, At, B1); PG8_BAR;
            PG8_LDB(B0, 1, 0); PG8_SCHED; PG8_LDA(At, 1, 0); PG8_STAGE(PG8_SA(0, 1), a2 + hstep, voffA);
            PG8_WAIT_L(8); PG8_BAR; PG8_WAIT_L(0); PG8_MMA(0, 0, At, B0); PG8_BAR; PG8_SCHED;
            PG8_LDB(B1, 1, 1); PG8_STAGE(PG8_SB(1, 0), b3, voffB);
            PG8_BAR; PG8_WAIT_L(0); PG8_MMA(0, 1, At, B1); PG8_BAR;
            PG8_LDA(At, 1, 1); PG8_STAGE(PG8_SA(1, 0), a3, voffA);
            PG8_BAR; PG8_WAIT_L(0); PG8_MMA(1, 0, At, B0); PG8_BAR; PG8_SCHED;
            PG8_STAGE(PG8_SB(1, 1), b3 + hstep, voffB);
            PG8_WAIT_V(6); PG8_BAR; PG8_MMA(1, 1, At, B1); PG8_BAR;
            }
        }
        if constexpr (ALIGN_EPI) { if (wr == 0) PG8_BAR; }
        if constexpr (!Epi::AFTER_DRAIN) { E(acc, cur, wr, wc, fr, fq); S.done(cur); }
        if (!has_next) break;
#pragma unroll
        for (int a = 0; a < 2; ++a)
#pragma unroll
            for (int b = 0; b < 2; ++b)
#pragma unroll
                for (int m = 0; m < 4; ++m)
#pragma unroll
                    for (int n = 0; n < 2; ++n) acc[a][b][m][n] = (f32x4){0.f, 0.f, 0.f, 0.f};
        cur = nxt; cA = nA; cB = nB; ++ui;
        if constexpr (ALIGN_EPI) { if (wr == 1) PG8_BAR; }
    }
    PG8_WAIT_V(0);
    if constexpr (!ALIGN_EPI) { if (wr == 0) PG8_BAR; }
    PG8_BAR;
    if constexpr (Epi::AFTER_DRAIN) { E.fused(acc, cur, wr, wc, fr, fq, lds, wid, lane); S.done(cur); }
#undef PG8_SA
#undef PG8_SB
#undef PG8_STAGE
#undef PG8_LDA
#undef PG8_LDB
#undef PG8_MMA
#undef PG8_WAIT_V
#undef PG8_WAIT_L
#undef PG8_BAR
#undef PG8_SCHED
}
}

namespace att {
typedef unsigned short bf16;
typedef short bf16x8 __attribute__((ext_vector_type(8)));
typedef short s16x4 __attribute__((ext_vector_type(4)));
typedef float f32x16 __attribute__((ext_vector_type(16)));
typedef float f32x4 __attribute__((ext_vector_type(4)));
typedef unsigned u32x4 __attribute__((ext_vector_type(4)));
template <class A, class Bt> struct same_t { static constexpr bool v = false; };
template <class A> struct same_t<A, A> { static constexpr bool v = true; };
constexpr int D = 128;
constexpr float THR = 8.f;
constexpr bool WSKIP = false;
constexpr float SCALE = 0.08838834764831845f;
constexpr int NW = 8, QBLK = 32, KVBLK = 64, QB = NW * QBLK;
constexpr int SHM_V = KVBLK * D * 2, SHM_K = KVBLK * D * 2;
constexpr int LDS_BIAS = 2 * SHM_V + 2 * SHM_K + NW * 64 * 4;
constexpr int LDS_BYTES = LDS_BIAS + 4096 * 4;
constexpr int OP = 2048;
#define KSWZ(row, colB) ((row) * 256 + ((colB) ^ (((row) & 7) << 4)))
#define SBAR() __builtin_amdgcn_sched_barrier(0)
__device__ __forceinline__ int v_st(int k, int c) { const int kk = (k & ~0xC) | ((k & 4) << 1) | ((k & 8) >> 1); return ((kk >> 3) * 4 + (c >> 5)) * 512 + ((kk & 7) * 32 + (c & 31)) * 2; }
__device__ __forceinline__ int v_rd_base(int lane) { return ((lane & 3) << 3) | (((lane >> 2) & 3) << 6) | (((lane >> 4) & 1) << 5) | (((lane >> 5) & 1) << 8); }
constexpr int v_rd_off(int d0, int ks, int half) { return d0 * 512 + ks * 4096 + half * 2048; }
__device__ __forceinline__ int crow(int r, int hi) { return (r & 3) + 8 * (r >> 2) + 4 * hi; }
__device__ __forceinline__ unsigned cvtpk(float lo, float hi) {
    unsigned r; asm volatile("v_cvt_pk_bf16_f32 %0, %1, %2" : "=v"(r) : "v"(lo), "v"(hi)); return r;
}
__device__ __forceinline__ bf16x8 pack8(f32x4 a, f32x4 b) {
    u32x4 w = {cvtpk(a[0], a[1]), cvtpk(a[2], a[3]), cvtpk(b[0], b[1]), cvtpk(b[2], b[3])};
    return *reinterpret_cast<bf16x8*>(&w);
}
template <class T> __device__ __forceinline__ bf16x8 load8(const T* p) {
    if constexpr (same_t<T, float>::v) { return pack8(*(const f32x4*)p, *(const f32x4*)(p + 4)); }
    else { return *reinterpret_cast<const bf16x8*>(p); }
}
__device__ __forceinline__ void mask_tile(f32x16& p0, f32x16& p1, int dq, unsigned W) {
    const float NEG = -__builtin_inff();
#pragma unroll
    for (int r = 0; r < 16; ++r) {
        const int c = (r & 3) + 8 * (r >> 2);
        if ((unsigned)(dq - c) >= W) p0[r] = NEG;
        if ((unsigned)(dq - c - 32) >= W) p1[r] = NEG;
    }
}
__device__ __forceinline__ void partialSM(f32x16& p0, f32x16& p1, float& m_reg, float& mn, float& alpha) {
    float pmax = p0[0]; for (int r = 1; r < 16; ++r) pmax = fmaxf(pmax, p0[r]); for (int r = 0; r < 16; ++r) pmax = fmaxf(pmax, p1[r]);
    { auto rr = __builtin_amdgcn_permlane32_swap(__float_as_uint(pmax), __float_as_uint(pmax), false, false);
      pmax = fmaxf(__uint_as_float(rr[0]), __uint_as_float(rr[1])); }
    constexpr float C2 = 1.4426950408889634f * SCALE;
    if (__builtin_expect(__all((pmax - m_reg) * SCALE <= THR), 1)) { mn = m_reg; alpha = 1.f; }
    else { mn = fmaxf(m_reg, pmax); alpha = __builtin_amdgcn_exp2f((m_reg - mn) * C2); m_reg = mn; }
    const float mnL = -mn * C2;
    for (int r = 0; r < 16; ++r) p0[r] = fmaf(p0[r], C2, mnL); for (int r = 0; r < 16; ++r) p1[r] = fmaf(p1[r], C2, mnL);
    for (int r = 0; r < 16; ++r) p0[r] = __builtin_amdgcn_exp2f(p0[r]);
}
__device__ __forceinline__ void finishSM(f32x16& p0, f32x16& p1, float alpha, float& l_reg, bf16x8& pa0, bf16x8& pa1, bf16x8& pa2, bf16x8& pa3) {
    for (int r = 0; r < 16; ++r) p1[r] = __builtin_amdgcn_exp2f(p1[r]);
    float ps = 0; for (int r = 0; r < 16; ++r) ps += p0[r]; for (int r = 0; r < 16; ++r) ps += p1[r];
    { auto rr = __builtin_amdgcn_permlane32_swap(__float_as_uint(ps), __float_as_uint(ps), false, false);
      ps = __uint_as_float(rr[0]) + __uint_as_float(rr[1]); }
    l_reg = l_reg * alpha + ps;
#define PK4(P, B_, OUT) do { unsigned a0 = cvtpk(P[B_+0], P[B_+1]), a1 = cvtpk(P[B_+2], P[B_+3]);                          \
        unsigned b0 = cvtpk(P[B_+4], P[B_+5]), b1 = cvtpk(P[B_+6], P[B_+7]);                                             \
        auto r0 = __builtin_amdgcn_permlane32_swap(a0, b0, false, false); auto r1 = __builtin_amdgcn_permlane32_swap(a1, b1, false, false); \
        u32x4 w = {r0[0], r1[0], r0[1], r1[1]}; OUT = *reinterpret_cast<bf16x8*>(&w); } while (0)
    PK4(p0, 0, pa0); PK4(p0, 8, pa1); PK4(p1, 0, pa2); PK4(p1, 8, pa3);
#undef PK4
}
template <int KB, bool SK>
__device__ __forceinline__ void qkt(f32x16& p0, f32x16& p1, const char* K_lds, int r32, int hi, const bf16x8* qr, bool act, const float* bl) {
    if (SK && !act) { const float NEG = -__builtin_inff();
#pragma unroll
        for (int r = 0; r < 16; ++r) { p0[r] = NEG; p1[r] = NEG; } return; }
    { const f32x4 c0 = *(const f32x4*)(bl), c1 = *(const f32x4*)(bl + 8), c2 = *(const f32x4*)(bl + 16), c3 = *(const f32x4*)(bl + 24);
      const f32x4 e0 = *(const f32x4*)(bl + 32), e1 = *(const f32x4*)(bl + 40), e2 = *(const f32x4*)(bl + 48), e3 = *(const f32x4*)(bl + 56);
      p0 = (f32x16){c0[0], c0[1], c0[2], c0[3], c1[0], c1[1], c1[2], c1[3], c2[0], c2[1], c2[2], c2[3], c3[0], c3[1], c3[2], c3[3]};
      p1 = (f32x16){e0[0], e0[1], e0[2], e0[3], e1[0], e1[1], e1[2], e1[3], e2[0], e2[1], e2[2], e2[3], e3[0], e3[1], e3[2], e3[3]}; }
    const char* kb[4];
#pragma unroll
    for (int dd = 0; dd < 4; ++dd) kb[dd] = K_lds + KB * SHM_K + KSWZ(r32, (dd * 16 + hi * 8) * 2);
#pragma unroll
    for (int d0 = 0; d0 < 8; ++d0) { const char* a = kb[d0 & 3] + (d0 >> 2) * 128;
        bf16x8 b0 = *reinterpret_cast<const bf16x8*>(a);
        bf16x8 b1 = *reinterpret_cast<const bf16x8*>(a + 32 * 256);
        p0 = __builtin_amdgcn_mfma_f32_32x32x16_bf16(b0, qr[d0], p0, 0, 0, 0);
        p1 = __builtin_amdgcn_mfma_f32_32x32x16_bf16(b1, qr[d0], p1, 0, 0, 0); }
}
template <int VB, bool SK>
__device__ __forceinline__ void pv_tile(f32x16* o, int vb0, bf16x8 pa0, bf16x8 pa1, bf16x8 pa2, bf16x8 pa3, bool act) {
    if (SK && !act) return;
#define TRRD(dst, off) asm volatile("ds_read_b64_tr_b16 %0, %1 offset:%2" : "=&v"(dst) : "v"(vb0), "i"(off) : "memory")
#define PV_D0(d0) do { s16x4 l0, l1, l2, l3, h0, h1, h2, h3; constexpr int b_ = VB * SHM_V + v_rd_off(d0, 0, 0);     \
        TRRD(l0, b_); TRRD(h0, b_ + 2048); TRRD(l1, b_ + 4096); TRRD(h1, b_ + 6144); TRRD(l2, b_ + 8192); TRRD(h2, b_ + 10240); TRRD(l3, b_ + 12288); TRRD(h3, b_ + 14336); \
        asm volatile("s_waitcnt lgkmcnt(0)" ::: "memory"); SBAR();                 \
        o[d0] = __builtin_amdgcn_mfma_f32_32x32x16_bf16(pa0, (bf16x8){l0[0], l0[1], l0[2], l0[3], h0[0], h0[1], h0[2], h0[3]}, o[d0], 0, 0, 0);   \
        o[d0] = __builtin_amdgcn_mfma_f32_32x32x16_bf16(pa1, (bf16x8){l1[0], l1[1], l1[2], l1[3], h1[0], h1[1], h1[2], h1[3]}, o[d0], 0, 0, 0);   \
        o[d0] = __builtin_amdgcn_mfma_f32_32x32x16_bf16(pa2, (bf16x8){l2[0], l2[1], l2[2], l2[3], h2[0], h2[1], h2[2], h2[3]}, o[d0], 0, 0, 0);   \
        o[d0] = __builtin_amdgcn_mfma_f32_32x32x16_bf16(pa3, (bf16x8){l3[0], l3[1], l3[2], l3[3], h3[0], h3[1], h3[2], h3[3]}, o[d0], 0, 0, 0); } while (0)
    PV_D0(0); PV_D0(1); PV_D0(2); PV_D0(3);
#undef PV_D0
#undef TRRD
}


struct BlockRef { const bf16* Q; const bf16* K; const bf16* V; bf16* O; const float* KB; int P0; };
struct Seam { bf16x8 qr[8]; bf16x8 st_v0, st_v1, st_k0, st_k1; };
#define ROW(p, k0, rr) ((p) + (size_t)((k0) + (rr)) * D + sc)
#define VMW() asm volatile("s_waitcnt vmcnt(0)" ::: "memory")
#define VMWN(n) asm volatile("s_waitcnt vmcnt(%0)" :: "i"(n) : "memory")
#define SLOAD_H(Kp, Vp, k0) do { S.st_v0 = load8<bf16>(ROW(Vp, k0, sr)); S.st_v1 = load8<bf16>(ROW(Vp, k0, 32 + sr));              \
                         S.st_k0 = load8<bf16>(ROW(Kp, k0, sr)); S.st_k1 = load8<bf16>(ROW(Kp, k0, 32 + sr)); } while (0)
#define SWRITE_HK(bf) do { *(bf16x8*)(K_lds + (bf) * SHM_K + kws) = S.st_k0; *(bf16x8*)(K_lds + (bf) * SHM_K + kws + 32 * 256) = S.st_k1; } while (0)
#define SWRITE_HV(bf) do { *(bf16x8*)(V_lds + (bf) * SHM_V + vst0) = S.st_v0; *(bf16x8*)(V_lds + (bf) * SHM_V + vst1) = S.st_v1; } while (0)
#define SWRITE_H(bf) do { SWRITE_HV(bf); SWRITE_HK(bf); } while (0)
__device__ __forceinline__ void fox_prime(const BlockRef& cur, char* lds, Seam& S, int kw) {
    const int tid = ktid(kw), wid = kw, lane = tid & 63, r32 = lane & 31, hi = lane >> 5;
    const int sr = tid >> 4, sc = (tid & 15) * 8, kws = KSWZ(sr, sc * 2); char* K_lds = lds + 2 * SHM_V;
#pragma unroll
    for (int d0 = 0; d0 < 8; ++d0) S.qr[d0] = load8<bf16>(cur.Q + (size_t)(wid * QBLK + r32) * D + d0 * 16 + hi * 8);
    SLOAD_H(cur.K, cur.V, 0); VMW(); SWRITE_HK(0);
    __syncthreads();
}
__device__ __forceinline__ void fox_block(const BlockRef& cur, const BlockRef& nxt, char* lds, Seam& S, int kw) {
    constexpr bool SK = false; constexpr unsigned W = 0x7fffffffu;
    const int tid = ktid(kw), wid = kw, lane = tid & 63, r32 = lane & 31, hi = lane >> 5;
    const int NT = (cur.P0 + QB - 1) / KVBLK + 1;
    const int qlo = cur.P0 + wid * QBLK, qm = qlo + r32 - 4 * hi;
    char* V_lds = lds; char* K_lds = lds + 2 * SHM_V;
    float* ws = (float*)(lds + 2 * SHM_V + 2 * SHM_K) + wid * 64; float* li_l = ws, * al_l = ws + 32;
    float m_reg = -1e30f, l_reg = 0; f32x16 o[4] = {};
    const int sr = tid >> 4, sc = (tid & 15) * 8, vst0 = v_st(sr, sc), vst1 = v_st(32 + sr, sc), kws = KSWZ(sr, sc * 2);
    const int vb0 = (int)(uintptr_t)V_lds + v_rd_base(lane);
    const bf16* Kh = cur.K; const bf16* Vh = cur.V;
    float* bias_l = (float*)(lds + LDS_BIAS);
    { const int nb4 = (cur.P0 + QB) / 4; int i0 = ktid(kw); asm volatile("" : "+v"(i0));
      for (int i = i0; i < nb4; i += NW * 64) ((f32x4*)bias_l)[i] = ((const f32x4*)cur.KB)[i]; }
    __syncthreads();
    const float* KBh = bias_l + 4 * hi;
#define RESC(a) do { if (__any((a) < 1.f)) { if (hi == 0) al_l[r32] = (a); asm volatile("s_waitcnt lgkmcnt(0)" ::: "memory");              \
                     for (int d_ = 0; d_ < 4; ++d_) for (int r = 0; r < 16; ++r) o[d_][r] *= al_l[crow(r, hi)]; } } while (0)
#define KBASE(t) ((t) * KVBLK)
#define ACT(t) true
#define MASKT(P0_, P1_, t) do { const int kb_ = KBASE(t); if (kb_ + KVBLK - 1 > qlo) mask_tile(P0_, P1_, qm - kb_, W); } while (0)
    constexpr int NQL = 8;
#define SEAM_K0() do { VMWN(NQL); SWRITE_HK(0); SBAR(); } while (0)
    f32x16 pA0, pA1, pB0, pB1; float mnA, mnB, alA, alB; bf16x8 pa0, pa1, pa2, pa3;
    SWRITE_HV(0); SBAR();
    if (NT > 1) { SLOAD_H(Kh, Vh, KBASE(1)); }
    SBAR(); qkt<0, SK>(pA0, pA1, K_lds, r32, hi, S.qr, ACT(0), KBh);
    MASKT(pA0, pA1, 0); partialSM(pA0, pA1, m_reg, mnA, alA);
    if (NT > 1) { VMW(); SWRITE_H(1); }
    __syncthreads();
#define HALF_STEP(PX0, PX1, mnX, alX, PY0, PY1, alY, t, KB, VB, SB) do {                                                      \
        SBAR(); qkt<KB, SK>(PX0, PX1, K_lds, r32, hi, S.qr, ACT(t), KBh + KBASE(t));                                             \
        finishSM(PY0, PY1, alY, l_reg, pa0, pa1, pa2, pa3); SBAR();                                                           \
        if ((t) + 1 < NT) { SLOAD_H(Kh, Vh, KBASE((t) + 1)); SBAR(); }                                                        \
        pv_tile<VB, SK>(o, vb0, pa0, pa1, pa2, pa3, ACT((t) - 1)); MASKT(PX0, PX1, (t)); partialSM(PX0, PX1, m_reg, mnX, alX);  \
        __syncthreads();                                                                                                      \
        if ((t) + 1 < NT) { VMW(); SWRITE_H(SB); }                                                                            \
        RESC(alX); __syncthreads(); } while (0)
    for (int t = 1; t + 1 < NT; t += 2) {
        HALF_STEP(pB0, pB1, mnB, alB, pA0, pA1, alA, t, 1, 0, 0);
        HALF_STEP(pA0, pA1, mnA, alA, pB0, pB1, alB, t + 1, 0, 1, 1);
    }
    const bool even = (NT & 1) == 0;
    if (even) { SBAR(); qkt<1, SK>(pB0, pB1, K_lds, r32, hi, S.qr, ACT(NT - 1), KBh + KBASE(NT - 1)); SBAR(); }
    SLOAD_H(nxt.K, nxt.V, 0); SBAR();
#pragma unroll
    for (int d0 = 0; d0 < 8; ++d0) S.qr[d0] = load8<bf16>(nxt.Q + (size_t)(wid * QBLK + r32) * D + d0 * 16 + hi * 8);
    SBAR();
    finishSM(pA0, pA1, alA, l_reg, pa0, pa1, pa2, pa3); SBAR();
    pv_tile<0, SK>(o, vb0, pa0, pa1, pa2, pa3, true);
    if (even) { MASKT(pB0, pB1, NT - 1); partialSM(pB0, pB1, m_reg, mnB, alB); __syncthreads(); RESC(alB);
        finishSM(pB0, pB1, alB, l_reg, pa0, pa1, pa2, pa3); SBAR(); pv_tile<1, SK>(o, vb0, pa0, pa1, pa2, pa3, true); }
    SBAR(); SEAM_K0();
    if (hi == 0) li_l[r32] = l_reg; asm volatile("s_waitcnt lgkmcnt(0)" ::: "memory");
    float rli[16];
#pragma unroll
    for (int r = 0; r < 16; ++r) rli[r] = __builtin_amdgcn_rcpf(li_l[crow(r, hi)]);
    bf16* Ow = cur.O + (size_t)(wid * QBLK) * OP;
#pragma unroll
    for (int r = 0; r < 16; ++r) { const int orow = crow(r, hi);
#pragma unroll
        for (int d0 = 0; d0 < 4; ++d0) { const float v = o[d0][r] * rli[r];
            const float vn = __shfl_xor(v, 1);
            if ((r32 & 1) == 0) *(unsigned*)(Ow + (size_t)orow * OP + d0 * 32 + r32) = cvtpk(v, vn); } }
    __syncthreads();
#undef RESC
#undef KBASE
#undef ACT
#undef MASKT
#undef SEAM_K0
#undef HALF_STEP
}
#undef ROW
#undef VMW
#undef VMWN
#undef SLOAD_H
#undef SWRITE_HK
#undef SWRITE_HV
#undef SWRITE_H
#undef KSWZ
#undef SBAR
}

struct Frame {
    LAS unsigned char* lds;
    volatile LAS unsigned* MISC;
    gu32* ctl;
    int tid, lane, wave;
    int vcu, G, bx;
    const float *x, *c, *w_ada, *b_ada, *g_mix, *w_in, *b_f, *conv_w, *conv_b, *lru_w_a, *lru_b_a, *lru_w_x, *lru_b_x, *lru_lambda,
                *g_attn_out, *g_lru_out, *w_out, *g_ffn, *peer_w_q, *peer_k1, *peer_k2, *peer_u, *peer_v, *g_final;
    float* out;
    float *MOD, *LF, *KB, *SUMM, *EW, *USC, *VSC, *PD, *Y, *ACT, *PART;
    int* EIDX;
    bf16_t *WLRU, *K1, *K2, *WIN, *WOUT, *WQ, *H, *Q, *K, *VV, *QP, *LX, *GLY, *MRG, *HL, *AC;
    unsigned char *U8, *V8;
};

struct Args { const float* in[24]; float* out; unsigned char* ws; int ph_lo, ph_hi, li, pad; };

__device__ __forceinline__ void p0_transpose_item(const float* W, int ldw, int K, bf16_t* WT, int kb, int scol, int drow, const float* gk, LAS float* scr, int lane) {
    const int k0 = 64 * kb;
    float wv[32];
#pragma unroll
    for (int i = 0; i < 32; ++i) { const int kk = 2 * i + (lane >> 5); wv[i] = W[(size_t)(k0 + kk) * ldw + scol + (lane & 31)]; }
    if (gk) {
#pragma unroll
        for (int i = 0; i < 32; ++i) wv[i] *= gk[k0 + 2 * i + (lane >> 5)]; }
#pragma unroll
    for (int i = 0; i < 32; ++i) { const int kk = 2 * i + (lane >> 5); scr[kk * 33 + (lane & 31)] = wv[i]; }
    LDS_WAIT(); asm volatile("" ::: "memory");
    const int c = lane & 7;
#pragma unroll
    for (int j = 0; j < 4; ++j) { const int n = (lane >> 3) + 8 * j; const LAS float* s = scr + (8 * c) * 33 + n;
        v4u o; o.x = pk2(s[0 * 33], s[1 * 33]); o.y = pk2(s[2 * 33], s[3 * 33]); o.z = pk2(s[4 * 33], s[5 * 33]); o.w = pk2(s[6 * 33], s[7 * 33]);
        *(GAS v4u*)(WT + (size_t)(drow + n) * K + k0 + 8 * c) = o; }
    LDS_WAIT(); asm volatile("" ::: "memory");
}
__device__ __forceinline__ void p0_convert(const float* src, bf16_t* dst, size_t n8, size_t gt, size_t ngt) {
#pragma unroll 4
    for (size_t i = gt; i < n8; i += ngt) { const f32x4 a = *(const GAS f32x4*)(src + i * 8), b = *(const GAS f32x4*)(src + i * 8 + 4);
        v4u o; o.x = pk2(a[0], a[1]); o.y = pk2(a[2], a[3]); o.z = pk2(b[0], b[1]); o.w = pk2(b[2], b[3]); *(GAS v4u*)(dst + i * 8) = o; }
}
template <int PARTS>
__device__ __forceinline__ void p0_prologue(Frame& F) {
    if (PARTS & 1) {
        LAS float* scs = (LAS float*)F.lds;
        LAS float* red = scs + 4 * 2048;
        for (int i = F.tid; i < 4 * DM; i += NTHR) { const float cv = F.c[i]; scs[i] = cv * sigmoidf_(cv); }
        __syncthreads();
        for (int cb = F.bx; cb < 256; cb += F.G) {
            const int cq = F.tid % 12, rl = F.tid / 12;
            if (F.tid < 504) {
                float acc[4][4];
#pragma unroll
                for (int b = 0; b < 4; ++b)
#pragma unroll
                    for (int j = 0; j < 4; ++j) acc[b][j] = 0.f;
                const float* wp = F.w_ada + (size_t)rl * NADA + cb * 48 + cq * 4;
#pragma unroll 8
                for (int r = rl; r < DM; r += 42, wp += (size_t)42 * NADA) { const f32x4 w = *(const GAS f32x4*)wp;
#pragma unroll
                    for (int b = 0; b < 4; ++b) { const float s = scs[b * DM + r]; acc[b][0] += s * w[0]; acc[b][1] += s * w[1]; acc[b][2] += s * w[2]; acc[b][3] += s * w[3]; } }
#pragma unroll
                for (int b = 0; b < 4; ++b)
#pragma unroll
                    for (int j = 0; j < 4; ++j) red[rl * 192 + cq * 16 + b * 4 + j] = acc[b][j];
            }
            __syncthreads();
            if (F.tid < 192) { float s = 0.f;
                for (int r = 0; r < 42; ++r) s += red[r * 192 + F.tid];
                const int q = F.tid >> 4, b = (F.tid >> 2) & 3, j = F.tid & 3, col = cb * 48 + q * 4 + j;
                F.MOD[b * NADA + col] = s + F.b_ada[col]; }
            __syncthreads();
        }
    }
    if (PARTS & 2) {
        LAS float* scr = (LAS float*)(F.lds + F.wave * 16384);
        const int gw = F.vcu * NWAVES + F.wave, NGW = F.G * NWAVES;
        constexpr int I_IN1 = 32 * 96, I_IN2 = 32 * 64, I_SQ = 32 * 64, I_LRU = 16 * 8;
        constexpr int NITEMS = I_IN1 + I_IN2 + 2 * I_SQ + I_LRU;
        for (int it = gw; it < NITEMS; it += NGW) {
            int r = it;
            if (r < I_IN1) { const int kb = r / 96, nb = r % 96; p0_transpose_item(F.w_in, INC, DM, F.WIN, kb, 32 * nb, 32 * nb, nullptr, scr, F.lane); continue; } r -= I_IN1;
            if (r < I_IN2) { const int kb = r / 64, nb = r % 64; p0_transpose_item(F.w_in, INC, DM, F.WIN, kb, OFF_LX + 32 * nb, OFF_F + 32 * nb, nullptr, scr, F.lane); continue; } r -= I_IN2;
            if (r < I_SQ) { const int kb = r / 64, nb = r % 64; const float* gk = kb < 16 ? F.g_attn_out : F.g_lru_out - AW;
                p0_transpose_item(F.w_out, DM, DM, F.WOUT, kb, 32 * nb, 32 * nb, gk, scr, F.lane); continue; } r -= I_SQ;
            if (r < I_SQ) { const int kb = r / 64, nb = r % 64; p0_transpose_item(F.peer_w_q, DM, DM, F.WQ, kb, 32 * nb, 32 * nb, nullptr, scr, F.lane); continue; } r -= I_SQ;
            { const int mat = r >> 3, sub = r & 7, n = mat >> 1, which = mat & 1, kb = sub >> 2, nb = sub & 3;
              const float* src = (which ? F.lru_w_x : F.lru_w_a) + (size_t)n * LBD * LBD;
              p0_transpose_item(src, LBD, LBD, F.WLRU + (size_t)(n * 256 + which * 128) * LBD, kb, 32 * nb, 32 * nb, nullptr, scr, F.lane); }
        }
    }
    if (PARTS & 4) {
        const size_t gt = (size_t)F.vcu * NTHR + F.tid, ngt = (size_t)F.G * NTHR;
        p0_convert(F.peer_k1, F.K1, (size_t)PH * PNK * 128 / 8, gt, ngt);
        p0_convert(F.peer_k2, F.K2, (size_t)PH * PNK * 128 / 8, gt, ngt);
    }
    if (PARTS & 8) {
        const int gw = F.vcu * NWAVES + F.wave, NGW = F.G * NWAVES;
        for (int r0 = gw; r0 < 2 * NEXP; r0 += 2 * NGW) {
            f32x4 v[2][8]; float am[2] = {0.f, 0.f};
#pragma unroll
            for (int u = 0; u < 2; ++u) { const int r = r0 + u * NGW; const bool isv = r >= NEXP; const int rr = isv ? r - NEXP : r;
                const GAS f32x4* src = (const GAS f32x4*)((isv ? F.peer_v : F.peer_u) + (size_t)rr * DM) + F.lane;
#pragma unroll
                for (int j = 0; j < 8; ++j) v[u][j] = src[64 * j]; }
#pragma unroll
            for (int u = 0; u < 2; ++u) { const int r = r0 + u * NGW; const bool isv = r >= NEXP; const int rr = isv ? r - NEXP : r;
#pragma unroll
                for (int j = 0; j < 8; ++j) am[u] = fmaxf(am[u], fmaxf(fmaxf(fabsf(v[u][j][0]), fabsf(v[u][j][1])), fmaxf(fabsf(v[u][j][2]), fabsf(v[u][j][3]))));
#pragma unroll
                for (int o = 1; o < 64; o <<= 1) am[u] = fmaxf(am[u], __shfl_xor(am[u], o));
                const float sc = am[u] > 0.f ? 416.f / am[u] : 1.f;
                GAS unsigned char* dstb = (GAS unsigned char*)(isv ? F.V8 : F.U8) + (size_t)(F.lane >> 5) * ((size_t)NEXP * 128) + (size_t)rr * 128 + (F.lane & 31) * 4;
#pragma unroll
                for (int j = 0; j < 8; ++j) { int pk = 0; pk = __builtin_amdgcn_cvt_pk_fp8_f32(v[u][j][0] * sc, v[u][j][1] * sc, pk, false); pk = __builtin_amdgcn_cvt_pk_fp8_f32(v[u][j][2] * sc, v[u][j][3] * sc, pk, true);
                    *(GAS unsigned*)(dstb + (size_t)(2 * j) * ((size_t)NEXP * 128)) = (unsigned)pk; }
                if (F.lane == 0) (isv ? F.VSC : F.USC)[rr] = am[u] > 0.f ? am[u] / 416.f : 1.f; }
        }
    }
}

template <bool WITH_F>
__device__ __forceinline__ void p_modnorm(Frame& F, const float* xin, const float* g, int off_sh, int off_sc) {
    LAS float* gsv = (LAS float*)F.lds;
    LAS float* shv = gsv + DM;
    LAS float* wfT = shv + DM;
    if (WITH_F) { for (int i = F.tid; i < 8 * DM; i += NTHR) { const int k = i >> 3, j = i & 7; wfT[j * DM + k] = F.w_in[(size_t)k * INC + OFF_F + j]; } }
    for (int rb = F.bx; rb < T / 64; rb += F.G) {
        const int b = rb >> 6;
        __syncthreads();
        for (int k = F.tid; k < DM; k += NTHR) { gsv[k] = g[k] * (1.f + F.MOD[b * NADA + off_sc + k]); shv[k] = F.MOD[b * NADA + off_sh + k]; }
        __syncthreads();
        for (int i = 0; i < 8; ++i) {
            const int row = rb * 64 + F.wave * 8 + i;
            const GAS f32x4* xr = (const GAS f32x4*)(xin + (size_t)row * DM) + F.lane;
            f32x4 v[8]; float ss = 0.f;
#pragma unroll
            for (int j = 0; j < 8; ++j) { v[j] = xr[64 * j]; ss += (v[j][0] * v[j][0] + v[j][1] * v[j][1]) + (v[j][2] * v[j][2] + v[j][3] * v[j][3]); }
            const float rstd = __builtin_amdgcn_rsqf(wave_sum(ss) * (1.f / DM) + EPS);
#pragma unroll
            for (int j = 0; j < 8; ++j) { const f32x4 gg = ((const LAS f32x4*)gsv)[F.lane + 64 * j], sh = ((const LAS f32x4*)shv)[F.lane + 64 * j]; v[j] = v[j] * rstd * gg + sh; }
            GAS v2u* o8 = (GAS v2u*)(F.H + (size_t)row * DM) + F.lane;
#pragma unroll
            for (int j = 0; j < 8; ++j) { v2u w; w.x = pk2(v[j][0], v[j][1]); w.y = pk2(v[j][2], v[j][3]); o8[64 * j] = w; }
            if (WITH_F) {
                float mine = 0.f;
#pragma unroll 1
                for (int jj = 0; jj < 8; ++jj) { float a = 0.f;
#pragma unroll
                    for (int j = 0; j < 8; ++j) { const f32x4 w = ((const LAS f32x4*)(wfT + jj * DM))[F.lane + 64 * j]; a += (v[j][0] * w[0] + v[j][1] * w[1]) + (v[j][2] * w[2] + v[j][3] * w[3]); }
                    a = wave_sum(a); mine = (F.lane == jj) ? a : mine; }
                if (F.lane < 8) { const float z = mine + F.b_f[F.lane]; const float lf = fminf(z, 0.f) - log1pf(fexp(-fabsf(z)));
                    F.LF[(size_t)(b * NH + F.lane) * SEQ + (row & (SEQ - 1))] = lf; }
            }
        }
    }
}

__device__ __forceinline__ void p2_cumsum(Frame& F) {
    LAS float* wt = (LAS float*)F.lds;
    for (int bh = F.bx; bh < BATCH * NH; bh += F.G) {
        const float* src = F.LF + (size_t)bh * SEQ + F.tid * 8;
        const f32x4 a = *(const GAS f32x4*)src, b = *(const GAS f32x4*)(src + 4);
        float p[8]; p[0] = a[0]; p[1] = p[0] + a[1]; p[2] = p[1] + a[2]; p[3] = p[2] + a[3]; p[4] = p[3] + b[0]; p[5] = p[4] + b[1]; p[6] = p[5] + b[2]; p[7] = p[6] + b[3];
        float incl = p[7];
#pragma unroll
        for (int o = 1; o < 64; o <<= 1) { const float n = __shfl_up(incl, o); if (F.lane >= o) incl += n; }
        __syncthreads();
        if (F.lane == 63) wt[F.wave] = incl;
        __syncthreads();
        float off = incl - p[7];
        for (int w = 0; w < F.wave; ++w) off += wt[w];
        constexpr float NIS = -1.0f / 0.08838834764831845f;
        f32x4 o0, o1;
        o0[0] = (off + p[0]) * NIS; o0[1] = (off + p[1]) * NIS; o0[2] = (off + p[2]) * NIS; o0[3] = (off + p[3]) * NIS;
        o1[0] = (off + p[4]) * NIS; o1[1] = (off + p[5]) * NIS; o1[2] = (off + p[6]) * NIS; o1[3] = (off + p[7]) * NIS;
        float* dst = F.KB + (size_t)bh * SEQ + F.tid * 8;
        *(GAS f32x4*)dst = o0; *(GAS f32x4*)(dst + 4) = o1;
    }
}

constexpr int L_LX = 0, L_A = 17408, L_XC = 34816, L_SA = 68608, L_SUM = 102400, L_CW = 106496, L_END = 126976;
constexpr int XS = 132;
typedef float f32x4v __attribute__((ext_vector_type(4)));
#define LDS_BAR() do { asm volatile("s_waitcnt lgkmcnt(0)" ::: "memory"); __builtin_amdgcn_s_barrier(); asm volatile("" ::: "memory"); } while (0)
__device__ __forceinline__ void lru_unit(Frame& F, int b, int chunk) {
    LAS unsigned char* L = F.lds;
    int tid_ = ktid(F.wave); asm volatile("" : "+v"(tid_));
    const int tid = tid_, lane = tid_ & 63, wave = F.wave;
    const int s0 = chunk * 64; const size_t row0 = (size_t)b * SEQ + s0;
    __syncthreads();
    LAS float* cwl = (LAS float*)(L + L_CW);
    for (int i = tid; i < 5 * LW; i += NTHR) cwl[i] = i < 4 * LW ? F.conv_w[i] : F.conv_b[i - 4 * LW];
    const int r16 = lane & 15, g4 = lane >> 4;
    v4u lxv[3]; bf16x8 bwa[4], bwx[4]; float pba, pbx, plam;
#define LRU_LOAD_LX(nn) do { _Pragma("unroll") for (int q_ = 0; q_ < 3; ++q_) { const int idx = tid + q_ * NTHR; const int r = idx >> 4, c8 = idx & 15; const int s = s0 - 3 + r; \
        v4u val = {0u, 0u, 0u, 0u}; if (idx < 67 * 16 && s >= 0) val = *(const GAS v4u*)(F.LX + ((size_t)b * SEQ + s) * LW + (nn) * LBD + c8 * 8); lxv[q_] = val; } } while (0)
#define LRU_LOAD_W(nn) do { const bf16_t* wa_ = F.WLRU + ((size_t)((nn) * 256 + 16 * wave + r16)) * LBD + 8 * g4; const bf16_t* wx_ = wa_ + (size_t)128 * LBD; \
        _Pragma("unroll") for (int ks = 0; ks < 4; ++ks) { bwa[ks] = *(const GAS bf16x8*)(wa_ + 32 * ks); bwx[ks] = *(const GAS bf16x8*)(wx_ + 32 * ks); } \
        const int chg_ = (nn) * LBD + 16 * wave + r16; pba = F.lru_b_a[chg_]; pbx = F.lru_b_x[chg_]; plam = F.lru_lambda[chg_]; } while (0)
    LRU_LOAD_LX(0); LRU_LOAD_W(0);
    for (int n = 0; n < NLB; ++n) {
        const int nn = n + 1 < NLB ? n + 1 : n;
        LDS_BAR();
#pragma unroll
        for (int q = 0; q < 3; ++q) { const int idx = tid + q * NTHR; if (idx < 67 * 16) *(LAS v4u*)(L + L_LX + (idx >> 4) * 256 + (idx & 15) * 16) = lxv[q]; }
        LDS_BAR();
        LRU_LOAD_LX(nn);
        { const int tok = tid >> 3, c16 = tid & 7; const int chg = n * LBD + c16 * 16;
          float xc[16];
#pragma unroll
          for (int e = 0; e < 16; e += 4) { const f32x4 cb = *(const LAS f32x4*)(cwl + 4 * LW + chg + e); xc[e] = cb[0]; xc[e + 1] = cb[1]; xc[e + 2] = cb[2]; xc[e + 3] = cb[3]; }
#pragma unroll
          for (int k = 0; k < 4; ++k) {
              const v4u x0 = *(const LAS v4u*)(L + L_LX + (tok + k) * 256 + c16 * 32), x1 = *(const LAS v4u*)(L + L_LX + (tok + k) * 256 + c16 * 32 + 16);
              const unsigned xd[8] = {x0.x, x0.y, x0.z, x0.w, x1.x, x1.y, x1.z, x1.w};
#pragma unroll
              for (int e = 0; e < 16; e += 4) { const f32x4 w = *(const LAS f32x4*)(cwl + k * LW + chg + e);
                  xc[e] += w[0] * bf_lo(xd[e / 2]); xc[e + 1] += w[1] * bf_hi(xd[e / 2]); xc[e + 2] += w[2] * bf_lo(xd[e / 2 + 1]); xc[e + 3] += w[3] * bf_hi(xd[e / 2 + 1]); } }
          v4u a0, a1; a0.x = pk2(xc[0], xc[1]); a0.y = pk2(xc[2], xc[3]); a0.z = pk2(xc[4], xc[5]); a0.w = pk2(xc[6], xc[7]);
          a1.x = pk2(xc[8], xc[9]); a1.y = pk2(xc[10], xc[11]); a1.z = pk2(xc[12], xc[13]); a1.w = pk2(xc[14], xc[15]);
          *(LAS v4u*)(L + L_A + tok * 272 + c16 * 32) = a0; *(LAS v4u*)(L + L_A + tok * 272 + c16 * 32 + 16) = a1;
          LAS float* xo = (LAS float*)(L + L_XC) + tok * XS + c16 * 16;
#pragma unroll
          for (int e = 0; e < 16; e += 4) *(LAS f32x4*)(xo + e) = (f32x4){xc[e], xc[e + 1], xc[e + 2], xc[e + 3]};
        }
        LDS_BAR();
        f32x4 acc_a[4], acc_x[4];
#pragma unroll
        for (int m = 0; m < 4; ++m) { acc_a[m] = (f32x4){0.f, 0.f, 0.f, 0.f}; acc_x[m] = (f32x4){0.f, 0.f, 0.f, 0.f}; }
#pragma unroll
        for (int ks = 0; ks < 4; ++ks) {
#pragma unroll
            for (int m = 0; m < 4; ++m) { const bf16x8 af = *(const LAS bf16x8*)(L + L_A + (16 * m + r16) * 272 + (32 * ks + 8 * g4) * 2);
                acc_a[m] = __builtin_amdgcn_mfma_f32_16x16x32_bf16(af, bwa[ks], acc_a[m], 0, 0, 0);
                acc_x[m] = __builtin_amdgcn_mfma_f32_16x16x32_bf16(af, bwx[ks], acc_x[m], 0, 0, 0); } }
        const float ba_ = pba, bx_ = pbx; const float sp8 = 8.f * softplusf_(-plam);
        LRU_LOAD_W(nn);
        { const int chl = 16 * wave + r16;
          LAS float* xcp = (LAS float*)(L + L_XC) + chl; LAS float* sap = (LAS float*)(L + L_SA) + chl;
#pragma unroll
          for (int m = 0; m < 4; ++m)
#pragma unroll
              for (int i = 0; i < 4; ++i) { const int tt = 16 * m + 4 * g4 + i;
                  const float rg = sigmoidf_(acc_a[m][i] + ba_), ig = sigmoidf_(acc_x[m][i] + bx_);
                  const float la = -sp8 * rg; const float a = fexp(la); const float x2 = 2.f * la;
                  const float em1 = (x2 > -0.3f) ? x2 * (1.f + x2 * (0.5f + x2 * (0.16666667f + x2 * (0.041666668f + x2 * (0.008333334f + x2 * 0.0013888889f))))) : (fexp(x2) - 1.f);
                  const float bt = __builtin_amdgcn_sqrtf(fmaxf(-em1, 0.f)) * (ig * xcp[tt * XS]);
                  sap[tt * XS] = a; xcp[tt * XS] = bt; } }
        LDS_BAR();
        { const int chl = tid & 127, sub = tid >> 7;
          const LAS float* sap = (const LAS float*)(L + L_SA) + (16 * sub) * XS + chl; const LAS float* sbp = (const LAS float*)(L + L_XC) + (16 * sub) * XS + chl;
          float av[16], bv[16];
#pragma unroll
          for (int j = 0; j < 16; ++j) { av[j] = sap[j * XS]; bv[j] = sbp[j * XS]; }
          float P = 1.f, Hh = 0.f;
#pragma unroll
          for (int j = 0; j < 16; ++j) { Hh = av[j] * Hh + bv[j]; P *= av[j]; }
          LAS f32x2* sm = (LAS f32x2*)(L + L_SUM);
          sm[sub * 128 + chl] = (f32x2){P, Hh};
          LDS_BAR();
          float h = 0.f, cp = 1.f;
          for (int s = 0; s < sub; ++s) { const f32x2 ph = sm[s * 128 + chl]; h = ph[0] * h + ph[1]; cp *= ph[0]; }
          bf16_t* hl = F.HL + (row0 + 16 * sub) * LW + n * LBD + chl; bf16_t* ac = F.AC + (row0 + 16 * sub) * LW + n * LBD + chl;
#pragma unroll
          for (int j = 0; j < 16; ++j) { h = av[j] * h + bv[j]; cp *= av[j]; hl[(size_t)j * LW] = (bf16_t)f2bf(h); ac[(size_t)j * LW] = (bf16_t)f2bf(cp); }
          if (sub == 3) *((GAS f32x2*)F.SUMM + ((size_t)(b * 64 + chunk)) * LW + n * LBD + chl) = (f32x2){cp, h};
        }
    }
}

__device__ __forceinline__ void lru_final(Frame& F, int b, int chunk) {
    LAS float* hin = (LAS float*)F.lds;
    int tid_ = ktid(F.wave); asm volatile("" : "+v"(tid_));
    const int tid = tid_;
    const size_t row0 = (size_t)b * SEQ + chunk * 64;
    __syncthreads();
    for (int ch = tid; ch < LW; ch += NTHR) { float h = 0.f;
        const GAS f32x2* sp = (const GAS f32x2*)F.SUMM + (size_t)(b * 64) * LW + ch;
        for (int c0 = 0; c0 < chunk; c0 += 8) { f32x2 ph[8];
#pragma unroll
            for (int q = 0; q < 8; ++q) ph[q] = sp[(size_t)(c0 + q < chunk ? c0 + q : chunk - 1) * LW];
#pragma unroll
            for (int q = 0; q < 8; ++q) if (c0 + q < chunk) h = ph[q][0] * h + ph[q][1]; }
        hin[ch] = h; }
    __syncthreads();
    const int tt = tid >> 3, part = tid & 7;
    const bf16_t* hlp = F.HL + (row0 + tt) * LW; const bf16_t* acp = F.AC + (row0 + tt) * LW; const bf16_t* glp = F.GLY + (row0 + tt) * LW;
    bf16_t* rowp = F.MRG + (row0 + tt) * DM;
    v4u ov[16]; float ssq = 0.f;
#pragma unroll
    for (int e = 0; e < 16; ++e) { const int c0 = (e * 8 + part) * 8;
        const v4u hv = *(const GAS v4u*)(hlp + c0), av = *(const GAS v4u*)(acp + c0), gv = *(const GAS v4u*)(glp + c0);
        const f32x4 c4a = *(const LAS f32x4*)(hin + c0), c4b = *(const LAS f32x4*)(hin + c0 + 4);
        const unsigned hd[4] = {hv.x, hv.y, hv.z, hv.w}, ad[4] = {av.x, av.y, av.z, av.w}, gd[4] = {gv.x, gv.y, gv.z, gv.w};
        const float ci[8] = {c4a[0], c4a[1], c4a[2], c4a[3], c4b[0], c4b[1], c4b[2], c4b[3]}; unsigned r[4];
#pragma unroll
        for (int q = 0; q < 4; ++q) { const float o0 = (bf_lo(hd[q]) + bf_lo(ad[q]) * ci[2 * q]) * bf_lo(gd[q]), o1 = (bf_hi(hd[q]) + bf_hi(ad[q]) * ci[2 * q + 1]) * bf_hi(gd[q]);
            ssq += o0 * o0 + o1 * o1; r[q] = pk2(o0, o1); }
        ov[e].x = r[0]; ov[e].y = r[1]; ov[e].z = r[2]; ov[e].w = r[3]; }
    ssq += __shfl_xor(ssq, 1); ssq += __shfl_xor(ssq, 2); ssq += __shfl_xor(ssq, 4);
    const float rl = __builtin_amdgcn_rsqf(ssq * (1.f / LW) + EPS);
#pragma unroll
    for (int e = 0; e < 16; ++e) { const int c0 = (e * 8 + part) * 8; const unsigned d[4] = {ov[e].x, ov[e].y, ov[e].z, ov[e].w}; v4u o;
        o.x = pk2(bf_lo(d[0]) * rl, bf_hi(d[0]) * rl); o.y = pk2(bf_lo(d[1]) * rl, bf_hi(d[1]) * rl); o.z = pk2(bf_lo(d[2]) * rl, bf_hi(d[2]) * rl); o.w = pk2(bf_lo(d[3]) * rl, bf_hi(d[3]) * rl);
        *(GAS v4u*)(rowp + AW + c0) = o; }
    float sa = 0.f;
#pragma unroll
    for (int e = 0; e < 16; ++e) { const int c0 = (e * 8 + part) * 8; ov[e] = *(const GAS v4u*)(rowp + c0); const unsigned d[4] = {ov[e].x, ov[e].y, ov[e].z, ov[e].w};
#pragma unroll
        for (int q = 0; q < 4; ++q) { const float lo = bf_lo(d[q]), hi = bf_hi(d[q]); sa += lo * lo + hi * hi; } }
    sa += __shfl_xor(sa, 1); sa += __shfl_xor(sa, 2); sa += __shfl_xor(sa, 4);
    const float ra = __builtin_amdgcn_rsqf(sa * (1.f / AW) + EPS);
#pragma unroll
    for (int e = 0; e < 16; ++e) { const int c0 = (e * 8 + part) * 8; const unsigned d[4] = {ov[e].x, ov[e].y, ov[e].z, ov[e].w}; v4u o;
        o.x = pk2(bf_lo(d[0]) * ra, bf_hi(d[0]) * ra); o.y = pk2(bf_lo(d[1]) * ra, bf_hi(d[1]) * ra); o.z = pk2(bf_lo(d[2]) * ra, bf_hi(d[2]) * ra); o.w = pk2(bf_lo(d[3]) * ra, bf_hi(d[3]) * ra);
        *(GAS v4u*)(rowp + c0) = o; }
}

__device__ __forceinline__ att::BlockRef att_ref(Frame& F, int bh, int qb) {
    att::BlockRef r; const int b = bh >> 3, h = bh & 7;
    r.Q = F.Q + ((size_t)bh * SEQ + (size_t)qb * att::QB) * HD; r.K = F.K + (size_t)bh * SEQ * HD; r.V = F.VV + (size_t)bh * SEQ * HD;
    r.O = F.MRG + ((size_t)b * SEQ + (size_t)qb * att::QB) * DM + h * HD; r.KB = F.KB + (size_t)bh * SEQ; r.P0 = qb * att::QB;
    return r;
}
__device__ __forceinline__ void p3_attention(Frame& F, char* lds) {
    constexpr int NQB = SEQ / att::QB, NX = NQB / 2, TOTAL = BATCH * NH * NX;
    int L = F.vcu; if (L >= TOTAL) return;
    int pass = 0; int bh = L / NX, x = L % NX;
    att::BlockRef cur = att_ref(F, bh, x);
    att::Seam S;
    att::fox_prime(cur, lds, S, F.wave);
    for (;;) {
        const bool more_pass = pass == 0, more_item = L + F.G < TOTAL, last = !more_pass && !more_item;
        int passn = pass + 1, Ln = L;
        if (!more_pass) { passn = 0; Ln = more_item ? L + F.G : L; }
        const int bhn = Ln / NX, xn = Ln % NX;
        const att::BlockRef nxt = last ? cur : att_ref(F, bhn, passn ? NQB - 1 - xn : xn);
        att::fox_block(cur, nxt, lds, S, F.wave);
        if (last) break;
        cur = nxt; pass = passn; L = Ln;
    }
}

template <int N> __device__ __forceinline__ float row_ror(float v) { return __builtin_bit_cast(float, __builtin_amdgcn_update_dpp(0, __builtin_bit_cast(int, v), 0x120 + N, 0xf, 0xf, false)); }
__device__ __forceinline__ float fmax_s(float a, float b) { float r; asm("v_max_f32_e32 %0, %1, %2" : "=v"(r) : "v"(a), "v"(b)); return r; }
__device__ __forceinline__ float fmin_s(float a, float b) { float r; asm("v_min_f32_e32 %0, %1, %2" : "=v"(r) : "v"(a), "v"(b)); return r; }
__device__ __forceinline__ float row_allmax(float v) {
    asm volatile("s_nop 1\n\tv_max_f32_dpp %0, %0, %0 row_ror:8 row_mask:0xf bank_mask:0xf\n\t"
                 "s_nop 1\n\tv_max_f32_dpp %0, %0, %0 row_ror:4 row_mask:0xf bank_mask:0xf\n\t"
                 "s_nop 1\n\tv_max_f32_dpp %0, %0, %0 row_ror:2 row_mask:0xf bank_mask:0xf\n\t"
                 "s_nop 1\n\tv_max_f32_dpp %0, %0, %0 row_ror:1 row_mask:0xf bank_mask:0xf" : "+v"(v));
    return v;
}
__device__ __forceinline__ float row_allsum(float v) { v += row_ror<8>(v); v += row_ror<4>(v); v += row_ror<2>(v); v += row_ror<1>(v); return v; }
#define CE_DESC(a, b) do { const float hi_ = fmax_s(a, b), lo_ = fmin_s(a, b); a = hi_; b = lo_; } while (0)
__device__ __forceinline__ float row_top16(float (&Lv)[8], int r16) {
    CE_DESC(Lv[0], Lv[1]); CE_DESC(Lv[2], Lv[3]); CE_DESC(Lv[4], Lv[5]); CE_DESC(Lv[6], Lv[7]);
    CE_DESC(Lv[0], Lv[2]); CE_DESC(Lv[1], Lv[3]); CE_DESC(Lv[4], Lv[6]); CE_DESC(Lv[5], Lv[7]);
    CE_DESC(Lv[1], Lv[2]); CE_DESC(Lv[5], Lv[6]);
    CE_DESC(Lv[0], Lv[4]); CE_DESC(Lv[1], Lv[5]); CE_DESC(Lv[2], Lv[6]); CE_DESC(Lv[3], Lv[7]);
    CE_DESC(Lv[2], Lv[4]); CE_DESC(Lv[3], Lv[5]);
    CE_DESC(Lv[1], Lv[2]); CE_DESC(Lv[3], Lv[4]); CE_DESC(Lv[5], Lv[6]);
    float res = 0.f; const float NEG = -__builtin_inff();
#pragma unroll
    for (int k = 0; k < 16; ++k) {
        const float m = row_allmax(Lv[0]);
        res = (r16 == k) ? m : res;
        const bool win = (Lv[0] == m);
#pragma unroll
        for (int j = 0; j < 7; ++j) Lv[j] = win ? Lv[j + 1] : Lv[j];
        Lv[7] = win ? NEG : Lv[7];
    }
    return res;
}
__device__ __forceinline__ void p8_topk(Frame& F) {
    LAS unsigned char* L = F.lds;
    const int lane = F.lane, wave = F.wave, r16 = lane & 15, g4 = lane >> 4;
    for (int grp = F.bx; grp < 256; grp += F.G) {
        const int hd = grp & 7, widx = grp >> 3;
        __syncthreads();
        for (int idx = F.tid; idx < 2 * 128 * 16; idx += NTHR) { const int half = idx >> 11, row = (idx >> 4) & 127, c8 = idx & 15;
            const bf16_t* src = (half ? F.K2 : F.K1) + ((size_t)hd * PNK + row) * 128 + c8 * 8;
            *(LAS v4u*)(L + half * 34816 + row * 272 + c8 * 16) = *(const GAS v4u*)src; }
        __syncthreads();
        for (int it = wave; it < 32; it += NWAVES) {
            const int t0 = widx * 512 + it * 16;
            bf16x8 a1[4], a2[4];
            { const bf16_t* qp = F.QP + (size_t)(t0 + r16) * DM + hd * PQD + 8 * g4;
#pragma unroll
              for (int ks = 0; ks < 4; ++ks) { a1[ks] = *(const GAS bf16x8*)(qp + 32 * ks); a2[ks] = *(const GAS bf16x8*)(qp + 128 + 32 * ks); } }
            f32x4 s1[8], s2[8];
#pragma unroll
            for (int nt = 0; nt < 8; ++nt) { s1[nt] = (f32x4){0.f, 0.f, 0.f, 0.f}; s2[nt] = (f32x4){0.f, 0.f, 0.f, 0.f};
#pragma unroll
                for (int ks = 0; ks < 4; ++ks) {
                    const bf16x8 b1 = *(const LAS bf16x8*)(L + (16 * nt + r16) * 272 + (32 * ks + 8 * g4) * 2);
                    const bf16x8 b2 = *(const LAS bf16x8*)(L + 34816 + (16 * nt + r16) * 272 + (32 * ks + 8 * g4) * 2);
                    s1[nt] = __builtin_amdgcn_mfma_f32_16x16x32_bf16(a1[ks], b1, s1[nt], 0, 0, 0);
                    s2[nt] = __builtin_amdgcn_mfma_f32_16x16x32_bf16(a2[ks], b2, s2[nt], 0, 0, 0); } }
#pragma unroll
            for (int i = 0; i < 4; ++i) {
                float l1[8], l2[8];
#pragma unroll
                for (int nt = 0; nt < 8; ++nt) {
                    l1[nt] = bitsf((fbits(s1[nt][i]) & ~0x7Fu) | (unsigned)(16 * nt + r16));
                    l2[nt] = bitsf((fbits(s2[nt][i]) & ~0x7Fu) | (unsigned)(16 * nt + r16)); }
                __builtin_amdgcn_sched_barrier(0);
                const float v1 = row_top16(l1, r16); __builtin_amdgcn_sched_barrier(0);
                const float v2 = row_top16(l2, r16); __builtin_amdgcn_sched_barrier(0);
                float cnd[16];
#pragma unroll
                for (int bb = 0; bb < 16; ++bb) { const float w = __shfl(v2, bb, 16);
                    cnd[bb] = __builtin_bit_cast(float, (__builtin_bit_cast(unsigned, v1 + w) & ~0xFFu) | (unsigned)(r16 * 16 + bb)); }
                float fin = 0.f; const float NEG = -__builtin_inff();
#pragma unroll
                for (int k = 0; k < 16; ++k) {
                    const float m = row_allmax(cnd[0]);
                    fin = (r16 == k) ? m : fin;
                    const bool win = (cnd[0] == m);
#pragma unroll
                    for (int j = 0; j < 15; ++j) cnd[j] = win ? cnd[j + 1] : cnd[j];
                    cnd[15] = win ? NEG : cnd[15];
                }
                const unsigned fb = __builtin_bit_cast(unsigned, fin); const int ra = (fb >> 4) & 15, rb = fb & 15;
                const float pv1 = __shfl(v1, ra, 16), pv2 = __shfl(v2, rb, 16);
                const int i1 = __builtin_bit_cast(unsigned, pv1) & 0x7F, i2 = __builtin_bit_cast(unsigned, pv2) & 0x7F;
                const float vs = pv1 + pv2;
                const float mx = row_allmax(vs); const float ex = fexp(vs - mx); const float sm = row_allsum(ex);
                const size_t o = (size_t)(t0 + 4 * g4 + i) * NSEL + hd * PTOPK + r16;
                F.EIDX[o] = i1 * PNK + i2; F.EW[o] = ex / sm;
                __builtin_amdgcn_sched_barrier(0);
            }
        }
    }
}

#ifdef P8_NAIVE
__device__ __forceinline__ void p8_naive(Frame& F) {
    LAS float* base = (LAS float*)F.lds;
    if (F.tid < 64) {
        LAS float* sc = base + F.tid * 320; LAS int* ia = (LAS int*)(sc + 256); LAS int* ib = ia + 16;
        for (int pair = F.bx * 64 + F.tid; pair < T * PH; pair += F.G * 64) { const int t = pair >> 3, hd = pair & 7;
            for (int n = 0; n < 128; ++n) { float a = 0.f, b = 0.f;
                for (int d = 0; d < 128; ++d) { const float q1 = bf_lo((unsigned)F.QP[(size_t)t * DM + hd * 256 + d]), q2 = bf_lo((unsigned)F.QP[(size_t)t * DM + hd * 256 + 128 + d]);
                    a += q1 * F.peer_k1[((size_t)hd * 128 + n) * 128 + d]; b += q2 * F.peer_k2[((size_t)hd * 128 + n) * 128 + d]; }
                sc[n] = a; sc[128 + n] = b; }
            int na = 0, nb = 0;
            for (int n = 0; n < 128; ++n) { int c1 = 0, c2 = 0; for (int m = 0; m < 128; ++m) { c1 += (sc[m] > sc[n]) || (sc[m] == sc[n] && m < n); c2 += (sc[128 + m] > sc[128 + n]) || (sc[128 + m] == sc[128 + n] && m < n); }
                if (c1 < 16) ia[na++] = n; if (c2 < 16) ib[nb++] = n; }
            float bound = 1e30f; int pa = -1, pb = -1; float vs[16]; int ee[16];
            for (int r = 0; r < 16; ++r) { float mx = -1e30f; int ba = 0, bb = 0;
                for (int a = 0; a < 16; ++a) for (int b = 0; b < 16; ++b) { const float v = sc[ia[a]] + sc[128 + ib[b]];
                    const bool lt = v < bound || (v == bound && (ia[a] * 128 + ib[b]) > (pa * 128 + pb));
                    if (lt && (v > mx)) { mx = v; ba = ia[a]; bb = ib[b]; } }
                bound = mx; pa = ba; pb = bb; vs[r] = mx; ee[r] = ba * 128 + bb; }
            float sm = 0.f;
#pragma unroll
            for (int r = 0; r < 16; ++r) { vs[r] = expf(vs[r] - vs[0]); sm += vs[r]; }
#pragma unroll
            for (int r = 0; r < 16; ++r) { F.EIDX[(size_t)t * NSEL + hd * 16 + r] = ee[r]; F.EW[(size_t)t * NSEL + hd * 16 + r] = vs[r] / sm; }
        }
    }
}
#endif
__device__ __forceinline__ void cvt16(const v4u& r, float (&f)[16]) {
    const unsigned dd[4] = {r.x, r.y, r.z, r.w};
#pragma unroll
    for (int c = 0; c < 4; ++c) { const f32x2 lo = __builtin_amdgcn_cvt_pk_f32_fp8((int)dd[c], false), hi = __builtin_amdgcn_cvt_pk_f32_fp8((int)dd[c], true);
        f[4 * c] = lo[0]; f[4 * c + 1] = lo[1]; f[4 * c + 2] = hi[0]; f[4 * c + 3] = hi[1]; }
}
__device__ __forceinline__ void p9a_udots(Frame& F) {
    const int lane = F.lane, sub = lane & 7, g = lane >> 3;
    const bool b2 = (lane & 4) != 0, b1 = (lane & 2) != 0, b0 = (lane & 1) != 0;
    for (int vid = F.bx; vid < 256; vid += F.G) { const int x = vid & 7, c = vid >> 3;
        for (int si = 0; si < 2; ++si) { const int s = x + 8 * si;
            const unsigned char* tab = F.U8 + (size_t)s * ((size_t)NEXP * 128) + 16 * sub;
            const int tb = c * 512 + F.wave;
            v4u rc[8]; int idp, idq; v4u hc0, hc1;
            { const int* ei = F.EIDX + (size_t)tb * NSEL; idp = ei[lane]; idq = ei[64 + lane];
              const GAS v4u* hp = (const GAS v4u*)(F.H + (size_t)tb * DM + 128 * s + 16 * sub); hc0 = hp[0]; hc1 = hp[1]; }
#pragma unroll
            for (int i = 0; i < 8; ++i) { const int id = __shfl(idp, 8 * i + g); rc[i] = *(const GAS v4u*)(tab + (size_t)id * 128); }
            idp = idq;
#pragma unroll 1
            for (int k = 0; k < 64; ++k) { const int t = tb + 8 * k; const int t1 = tb + 8 * (k + 1 < 64 ? k + 1 : 63);
                float hf[16];
                { const unsigned dd[8] = {hc0.x, hc0.y, hc0.z, hc0.w, hc1.x, hc1.y, hc1.z, hc1.w};
#pragma unroll
                  for (int q = 0; q < 8; ++q) { hf[2 * q] = bf_lo(dd[q]); hf[2 * q + 1] = bf_hi(dd[q]); } }
                { const GAS v4u* hp = (const GAS v4u*)(F.H + (size_t)t1 * DM + 128 * s + 16 * sub); hc0 = hp[0]; hc1 = hp[1]; }
                const int* ei1 = F.EIDX + (size_t)t1 * NSEL;
                float p[16];
#pragma unroll
                for (int h = 0; h < 2; ++h) {
                    idq = ei1[64 * h + lane];
#pragma unroll
                    for (int i = 0; i < 8; ++i) { float f[16]; cvt16(rc[i], f);
                        const int id = __shfl(idp, 8 * i + g);
                        rc[i] = *(const GAS v4u*)(tab + (size_t)id * 128);
                        float p0 = 0.f, p1 = 0.f;
#pragma unroll
                        for (int q = 0; q < 16; q += 2) { p0 = fmaf(f[q], hf[q], p0); p1 = fmaf(f[q + 1], hf[q + 1], p1); }
                        p[8 * h + i] = p0 + p1; }
                    idp = idq; }
                float q8[8], q4[4], q2[2];
#pragma unroll
                for (int i = 0; i < 8; ++i) { const float keep = b2 ? p[8 + i] : p[i], send = b2 ? p[i] : p[8 + i]; q8[i] = keep + __shfl_xor(send, 4); }
#pragma unroll
                for (int i = 0; i < 4; ++i) { const float keep = b1 ? q8[4 + i] : q8[i], send = b1 ? q8[i] : q8[4 + i]; q4[i] = keep + __shfl_xor(send, 2); }
#pragma unroll
                for (int i = 0; i < 2; ++i) { const float keep = b0 ? q4[2 + i] : q4[i], send = b0 ? q4[i] : q4[2 + i]; q2[i] = keep + __shfl_xor(send, 1); }
                float* pd = F.PD + ((size_t)s * T + t) * NSEL + 16 * sub + g;
                pd[0] = q2[0]; pd[8] = q2[1];
            }
        }
    }
}
__device__ __forceinline__ void p9b_act(Frame& F) {
    const size_t gt = (size_t)F.vcu * NTHR + F.tid, ngt = (size_t)F.G * NTHR;
    for (size_t idx = gt; idx < (size_t)T * NSEL; idx += ngt) {
        const int ex = F.EIDX[idx]; float sum = 0.f;
#pragma unroll
        for (int s = 0; s < 16; ++s) sum += F.PD[(size_t)s * T * NSEL + idx];
        F.ACT[idx] = gelu_tanh(sum * F.USC[ex]) * F.EW[idx] * F.VSC[ex];
    }
}
__device__ __forceinline__ void p9c_vacc(Frame& F) {
    const int lane = F.lane, sub = lane & 7, g = lane >> 3;
    const bool b5 = (lane & 32) != 0, b4 = (lane & 16) != 0, b3 = (lane & 8) != 0;
    for (int vid = F.bx; vid < 256; vid += F.G) { const int x = vid & 7, c = vid >> 3;
        for (int si = 0; si < 2; ++si) { const int s = x + 8 * si;
            const unsigned char* tab = F.V8 + (size_t)s * ((size_t)NEXP * 128) + 16 * sub;
            const int tb = c * 512 + F.wave;
            v4u rc[8]; int idp, idq; float acp, acq;
            { const int* ei = F.EIDX + (size_t)tb * NSEL; const float* ap = F.ACT + (size_t)tb * NSEL;
              idp = ei[lane]; acp = ap[lane]; idq = ei[64 + lane]; acq = ap[64 + lane]; }
            float ac[8];
#pragma unroll
            for (int i = 0; i < 8; ++i) { const int id = __shfl(idp, 8 * i + g); ac[i] = __shfl(acp, 8 * i + g); rc[i] = *(const GAS v4u*)(tab + (size_t)id * 128); }
            idp = idq; acp = acq;
#pragma unroll 1
            for (int k = 0; k < 64; ++k) { const int t = tb + 8 * k; const int t1 = tb + 8 * (k + 1 < 64 ? k + 1 : 63);
                const int* ei1 = F.EIDX + (size_t)t1 * NSEL; const float* ap1 = F.ACT + (size_t)t1 * NSEL;
                float ya[16];
#pragma unroll
                for (int i = 0; i < 16; ++i) ya[i] = 0.f;
#pragma unroll
                for (int h = 0; h < 2; ++h) {
                    idq = ei1[64 * h + lane]; acq = ap1[64 * h + lane];
#pragma unroll
                    for (int i = 0; i < 8; ++i) { float f[16]; cvt16(rc[i], f); const float a = ac[i];
                        const int id = __shfl(idp, 8 * i + g); ac[i] = __shfl(acp, 8 * i + g);
                        rc[i] = *(const GAS v4u*)(tab + (size_t)id * 128);
#pragma unroll
                        for (int q = 0; q < 16; ++q) ya[q] = fmaf(a, f[q], ya[q]); }
                    idp = idq; acp = acq; }
                float y8[8], y4[4], y2[2];
#pragma unroll
                for (int i = 0; i < 8; ++i) { const float keep = b5 ? ya[8 + i] : ya[i], send = b5 ? ya[i] : ya[8 + i]; y8[i] = keep + __shfl_xor(send, 32); }
#pragma unroll
                for (int i = 0; i < 4; ++i) { const float keep = b4 ? y8[4 + i] : y8[i], send = b4 ? y8[i] : y8[4 + i]; y4[i] = keep + __shfl_xor(send, 16); }
#pragma unroll
                for (int i = 0; i < 2; ++i) { const float keep = b3 ? y4[2 + i] : y4[i], send = b3 ? y4[i] : y4[2 + i]; y2[i] = keep + __shfl_xor(send, 8); }
                float* yp = F.Y + (size_t)t * DM + 128 * s + 16 * sub + 2 * g;
                *(GAS f32x2*)yp = (f32x2){y2[0], y2[1]};
            }
        }
    }
}
__device__ __forceinline__ void p9d_final(Frame& F) {
    const int lane = F.lane; const int gw = F.vcu * NWAVES + F.wave, NGW = F.G * NWAVES;
    for (int t = gw; t < T; t += NGW) {
        const int b = t >> 12;
        float* op = F.out + (size_t)t * DM; const float* ga = F.MOD + (size_t)b * NADA + 5 * DM; const float* yp = F.Y + (size_t)t * DM;
        f32x4 v[8]; float ss = 0.f;
#pragma unroll
        for (int j = 0; j < 8; ++j) { const int col = 4 * (lane + 64 * j); const f32x4 xa = *(const GAS f32x4*)(op + col), g4v = *(const GAS f32x4*)(ga + col), yv = *(const GAS f32x4*)(yp + col);
            v[j] = xa + g4v * yv; ss += (v[j][0] * v[j][0] + v[j][1] * v[j][1]) + (v[j][2] * v[j][2] + v[j][3] * v[j][3]); }
        const float rstd = __builtin_amdgcn_rsqf(wave_sum(ss) * (1.f / DM) + EPS);
#pragma unroll
        for (int j = 0; j < 8; ++j) { const int col = 4 * (lane + 64 * j); const f32x4 gf = *(const GAS f32x4*)(F.g_final + col); *(GAS f32x4*)(op + col) = v[j] * rstd * gf; }
    }
}

#ifdef DBG_UPTO
__device__ __forceinline__ unsigned dhash(unsigned x) { x ^= x >> 16; x *= 0x7feb352du; x ^= x >> 15; x *= 0x846ca68bu; x ^= x >> 16; return x; }
__device__ __forceinline__ float dbf(const bf16_t* p, size_t i) { return __builtin_bit_cast(float, (unsigned)p[i] << 16); }
__device__ __forceinline__ float dsilu(float v) { return v / (1.f + expf(-v)); }
__device__ __forceinline__ float dgelu(float x) { return 0.5f * x * (1.f + tanhf(0.7978845608028654f * (x + 0.044715f * x * x * x))); }
__global__ void __launch_bounds__(512) dbg_check(Args args, int upto) {
    __shared__ unsigned emax[20];
    __shared__ float sbuf[8][4096 + 128];
    const int tid = threadIdx.x, lane = tid & 63, wave = tid >> 6;
    if (tid < 20) emax[tid] = 0u;
    __syncthreads();
    const float* x = args.in[0]; const float* c = args.in[1]; const float* w_ada = args.in[2]; const float* b_ada = args.in[3]; const float* g_mix = args.in[4];
    const float* w_in = args.in[5]; const float* b_f = args.in[6]; const float* conv_w = args.in[7]; const float* conv_b = args.in[8];
    const float* lru_w_a = args.in[9]; const float* lru_b_a = args.in[10]; const float* lru_w_x = args.in[11]; const float* lru_b_x = args.in[12]; const float* lru_lambda = args.in[13];
    const float* g_attn_out = args.in[14]; const float* g_lru_out = args.in[15]; const float* w_out = args.in[16];
    unsigned char* ws = args.ws; float* out = args.out;
    const float* MOD = (const float*)(ws + WS_MOD); const float* LF = (const float*)(ws + WS_LF); const float* KB = (const float*)(ws + WS_KB); const float* SUMM = (const float*)(ws + WS_SUMM);
    const bf16_t* H = (const bf16_t*)(ws + WS_H); const bf16_t* Q = (const bf16_t*)(ws + WS_Q); const bf16_t* K = (const bf16_t*)(ws + WS_K); const bf16_t* V = (const bf16_t*)(ws + WS_VV);
    const bf16_t* LX = (const bf16_t*)(ws + WS_LX); const bf16_t* GLY = (const bf16_t*)(ws + WS_GLY); const bf16_t* MRG = (const bf16_t*)(ws + WS_MRG);
#define REPORT(k, e) atomicMax(&emax[k], __float_as_uint(fminf(fmaxf((e), 0.f), 1e30f)))
    if (upto >= 1) { const int b = tid & 3, col = dhash(tid * 7 + 1) % NADA; float s = 0.f;
        for (int k = 0; k < DM; ++k) s += dsilu(c[b * DM + k]) * w_ada[(size_t)k * NADA + col];
        s += b_ada[col]; REPORT(1, fabsf(MOD[b * NADA + col] - s) / (2e-3f * (fabsf(s) + 0.05f))); }
    if (upto >= 2 && upto < 7) { const int row = dhash(tid * 13 + 5) % T, col = dhash(tid * 17 + 3) % DM, b = row >> 12; float ss = 0.f;
        for (int k = 0; k < DM; ++k) { const float v = x[(size_t)row * DM + k]; ss += v * v; }
        const float rstd = 1.f / sqrtf(ss / DM + EPS);
        const float h = x[(size_t)row * DM + col] * rstd * g_mix[col] * (1.f + MOD[b * NADA + DM + col]) + MOD[b * NADA + col];
        REPORT(2, fabsf(dbf(H, (size_t)row * DM + col) - h) / (1e-2f * (fabsf(h) + 0.1f)));
        const int j = tid & 7; float z = b_f[j];
        for (int k = 0; k < DM; ++k) z += dbf(H, (size_t)row * DM + k) * w_in[(size_t)k * INC + OFF_F + j];
        const float lf = fminf(z, 0.f) - log1pf(expf(-fabsf(z)));
        REPORT(3, fabsf(LF[(size_t)(b * NH + j) * SEQ + (row & (SEQ - 1))] - lf) / 2e-2f); }
    if (upto >= 3 && upto < 7) { const int row = dhash(tid * 19 + 11) % T, coln = dhash(tid * 23 + 7) % 5120, b = row >> 12, s = row & 4095;
        const int src = coln < 3072 ? coln : coln + 8; float v = 0.f;
        for (int k = 0; k < DM; ++k) v += dbf(H, (size_t)row * DM + k) * w_in[(size_t)k * INC + src];
        const int cat = coln >> 10, cc = coln & 1023; float got;
        if (cat < 3) { const bf16_t* base = cat == 0 ? Q : (cat == 1 ? K : V); got = dbf(base, ((size_t)((b * 8 + (cc >> 7)) * 4096 + s)) * 128 + (cc & 127)); }
        else if (cat == 3) got = dbf(LX, (size_t)row * 1024 + cc);
        else { got = dbf(GLY, (size_t)row * 1024 + cc); v = dgelu(v); }
        REPORT(4 + (cat == 4 ? 1 : 0) + (cat == 3 ? 2 : 0), fabsf(got - v) / (3e-2f * (fabsf(v) + 0.3f)));
        if (tid < 32) { float cum = 0.f, e = 0.f;
            for (int t = 0; t < SEQ; ++t) { cum += LF[(size_t)tid * SEQ + t]; e = fmaxf(e, fabsf(KB[(size_t)tid * SEQ + t] * (-0.08838834764831845f) - cum) / (1e-3f * (fabsf(cum) + 1.f))); }
            REPORT(7, e); } }
    if (upto >= 4) {
        for (int smp = 0; smp < 4; ++smp) { const unsigned hsh = dhash((wave * 4 + smp) * 31 + 17); const int bh = hsh & 31, t = (smp == 0) ? (int)((hsh >> 5) & 255) : (int)((hsh >> 5) & 4095); const int b = bh >> 3, h = bh & 7;
            float* lg = sbuf[wave]; float* qs = lg + 4096;
            qs[lane] = dbf(Q, ((size_t)bh * SEQ + t) * HD + lane); qs[64 + lane] = dbf(Q, ((size_t)bh * SEQ + t) * HD + 64 + lane);
            __builtin_amdgcn_wave_barrier();
            float mx = -1e30f;
            for (int s = lane; s <= t; s += 64) { float d = 0.f; for (int k = 0; k < HD; ++k) d += qs[k] * dbf(K, ((size_t)bh * SEQ + s) * HD + k);
                const float l = d * 0.08838834764831845f + KB[(size_t)bh * SEQ + s] * 0.08838834764831845f; lg[s] = l; mx = fmaxf(mx, l); }
            for (int o = 1; o < 64; o <<= 1) mx = fmaxf(mx, __shfl_xor(mx, o));
            float sm = 0.f;
            for (int s = lane; s <= t; s += 64) { const float p = expf(lg[s] - mx); lg[s] = p; sm += p; }
            for (int o = 1; o < 64; o <<= 1) sm += __shfl_xor(sm, o);
            __builtin_amdgcn_wave_barrier();
            float o0 = 0.f, o1 = 0.f;
            for (int s = 0; s <= t; ++s) { const float p = lg[s]; o0 += p * dbf(V, ((size_t)bh * SEQ + s) * HD + lane); o1 += p * dbf(V, ((size_t)bh * SEQ + s) * HD + 64 + lane); }
            o0 /= sm; o1 /= sm;
            if (upto == 4) {
                const float g0 = dbf(MRG, ((size_t)b * SEQ + t) * DM + h * HD + lane), g1 = dbf(MRG, ((size_t)b * SEQ + t) * DM + h * HD + 64 + lane);
                REPORT(8, fmaxf(fabsf(g0 - o0) / (3e-2f * (fabsf(o0) + 0.3f)), fabsf(g1 - o1) / (3e-2f * (fabsf(o1) + 0.3f)))); }
            __builtin_amdgcn_wave_barrier();
        }
        { const unsigned hsh = dhash(tid * 37 + 29); const int b = hsh & 3, chunk = (hsh >> 2) & 63, ch = (hsh >> 8) & 1023, n = ch >> 7, j = ch & 127;
          const float sp = log1pf(expf(-lru_lambda[ch])) ;
          float P = 1.f, Hh = 0.f;
          for (int tt = 0; tt < 64; ++tt) { const int s = chunk * 64 + tt; float ga = lru_b_a[ch], gx = lru_b_x[ch], xcj = 0.f;
              for (int i = 0; i < 128; ++i) { float xc = conv_b[n * 128 + i];
                  for (int k = 0; k < 4; ++k) { const int ss = s - 3 + k; if (ss >= 0) xc += conv_w[k * LW + n * 128 + i] * dbf(LX, ((size_t)b * SEQ + ss) * LW + n * 128 + i); }
                  ga += xc * lru_w_a[((size_t)n * 128 + i) * 128 + j]; gx += xc * lru_w_x[((size_t)n * 128 + i) * 128 + j]; if (i == j) xcj = xc; }
              const float r = 1.f / (1.f + expf(-ga)), ig = 1.f / (1.f + expf(-gx)); const float la = -8.f * r * sp; const float a = expf(la);
              const float bt = sqrtf(-expm1f(2.f * la)) * (ig * xcj); Hh = a * Hh + bt; P *= a; }
          const float gp = SUMM[(((size_t)(b * 64 + chunk)) * LW + ch) * 2], gh = SUMM[(((size_t)(b * 64 + chunk)) * LW + ch) * 2 + 1];
          REPORT(9, fmaxf(fabsf(gp - P) / (2e-2f * (fabsf(P) + 0.01f)), fabsf(gh - Hh) / (3e-2f * (fabsf(Hh) + 0.05f)))); }
    }
    if (upto >= 5) { const int row = dhash(tid * 41 + 3) % T; float sa = 0.f, sl = 0.f;
        for (int k = 0; k < 1024; ++k) { const float a = dbf(MRG, (size_t)row * DM + k), l = dbf(MRG, (size_t)row * DM + 1024 + k); sa += a * a; sl += l * l; }
        REPORT(10, fmaxf(fabsf(sa / 1024.f - 1.f), fabsf(sl / 1024.f - 1.f)) / 2e-2f);
        if (tid < 64) { const int pr = tid >> 1; const int b = pr & 3, ch = dhash(tid * 43 + 1) & 1023, n = ch >> 7, j = ch & 127, tend = 70 + (pr >> 2) * 8;
            const float sp = log1pf(expf(-lru_lambda[ch])); float hcur = 0.f;
            for (int s = 0; s <= tend; ++s) { float ga = lru_b_a[ch], gx = lru_b_x[ch], xcj = 0.f;
                for (int i = 0; i < 128; ++i) { float xc = conv_b[n * 128 + i];
                    for (int k = 0; k < 4; ++k) { const int ss = s - 3 + k; if (ss >= 0) xc += conv_w[k * LW + n * 128 + i] * dbf(LX, ((size_t)b * SEQ + ss) * LW + n * 128 + i); }
                    ga += xc * lru_w_a[((size_t)n * 128 + i) * 128 + j]; gx += xc * lru_w_x[((size_t)n * 128 + i) * 128 + j]; if (i == j) xcj = xc; }
                const float r = 1.f / (1.f + expf(-ga)), ig = 1.f / (1.f + expf(-gx)); const float la = -8.f * r * sp; const float a = expf(la);
                hcur = a * hcur + sqrtf(-expm1f(2.f * la)) * (ig * xcj); }
            sbuf[0][tid] = hcur * dbf(GLY, ((size_t)b * SEQ + tend) * LW + ch);
            sbuf[1][tid] = dbf(MRG, ((size_t)b * SEQ + tend) * DM + 1024 + ch); }
        __syncthreads();
        if (tid < 64 && (tid & 1) == 0) {
            const float r0 = sbuf[0][tid], r1 = sbuf[0][tid + 1], k0 = sbuf[1][tid], k1 = sbuf[1][tid + 1];
            REPORT(11, fabsf(r0 * k1 - r1 * k0) / (5e-2f * (fabsf(r0 * k1) + fabsf(r1 * k0) + 1e-3f))); }
    }
    if (upto >= 6 && upto < 10) { const int row = dhash(tid * 47 + 9) % T, col = dhash(tid * 53 + 13) % DM, b = row >> 12; float v = 0.f;
        for (int k = 0; k < DM; ++k) v += dbf(MRG, (size_t)row * DM + k) * w_out[(size_t)k * DM + col] * (k < 1024 ? g_attn_out[k] : g_lru_out[k - 1024]);
        const float x1 = x[(size_t)row * DM + col] + MOD[b * NADA + 2 * DM + col] * v;
        REPORT(12, fabsf(out[(size_t)row * DM + col] - x1) / (2e-2f * (fabsf(x1) + 0.2f))); }
    const float* g_ffn = args.in[17]; const float* w_q = args.in[18]; const float* pk1 = args.in[19]; const float* pk2 = args.in[20]; const float* pu = args.in[21]; const float* pv = args.in[22]; const float* g_final = args.in[23];
    const bf16_t* QP = (const bf16_t*)(ws + WS_QP); const int* EIDX = (const int*)(ws + WS_EIDX); const float* EW = (const float*)(ws + WS_EW);
    if (upto >= 7 && upto < 10) { const int row = dhash(tid * 59 + 5) % T, col = dhash(tid * 61 + 3) % DM, b = row >> 12; float ss = 0.f;
        for (int k = 0; k < DM; ++k) { const float v = out[(size_t)row * DM + k]; ss += v * v; }
        const float rstd = 1.f / sqrtf(ss / DM + EPS);
        const float h = out[(size_t)row * DM + col] * rstd * g_ffn[col] * (1.f + MOD[b * NADA + 4 * DM + col]) + MOD[b * NADA + 3 * DM + col];
        REPORT(13, fabsf(dbf(H, (size_t)row * DM + col) - h) / (1e-2f * (fabsf(h) + 0.1f))); }
    if (upto >= 8) { const int row = dhash(tid * 67 + 11) % T, col = dhash(tid * 71 + 7) % DM; float v = 0.f;
        for (int k = 0; k < DM; ++k) v += dbf(H, (size_t)row * DM + k) * w_q[(size_t)k * DM + col];
        REPORT(14, fabsf(dbf(QP, (size_t)row * DM + col) - v) / (3e-2f * (fabsf(v) + 0.3f))); }
    __syncthreads();
    if (upto >= 9 && tid < 64) { float* sc = &sbuf[0][0] + tid * 256; const unsigned hsh = dhash(tid * 73 + 19); const int t = hsh % T, hd = (hsh >> 16) & 7;
        for (int n = 0; n < 128; ++n) { float a = 0.f, bsum = 0.f;
            for (int d = 0; d < 128; ++d) { a += dbf(QP, (size_t)t * DM + hd * 256 + d) * dbf((const bf16_t*)(ws + WS_K1), ((size_t)hd * 128 + n) * 128 + d); bsum += dbf(QP, (size_t)t * DM + hd * 256 + 128 + d) * dbf((const bf16_t*)(ws + WS_K2), ((size_t)hd * 128 + n) * 128 + d); }
            sc[n] = a; sc[128 + n] = bsum; }
        float th1 = 0.f, th2 = 0.f;
        for (int n = 0; n < 128; ++n) { int c1 = 0, c2 = 0; for (int m = 0; m < 128; ++m) { c1 += sc[m] > sc[n]; c2 += sc[128 + m] > sc[128 + n]; } if (c1 == 15) th1 = sc[n]; if (c2 == 15) th2 = sc[128 + n]; }
        float best16 = -1e30f;
        {
          float bound = 1e30f;
          for (int r = 0; r < 16; ++r) { float mx = -1e30f;
              for (int a = 0; a < 128; ++a) if (sc[a] >= th1) for (int bq = 0; bq < 128; ++bq) if (sc[128 + bq] >= th2) { const float v = sc[a] + sc[128 + bq]; if (v < bound && v > mx) mx = v; }
              bound = mx; }
          best16 = bound; }
        float e = 0.f, e2 = 0.f, e3 = 0.f, mxs = -1e30f;
        for (int k = 0; k < 16; ++k) { const int ex = EIDX[(size_t)t * NSEL + hd * 16 + k]; const int i1 = ex >> 7, i2 = ex & 127;
            if (ex < 0 || ex >= NEXP) { e3 = 1e6f; continue; }
            const float v = sc[i1] + sc[128 + i2]; mxs = fmaxf(mxs, v);
            e = fmaxf(e, (best16 - v) / 3e-2f);
            for (int k2 = 0; k2 < k; ++k2) if (EIDX[(size_t)t * NSEL + hd * 16 + k2] == ex) e3 = 1e5f; }
        float sm = 0.f; for (int k = 0; k < 16; ++k) { const int ex = EIDX[(size_t)t * NSEL + hd * 16 + k] & (NEXP - 1); sm += expf(sc[ex >> 7] + sc[128 + (ex & 127)] - mxs); }
        for (int k = 0; k < 16; ++k) { const int ex = EIDX[(size_t)t * NSEL + hd * 16 + k] & (NEXP - 1); const float w = expf(sc[ex >> 7] + sc[128 + (ex & 127)] - mxs) / sm;
            e2 = fmaxf(e2, fabsf(EW[(size_t)t * NSEL + hd * 16 + k] - w) / (3e-2f * (w + 0.02f))); }
        REPORT(15, e); REPORT(17, e2); REPORT(18, e3); }
    __syncthreads();
    if (upto >= 10) {
        for (int smp = 0; smp < 2; ++smp) { const int row = dhash((wave * 2 + smp) * 79 + 23) % T, b = row >> 12;
            float x2[32]; float ss = 0.f;
#pragma unroll 1
            for (int j = 0; j < 32; ++j) { const int col = lane + 64 * j; float v = 0.f;
                for (int k = 0; k < DM; ++k) v += dbf(MRG, (size_t)row * DM + k) * w_out[(size_t)k * DM + col] * (k < 1024 ? g_attn_out[k] : g_lru_out[k - 1024]);
                sbuf[wave][col] = x[(size_t)row * DM + col] + MOD[b * NADA + 2 * DM + col] * v; }
            for (int j = 0; j < 32; ++j) sbuf[wave][2048 + lane + 64 * j] = 0.f;
            for (int e = 0; e < NSEL; ++e) { const int ex = EIDX[(size_t)row * NSEL + e] & (NEXP - 1); const float w = EW[(size_t)row * NSEL + e]; float d = 0.f;
                for (int j = 0; j < 32; ++j) { const int col = lane + 64 * j; d += dbf(H, (size_t)row * DM + col) * pu[(size_t)ex * DM + col]; }
                for (int o = 1; o < 64; o <<= 1) d += __shfl_xor(d, o);
                const float act = dgelu(d) * w;
                for (int j = 0; j < 32; ++j) { const int col = lane + 64 * j; sbuf[wave][2048 + col] += act * pv[(size_t)ex * DM + col]; } }
            for (int j = 0; j < 32; ++j) { const int col = lane + 64 * j; const float v = sbuf[wave][col] + MOD[b * NADA + 5 * DM + col] * sbuf[wave][2048 + col]; sbuf[wave][col] = v; ss += v * v; }
            for (int o = 1; o < 64; o <<= 1) ss += __shfl_xor(ss, o);
            const float rstd = 1.f / sqrtf(ss / DM + EPS); float e = 0.f;
            for (int j = 0; j < 32; ++j) { const int col = lane + 64 * j; const float r = sbuf[wave][col] * rstd * g_final[col]; e = fmaxf(e, fabsf(out[(size_t)row * DM + col] - r) / (3e-2f * (fabsf(r) + 0.3f))); }
            REPORT(16, e); (void)x2; }
    }
    __syncthreads();
    for (size_t i = tid; i < (size_t)T * DM; i += 512) out[i] = 0.f;
    __syncthreads();
    if (tid == 0) { float code = 0.f;
        for (int k = 18; k >= 1; --k) if (k != 16 && __uint_as_float(emax[k]) > 1.f) code = powf(10.f, (float)(k + 1)) * fminf(9.9f, 1.f + log10f(__uint_as_float(emax[k])));
        out[0] = code; }
}
#endif

__global__ void __launch_bounds__(NWAVES * 64, 2) hymba_fwd(Args args) {
    unsigned char* const lds = g_lds;
    Frame F;
    F.lds = (LAS unsigned char*)lds;
    F.MISC = (volatile LAS unsigned*)(F.lds + MISC_OFF);
    { const int t0_ = (int)__builtin_amdgcn_workitem_id_x();
      F.wave = __builtin_amdgcn_readfirstlane(t0_ >> 6); }
    F.tid = ktid(F.wave); F.lane = F.tid & 63;
    for (int u = F.tid; u < (LDS_BYTES - LDSCTL_OFF) / 4; u += NWAVES * 64) ((LAS unsigned*)(F.lds + LDSCTL_OFF))[u] = 0u;
    __syncthreads();
    F.G = gridDim.x; F.bx = blockIdx.x; { const int bx = blockIdx.x; F.vcu = (F.G % 8 == 0) ? (bx % 8) * (F.G / 8) + bx / 8 : bx; }
    unsigned char* ws0 = args.ws;
    F.ctl = (gu32*)(ws0 + WS_CTL);
#define FILL_PTRS(F) do { const __attribute__((address_space(4))) void* kp_ = (const __attribute__((address_space(4))) void*)__builtin_amdgcn_kernarg_segment_ptr(); asm volatile("" : "+s"(kp_)); \
    const float* const __attribute__((address_space(4)))* in_ = (const float* const __attribute__((address_space(4)))*)kp_; \
    unsigned char* ws = (unsigned char*)in_[25]; \
    { int t_ = ktid(F.wave); asm volatile("" : "+v"(t_)); F.tid = t_; F.lane = t_ & 63; } \
    F.x = in_[0]; F.c = in_[1]; F.w_ada = in_[2]; F.b_ada = in_[3]; F.g_mix = in_[4]; F.w_in = in_[5]; F.b_f = in_[6]; \
    F.conv_w = in_[7]; F.conv_b = in_[8]; F.lru_w_a = in_[9]; F.lru_b_a = in_[10]; F.lru_w_x = in_[11]; F.lru_b_x = in_[12]; \
    F.lru_lambda = in_[13]; F.g_attn_out = in_[14]; F.g_lru_out = in_[15]; F.w_out = in_[16]; F.g_ffn = in_[17]; \
    F.peer_w_q = in_[18]; F.peer_k1 = in_[19]; F.peer_k2 = in_[20]; F.peer_u = in_[21]; F.peer_v = in_[22]; F.g_final = in_[23]; \
    F.out = (float*)in_[24]; \
    F.MOD = (float*)(ws + WS_MOD); F.LF = (float*)(ws + WS_LF); F.KB = (float*)(ws + WS_KB); F.SUMM = (float*)(ws + WS_SUMM); \
    F.EW = (float*)(ws + WS_EW); F.EIDX = (int*)(ws + WS_EIDX); \
    F.WLRU = (bf16_t*)(ws + WS_WLRU); F.K1 = (bf16_t*)(ws + WS_K1); F.K2 = (bf16_t*)(ws + WS_K2); F.WIN = (bf16_t*)(ws + WS_WIN); \
    F.WOUT = (bf16_t*)(ws + WS_WOUT); F.WQ = (bf16_t*)(ws + WS_WQ); F.U8 = ws + WS_U; F.V8 = ws + WS_V; F.USC = (float*)(ws + WS_USC); F.VSC = (float*)(ws + WS_VSC); F.PD = (float*)(ws + WS_PD); F.Y = (float*)(ws + WS_Y); F.ACT = (float*)(ws + WS_ACT); \
    F.H = (bf16_t*)(ws + WS_H); F.Q = (bf16_t*)(ws + WS_Q); F.K = (bf16_t*)(ws + WS_K); F.VV = (bf16_t*)(ws + WS_VV); F.QP = (bf16_t*)(ws + WS_QP); \
    F.LX = (bf16_t*)(ws + WS_LX); F.GLY = (bf16_t*)(ws + WS_GLY); F.MRG = (bf16_t*)(ws + WS_MRG); F.HL = (bf16_t*)(ws + WS_HL); F.AC = (bf16_t*)(ws + WS_AC); F.PART = (float*)(ws + WS_PART); } while (0)
    XcdBarrier bar; bar.bar = (unsigned*)(F.ctl + CW_BAR); bar.x = 0; bar.st = nullptr;
    if (N_LAUNCHES == 1) bar = xcd_barrier_post((unsigned*)(F.ctl + CW_BAR), F.MISC + 8, F.wave);
#define GRID_BAR() do { if (N_LAUNCHES == 1) xcd_barrier(bar, F.wave); } while (0)
    const int lo = args.ph_lo, hi = args.ph_hi;
#ifndef PHASE_MASK
#define PHASE_MASK 0xffff
#endif
#define IN(k) (((PHASE_MASK >> (k)) & 1) && lo <= (k) && (k) < hi)
#define BOTH(k) (IN(k) && IN((k) + 1))
#ifndef REPEAT_PHASE
#define REPEAT_PHASE -1
#endif
#define REP(k)
#define REPBAR(k)

    if (IN(0)) { FILL_PTRS(F); p0_prologue<15>(F);
#if REPEAT_PHASE == 0
        GRID_BAR(); FILL_PTRS(F); p0_prologue<15>(F);
#endif
#if REPEAT_PHASE >= 100 && REPEAT_PHASE < 116
        GRID_BAR(); FILL_PTRS(F); p0_prologue<REPEAT_PHASE - 100>(F);
#endif
        if (BOTH(0)) GRID_BAR(); }
    if (IN(1)) { FILL_PTRS(F); p_modnorm<true>(F, F.x, F.g_mix, 0, DM);
#if REPEAT_PHASE == 1
        GRID_BAR(); FILL_PTRS(F); p_modnorm<true>(F, F.x, F.g_mix, 0, DM);
#endif
        if (BOTH(1)) GRID_BAR(); }
    if (IN(2)) {
        FILL_PTRS(F); p2_cumsum(F); __syncthreads();
        { pg8::Gemm g{F.H, F.WIN, T, 5120, DM}; pg8::StaticOrder S; S.init(T, 5120, F.G, (int)blockIdx.x);
        pg8::EpiProj E{F.Q};
        pg8::gemm_phase<pg8::EpiProj, pg8::StaticOrder, true, true>(F.lds + RING_OFF, g, S, E, F.wave); }
#if REPEAT_PHASE == 2
        GRID_BAR(); FILL_PTRS(F);
        { pg8::Gemm g{F.H, F.WIN, T, 5120, DM}; pg8::StaticOrder S; S.init(T, 5120, F.G, (int)blockIdx.x);
        pg8::EpiProj E{F.Q};
        pg8::gemm_phase<pg8::EpiProj, pg8::StaticOrder, true, true>(F.lds + RING_OFF, g, S, E, F.wave); }
#endif
        if (BOTH(2)) GRID_BAR();
    }
    if (IN(3)) {
        FILL_PTRS(F);
        p3_attention(F, (char*)lds + RING_OFF);
        for (int u = F.vcu; u < BATCH * 64; u += F.G) lru_unit(F, u >> 6, u & 63);
#if REPEAT_PHASE == 3
        GRID_BAR(); FILL_PTRS(F);
        p3_attention(F, (char*)lds + RING_OFF);
        for (int u = F.vcu; u < BATCH * 64; u += F.G) lru_unit(F, u >> 6, u & 63);
#endif
#if REPEAT_PHASE == 30
        GRID_BAR(); FILL_PTRS(F);
        p3_attention(F, (char*)lds + RING_OFF);
#endif
#if REPEAT_PHASE == 31
        GRID_BAR(); FILL_PTRS(F);
        for (int u = F.vcu; u < BATCH * 64; u += F.G) lru_unit(F, u >> 6, u & 63);
#endif
        if (BOTH(3)) GRID_BAR();
    }
    if (IN(4)) {
        FILL_PTRS(F);
        for (int u = F.vcu; u < BATCH * 64; u += F.G) lru_final(F, u >> 6, u & 63);
#if REPEAT_PHASE == 4
        GRID_BAR(); FILL_PTRS(F);
        for (int u = F.vcu; u < BATCH * 64; u += F.G) lru_final(F, u >> 6, u & 63);
#endif
        if (BOTH(4)) GRID_BAR();
    }
    if (IN(5)) {
        FILL_PTRS(F);
        pg8::Gemm g{F.MRG, F.WOUT, T, DM, DM}; pg8::StaticOrder S; S.init(T, DM, F.G, (int)blockIdx.x);
        pg8::EpiRes E{F.x, F.out, DM, F.MOD + 2 * DM, NADA};
        pg8::gemm_phase<pg8::EpiRes, pg8::StaticOrder, true, true>(F.lds + RING_OFF, g, S, E, F.wave);
        if (BOTH(5)) GRID_BAR();
    }
    if (IN(6)) { FILL_PTRS(F); p_modnorm<false>(F, F.out, F.g_ffn, 3 * DM, 4 * DM); if (BOTH(6)) GRID_BAR(); }
    if (IN(7)) {
        FILL_PTRS(F);
        pg8::Gemm g{F.H, F.WQ, T, DM, DM}; pg8::StaticOrder S; S.init(T, DM, F.G, (int)blockIdx.x);
        pg8::EpiPlain E{F.QP, DM};
        pg8::gemm_phase<pg8::EpiPlain, pg8::StaticOrder, true, true>(F.lds + RING_OFF, g, S, E, F.wave);
        if (BOTH(7)) GRID_BAR();
    }
    #ifdef P8_NAIVE
    if (IN(8)) { FILL_PTRS(F); p8_naive(F); }
#else
    if (IN(8)) { FILL_PTRS(F); p8_topk(F);
#if REPEAT_PHASE == 8
        GRID_BAR(); FILL_PTRS(F); p8_topk(F);
#endif
        if (BOTH(8)) GRID_BAR(); }
#endif
    if (IN(9)) { FILL_PTRS(F); p9a_udots(F);
#if REPEAT_PHASE == 9
        GRID_BAR(); FILL_PTRS(F); p9a_udots(F);
#endif
        if (BOTH(9)) GRID_BAR(); }
    if (IN(10)) { FILL_PTRS(F); p9b_act(F);
#if REPEAT_PHASE == 10
        GRID_BAR(); FILL_PTRS(F); p9b_act(F);
#endif
        if (BOTH(10)) GRID_BAR(); }
    if (IN(11)) { FILL_PTRS(F); p9c_vacc(F);
#if REPEAT_PHASE == 11
        GRID_BAR(); FILL_PTRS(F); p9c_vacc(F);
#endif
        if (BOTH(11)) GRID_BAR(); }
    if (IN(12)) { FILL_PTRS(F); p9d_final(F); }
#undef IN
#undef BOTH
#undef GRID_BAR
}

extern "C" void kernel_launch(void* const* d_in, const int* in_sizes, int n_in, void* d_out, int out_size, void* d_ws, size_t ws_size, hipStream_t stream) {
    static int grid = 0;
    if (grid == 0) {
        if (n_in != 24 || in_sizes[0] != T * DM || out_size != T * DM || ws_size < WS_END) {
            fprintf(stderr, "kernel_launch: built for 24 inputs, x/out of %d floats, >= %zu bytes of workspace; got n_in %d, in0 %d, out %d, ws %zu; nothing launched\n", T * DM, (size_t)WS_END, n_in, n_in > 0 ? in_sizes[0] : -1, out_size, ws_size); grid = -1; return; }
        int dev = 0, cus = 0, per_cu = 0;
        if (hipGetDevice(&dev) != hipSuccess || hipDeviceGetAttribute(&cus, hipDeviceAttributeMultiprocessorCount, dev) != hipSuccess) { fprintf(stderr, "kernel_launch: device query failed\n"); grid = -1; return; }
        if (hipFuncSetAttribute((const void*)hymba_fwd, hipFuncAttributeMaxDynamicSharedMemorySize, LDS_BYTES) != hipSuccess) { fprintf(stderr, "kernel_launch: hipFuncSetAttribute failed\n"); grid = -1; return; }
        if (hipOccupancyMaxActiveBlocksPerMultiprocessor(&per_cu, (const void*)hymba_fwd, NWAVES * 64, LDS_BYTES) != hipSuccess || per_cu < 1)
            fprintf(stderr, "kernel_launch: note: occupancy query reports %d workgroups per CU\n", per_cu);
        (void)hipGetLastError();
        grid = cus;
    }
    if (grid < 0) return;
    if (hipMemsetAsync((char*)d_ws + WS_CTL, 0, CTL_ZERO_BYTES, stream) != hipSuccess) { fprintf(stderr, "kernel_launch: hipMemsetAsync failed\n"); return; }
    Args a{};
    for (int i = 0; i < 24; ++i) a.in[i] = (const float*)d_in[i];
    a.out = (float*)d_out; a.ws = (unsigned char*)d_ws;
#ifdef DBG_UPTO
    static_assert(N_LAUNCHES == N_PHASES, "probe builds launch one kernel per phase");
    for (int li = 0; li < DBG_UPTO; ++li) {
#else
    for (int li = 0; li < N_LAUNCHES; ++li) {
#endif
        a.ph_lo = (N_LAUNCHES == 1) ? 0 : li; a.ph_hi = (N_LAUNCHES == 1) ? N_PHASES : li + 1; a.li = li;
        hipLaunchKernelGGL(hymba_fwd, dim3(grid), dim3(NWAVES * 64), LDS_BYTES, stream, a);
        const hipError_t le = hipPeekAtLastError();
        if (le != hipSuccess) { fprintf(stderr, "kernel_launch: launch %d failed: %s\n", li, hipGetErrorName(le)); break; }
    }
#ifdef DBG_UPTO
    hipLaunchKernelGGL(dbg_check, dim3(1), dim3(512), 0, stream, a, (int)DBG_UPTO);
#endif
}
```

```cpp
#include <hip/hip_runtime.h>
#include <hip/hip_bf16.h>
#include <cstdio>
#include <cstdint>

constexpr int BATCH = 4, SEQ = 4096, DM = 2048, T = BATCH * SEQ;
constexpr int AW = 1024, NH = 8, HD = 128, LW = 1024, NLB = 8, LBD = 128;
constexpr int INC = 5128, OFF_F = 3072, OFF_LX = 3080;
constexpr int PH = 8, PNK = 128, PQD = 256, PTOPK = 16, NEXP = 16384, NSEL = PH * PTOPK;
constexpr int NADA = 6 * DM;
constexpr float EPS = 1e-6f;
constexpr int NWAVES = 8, NTHR = 512;

#ifndef MK_N_LAUNCHES
#define MK_N_LAUNCHES 1
#endif
constexpr int N_PHASES = 13;
constexpr int N_LAUNCHES = MK_N_LAUNCHES;

constexpr size_t MiB = 1u << 20;
constexpr size_t WS_CTL = 0, CTL_ZERO_BYTES = 128 * 1024;
constexpr size_t WS_MOD = 1 * MiB;
constexpr size_t WS_LF = WS_MOD + 256 * 1024;
constexpr size_t WS_KB = WS_LF + 512 * 1024;
constexpr size_t WS_SUMM = WS_KB + 512 * 1024;
constexpr size_t WS_WLRU = 5 * MiB;
constexpr size_t WS_K1 = WS_WLRU + 512 * 1024;
constexpr size_t WS_K2 = WS_K1 + 256 * 1024;
constexpr size_t WS_WIN = 6 * MiB;
constexpr size_t WS_WOUT = 26 * MiB;
constexpr size_t WS_WQ = 34 * MiB;
constexpr size_t WS_U = 42 * MiB, WS_V = 106 * MiB;
constexpr size_t WS_USC = WS_SUMM + 2 * MiB, WS_VSC = WS_USC + 64 * 1024;
constexpr size_t WS_H = 170 * MiB;
constexpr size_t WS_Q = 234 * MiB, WS_K = 266 * MiB, WS_VV = 298 * MiB;
constexpr size_t WS_QP = 234 * MiB;
constexpr size_t WS_EIDX = 298 * MiB, WS_EW = 306 * MiB;
constexpr size_t WS_LX = 330 * MiB, WS_GLY = 362 * MiB;
constexpr size_t WS_MRG = 394 * MiB;
constexpr size_t WS_PART = 458 * MiB;
constexpr size_t WS_HL = 170 * MiB, WS_AC = 202 * MiB;
constexpr size_t WS_OB = 74 * MiB;
constexpr size_t WS_LW = 138 * MiB;
constexpr size_t WS_SPLIT = WS_LW + 2 * MiB;
constexpr size_t WS_CS = WS_LW + 3 * MiB + 128 * 1024;
constexpr size_t WS_WQ8 = 330 * MiB;
constexpr size_t WS_WF = WS_LW + 4 * MiB;
constexpr size_t WS_WIN8 = 42 * MiB, WS_WOUT8 = 52 * MiB;
constexpr size_t WS_RS = WS_LW + 3 * MiB;
constexpr size_t WS_H8 = 74 * MiB;
constexpr size_t WS_M8 = 234 * MiB;
constexpr size_t WS_PD = 330 * MiB;
constexpr size_t WS_Y = 170 * MiB;
constexpr size_t WS_ACT = 314 * MiB;
constexpr size_t WS_X1 = 464 * MiB;
constexpr size_t WS_END = 528 * MiB;
static_assert(WS_K == WS_Q + 32 * MiB && WS_VV == WS_Q + 64 * MiB && WS_LX == WS_Q + 96 * MiB && WS_GLY == WS_Q + 128 * MiB, "EpiProj: destinations 32 MiB apart");
constexpr int CW_BAR = 4096;
static_assert((9216 + 9216) * 4 <= 128 * 1024, "control words inside the per-call memset");
constexpr int CW_KMAX = 8192, CW_QMAX = 8256, CW_QUEUE = 8832, CW_CMAX = 9216;

constexpr int RING_OFF = 0, RING_BYTES = 131072;
constexpr int LDSCTL_OFF = RING_BYTES, MISC_OFF = LDSCTL_OFF + 320;
constexpr int LDS_BYTES = 147456;
static_assert(MISC_OFF + 128 <= LDS_BYTES, "LDS map");

#define GAS __attribute__((address_space(1)))
#define LAS __attribute__((address_space(3)))
typedef unsigned short bf16_t;
typedef unsigned v4u __attribute__((ext_vector_type(4)));
typedef unsigned v2u __attribute__((ext_vector_type(2)));
typedef float f32x4 __attribute__((ext_vector_type(4)));
typedef float f32x2 __attribute__((ext_vector_type(2)));
typedef short bf16x8 __attribute__((ext_vector_type(8)));
typedef __bf16 bf16x2_t __attribute__((ext_vector_type(2)));
typedef GAS unsigned gu32;
#define RLX_AGENT __ATOMIC_RELAXED, __HIP_MEMORY_SCOPE_AGENT
#define LDS_WAIT() asm volatile("s_waitcnt lgkmcnt(0)" ::: "memory")
#define VM_WAIT() asm volatile("s_waitcnt vmcnt(0)" ::: "memory")

extern __shared__ __attribute__((aligned(16))) unsigned char g_lds[];
__device__ __forceinline__ int ktid(int kw) { int l; asm volatile("v_mbcnt_lo_u32_b32 %0, -1, 0\n\tv_mbcnt_hi_u32_b32 %0, -1, %0" : "=v"(l)); return kw * 64 + l; }
__device__ __forceinline__ unsigned fbits(float x) { return __builtin_bit_cast(unsigned, x); }
__device__ __forceinline__ float bitsf(unsigned x) { return __builtin_bit_cast(float, x); }
__device__ __forceinline__ bf16x2_t asbf2(unsigned x) { return __builtin_bit_cast(bf16x2_t, x); }
__device__ __forceinline__ unsigned f2bf(float f) { unsigned u = __builtin_bit_cast(unsigned, f); return (u + 0x7fffu + ((u >> 16) & 1u)) >> 16; }
__device__ __forceinline__ unsigned pk2(float lo, float hi) { f32x2 v = {lo, hi}; bf16x2_t b = __builtin_convertvector(v, bf16x2_t); return __builtin_bit_cast(unsigned, b); }
__device__ __forceinline__ float bf_lo(unsigned d) { return __builtin_bit_cast(float, d << 16); }
__device__ __forceinline__ float bf_hi(unsigned d) { return __builtin_bit_cast(float, d & 0xffff0000u); }
__device__ __forceinline__ float fexp(float x) { return __builtin_amdgcn_exp2f(x * 1.4426950408889634f); }
__device__ __forceinline__ float sigmoidf_(float z) { return __builtin_amdgcn_rcpf(1.f + fexp(-z)); }
__device__ __forceinline__ float gelu_tanh(float x) { const float z = x * (1.5957691216057308f + 0.07135481627260025f * x * x); return x * __builtin_amdgcn_rcpf(1.f + fexp(-z)); }
__device__ __forceinline__ float softplusf_(float z) { return fmaxf(z, 0.f) + log1pf(fexp(-fabsf(z))); }
__device__ __forceinline__ float wave_sum(float v) {
#pragma unroll
    for (int o = 1; o < 64; o <<= 1) v += __shfl_xor(v, o);
    return v;
}
#define XB_TMO      128
#define XB_XCNT(j)  (256  + 64 * (j))
#define XB_XSUB(j)  (1280 + 64 * (j))
#define XB_XGEN(j)  (2304 + 64 * (j))
#define XB_TOP      3328
#define XB_TOPGEN   3392
#define XCD_BAR_WORDS 3456
#define XB_SPIN_CAP (1u << 18)

__device__ __forceinline__ unsigned xb_ld(unsigned* p)              { return __hip_atomic_load(p, __ATOMIC_RELAXED, __HIP_MEMORY_SCOPE_AGENT); }
__device__ __forceinline__ unsigned xb_add(unsigned* p, unsigned v) { return __hip_atomic_fetch_add(p, v, __ATOMIC_RELAXED, __HIP_MEMORY_SCOPE_AGENT); }
__device__ __forceinline__ unsigned xb_xcc_id() { return (unsigned)__builtin_amdgcn_s_getreg((3 << 11) | 20) & 0xFu; }
#define XB_SPIN(cond, bar) do { unsigned _sp = 0; while (cond) { __builtin_amdgcn_s_sleep(1); \
    if ((++_sp & 255u) == 0u) { if (xb_ld(&(bar)[XB_TMO])) break; if (_sp > XB_SPIN_CAP) { atomicAdd(&(bar)[XB_TMO], 1u); break; } } } } while (0)

struct XcdBarrier {
    unsigned* bar; unsigned x;
    volatile LAS unsigned* st;
};

__device__ __forceinline__ XcdBarrier xcd_barrier_post(unsigned* bar, volatile LAS unsigned* st, int kw) {
    XcdBarrier b; b.bar = bar; b.x = xb_xcc_id(); b.st = st;
    if (ktid(kw) == 0) (void)xb_add(&bar[XB_XCNT(b.x)], 1u);
    return b;
}
__device__ __forceinline__ void xcd_barrier_complete(unsigned* bar, unsigned x, unsigned& nloc, unsigned& nx) {
    const unsigned G = gridDim.x * gridDim.y * gridDim.z;
    unsigned sum, cnt, mine, sp = 0u;
    for (;;) {
        sum = 0u; cnt = 0u; mine = 0u;
#pragma unroll
        for (unsigned j = 0; j < 16; ++j) { const unsigned c = xb_ld(&bar[XB_XCNT(j)]); sum += c; cnt += (c > 0u) ? 1u : 0u; mine = (j == x) ? c : mine; }
        if (sum == G) break;
        __builtin_amdgcn_s_sleep(1);
        if ((++sp & 255u) == 0u) { if (xb_ld(&bar[XB_TMO])) break; if (sp > XB_SPIN_CAP) { atomicAdd(&bar[XB_TMO], 1u); break; } }
    }
    nloc = mine > 0u ? mine : 1u; nx = cnt > 0u ? cnt : 1u;
}

__device__ __forceinline__ void xcd_barrier(const XcdBarrier& b, int kw) {
    asm volatile("s_waitcnt vmcnt(0)" ::: "memory");
    __syncthreads();
    if (ktid(kw) == 0) {
        unsigned* bar = b.bar;
        __builtin_amdgcn_s_waitcnt(0);
        unsigned nloc = b.st[0], nx = b.st[1];
        if (nloc == 0u) { xcd_barrier_complete(bar, b.x, nloc, nx); b.st[0] = nloc; b.st[1] = nx; }
        const unsigned old = xb_add(&bar[XB_XSUB(b.x)], 1u);
        const unsigned gen = old / nloc;
        if (old + 1u == (gen + 1u) * nloc) {
            __builtin_amdgcn_fence(__ATOMIC_RELEASE, "agent");
            asm volatile("s_waitcnt vmcnt(0)" ::: "memory");
            const unsigned og = xb_add(&bar[XB_TOP], 1u);
            const unsigned tg = og / nx;
            if (og + 1u == (tg + 1u) * nx) xb_add(&bar[XB_TOPGEN], 1u);
            else XB_SPIN(xb_ld(&bar[XB_TOPGEN]) == tg, bar);
            __builtin_amdgcn_fence(__ATOMIC_ACQUIRE, "agent");
            xb_add(&bar[XB_XGEN(b.x)], 1u);
            asm volatile("s_waitcnt vmcnt(0)" ::: "memory");
        } else {
            XB_SPIN(xb_ld(&bar[XB_XGEN(b.x)]) == gen, bar);
            __builtin_amdgcn_fence(__ATOMIC_ACQUIRE, "agent");
            asm volatile("s_waitcnt vmcnt(0)" ::: "memory");
        }
    }
    __syncthreads();
}

namespace pg8 {
#define PG8_LAS __attribute__((address_space(3)))
typedef unsigned short bf16_t;
typedef short bf16x8 __attribute__((ext_vector_type(8)));
typedef float f32x4 __attribute__((ext_vector_type(4)));
typedef unsigned u32x4 __attribute__((ext_vector_type(4)));
typedef int i32x4 __attribute__((ext_vector_type(4)));
typedef int i32x8 __attribute__((ext_vector_type(8)));
constexpr int BM = 256, BK = 64, HALF = 128, HTB = HALF * BK * 2  , STAGE_BYTES = 8 * HTB, NXCD = 8, WGM = 8;

__host__ __device__ __forceinline__ int lds_byte(int r, int c) { const int st = (r >> 4) * 2 + (c >> 5), rr = r & 15, cc = c & 31, ob = rr * 64 + cc * 2; return st * 1024 + (ob ^ (((ob >> 9) & 1) << 5)); }
__host__ __device__ __forceinline__ void stage_rc(int b, int& R, int& C) { const int st = b / 1024, sb = b % 1024, swz = sb ^ (((sb >> 9) & 1) << 5); R = (st >> 1) * 16 + swz / 64; C = (st & 1) * 32 + (swz % 64) / 2; }
__host__ __device__ __forceinline__ int perm32(int rho) { const int n = rho >> 4, i = rho & 15; return 8 * (i >> 2) + 4 * n + (i & 3); }

struct Unit { int pm, pn; };
struct Gemm { const bf16_t* A; const bf16_t* Bt; int M, N, K; };

struct StaticOrder {
    int nM, nN, nwg, G, c;
    __host__ __device__ void init(int M, int N, int G_, int c_) { nM = M / BM; nN = N / BM; nwg = nM * nN; G = G_; c = c_; }
    __host__ __device__ bool next(int i, Unit& u) const {
        const long L = (long)i * G + c; if (L >= nwg) return false;
        int wgid = (int)L; { const int q = nwg / NXCD, r = nwg % NXCD, xcd = wgid % NXCD, off = wgid / NXCD; wgid = (xcd < r ? xcd * (q + 1) : r * (q + 1) + (xcd - r) * q) + off; }
        const int nig = WGM * nN, gid = wgid / nig, fm = gid * WGM, gsz = (nM - fm) < WGM ? (nM - fm) : WGM;
        u.pm = fm + ((wgid % nig) % gsz); u.pn = (wgid % nig) / gsz; return true;
    }
    __device__ __forceinline__ void a_ready(const Unit&) const {}
    __device__ __forceinline__ void done(const Unit&) const {}
};


__device__ __forceinline__ unsigned cvt_pk_bf16(float lo, float hi) { unsigned r; asm volatile("v_cvt_pk_bf16_f32 %0, %1, %2" : "=v"(r) : "v"(lo), "v"(hi)); return r; }

struct EpiPlainI8 {
    static constexpr bool PERM = true, AFTER_DRAIN = false;
    bf16_t* O; int ldc; const float* rs; const float* cs;
    __device__ __forceinline__ void operator()(const f32x4 (&acc)[2][2][4][2], const Unit& u, int wr, int wc, int fr_, int fq_) const {
        int le; asm volatile("v_mbcnt_lo_u32_b32 %0, -1, 0\n\tv_mbcnt_hi_u32_b32 %0, -1, %0" : "=v"(le)); const int fr = le & 15, fq = le >> 4;
        const int row0 = u.pm * BM + wr * 64 + fr, col0 = u.pn * BM + wc * 32 + 8 * fq;
        f32x4 cv[2][2];
#pragma unroll
        for (int bj = 0; bj < 2; ++bj)
#pragma unroll
            for (int n = 0; n < 2; ++n) cv[bj][n] = *(const f32x4*)(cs + col0 + bj * HALF + n * 4);
#pragma unroll
        for (int ai = 0; ai < 2; ++ai)
#pragma unroll
            for (int m = 0; m < 4; ++m) { const int row = row0 + ai * HALF + m * 16; bf16_t* rowp = O + (size_t)row * ldc + col0; const float sc = rs[row];
#pragma unroll
                for (int bj = 0; bj < 2; ++bj) { const f32x4 v0 = acc[ai][bj][m][0] * sc * cv[bj][0], v1 = acc[ai][bj][m][1] * sc * cv[bj][1];
                    u32x4 w; w.x = cvt_pk_bf16(v0[0], v0[1]); w.y = cvt_pk_bf16(v0[2], v0[3]); w.z = cvt_pk_bf16(v1[0], v1[1]); w.w = cvt_pk_bf16(v1[2], v1[3]);
                    *(u32x4*)(rowp + bj * HALF) = w; } }
    }
};
template <bool SCALED>
struct EpiProj {
    static constexpr bool PERM = true, AFTER_DRAIN = false;
    bf16_t* Q;
    int cat0; const float* rs; const float* cs;
    __device__ __forceinline__ void operator()(const f32x4 (&acc)[2][2][4][2], const Unit& u, int wr, int wc, int fr_, int fq_) const {
        int fr = fr_, fq = fq_;
        if constexpr (SCALED) { int le; asm volatile("v_mbcnt_lo_u32_b32 %0, -1, 0\n\tv_mbcnt_hi_u32_b32 %0, -1, %0" : "=v"(le)); fr = le & 15; fq = le >> 4; }
        const int row0 = u.pm * BM + wr * 64 + fr; const int cat = cat0 + (u.pn >> 2), pnl = u.pn & 3;
        bf16_t* basep = Q + (size_t)cat * ((size_t)16 << 20);
        const bool headmajor = cat < 3, dogelu = cat == 4;
#pragma unroll
        for (int ai = 0; ai < 2; ++ai)
#pragma unroll
            for (int m = 0; m < 4; ++m) { const int row = row0 + ai * HALF + m * 16; const int b = row >> 12, s = row & 4095; float sc = 1.f; if constexpr (SCALED) sc = rs[row];
#pragma unroll
                for (int bj = 0; bj < 2; ++bj) { f32x4 v0 = acc[ai][bj][m][0], v1 = acc[ai][bj][m][1];
                    if constexpr (SCALED) { const float* cp = cs + u.pn * BM + bj * HALF + wc * 32 + 8 * fq; v0 *= sc * *(const f32x4*)cp; v1 *= sc * *(const f32x4*)(cp + 4); }
                    const int colt = pnl * BM + bj * HALF + wc * 32 + 8 * fq;
                    const int head = colt >> 7, d = colt & 127;
                    const size_t offA = ((size_t)((b * 8 + head) * 4096 + s)) * 128 + d, offB = (size_t)row * 1024 + colt;
                    bf16_t* dst = basep + (headmajor ? offA : offB);
                    if (dogelu) {
#pragma unroll
                        for (int e = 0; e < 4; ++e) { v0[e] = gelu_tanh(v0[e]); v1[e] = gelu_tanh(v1[e]); } }
                    u32x4 w; w.x = cvt_pk_bf16(v0[0], v0[1]); w.y = cvt_pk_bf16(v0[2], v0[3]); w.z = cvt_pk_bf16(v1[0], v1[1]); w.w = cvt_pk_bf16(v1[2], v1[3]);
                    *(u32x4*)dst = w; } }
    }
};
struct EpiRes {
    static constexpr bool PERM = true, AFTER_DRAIN = false;
    const float* base; bf16_t* out; int ldc; const float* gate; int gstride; const float* rs; const float* cs;
    __device__ __forceinline__ void operator()(const f32x4 (&acc)[2][2][4][2], const Unit& u, int wr, int wc, int fr, int fq) const {
        const int row0 = u.pm * BM + wr * 64 + fr, col0 = u.pn * BM + wc * 32 + 8 * fq;
        const int b = (u.pm * BM) >> 12;
        f32x4 gv[2][2];
#pragma unroll
        for (int bj = 0; bj < 2; ++bj)
#pragma unroll
            for (int n = 0; n < 2; ++n) gv[bj][n] = *(const f32x4*)(gate + (size_t)b * gstride + col0 + bj * HALF + n * 4) * *(const f32x4*)(cs + col0 + bj * HALF + n * 4);
#pragma unroll
        for (int ai = 0; ai < 2; ++ai)
#pragma unroll
            for (int m = 0; m < 4; ++m) { const size_t off = (size_t)(row0 + ai * HALF + m * 16) * ldc + col0; const float sr = rs[row0 + ai * HALF + m * 16];
#pragma unroll
                for (int bj = 0; bj < 2; ++bj) { const f32x4 b0 = *(const f32x4*)(base + off + bj * HALF), b1 = *(const f32x4*)(base + off + bj * HALF + 4);
                    const f32x4 v0 = b0 + gv[bj][0] * (acc[ai][bj][m][0] * sr), v1 = b1 + gv[bj][1] * (acc[ai][bj][m][1] * sr);
                    u32x4 w; w.x = cvt_pk_bf16(v0[0], v0[1]); w.y = cvt_pk_bf16(v0[2], v0[3]); w.z = cvt_pk_bf16(v1[0], v1[1]); w.w = cvt_pk_bf16(v1[2], v1[3]);
                    *(u32x4*)(out + off + bj * HALF) = w; } }
    }
};

template <class Epi, class Sched, bool ALIGN_EPI = false, bool SP2 = false, bool I8 = false>
__device__ __forceinline__ void gemm_phase(PG8_LAS unsigned char* lds, const Gemm g, const Sched& S, const Epi& E, const int kw) {
    const int tid = ktid(kw), wid = kw, lane = tid & 63, wr = wid >> 2, wc = wid & 3, fr = lane & 15, fq = lane >> 4;
    const int K = g.K, nt = K / BK;
    unsigned voffA[2], voffB[2];
#pragma unroll
    for (int i = 0; i < 2; ++i) { int R, C; stage_rc(tid * 16 + i * 8192, R, C); const int Rb = Epi::PERM ? ((R & ~31) + perm32(R & 31)) : R;
        voffA[i] = (unsigned)(R * K + C) * 2u; voffB[i] = (unsigned)(Rb * K + C) * 2u; }
    const size_t kstep = (size_t)(BK * 2);
    const size_t hstep = (size_t)HALF * K * 2;
    const size_t tstep = 2 * hstep;
    const unsigned ldsw = (unsigned)wid * 1024u;
    const int aoff = lds_byte(wr * 64 + fr, fq * 8), boff = lds_byte(wc * 32 + fr, fq * 8);
#define PG8_SA(b, h) (((b) * 2 + (h)) * HTB)
#define PG8_SB(b, h) ((4 + (b) * 2 + (h)) * HTB)
#define PG8_STAGE(bufoff, gbase, voff) do { _Pragma("unroll") for (int _i = 0; _i < 2; ++_i) \
        __builtin_amdgcn_global_load_lds((const unsigned*)((const char*)(gbase) + (voff)[_i]), (PG8_LAS unsigned*)(lds + (bufoff) + ldsw + _i * 8192), 16, 0, 0); } while (0)
#define PG8_LDA(dst, b, h) do { _Pragma("unroll") for (int m = 0; m < 4; ++m) _Pragma("unroll") for (int k = 0; k < 2; ++k) dst[m][k] = *(const PG8_LAS bf16x8*)(lds + PG8_SA(b, h) + aoff + m * 2048 + k * 1024); } while (0)
#define PG8_LDB(dst, b, h) do { _Pragma("unroll") for (int n = 0; n < 2; ++n) _Pragma("unroll") for (int k = 0; k < 2; ++k) dst[n][k] = *(const PG8_LAS bf16x8*)(lds + PG8_SB(b, h) + boff + n * 2048 + k * 1024); } while (0)
#define PG8_MMA(ai, bj, At, Bt) do { __builtin_amdgcn_s_setprio(1); _Pragma("unroll") for (int m = 0; m < 4; ++m) _Pragma("unroll") for (int n = 0; n < 2; ++n) { \
        if constexpr (I8) { _Pragma("unroll") for (int k = 0; k < 2; ++k) acc[ai][bj][m][n] = __builtin_bit_cast(f32x4, __builtin_amdgcn_mfma_i32_16x16x64_i8(__builtin_bit_cast(i32x4, Bt[n][k]), __builtin_bit_cast(i32x4, At[m][k]), __builtin_bit_cast(i32x4, acc[ai][bj][m][n]), 0, 0, 0)); } \
        else { _Pragma("unroll") for (int k = 0; k < 2; ++k) acc[ai][bj][m][n] = __builtin_amdgcn_mfma_f32_16x16x32_bf16(Bt[n][k], At[m][k], acc[ai][bj][m][n], 0, 0, 0); } } \
        __builtin_amdgcn_s_setprio(0); } while (0)
#define PG8_WAIT_V(n) asm volatile("s_waitcnt vmcnt(" #n ")" ::: "memory")
#define PG8_WAIT_L(n) asm volatile("s_waitcnt lgkmcnt(" #n ")" ::: "memory")
#define PG8_BAR __builtin_amdgcn_s_barrier()
#define PG8_SCHED __builtin_amdgcn_sched_barrier(0)
    Unit cur, nxt; int ui = 0;
    if (!S.next(0, cur)) return;
    f32x4 acc[2][2][4][2];
#pragma unroll
    for (int a = 0; a < 2; ++a)
#pragma unroll
        for (int b = 0; b < 2; ++b)
#pragma unroll
            for (int m = 0; m < 4; ++m)
#pragma unroll
                for (int n = 0; n < 2; ++n) acc[a][b][m][n] = (f32x4){0.f, 0.f, 0.f, 0.f};
    bf16x8 At[4][2], B0[2][2], B1[2][2];
    const char* cA = (const char*)g.A + (size_t)cur.pm * tstep; const char* cB = (const char*)g.Bt + (size_t)cur.pn * tstep;
    S.a_ready(cur);
    if constexpr (SP2) {
        PG8_STAGE(PG8_SB(0, 0), cB, voffB); PG8_STAGE(PG8_SB(0, 1), cB + hstep, voffB); PG8_STAGE(PG8_SA(0, 0), cA, voffA); PG8_STAGE(PG8_SA(0, 1), cA + hstep, voffA);
        if (wr == 1) PG8_BAR;
        PG8_WAIT_V(2); PG8_BAR;
        PG8_STAGE(PG8_SB(1, 0), cB + kstep, voffB); PG8_STAGE(PG8_SA(1, 0), cA + kstep, voffA); PG8_STAGE(PG8_SB(1, 1), cB + hstep + kstep, voffB);
        PG8_WAIT_V(6); PG8_BAR;
    } else {
        PG8_STAGE(PG8_SB(0, 0), cB, voffB); PG8_STAGE(PG8_SA(0, 0), cA, voffA); PG8_STAGE(PG8_SB(0, 1), cB + hstep, voffB); PG8_STAGE(PG8_SA(0, 1), cA + hstep, voffA);
        if (wr == 1) PG8_BAR;
        PG8_WAIT_V(4); PG8_BAR;
        PG8_STAGE(PG8_SB(1, 0), cB + kstep, voffB); PG8_STAGE(PG8_SA(1, 0), cA + kstep, voffA); PG8_STAGE(PG8_SB(1, 1), cB + hstep + kstep, voffB);
        PG8_WAIT_V(6); PG8_BAR;
    }
    for (;;) {
        const bool has_next = S.next(ui + 1, nxt);
        const char* nA = has_next ? (const char*)g.A + (size_t)nxt.pm * tstep : cA; const char* nB = has_next ? (const char*)g.Bt + (size_t)nxt.pn * tstep : cB;
        for (int t = 0; t < nt; t += 2) {
            const bool last = (t == nt - 2);
            const char* a1 = cA + (size_t)(t + 1) * kstep;
            const char* a2 = last ? nA : cA + (size_t)(t + 2) * kstep; const char* b2 = last ? nB : cB + (size_t)(t + 2) * kstep;
            const char* a3 = a2 + kstep; const char* b3 = b2 + kstep;
            if (last && has_next) S.a_ready(nxt);
            if constexpr (SP2) {
            PG8_LDB(B0, 0, 0); PG8_LDB(B1, 0, 1); PG8_SCHED; PG8_LDA(At, 0, 0); PG8_STAGE(PG8_SA(1, 1), a1 + hstep, voffA);
            PG8_WAIT_V(8); PG8_WAIT_L(0); PG8_BAR; PG8_MMA(0, 0, At, B0); PG8_MMA(0, 1, At, B1); PG8_BAR; PG8_SCHED;
            PG8_LDA(At, 0, 1); PG8_STAGE(PG8_SB(0, 0), b2, voffB); PG8_STAGE(PG8_SB(0, 1), b2 + hstep, voffB); PG8_STAGE(PG8_SA(0, 0), a2, voffA);
            PG8_WAIT_V(8); PG8_WAIT_L(0); PG8_BAR; PG8_MMA(1, 0, At, B0); PG8_MMA(1, 1, At, B1); PG8_BAR; PG8_SCHED;
            PG8_LDB(B0, 1, 0); PG8_LDB(B1, 1, 1); PG8_SCHED; PG8_LDA(At, 1, 0); PG8_STAGE(PG8_SA(0, 1), a2 + hstep, voffA);
            PG8_WAIT_V(8); PG8_WAIT_L(0); PG8_BAR; PG8_MMA(0, 0, At, B0); PG8_MMA(0, 1, At, B1); PG8_BAR; PG8_SCHED;
            PG8_LDA(At, 1, 1); PG8_STAGE(PG8_SB(1, 0), b3, voffB); PG8_STAGE(PG8_SB(1, 1), b3 + hstep, voffB); PG8_STAGE(PG8_SA(1, 0), a3, voffA);
            PG8_WAIT_V(8); PG8_WAIT_L(0); PG8_BAR; PG8_MMA(1, 0, At, B0); PG8_MMA(1, 1, At, B1); PG8_BAR; PG8_SCHED;
            } else {
            PG8_LDB(B0, 0, 0); PG8_SCHED; PG8_LDA(At, 0, 0); PG8_STAGE(PG8_SA(1, 1), a1 + hstep, voffA);
            PG8_WAIT_L(8); PG8_BAR; PG8_WAIT_L(0); PG8_MMA(0, 0, At, B0); PG8_BAR; PG8_SCHED;
            PG8_LDB(B1, 0, 1); PG8_STAGE(PG8_SB(0, 0), b2, voffB);
            PG8_BAR; PG8_WAIT_L(0); PG8_MMA(0, 1, At, B1); PG8_BAR;
            PG8_LDA(At, 0, 1); PG8_STAGE(PG8_SA(0, 0), a2, voffA);
            PG8_BAR; PG8_WAIT_L(0); PG8_MMA(1, 0, At, B0); PG8_BAR; PG8_SCHED;
            PG8_STAGE(PG8_SB(0, 1), b2 + hstep, voffB);
            PG8_WAIT_V(6); PG8_BAR; PG8_MMA(1, 1, At, B1); PG8_BAR;
            PG8_LDB(B0, 1, 0); PG8_SCHED; PG8_LDA(At, 1, 0); PG8_STAGE(PG8_SA(0, 1), a2 + hstep, voffA);
            PG8_WAIT_L(8); PG8_BAR; PG8_WAIT_L(0); PG8_MMA(0, 0, At, B0); PG8_BAR; PG8_SCHED;
            PG8_LDB(B1, 1, 1); PG8_STAGE(PG8_SB(1, 0), b3, voffB);
            PG8_BAR; PG8_WAIT_L(0); PG8_MMA(0, 1, At, B1); PG8_BAR;
            PG8_LDA(At, 1, 1); PG8_STAGE(PG8_SA(1, 0), a3, voffA);
            PG8_BAR; PG8_WAIT_L(0); PG8_MMA(1, 0, At, B0); PG8_BAR; PG8_SCHED;
            PG8_STAGE(PG8_SB(1, 1), b3 + hstep, voffB);
            PG8_WAIT_V(6); PG8_BAR; PG8_MMA(1, 1, At, B1); PG8_BAR;
            }
        }
        if constexpr (I8) {
            _Pragma("unroll") for (int a = 0; a < 2; ++a) _Pragma("unroll") for (int b = 0; b < 2; ++b) _Pragma("unroll") for (int m = 0; m < 4; ++m) _Pragma("unroll") for (int n = 0; n < 2; ++n)
                acc[a][b][m][n] = __builtin_convertvector(__builtin_bit_cast(i32x4, acc[a][b][m][n]), f32x4); }
        if constexpr (ALIGN_EPI) { if (wr == 0) PG8_BAR; }
        if constexpr (!Epi::AFTER_DRAIN) { E(acc, cur, wr, wc, fr, fq); S.done(cur); }
        if (!has_next) break;
#pragma unroll
        for (int a = 0; a < 2; ++a)
#pragma unroll
            for (int b = 0; b < 2; ++b)
#pragma unroll
                for (int m = 0; m < 4; ++m)
#pragma unroll
                    for (int n = 0; n < 2; ++n) acc[a][b][m][n] = (f32x4){0.f, 0.f, 0.f, 0.f};
        cur = nxt; cA = nA; cB = nB; ++ui;
        if constexpr (ALIGN_EPI) { if (wr == 1) PG8_BAR; }
    }
    PG8_WAIT_V(0);
    if constexpr (!ALIGN_EPI) { if (wr == 0) PG8_BAR; }
    PG8_BAR;
    if constexpr (Epi::AFTER_DRAIN) { E.fused(acc, cur, wr, wc, fr, fq, lds, wid, lane); S.done(cur); }
#undef PG8_SA
#undef PG8_SB
#undef PG8_STAGE
#undef PG8_LDA
#undef PG8_LDB
#undef PG8_MMA
#undef PG8_WAIT_V
#undef PG8_WAIT_L
#undef PG8_BAR
#undef PG8_SCHED
}
}

namespace att {
typedef unsigned short bf16;
typedef short bf16x8 __attribute__((ext_vector_type(8)));
typedef short s16x4 __attribute__((ext_vector_type(4)));
typedef float f32x16 __attribute__((ext_vector_type(16)));
typedef float f32x4 __attribute__((ext_vector_type(4)));
typedef unsigned u32x4 __attribute__((ext_vector_type(4)));
template <class A, class Bt> struct same_t { static constexpr bool v = false; };
template <class A> struct same_t<A, A> { static constexpr bool v = true; };
constexpr int D = 128;
constexpr float THR = 8.f;
constexpr bool WSKIP = false;
constexpr float SCALE = 0.08838834764831845f;
constexpr int NW = 8, QBLK = 32, KVBLK = 64, QB = NW * QBLK;
constexpr int SHM_V = KVBLK * D * 2, SHM_K = KVBLK * D * 2;
constexpr int LDS_BIAS = 2 * SHM_V + 2 * SHM_K + NW * 64 * 4;
constexpr int LDS_BYTES = LDS_BIAS + 4096 * 4;
constexpr int OP = 2048;
#define KSWZ(row, colB) ((row) * 256 + ((colB) ^ (((row) & 7) << 4)))
#define SBAR() __builtin_amdgcn_sched_barrier(0)
__device__ __forceinline__ int v_st(int k, int c) { const int kk = (k & ~0xC) | ((k & 4) << 1) | ((k & 8) >> 1); return ((kk >> 3) * 4 + (c >> 5)) * 512 + ((kk & 7) * 32 + (c & 31)) * 2; }
__device__ __forceinline__ int v_rd_base(int lane) { return ((lane & 3) << 3) | (((lane >> 2) & 3) << 6) | (((lane >> 4) & 1) << 5) | (((lane >> 5) & 1) << 8); }
constexpr int v_rd_off(int d0, int ks, int half) { return d0 * 512 + ks * 4096 + half * 2048; }
__device__ __forceinline__ int crow(int r, int hi) { return (r & 3) + 8 * (r >> 2) + 4 * hi; }
__device__ __forceinline__ unsigned cvtpk(float lo, float hi) {
    unsigned r; asm volatile("v_cvt_pk_bf16_f32 %0, %1, %2" : "=v"(r) : "v"(lo), "v"(hi)); return r;
}
__device__ __forceinline__ bf16x8 pack8(f32x4 a, f32x4 b) {
    u32x4 w = {cvtpk(a[0], a[1]), cvtpk(a[2], a[3]), cvtpk(b[0], b[1]), cvtpk(b[2], b[3])};
    return *reinterpret_cast<bf16x8*>(&w);
}
template <class T> __device__ __forceinline__ bf16x8 load8(const T* p) {
    if constexpr (same_t<T, float>::v) { return pack8(*(const f32x4*)p, *(const f32x4*)(p + 4)); }
    else { return *reinterpret_cast<const bf16x8*>(p); }
}
__device__ __forceinline__ void mask_tile(f32x16& p0, f32x16& p1, int dq, unsigned W) {
    const float NEG = -__builtin_inff();
#pragma unroll
    for (int r = 0; r < 16; ++r) {
        const int c = (r & 3) + 8 * (r >> 2);
        if ((unsigned)(dq - c) >= W) p0[r] = NEG;
        if ((unsigned)(dq - c - 32) >= W) p1[r] = NEG;
    }
}
__device__ __forceinline__ void partialSM(f32x16& p0, f32x16& p1, float& m_reg, float& mn, float& alpha) {
    float pmax = p0[0]; for (int r = 1; r < 16; ++r) pmax = fmaxf(pmax, p0[r]); for (int r = 0; r < 16; ++r) pmax = fmaxf(pmax, p1[r]);
    { auto rr = __builtin_amdgcn_permlane32_swap(__float_as_uint(pmax), __float_as_uint(pmax), false, false);
      pmax = fmaxf(__uint_as_float(rr[0]), __uint_as_float(rr[1])); }
    constexpr float C2 = 1.4426950408889634f * SCALE;
    if (__builtin_expect(__all((pmax - m_reg) * SCALE <= THR), 1)) { mn = m_reg; alpha = 1.f; }
    else { mn = fmaxf(m_reg, pmax); alpha = __builtin_amdgcn_exp2f((m_reg - mn) * C2); m_reg = mn; }
    const float mnL = -mn * C2;
    for (int r = 0; r < 16; ++r) p0[r] = fmaf(p0[r], C2, mnL); for (int r = 0; r < 16; ++r) p1[r] = fmaf(p1[r], C2, mnL);
    for (int r = 0; r < 16; ++r) p0[r] = __builtin_amdgcn_exp2f(p0[r]);
}
__device__ __forceinline__ void finishSM(f32x16& p0, f32x16& p1, float alpha, float& l_reg, bf16x8& pa0, bf16x8& pa1, bf16x8& pa2, bf16x8& pa3) {
    for (int r = 0; r < 16; ++r) p1[r] = __builtin_amdgcn_exp2f(p1[r]);
    float ps = 0; for (int r = 0; r < 16; ++r) ps += p0[r]; for (int r = 0; r < 16; ++r) ps += p1[r];
    { auto rr = __builtin_amdgcn_permlane32_swap(__float_as_uint(ps), __float_as_uint(ps), false, false);
      ps = __uint_as_float(rr[0]) + __uint_as_float(rr[1]); }
    l_reg = l_reg * alpha + ps;
#define PK4(P, B_, OUT) do { unsigned a0 = cvtpk(P[B_+0], P[B_+1]), a1 = cvtpk(P[B_+2], P[B_+3]);                          \
        unsigned b0 = cvtpk(P[B_+4], P[B_+5]), b1 = cvtpk(P[B_+6], P[B_+7]);                                             \
        auto r0 = __builtin_amdgcn_permlane32_swap(a0, b0, false, false); auto r1 = __builtin_amdgcn_permlane32_swap(a1, b1, false, false); \
        u32x4 w = {r0[0], r1[0], r0[1], r1[1]}; OUT = *reinterpret_cast<bf16x8*>(&w); } while (0)
    PK4(p0, 0, pa0); PK4(p0, 8, pa1); PK4(p1, 0, pa2); PK4(p1, 8, pa3);
#undef PK4
}
template <int KB, bool SK>
__device__ __forceinline__ void qkt(f32x16& p0, f32x16& p1, const char* K_lds, int r32, int hi, const bf16x8* qr, bool act, const float* bl) {
    if (SK && !act) { const float NEG = -__builtin_inff();
#pragma unroll
        for (int r = 0; r < 16; ++r) { p0[r] = NEG; p1[r] = NEG; } return; }
    { const f32x4 c0 = *(const f32x4*)(bl), c1 = *(const f32x4*)(bl + 8), c2 = *(const f32x4*)(bl + 16), c3 = *(const f32x4*)(bl + 24);
      const f32x4 e0 = *(const f32x4*)(bl + 32), e1 = *(const f32x4*)(bl + 40), e2 = *(const f32x4*)(bl + 48), e3 = *(const f32x4*)(bl + 56);
      p0 = (f32x16){c0[0], c0[1], c0[2], c0[3], c1[0], c1[1], c1[2], c1[3], c2[0], c2[1], c2[2], c2[3], c3[0], c3[1], c3[2], c3[3]};
      p1 = (f32x16){e0[0], e0[1], e0[2], e0[3], e1[0], e1[1], e1[2], e1[3], e2[0], e2[1], e2[2], e2[3], e3[0], e3[1], e3[2], e3[3]}; }
    const char* kb[4];
#pragma unroll
    for (int dd = 0; dd < 4; ++dd) kb[dd] = K_lds + KB * SHM_K + KSWZ(r32, (dd * 16 + hi * 8) * 2);
#pragma unroll
    for (int d0 = 0; d0 < 8; ++d0) { const char* a = kb[d0 & 3] + (d0 >> 2) * 128;
        bf16x8 b0 = *reinterpret_cast<const bf16x8*>(a);
        bf16x8 b1 = *reinterpret_cast<const bf16x8*>(a + 32 * 256);
        p0 = __builtin_amdgcn_mfma_f32_32x32x16_bf16(b0, qr[d0], p0, 0, 0, 0);
        p1 = __builtin_amdgcn_mfma_f32_32x32x16_bf16(b1, qr[d0], p1, 0, 0, 0); }
}
template <int VB, bool SK>
__device__ __forceinline__ void pv_tile(f32x16* o, int vb0, bf16x8 pa0, bf16x8 pa1, bf16x8 pa2, bf16x8 pa3, bool act) {
    if (SK && !act) return;
#define TRRD(dst, off) asm volatile("ds_read_b64_tr_b16 %0, %1 offset:%2" : "=&v"(dst) : "v"(vb0), "i"(off) : "memory")
#define PV_D0(d0) do { s16x4 l0, l1, l2, l3, h0, h1, h2, h3; constexpr int b_ = VB * SHM_V + v_rd_off(d0, 0, 0);     \
        TRRD(l0, b_); TRRD(h0, b_ + 2048); TRRD(l1, b_ + 4096); TRRD(h1, b_ + 6144); TRRD(l2, b_ + 8192); TRRD(h2, b_ + 10240); TRRD(l3, b_ + 12288); TRRD(h3, b_ + 14336); \
        asm volatile("s_waitcnt lgkmcnt(0)" ::: "memory"); SBAR();                 \
        o[d0] = __builtin_amdgcn_mfma_f32_32x32x16_bf16(pa0, (bf16x8){l0[0], l0[1], l0[2], l0[3], h0[0], h0[1], h0[2], h0[3]}, o[d0], 0, 0, 0);   \
        o[d0] = __builtin_amdgcn_mfma_f32_32x32x16_bf16(pa1, (bf16x8){l1[0], l1[1], l1[2], l1[3], h1[0], h1[1], h1[2], h1[3]}, o[d0], 0, 0, 0);   \
        o[d0] = __builtin_amdgcn_mfma_f32_32x32x16_bf16(pa2, (bf16x8){l2[0], l2[1], l2[2], l2[3], h2[0], h2[1], h2[2], h2[3]}, o[d0], 0, 0, 0);   \
        o[d0] = __builtin_amdgcn_mfma_f32_32x32x16_bf16(pa3, (bf16x8){l3[0], l3[1], l3[2], l3[3], h3[0], h3[1], h3[2], h3[3]}, o[d0], 0, 0, 0); } while (0)
    PV_D0(0); PV_D0(1); PV_D0(2); PV_D0(3);
#undef PV_D0
#undef TRRD
}


struct BlockRef { unsigned char* ws; int bh, P0, jbot, jtop, far;
    __device__ __forceinline__ const bf16* Qp() const { return (const bf16*)(ws + WS_Q) + ((size_t)bh * SEQ + P0) * D; }
    __device__ __forceinline__ const bf16* Kp() const { return (const bf16*)(ws + WS_K) + (size_t)bh * SEQ * D; }
    __device__ __forceinline__ const bf16* Vp() const { return (const bf16*)(ws + WS_VV) + (size_t)bh * SEQ * D; }
    __device__ __forceinline__ const float* KBp() const { return (const float*)(ws + WS_KB) + (size_t)bh * SEQ; }
    __device__ __forceinline__ int opitch() const { return far ? AW : DM; }
    __device__ __forceinline__ bf16* Op() const { const size_t rowb = (size_t)(bh >> 3) * SEQ + P0; return far ? (bf16*)(ws + WS_OB) + rowb * AW + (bh & 7) * D : (bf16*)(ws + WS_MRG) + rowb * DM + (bh & 7) * D; }
    __device__ __forceinline__ float* LWp() const { const size_t rowb = (size_t)(bh >> 3) * SEQ + P0; return (float*)(ws + WS_LW) + (size_t)far * T * 8 + rowb * 8 + (bh & 7); } };
struct Seam { bf16x8 qr[8]; bf16x8 st_v0, st_v1, st_k0, st_k1; };
#define ROW(p, k0, rr) ((p) + (size_t)((k0) + (rr)) * D + sc)
#define VMW() asm volatile("s_waitcnt vmcnt(0)" ::: "memory")
#define VMWN(n) asm volatile("s_waitcnt vmcnt(%0)" :: "i"(n) : "memory")
#define SLOAD_H(Kp, Vp, k0) do { S.st_v0 = load8<bf16>(ROW(Vp, k0, sr)); S.st_v1 = load8<bf16>(ROW(Vp, k0, 32 + sr));              \
                         S.st_k0 = load8<bf16>(ROW(Kp, k0, sr)); S.st_k1 = load8<bf16>(ROW(Kp, k0, 32 + sr)); } while (0)
#define SWRITE_HK(bf) do { *(bf16x8*)(K_lds + (bf) * SHM_K + kws) = S.st_k0; *(bf16x8*)(K_lds + (bf) * SHM_K + kws + 32 * 256) = S.st_k1; } while (0)
#define SWRITE_HV(bf) do { *(bf16x8*)(V_lds + (bf) * SHM_V + vst0) = S.st_v0; *(bf16x8*)(V_lds + (bf) * SHM_V + vst1) = S.st_v1; } while (0)
#define SWRITE_H(bf) do { SWRITE_HV(bf); SWRITE_HK(bf); } while (0)
__device__ __forceinline__ void fox_prime(const BlockRef& cur, char* lds, Seam& S, int kw) {
    const int tid = ktid(kw), wid = kw, lane = tid & 63, r32 = lane & 31, hi = lane >> 5;
    const int sr = tid >> 4, sc = (tid & 15) * 8, kws = KSWZ(sr, sc * 2); char* K_lds = lds + 2 * SHM_V;
#pragma unroll
    for (int d0 = 0; d0 < 8; ++d0) S.qr[d0] = load8<bf16>(cur.Qp() + (size_t)(wid * QBLK + r32) * D + d0 * 16 + hi * 8);
    SLOAD_H(cur.Kp(), cur.Vp(), cur.jtop * KVBLK); VMW(); SWRITE_HK(0);
    __syncthreads();
}
__device__ __forceinline__ void fox_block(const BlockRef& cur, const BlockRef& nxt, char* lds, Seam& S, int kw) {
    constexpr bool SK = false; constexpr unsigned W = 0x7fffffffu;
    const int tid = ktid(kw), wid = kw, lane = tid & 63, r32 = lane & 31, hi = lane >> 5;
    const int JH = cur.jtop;
    const int NT = JH + 1 - cur.jbot;
    const int qlo = cur.P0 + wid * QBLK, qm = qlo + r32 - 4 * hi;
    char* V_lds = lds; char* K_lds = lds + 2 * SHM_V;
    float* ws = (float*)(lds + 2 * SHM_V + 2 * SHM_K) + wid * 64; float* li_l = ws, * al_l = ws + 32;
    float m_reg = -1e30f, l_reg = 0; f32x16 o[4] = {};
    const int sr = tid >> 4, sc = (tid & 15) * 8, vst0 = v_st(sr, sc), vst1 = v_st(32 + sr, sc), kws = KSWZ(sr, sc * 2);
    const int vb0 = (int)(uintptr_t)V_lds + v_rd_base(lane);
    const bf16* Kh = cur.Kp(); const bf16* Vh = cur.Vp();
    float* bias_l = (float*)(lds + LDS_BIAS);
    { const int nb4 = 16 * (cur.jtop + 1); int i0 = ktid(kw); asm volatile("" : "+v"(i0));
      for (int i = 16 * cur.jbot + i0; i < nb4; i += NW * 64) ((f32x4*)bias_l)[i] = ((const f32x4*)cur.KBp())[i]; }
    __syncthreads();
    const float* KBh = bias_l + 4 * hi;
#define RESC(a) do { if (__any((a) < 1.f)) { if (hi == 0) al_l[r32] = (a); asm volatile("s_waitcnt lgkmcnt(0)" ::: "memory");              \
                     for (int d_ = 0; d_ < 4; ++d_) for (int r = 0; r < 16; ++r) o[d_][r] *= al_l[crow(r, hi)]; } } while (0)
#define KBASE(t) ((JH - (t)) * KVBLK)
#define ACT(t) true
#define MASKT(P0_, P1_, t) do { const int kb_ = KBASE(t); if (kb_ + KVBLK - 1 > qlo) mask_tile(P0_, P1_, qm - kb_, W); } while (0)
    constexpr int NQL = 8;
#define SEAM_K0() do { VMWN(NQL); SWRITE_HK(0); SBAR(); } while (0)
    f32x16 pA0, pA1, pB0, pB1; float mnA, mnB, alA, alB; bf16x8 pa0, pa1, pa2, pa3;
    SWRITE_HV(0); SBAR();
    if (NT > 1) { SLOAD_H(Kh, Vh, KBASE(1)); }
    SBAR(); qkt<0, SK>(pA0, pA1, K_lds, r32, hi, S.qr, ACT(0), KBh + KBASE(0));
    MASKT(pA0, pA1, 0); partialSM(pA0, pA1, m_reg, mnA, alA);
    if (NT > 1) { VMW(); SWRITE_H(1); }
    __syncthreads();
#define HALF_STEP(PX0, PX1, mnX, alX, PY0, PY1, alY, t, KB, VB, SB) do {                                                      \
        SBAR(); qkt<KB, SK>(PX0, PX1, K_lds, r32, hi, S.qr, ACT(t), KBh + KBASE(t));                                             \
        finishSM(PY0, PY1, alY, l_reg, pa0, pa1, pa2, pa3); SBAR();                                                           \
        if ((t) + 1 < NT) { SLOAD_H(Kh, Vh, KBASE((t) + 1)); SBAR(); }                                                        \
        pv_tile<VB, SK>(o, vb0, pa0, pa1, pa2, pa3, ACT((t) - 1)); MASKT(PX0, PX1, (t)); partialSM(PX0, PX1, m_reg, mnX, alX);  \
        __syncthreads();                                                                                                      \
        if ((t) + 1 < NT) { VMW(); SWRITE_H(SB); }                                                                            \
        RESC(alX); __syncthreads(); } while (0)
    for (int t = 1; t + 1 < NT; t += 2) {
        HALF_STEP(pB0, pB1, mnB, alB, pA0, pA1, alA, t, 1, 0, 0);
        HALF_STEP(pA0, pA1, mnA, alA, pB0, pB1, alB, t + 1, 0, 1, 1);
    }
    const bool even = (NT & 1) == 0;
    if (even) { SBAR(); qkt<1, SK>(pB0, pB1, K_lds, r32, hi, S.qr, ACT(NT - 1), KBh + KBASE(NT - 1)); SBAR(); }
    SLOAD_H(nxt.Kp(), nxt.Vp(), nxt.jtop * KVBLK); SBAR();
#pragma unroll
    for (int d0 = 0; d0 < 8; ++d0) S.qr[d0] = load8<bf16>(nxt.Qp() + (size_t)(wid * QBLK + r32) * D + d0 * 16 + hi * 8);
    SBAR();
    finishSM(pA0, pA1, alA, l_reg, pa0, pa1, pa2, pa3); SBAR();
    pv_tile<0, SK>(o, vb0, pa0, pa1, pa2, pa3, true);
    if (even) { MASKT(pB0, pB1, NT - 1); partialSM(pB0, pB1, m_reg, mnB, alB); __syncthreads(); RESC(alB);
        finishSM(pB0, pB1, alB, l_reg, pa0, pa1, pa2, pa3); SBAR(); pv_tile<1, SK>(o, vb0, pa0, pa1, pa2, pa3, true); }
    SBAR(); SEAM_K0();
    { int le = ktid(kw); asm volatile("" : "+v"(le)); const int r32e = le & 31, hie = (le >> 5) & 1;
      if (hie == 0) { li_l[r32e] = l_reg; cur.LWp()[(size_t)(wid * QBLK + r32e) * 8] = m_reg * (1.4426950408889634f * SCALE) + __builtin_amdgcn_logf(l_reg); }
      asm volatile("s_waitcnt lgkmcnt(0)" ::: "memory");
      float rli[16];
#pragma unroll
      for (int r = 0; r < 16; ++r) rli[r] = __builtin_amdgcn_rcpf(li_l[crow(r, hie)]);
      bf16* Ow = cur.Op() + (size_t)(wid * QBLK) * cur.opitch() + r32e;
#pragma unroll
      for (int r = 0; r < 16; ++r) { const int orow = crow(r, hie);
#pragma unroll
          for (int d0 = 0; d0 < 4; ++d0) { const float v = o[d0][r] * rli[r];
              const float vn = __shfl_xor(v, 1);
              if ((r32e & 1) == 0) *(unsigned*)(Ow + (size_t)orow * cur.opitch() + d0 * 32) = cvtpk(v, vn); } } }
    __syncthreads();
#undef RESC
#undef KBASE
#undef ACT
#undef MASKT
#undef SEAM_K0
#undef HALF_STEP
}
#undef ROW
#undef VMW
#undef VMWN
#undef SLOAD_H
#undef SWRITE_HK
#undef SWRITE_HV
#undef SWRITE_H
#undef KSWZ
#undef SBAR
}

struct Frame {
    LAS unsigned char* lds;
    volatile LAS unsigned* MISC;
    gu32* ctl;
    int tid, lane, wave;
    int vcu, G, bx;
    const float *x, *c, *w_ada, *b_ada, *g_mix, *w_in, *b_f, *conv_w, *conv_b, *lru_w_a, *lru_b_a, *lru_w_x, *lru_b_x, *lru_lambda,
                *g_attn_out, *g_lru_out, *w_out, *g_ffn, *peer_w_q, *peer_k1, *peer_k2, *peer_u, *peer_v, *g_final;
    float* out;
    float *MOD, *LF, *KB, *SUMM, *EW, *USC, *VSC, *PD, *Y, *ACT, *PART;
    int* EIDX;
    bf16_t *WLRU, *K1, *K2, *WIN, *WOUT, *WQ, *H, *Q, *K, *VV, *QP, *LX, *GLY, *MRG, *HL, *AC, *X1, *OB;
    float* LW; unsigned* SPLIT;
    unsigned char *U8, *V8, *H8, *M8, *WQ8, *WIN8, *WOUT8;
    float *RS, *CS, *WF;
};

struct Args { const float* in[24]; float* out; unsigned char* ws; int ph_lo, ph_hi, li, pad; };

__device__ __forceinline__ void p0_transpose_item(const float* W, int ldw, int K, bf16_t* WT, int kb, int scol, int drow, const float* gk, LAS float* scr, int lane, unsigned* cmax = nullptr) {
    const int k0 = 64 * kb;
    float wv[32];
#pragma unroll
    for (int i = 0; i < 32; ++i) { const int kk = 2 * i + (lane >> 5); wv[i] = W[(size_t)(k0 + kk) * ldw + scol + (lane & 31)]; }
    if (gk) {
#pragma unroll
        for (int i = 0; i < 32; ++i) wv[i] *= gk[k0 + 2 * i + (lane >> 5)]; }
    if (cmax) { float am = 0.f;
#pragma unroll
        for (int i = 0; i < 32; ++i) am = fmaxf(am, fabsf(wv[i]));
        am = fmaxf(am, __shfl_xor(am, 32));
        if (lane < 32) __hip_atomic_fetch_max(cmax + drow + lane, fbits(am), RLX_AGENT); }
#pragma unroll
    for (int i = 0; i < 32; ++i) { const int kk = 2 * i + (lane >> 5); scr[kk * 33 + (lane & 31)] = wv[i]; }
    LDS_WAIT(); asm volatile("" ::: "memory");
    const int c = lane & 7;
#pragma unroll
    for (int j = 0; j < 4; ++j) { const int n = (lane >> 3) + 8 * j; const LAS float* s = scr + (8 * c) * 33 + n;
        v4u o; o.x = pk2(s[0 * 33], s[1 * 33]); o.y = pk2(s[2 * 33], s[3 * 33]); o.z = pk2(s[4 * 33], s[5 * 33]); o.w = pk2(s[6 * 33], s[7 * 33]);
        *(GAS v4u*)(WT + (size_t)(drow + n) * K + k0 + 8 * c) = o; }
    LDS_WAIT(); asm volatile("" ::: "memory");
}
__device__ __forceinline__ void p0_convert(const float* src, bf16_t* dst, size_t n8, size_t gt, size_t ngt) {
#pragma unroll 4
    for (size_t i = gt; i < n8; i += ngt) { const f32x4 a = *(const GAS f32x4*)(src + i * 8), b = *(const GAS f32x4*)(src + i * 8 + 4);
        v4u o; o.x = pk2(a[0], a[1]); o.y = pk2(a[2], a[3]); o.z = pk2(b[0], b[1]); o.w = pk2(b[2], b[3]); *(GAS v4u*)(dst + i * 8) = o; }
}
template <int PARTS>
__device__ __forceinline__ void p0_prologue(Frame& F) {
    if (PARTS & 1) {
        LAS float* scs = (LAS float*)F.lds;
        LAS float* red = scs + 4 * 2048;
        for (int i = F.tid; i < 4 * DM; i += NTHR) { const float cv = F.c[i]; scs[i] = cv * sigmoidf_(cv); }
        __syncthreads();
        for (int cb = F.bx; cb < 192; cb += F.G) {
            const int cq = F.tid & 15, rl = F.tid >> 4;
            { float acc[4][4];
#pragma unroll
              for (int b = 0; b < 4; ++b)
#pragma unroll
                  for (int j = 0; j < 4; ++j) acc[b][j] = 0.f;
              const float* wp = F.w_ada + (size_t)rl * NADA + cb * 64 + cq * 4;
#pragma unroll 16
              for (int r = rl; r < DM; r += 32, wp += (size_t)32 * NADA) { const f32x4 w = *(const GAS f32x4*)wp;
#pragma unroll
                  for (int b = 0; b < 4; ++b) { const float sv = scs[b * DM + r]; acc[b][0] += sv * w[0]; acc[b][1] += sv * w[1]; acc[b][2] += sv * w[2]; acc[b][3] += sv * w[3]; } }
#pragma unroll
              for (int b = 0; b < 4; ++b)
#pragma unroll
                  for (int j = 0; j < 4; ++j) red[rl * 256 + cq * 16 + b * 4 + j] = acc[b][j]; }
            __syncthreads();
            if (F.tid < 256) { float sm = 0.f;
                for (int r = 0; r < 32; ++r) sm += red[r * 256 + F.tid];
                const int q = F.tid >> 4, b = (F.tid >> 2) & 3, j = F.tid & 3, col = cb * 64 + q * 4 + j;
                F.MOD[b * NADA + col] = sm + F.b_ada[col]; }
            __syncthreads();
        }
        __syncthreads();
    }
    if (PARTS & 2) {
        LAS float* scr = (LAS float*)(F.lds + F.wave * 16384);
        const int gw = F.vcu * NWAVES + F.wave, NGW = F.G * NWAVES;
        constexpr int I_IN1 = 32 * 96, I_IN2 = 32 * 64, I_SQ = 32 * 64, I_LRU = 16 * 8;
        constexpr int NITEMS = I_IN1 + I_IN2 + 2 * I_SQ + I_LRU;
        for (int it = gw; it < NITEMS; it += NGW) {
            int r = it;
            unsigned* cmx = (unsigned*)F.ctl + CW_CMAX;
            if (r < I_IN1) { const int kb = r / 96, nb = r % 96; p0_transpose_item(F.w_in, INC, DM, F.WIN, kb, 32 * nb, 32 * nb, nullptr, scr, F.lane, cmx + 4096); continue; } r -= I_IN1;
            if (r < I_IN2) { const int kb = r / 64, nb = r % 64; p0_transpose_item(F.w_in, INC, DM, F.WIN, kb, OFF_LX + 32 * nb, OFF_F + 32 * nb, nullptr, scr, F.lane, cmx + 4096); continue; } r -= I_IN2;
            if (r < I_SQ) { const int kb = r / 64, nb = r % 64; const float* gk = kb < 16 ? F.g_attn_out : F.g_lru_out - AW;
                p0_transpose_item(F.w_out, DM, DM, F.WOUT, kb, 32 * nb, 32 * nb, gk, scr, F.lane, cmx + 2048); continue; } r -= I_SQ;
            if (r < I_SQ) { const int kb = r / 64, nb = r % 64; p0_transpose_item(F.peer_w_q, DM, DM, F.WQ, kb, 32 * nb, 32 * nb, nullptr, scr, F.lane, (unsigned*)F.ctl + CW_CMAX); continue; } r -= I_SQ;
            { const int mat = r >> 3, sub = r & 7, n = mat >> 1, which = mat & 1, kb = sub >> 2, nb = sub & 3;
              const float* src = (which ? F.lru_w_x : F.lru_w_a) + (size_t)n * LBD * LBD;
              p0_transpose_item(src, LBD, LBD, F.WLRU + (size_t)(n * 256 + which * 128) * LBD, kb, 32 * nb, 32 * nb, nullptr, scr, F.lane); }
        }
    }
    if (PARTS & 4) {
        if (F.bx == F.G - 1) { for (int i = F.tid; i < 8 * DM; i += NTHR) { const int k = i >> 3, j = i & 7; F.WF[j * DM + k] = F.w_in[(size_t)k * INC + OFF_F + j]; } }
        const size_t gt = (size_t)F.vcu * NTHR + F.tid, ngt = (size_t)F.G * NTHR;
        p0_convert(F.peer_k1, F.K1, (size_t)PH * PNK * 128 / 8, gt, ngt);
        p0_convert(F.peer_k2, F.K2, (size_t)PH * PNK * 128 / 8, gt, ngt);
    }
}

__device__ __forceinline__ unsigned pk_i8(float a, float b, float c, float d) {
    const int ia = (int)__builtin_rintf(a), ib = (int)__builtin_rintf(b), ic = (int)__builtin_rintf(c), id = (int)__builtin_rintf(d);
    return (unsigned)(ia & 255) | ((unsigned)(ib & 255) << 8) | ((unsigned)(ic & 255) << 16) | ((unsigned)id << 24);
}
constexpr int CONV_P8_ROWS = NEXP;
__device__ __forceinline__ void conv_row_load(Frame& F, int r, f32x4 (&v)[8]) {
    const bool isv = r >= NEXP; const int rr = isv ? r - NEXP : r;
    const GAS f32x4* src = (const GAS f32x4*)((isv ? F.peer_v : F.peer_u) + (size_t)rr * DM) + F.lane;
#pragma unroll
    for (int j = 0; j < 8; ++j) v[j] = src[64 * j];
}
__device__ __forceinline__ void conv_row_finish(Frame& F, int r, const f32x4 (&v)[8]) {
    const bool isv = r >= NEXP; const int rr = isv ? r - NEXP : r; float am = 0.f;
#pragma unroll
    for (int j = 0; j < 8; ++j) am = fmaxf(am, fmaxf(fmaxf(fabsf(v[j][0]), fabsf(v[j][1])), fmaxf(fabsf(v[j][2]), fabsf(v[j][3]))));
#pragma unroll
    for (int o = 1; o < 64; o <<= 1) am = fmaxf(am, __shfl_xor(am, o));
    const float sc = am > 0.f ? 127.f / am : 1.f;
    GAS unsigned char* dstb = (GAS unsigned char*)(isv ? F.V8 : F.U8) + (size_t)(F.lane >> 5) * ((size_t)NEXP * 128) + (size_t)rr * 128 + (F.lane & 31) * 4;
#pragma unroll
    for (int j = 0; j < 8; ++j) *(GAS unsigned*)(dstb + (size_t)(2 * j) * ((size_t)NEXP * 128)) = pk_i8(v[j][0] * sc, v[j][1] * sc, v[j][2] * sc, v[j][3] * sc);
    if (F.lane == 0) (isv ? F.VSC : F.USC)[rr] = am > 0.f ? am * (1.f / 127.f) : 1.f;
}
__device__ __forceinline__ void conv_item(Frame& F, int item) {
#pragma unroll 1
    for (int pr = 0; pr < 2; ++pr) {
        f32x4 v[2][8]; float am[2] = {0.f, 0.f};
#pragma unroll
        for (int u = 0; u < 2; ++u) { const int r = item * 32 + F.wave * 4 + pr * 2 + u; const bool isv = r >= NEXP; const int rr = isv ? r - NEXP : r;
            const GAS f32x4* src = (const GAS f32x4*)((isv ? F.peer_v : F.peer_u) + (size_t)rr * DM) + F.lane;
#pragma unroll
            for (int j = 0; j < 8; ++j) v[u][j] = src[64 * j]; }
#pragma unroll
        for (int u = 0; u < 2; ++u) { const int r = item * 32 + F.wave * 4 + pr * 2 + u; const bool isv = r >= NEXP; const int rr = isv ? r - NEXP : r;
#pragma unroll
            for (int j = 0; j < 8; ++j) am[u] = fmaxf(am[u], fmaxf(fmaxf(fabsf(v[u][j][0]), fabsf(v[u][j][1])), fmaxf(fabsf(v[u][j][2]), fabsf(v[u][j][3]))));
#pragma unroll
            for (int o = 1; o < 64; o <<= 1) am[u] = fmaxf(am[u], __shfl_xor(am[u], o));
            const float sc = am[u] > 0.f ? 416.f / am[u] : 1.f;
            GAS unsigned char* dstb = (GAS unsigned char*)(isv ? F.V8 : F.U8) + (size_t)(F.lane >> 5) * ((size_t)NEXP * 128) + (size_t)rr * 128 + (F.lane & 31) * 4;
#pragma unroll
            for (int j = 0; j < 8; ++j) { int pk = 0; pk = __builtin_amdgcn_cvt_pk_fp8_f32(v[u][j][0] * sc, v[u][j][1] * sc, pk, false); pk = __builtin_amdgcn_cvt_pk_fp8_f32(v[u][j][2] * sc, v[u][j][3] * sc, pk, true);
                *(GAS unsigned*)(dstb + (size_t)(2 * j) * ((size_t)NEXP * 128)) = (unsigned)pk; }
            if (F.lane == 0) (isv ? F.VSC : F.USC)[rr] = am[u] > 0.f ? am[u] / 416.f : 1.f; }
    }
}

__device__ __forceinline__ void quant_rows_i8(Frame& F, const bf16_t* WT, unsigned char* W8, float* cs, const unsigned* cmax, int rows) {
    const int gw = F.vcu * NWAVES + F.wave, NGW = F.G * NWAVES;
    for (int r = gw; r < rows; r += NGW) {
        const float am = bitsf(cmax[r]) * 1.004f;
        const float s8 = am > 0.f ? 127.f / am : 1.f;
        const GAS v4u* src = (const GAS v4u*)(WT + (size_t)r * DM) + F.lane; GAS v2u* dst = (GAS v2u*)(W8 + (size_t)r * DM) + F.lane;
#pragma unroll
        for (int j = 0; j < 4; ++j) { const v4u w = src[64 * j];
            v2u o; o.x = pk_i8(bf_lo(w.x) * s8, bf_hi(w.x) * s8, bf_lo(w.y) * s8, bf_hi(w.y) * s8); o.y = pk_i8(bf_lo(w.z) * s8, bf_hi(w.z) * s8, bf_lo(w.w) * s8, bf_hi(w.w) * s8);
            dst[64 * j] = o; }
        if (F.lane == 0) cs[r] = am > 0.f ? am * (1.f / 127.f) : 1.f;
    }
}

template <bool WITH_F, bool I8OUT = false, bool BF16OUT = true>
__device__ __forceinline__ void p_modnorm(Frame& F, const float* xin, const float* g, int off_sh, int off_sc) {
    LAS float* gsv = (LAS float*)F.lds;
    LAS float* shv = gsv + DM;
    LAS float* wfT = shv + DM;
    if (WITH_F) { for (int i = F.tid; i < 2 * DM; i += NTHR) ((LAS f32x4*)wfT)[i] = ((const GAS f32x4*)F.WF)[i]; }
    for (int rb = F.bx; rb < T / 64; rb += F.G) {
        const int b = rb >> 6;
        __syncthreads();
        for (int k = F.tid; k < DM; k += NTHR) { gsv[k] = g[k] * (1.f + F.MOD[b * NADA + off_sc + k]); shv[k] = F.MOD[b * NADA + off_sh + k]; }
        __syncthreads();
        for (int i = 0; i < 8; ++i) {
            const int row = rb * 64 + F.wave * 8 + i;
            f32x4 v[8]; float ss = 0.f;
            if (WITH_F) { const GAS f32x4* xr = (const GAS f32x4*)(xin + (size_t)row * DM) + F.lane;
#pragma unroll
                for (int j = 0; j < 8; ++j) v[j] = xr[64 * j]; }
            else { const GAS v2u* xr = (const GAS v2u*)(F.X1 + (size_t)row * DM) + F.lane;
#pragma unroll
                for (int j = 0; j < 8; ++j) { const v2u w = xr[64 * j]; v[j] = (f32x4){bf_lo(w.x), bf_hi(w.x), bf_lo(w.y), bf_hi(w.y)}; } }
#pragma unroll
            for (int j = 0; j < 8; ++j) ss += (v[j][0] * v[j][0] + v[j][1] * v[j][1]) + (v[j][2] * v[j][2] + v[j][3] * v[j][3]);
            const float rstd = __builtin_amdgcn_rsqf(wave_sum(ss) * (1.f / DM) + EPS);
#pragma unroll
            for (int j = 0; j < 8; ++j) { const f32x4 gg = ((const LAS f32x4*)gsv)[F.lane + 64 * j], sh = ((const LAS f32x4*)shv)[F.lane + 64 * j]; v[j] = v[j] * rstd * gg + sh; }
            if (BF16OUT) { GAS v2u* o8 = (GAS v2u*)(F.H + (size_t)row * DM) + F.lane;
#pragma unroll
                for (int j = 0; j < 8; ++j) { v2u w; w.x = pk2(v[j][0], v[j][1]); w.y = pk2(v[j][2], v[j][3]); o8[64 * j] = w; } }
            if (I8OUT) {
                float am = 0.f;
#pragma unroll
                for (int j = 0; j < 8; ++j) am = fmaxf(am, fmaxf(fmaxf(fabsf(v[j][0]), fabsf(v[j][1])), fmaxf(fabsf(v[j][2]), fabsf(v[j][3]))));
#pragma unroll
                for (int o = 1; o < 64; o <<= 1) am = fmaxf(am, __shfl_xor(am, o));
                const float s8 = am > 0.f ? 127.f / am : 1.f;
                GAS unsigned* o4 = (GAS unsigned*)(F.H8 + (size_t)row * DM) + F.lane;
#pragma unroll
                for (int j = 0; j < 8; ++j) o4[64 * j] = pk_i8(v[j][0] * s8, v[j][1] * s8, v[j][2] * s8, v[j][3] * s8);
                if (F.lane == 0) F.RS[row] = am > 0.f ? am * (1.f / 127.f) : 1.f;
            }
            if (WITH_F) {
                float fa[8];
#pragma unroll
                for (int jj = 0; jj < 8; ++jj) { float a = 0.f;
#pragma unroll
                    for (int j = 0; j < 8; ++j) { const f32x4 w = ((const LAS f32x4*)(wfT + jj * DM))[F.lane + 64 * j]; a += (v[j][0] * w[0] + v[j][1] * w[1]) + (v[j][2] * w[2] + v[j][3] * w[3]); }
                    fa[jj] = a; __builtin_amdgcn_sched_barrier(0); }
                const bool c5 = (F.lane & 32) != 0, c4 = (F.lane & 16) != 0, c3 = (F.lane & 8) != 0;
                float f4[4], f2[2], mine;
#pragma unroll
                for (int q = 0; q < 4; ++q) { const float keep = c5 ? fa[4 + q] : fa[q], send = c5 ? fa[q] : fa[4 + q]; f4[q] = keep + __shfl_xor(send, 32); }
#pragma unroll
                for (int q = 0; q < 2; ++q) { const float keep = c4 ? f4[2 + q] : f4[q], send = c4 ? f4[q] : f4[2 + q]; f2[q] = keep + __shfl_xor(send, 16); }
                { const float keep = c3 ? f2[1] : f2[0], send = c3 ? f2[0] : f2[1]; mine = keep + __shfl_xor(send, 8); }
                mine += __shfl_xor(mine, 4); mine += __shfl_xor(mine, 2); mine += __shfl_xor(mine, 1);
                if ((F.lane & 7) == 0) { const int jf = F.lane >> 3; const float z = mine + F.b_f[jf]; const float lf = fminf(z, 0.f) - log1pf(fexp(-fabsf(z)));
                    F.LF[(size_t)(b * NH + jf) * SEQ + (row & (SEQ - 1))] = lf; }
            }
        }
    }
}

__device__ __forceinline__ void p2_cumsum(Frame& F) {
    LAS float* wt = (LAS float*)F.lds;
    for (int bh = F.bx; bh < BATCH * NH; bh += F.G) {
        const float* src = F.LF + (size_t)bh * SEQ + F.tid * 8;
        const f32x4 a = *(const GAS f32x4*)src, b = *(const GAS f32x4*)(src + 4);
        float p[8]; p[0] = a[0]; p[1] = p[0] + a[1]; p[2] = p[1] + a[2]; p[3] = p[2] + a[3]; p[4] = p[3] + b[0]; p[5] = p[4] + b[1]; p[6] = p[5] + b[2]; p[7] = p[6] + b[3];
        float incl = p[7];
#pragma unroll
        for (int o = 1; o < 64; o <<= 1) { const float n = __shfl_up(incl, o); if (F.lane >= o) incl += n; }
        __syncthreads();
        if (F.lane == 63) wt[F.wave] = incl;
        __syncthreads();
        float off = incl - p[7];
        for (int w = 0; w < F.wave; ++w) off += wt[w];
        constexpr float NIS = -1.0f / 0.08838834764831845f;
        f32x4 o0, o1;
        o0[0] = (off + p[0]) * NIS; o0[1] = (off + p[1]) * NIS; o0[2] = (off + p[2]) * NIS; o0[3] = (off + p[3]) * NIS;
        o1[0] = (off + p[4]) * NIS; o1[1] = (off + p[5]) * NIS; o1[2] = (off + p[6]) * NIS; o1[3] = (off + p[7]) * NIS;
        float* dst = F.KB + (size_t)bh * SEQ + F.tid * 8;
        *(GAS f32x4*)dst = o0; *(GAS f32x4*)(dst + 4) = o1;
    }
}

constexpr int L_LX = 0, L_A = 17408, L_XC = 34816, L_SA = 68608, L_SUM = 102400, L_CW = 106496, L_END = 126976;
constexpr int XS = 132;
typedef float f32x4v __attribute__((ext_vector_type(4)));
#define LDS_BAR() do { asm volatile("s_waitcnt lgkmcnt(0)" ::: "memory"); __builtin_amdgcn_s_barrier(); asm volatile("" ::: "memory"); } while (0)
__device__ __forceinline__ void lru_unit(Frame& F, int b, int chunk) {
    LAS unsigned char* L = F.lds;
    int tid_ = ktid(F.wave); asm volatile("" : "+v"(tid_));
    const int tid = tid_, lane = tid_ & 63, wave = F.wave;
    const int s0 = chunk * 64; const size_t row0 = (size_t)b * SEQ + s0;
    __syncthreads();
    LAS float* cwl = (LAS float*)(L + L_CW);
    for (int i = tid; i < 5 * LW; i += NTHR) cwl[i] = i < 4 * LW ? F.conv_w[i] : F.conv_b[i - 4 * LW];
    const int r16 = lane & 15, g4 = lane >> 4;
    v4u lxv[3]; bf16x8 bwa[4], bwx[4]; float pba, pbx, plam;
#define LRU_LOAD_LX(nn) do { _Pragma("unroll") for (int q_ = 0; q_ < 3; ++q_) { const int idx = tid + q_ * NTHR; const int r = idx >> 4, c8 = idx & 15; const int s = s0 - 3 + r; \
        v4u val = {0u, 0u, 0u, 0u}; if (idx < 67 * 16 && s >= 0) val = *(const GAS v4u*)(F.LX + ((size_t)b * SEQ + s) * LW + (nn) * LBD + c8 * 8); lxv[q_] = val; } } while (0)
#define LRU_LOAD_W(nn) do { const bf16_t* wa_ = F.WLRU + ((size_t)((nn) * 256 + 16 * wave + r16)) * LBD + 8 * g4; const bf16_t* wx_ = wa_ + (size_t)128 * LBD; \
        _Pragma("unroll") for (int ks = 0; ks < 4; ++ks) { bwa[ks] = *(const GAS bf16x8*)(wa_ + 32 * ks); bwx[ks] = *(const GAS bf16x8*)(wx_ + 32 * ks); } \
        const int chg_ = (nn) * LBD + 16 * wave + r16; pba = F.lru_b_a[chg_]; pbx = F.lru_b_x[chg_]; plam = F.lru_lambda[chg_]; } while (0)
    LRU_LOAD_LX(0); LRU_LOAD_W(0);
    for (int n = 0; n < NLB; ++n) {
        const int nn = n + 1 < NLB ? n + 1 : n;
        LDS_BAR();
#pragma unroll
        for (int q = 0; q < 3; ++q) { const int idx = tid + q * NTHR; if (idx < 67 * 16) *(LAS v4u*)(L + L_LX + (idx >> 4) * 256 + (idx & 15) * 16) = lxv[q]; }
        LDS_BAR();
        LRU_LOAD_LX(nn);
        { const int tok = tid >> 3, c16 = tid & 7; const int chg = n * LBD + c16 * 16;
          float xc[16];
#pragma unroll
          for (int e = 0; e < 16; e += 4) { const f32x4 cb = *(const LAS f32x4*)(cwl + 4 * LW + chg + e); xc[e] = cb[0]; xc[e + 1] = cb[1]; xc[e + 2] = cb[2]; xc[e + 3] = cb[3]; }
#pragma unroll
          for (int k = 0; k < 4; ++k) {
              const v4u x0 = *(const LAS v4u*)(L + L_LX + (tok + k) * 256 + c16 * 32), x1 = *(const LAS v4u*)(L + L_LX + (tok + k) * 256 + c16 * 32 + 16);
              const unsigned xd[8] = {x0.x, x0.y, x0.z, x0.w, x1.x, x1.y, x1.z, x1.w};
#pragma unroll
              for (int e = 0; e < 16; e += 4) { const f32x4 w = *(const LAS f32x4*)(cwl + k * LW + chg + e);
                  xc[e] += w[0] * bf_lo(xd[e / 2]); xc[e + 1] += w[1] * bf_hi(xd[e / 2]); xc[e + 2] += w[2] * bf_lo(xd[e / 2 + 1]); xc[e + 3] += w[3] * bf_hi(xd[e / 2 + 1]); } }
          v4u a0, a1; a0.x = pk2(xc[0], xc[1]); a0.y = pk2(xc[2], xc[3]); a0.z = pk2(xc[4], xc[5]); a0.w = pk2(xc[6], xc[7]);
          a1.x = pk2(xc[8], xc[9]); a1.y = pk2(xc[10], xc[11]); a1.z = pk2(xc[12], xc[13]); a1.w = pk2(xc[14], xc[15]);
          *(LAS v4u*)(L + L_A + tok * 272 + c16 * 32) = a0; *(LAS v4u*)(L + L_A + tok * 272 + c16 * 32 + 16) = a1;
          LAS float* xo = (LAS float*)(L + L_XC) + tok * XS + c16 * 16;
#pragma unroll
          for (int e = 0; e < 16; e += 4) *(LAS f32x4*)(xo + e) = (f32x4){xc[e], xc[e + 1], xc[e + 2], xc[e + 3]};
        }
        LDS_BAR();
        f32x4 acc_a[4], acc_x[4];
#pragma unroll
        for (int m = 0; m < 4; ++m) { acc_a[m] = (f32x4){0.f, 0.f, 0.f, 0.f}; acc_x[m] = (f32x4){0.f, 0.f, 0.f, 0.f}; }
#pragma unroll
        for (int ks = 0; ks < 4; ++ks) {
#pragma unroll
            for (int m = 0; m < 4; ++m) { const bf16x8 af = *(const LAS bf16x8*)(L + L_A + (16 * m + r16) * 272 + (32 * ks + 8 * g4) * 2);
                acc_a[m] = __builtin_amdgcn_mfma_f32_16x16x32_bf16(af, bwa[ks], acc_a[m], 0, 0, 0);
                acc_x[m] = __builtin_amdgcn_mfma_f32_16x16x32_bf16(af, bwx[ks], acc_x[m], 0, 0, 0); } }
        const float ba_ = pba, bx_ = pbx; const float sp8 = 8.f * softplusf_(-plam);
        LRU_LOAD_W(nn);
        { const int chl = 16 * wave + r16;
          LAS float* xcp = (LAS float*)(L + L_XC) + chl; LAS float* sap = (LAS float*)(L + L_SA) + chl;
#pragma unroll
          for (int m = 0; m < 4; ++m)
#pragma unroll
              for (int i = 0; i < 4; ++i) { const int tt = 16 * m + 4 * g4 + i;
                  const float rg = sigmoidf_(acc_a[m][i] + ba_), ig = sigmoidf_(acc_x[m][i] + bx_);
                  const float la = -sp8 * rg; const float a = fexp(la); const float x2 = 2.f * la;
                  const float em1 = (x2 > -0.3f) ? x2 * (1.f + x2 * (0.5f + x2 * (0.16666667f + x2 * (0.041666668f + x2 * (0.008333334f + x2 * 0.0013888889f))))) : (fexp(x2) - 1.f);
                  const float bt = __builtin_amdgcn_sqrtf(fmaxf(-em1, 0.f)) * (ig * xcp[tt * XS]);
                  sap[tt * XS] = a; xcp[tt * XS] = bt; } }
        LDS_BAR();
        { const int chl = tid & 127, sub = tid >> 7;
          const LAS float* sap = (const LAS float*)(L + L_SA) + (16 * sub) * XS + chl; const LAS float* sbp = (const LAS float*)(L + L_XC) + (16 * sub) * XS + chl;
          float av[16], bv[16];
#pragma unroll
          for (int j = 0; j < 16; ++j) { av[j] = sap[j * XS]; bv[j] = sbp[j * XS]; }
          float P = 1.f, Hh = 0.f;
#pragma unroll
          for (int j = 0; j < 16; ++j) { Hh = av[j] * Hh + bv[j]; P *= av[j]; }
          LAS f32x2* sm = (LAS f32x2*)(L + L_SUM);
          sm[sub * 128 + chl] = (f32x2){P, Hh};
          LDS_BAR();
          float h = 0.f, cp = 1.f;
          for (int s = 0; s < sub; ++s) { const f32x2 ph = sm[s * 128 + chl]; h = ph[0] * h + ph[1]; cp *= ph[0]; }
          bf16_t* hl = F.HL + (row0 + 16 * sub) * LW + n * LBD + chl; bf16_t* ac = F.AC + (row0 + 16 * sub) * LW + n * LBD + chl;
#pragma unroll
          for (int j = 0; j < 16; ++j) { h = av[j] * h + bv[j]; cp *= av[j]; hl[(size_t)j * LW] = (bf16_t)f2bf(h); ac[(size_t)j * LW] = (bf16_t)f2bf(cp); }
          if (sub == 3) *((GAS f32x2*)F.SUMM + ((size_t)(b * 64 + chunk)) * LW + n * LBD + chl) = (f32x2){cp, h};
        }
    }
}

__device__ __forceinline__ void lru_final(Frame& F, int b, int chunk) {
    LAS float* hin = (LAS float*)F.lds;
    int tid_ = ktid(F.wave); asm volatile("" : "+v"(tid_));
    const int tid = tid_;
    const size_t row0 = (size_t)b * SEQ + chunk * 64;
    __syncthreads();
    { float h0 = 0.f, h1 = 0.f;
      const GAS f32x2* sp = (const GAS f32x2*)F.SUMM + (size_t)(b * 64) * LW + tid;
      for (int c0 = 0; c0 < chunk; c0 += 16) { f32x2 pa[16], pb[16];
#pragma unroll
          for (int q = 0; q < 16; ++q) { const size_t o = (size_t)(c0 + q < chunk ? c0 + q : chunk - 1) * LW; pa[q] = sp[o]; pb[q] = sp[o + NTHR]; }
#pragma unroll
          for (int q = 0; q < 16; ++q) if (c0 + q < chunk) { h0 = pa[q][0] * h0 + pa[q][1]; h1 = pb[q][0] * h1 + pb[q][1]; } }
      hin[tid] = h0; hin[tid + NTHR] = h1; }
    __syncthreads();
    const int tt = tid >> 3, part = tid & 7;
    const bf16_t* hlp = F.HL + (row0 + tt) * LW; const bf16_t* acp = F.AC + (row0 + tt) * LW; const bf16_t* glp = F.GLY + (row0 + tt) * LW;
    bf16_t* rowp = F.MRG + (row0 + tt) * DM;
    const int qb = chunk >> 2; const size_t rowg = row0 + tt;
#define ATT_HALF_PIECE(e_, dst_) do { const int c0_ = ((e_) * 8 + part) * 8, hd_ = (e_) >> 1; v4u a_ = *(const GAS v4u*)(rowp + c0_);                                         \
        if (F.SPLIT[(b * NH + hd_) * (SEQ / 256) + qb]) {                                                                                                                       \
            const float la = F.LW[rowg * 8 + hd_], lb = F.LW[(size_t)T * 8 + rowg * 8 + hd_]; const float mx = fmaxf(la, lb);                                                   \
            const float wa = __builtin_amdgcn_exp2f(la - mx), wb = __builtin_amdgcn_exp2f(lb - mx); const float inv = __builtin_amdgcn_rcpf(wa + wb); const float fa = wa * inv, fb = wb * inv; \
            const v4u fv = *(const GAS v4u*)(F.OB + rowg * AW + c0_); const unsigned da[4] = {a_.x, a_.y, a_.z, a_.w}, db[4] = {fv.x, fv.y, fv.z, fv.w}; unsigned r_[4];           \
            _Pragma("unroll") for (int q = 0; q < 4; ++q) r_[q] = pk2(bf_lo(da[q]) * fa + bf_lo(db[q]) * fb, bf_hi(da[q]) * fa + bf_hi(db[q]) * fb);                            \
            a_.x = r_[0]; a_.y = r_[1]; a_.z = r_[2]; a_.w = r_[3]; }                                                                                                           \
        dst_ = a_; } while (0)
    float sa = 0.f, ama = 0.f;
#pragma unroll
    for (int e = 0; e < 16; ++e) { v4u a; ATT_HALF_PIECE(e, a); const unsigned d[4] = {a.x, a.y, a.z, a.w};
#pragma unroll
        for (int q = 0; q < 4; ++q) { const float lo = bf_lo(d[q]), hi = bf_hi(d[q]); sa += lo * lo + hi * hi; ama = fmaxf(ama, fmaxf(fabsf(lo), fabsf(hi))); } }
    sa += __shfl_xor(sa, 1); sa += __shfl_xor(sa, 2); sa += __shfl_xor(sa, 4);
    const float ra = __builtin_amdgcn_rsqf(sa * (1.f / AW) + EPS);
    __builtin_amdgcn_sched_barrier(0);
    v4u ovl[16]; float ssq = 0.f, aml = 0.f;
#pragma unroll
    for (int e = 0; e < 16; ++e) { const int c0 = (e * 8 + part) * 8;
        const v4u hv = *(const GAS v4u*)(hlp + c0), av = *(const GAS v4u*)(acp + c0), gv = *(const GAS v4u*)(glp + c0);
        const f32x4 c4a = *(const LAS f32x4*)(hin + c0), c4b = *(const LAS f32x4*)(hin + c0 + 4);
        const unsigned hd[4] = {hv.x, hv.y, hv.z, hv.w}, ad[4] = {av.x, av.y, av.z, av.w}, gd[4] = {gv.x, gv.y, gv.z, gv.w};
        const float ci[8] = {c4a[0], c4a[1], c4a[2], c4a[3], c4b[0], c4b[1], c4b[2], c4b[3]}; unsigned r[4];
#pragma unroll
        for (int q = 0; q < 4; ++q) { const float o0 = (bf_lo(hd[q]) + bf_lo(ad[q]) * ci[2 * q]) * bf_lo(gd[q]), o1 = (bf_hi(hd[q]) + bf_hi(ad[q]) * ci[2 * q + 1]) * bf_hi(gd[q]);
            ssq += o0 * o0 + o1 * o1; aml = fmaxf(aml, fmaxf(fabsf(o0), fabsf(o1))); r[q] = pk2(o0, o1); }
        ovl[e].x = r[0]; ovl[e].y = r[1]; ovl[e].z = r[2]; ovl[e].w = r[3]; }
    ssq += __shfl_xor(ssq, 1); ssq += __shfl_xor(ssq, 2); ssq += __shfl_xor(ssq, 4);
    const float rl = __builtin_amdgcn_rsqf(ssq * (1.f / LW) + EPS);
    float am = fmaxf(aml * rl * 1.004f, ama * ra);
    am = fmaxf(am, __shfl_xor(am, 1)); am = fmaxf(am, __shfl_xor(am, 2)); am = fmaxf(am, __shfl_xor(am, 4));
    const float s8 = am > 0.f ? 127.f / am : 1.f; const float rl8 = rl * s8, ra8 = ra * s8;
    unsigned char* row8 = F.M8 + (row0 + tt) * DM;
#pragma unroll
    for (int e = 0; e < 16; ++e) { const int c0 = (e * 8 + part) * 8; const unsigned dl[4] = {ovl[e].x, ovl[e].y, ovl[e].z, ovl[e].w};
        *(GAS v2u*)(row8 + AW + c0) = (v2u){pk_i8(bf_lo(dl[0]) * rl8, bf_hi(dl[0]) * rl8, bf_lo(dl[1]) * rl8, bf_hi(dl[1]) * rl8), pk_i8(bf_lo(dl[2]) * rl8, bf_hi(dl[2]) * rl8, bf_lo(dl[3]) * rl8, bf_hi(dl[3]) * rl8)}; }
    __builtin_amdgcn_sched_barrier(0);
#pragma unroll
    for (int e = 0; e < 16; ++e) { const int c0 = (e * 8 + part) * 8; v4u a; ATT_HALF_PIECE(e, a); const unsigned da[4] = {a.x, a.y, a.z, a.w};
        *(GAS v2u*)(row8 + c0) = (v2u){pk_i8(bf_lo(da[0]) * ra8, bf_hi(da[0]) * ra8, bf_lo(da[1]) * ra8, bf_hi(da[1]) * ra8), pk_i8(bf_lo(da[2]) * ra8, bf_hi(da[2]) * ra8, bf_lo(da[3]) * ra8, bf_hi(da[3]) * ra8)}; }
#undef ATT_HALF_PIECE
    if (part == 0) F.RS[row0 + tt] = am > 0.f ? am * (1.f / 127.f) : 1.f;
}

constexpr float ATT_TH = 24.f;
__device__ __forceinline__ void p3_norms(Frame& F) {
    const int lane = F.lane; const int gw = F.vcu * NWAVES + F.wave, NGW = F.G * NWAVES;
    for (int it = gw; it < 4096; it += NGW) { const bool isq = it >= 2048; const int r64 = it & 2047;
        const bf16_t* rowp = (isq ? F.Q : F.K) + ((size_t)r64 * 64 + lane) * HD; float ss = 0.f;
#pragma unroll
        for (int e = 0; e < 16; ++e) { const v4u v = *(const GAS v4u*)(rowp + 8 * e); const unsigned d[4] = {v.x, v.y, v.z, v.w};
#pragma unroll
            for (int q = 0; q < 4; ++q) { const float lo = bf_lo(d[q]), hi = bf_hi(d[q]); ss += lo * lo + hi * hi; } }
#pragma unroll
        for (int o = 1; o < 64; o <<= 1) ss = fmaxf(ss, __shfl_xor(ss, o));
        if (lane == 0) { unsigned* w = (unsigned*)F.ctl + (isq ? CW_QMAX + (r64 >> 2) : CW_KMAX + (r64 >> 6)); __hip_atomic_fetch_max(w, fbits(ss), RLX_AGENT); }
    }
}
constexpr int ATT_SPLIT_MIN = 24;
struct AttItem { att::BlockRef r; bool valid; };
__device__ __forceinline__ AttItem att_ref(Frame& F, int L) {
    constexpr int NQB = SEQ / att::QB;
    const int qb = NQB - 1 - (L >> 6), bh = L & 31; const bool far = (L & 32) != 0;
    AttItem it; att::BlockRef& r = it.r;
    const int tid_ = ktid(F.wave);
    r.ws = (unsigned char*)F.ctl; r.bh = bh; r.P0 = qb * att::QB; r.far = far ? 1 : 0;
    const float* KB = r.KBp();
    int jlo = 0;
    if (N_LAUNCHES == 1) {
        const float k2 = bitsf(__hip_atomic_load((unsigned*)F.ctl + CW_KMAX + bh, RLX_AGENT)), q2 = bitsf(__hip_atomic_load((unsigned*)F.ctl + CW_QMAX + bh * NQB + qb, RLX_AGENT));
        const float thr = KB[r.P0] - 2.f * __builtin_sqrtf(k2 * q2) * 1.0001f - ATT_TH * (1.0f / 0.08838834764831845f);
        const int j = tid_ & 63; const bool cut = j < (r.P0 >> 6) && KB[64 * j + 63] < thr;
        jlo = __builtin_popcountll(__ballot(cut));
    }
    jlo = __builtin_amdgcn_readfirstlane(jlo);
    const int JH = (r.P0 >> 6) + 3, ntf = JH + 1 - jlo; const bool split = ntf >= ATT_SPLIT_MIN; const int jmid = jlo + (ntf - 4) / 2;
    if (!far) { r.jbot = split ? jmid : jlo; r.jtop = JH; it.valid = true; if (tid_ == 0) F.SPLIT[bh * NQB + qb] = split ? 1u : 0u; }
    else { r.jbot = jlo; r.jtop = jmid - 1; it.valid = split; }
    return it;
}
__device__ __forceinline__ int att_dequeue(Frame& F) {
    if (ktid(F.wave) == 0) F.MISC[16] = __hip_atomic_fetch_add((unsigned*)F.ctl + CW_QUEUE, 1u, RLX_AGENT);
    __syncthreads();
    const int v = (int)F.MISC[16];
    __syncthreads();
    return __builtin_amdgcn_readfirstlane(v);
}
__device__ __forceinline__ int att_next(Frame& F, int total) {
    for (;;) { const int L = att_dequeue(F); if (L >= total) return L; if (att_ref(F, L).valid) return L; }
}
__device__ __forceinline__ int p3_attention(Frame& F, char* lds) {
    constexpr int TOTAL = 2 * BATCH * NH * (SEQ / att::QB);
    int Lc = att_next(F, TOTAL); if (Lc >= TOTAL) return Lc;
    att::Seam S;
    { const AttItem c0 = att_ref(F, Lc); att::fox_prime(c0.r, lds, S, F.wave); }
    for (;;) {
        const int Ln = att_next(F, TOTAL); const bool last = Ln >= TOTAL;
        const AttItem c = att_ref(F, Lc); const AttItem n = att_ref(F, last ? Lc : Ln);
        att::fox_block(c.r, n.r, lds, S, F.wave);
        if (last) return Ln;
        Lc = Ln;
    }
}

template <int N> __device__ __forceinline__ float row_ror(float v) { return __builtin_bit_cast(float, __builtin_amdgcn_update_dpp(0, __builtin_bit_cast(int, v), 0x120 + N, 0xf, 0xf, false)); }
__device__ __forceinline__ float fmax_s(float a, float b) { float r; asm("v_max_f32_e32 %0, %1, %2" : "=v"(r) : "v"(a), "v"(b)); return r; }
__device__ __forceinline__ float fmin_s(float a, float b) { float r; asm("v_min_f32_e32 %0, %1, %2" : "=v"(r) : "v"(a), "v"(b)); return r; }
__device__ __forceinline__ float row_allmax(float v) {
    asm volatile("s_nop 1\n\tv_max_f32_dpp %0, %0, %0 row_ror:8 row_mask:0xf bank_mask:0xf\n\t"
                 "s_nop 1\n\tv_max_f32_dpp %0, %0, %0 row_ror:4 row_mask:0xf bank_mask:0xf\n\t"
                 "s_nop 1\n\tv_max_f32_dpp %0, %0, %0 row_ror:2 row_mask:0xf bank_mask:0xf\n\t"
                 "s_nop 1\n\tv_max_f32_dpp %0, %0, %0 row_ror:1 row_mask:0xf bank_mask:0xf" : "+v"(v));
    return v;
}
__device__ __forceinline__ float row_allsum(float v) { v += row_ror<8>(v); v += row_ror<4>(v); v += row_ror<2>(v); v += row_ror<1>(v); return v; }
#define CE_DESC(a, b) do { const float hi_ = fmax_s(a, b), lo_ = fmin_s(a, b); a = hi_; b = lo_; } while (0)
__device__ __forceinline__ float row_top16(float (&Lv)[8], int r16) {
    CE_DESC(Lv[0], Lv[1]); CE_DESC(Lv[2], Lv[3]); CE_DESC(Lv[4], Lv[5]); CE_DESC(Lv[6], Lv[7]);
    CE_DESC(Lv[0], Lv[2]); CE_DESC(Lv[1], Lv[3]); CE_DESC(Lv[4], Lv[6]); CE_DESC(Lv[5], Lv[7]);
    CE_DESC(Lv[1], Lv[2]); CE_DESC(Lv[5], Lv[6]);
    CE_DESC(Lv[0], Lv[4]); CE_DESC(Lv[1], Lv[5]); CE_DESC(Lv[2], Lv[6]); CE_DESC(Lv[3], Lv[7]);
    CE_DESC(Lv[2], Lv[4]); CE_DESC(Lv[3], Lv[5]);
    CE_DESC(Lv[1], Lv[2]); CE_DESC(Lv[3], Lv[4]); CE_DESC(Lv[5], Lv[6]);
    float res = 0.f; const float NEG = -__builtin_inff();
#pragma unroll
    for (int k = 0; k < 16; ++k) {
        const float m = row_allmax(Lv[0]);
        res = (r16 == k) ? m : res;
        const bool win = (Lv[0] == m);
#pragma unroll
        for (int j = 0; j < 7; ++j) Lv[j] = win ? Lv[j + 1] : Lv[j];
        Lv[7] = win ? NEG : Lv[7];
    }
    return res;
}
__device__ __forceinline__ void p8_topk(Frame& F) {
    LAS unsigned char* L = F.lds;
    const int lane = F.lane, wave = F.wave, r16 = lane & 15, g4 = lane >> 4;
    unsigned ctab;
    { constexpr unsigned CT[16] = {0x03020100u, 0x13121110u, 0x23222120u, 0x33323130u, 0x04424140u, 0x06055150u, 0x08076160u, 0x0a097170u,
                                   0x0d0c0b80u, 0x140f0e90u, 0x171615a0u, 0xffff24b0u, 0xffffffc0u, 0xffffffd0u, 0xffffffe0u, 0xfffffff0u};
      ctab = CT[0];
#pragma unroll
      for (int i = 1; i < 16; ++i) ctab = (r16 == i) ? CT[i] : ctab; }
    for (int grp = F.bx; grp < 256; grp += F.G) {
        const int hd = grp & 7, widx = grp >> 3;
        __syncthreads();
        for (int idx = F.tid; idx < 2 * 128 * 16; idx += NTHR) { const int half = idx >> 11, row = (idx >> 4) & 127, c8 = idx & 15;
            const bf16_t* src = (half ? F.K2 : F.K1) + ((size_t)hd * PNK + row) * 128 + c8 * 8;
            *(LAS v4u*)(L + half * 34816 + row * 272 + c8 * 16) = *(const GAS v4u*)src; }
        __syncthreads();
        for (int it = wave; it < 32; it += NWAVES) {
            const int t0 = widx * 512 + it * 16;
            bf16x8 a1[4], a2[4];
            { const bf16_t* qp = F.QP + (size_t)(t0 + r16) * DM + hd * PQD + 8 * g4;
#pragma unroll
              for (int ks = 0; ks < 4; ++ks) { a1[ks] = *(const GAS bf16x8*)(qp + 32 * ks); a2[ks] = *(const GAS bf16x8*)(qp + 128 + 32 * ks); } }
            f32x4 s1[8], s2[8];
#pragma unroll
            for (int nt = 0; nt < 8; ++nt) { s1[nt] = (f32x4){0.f, 0.f, 0.f, 0.f}; s2[nt] = (f32x4){0.f, 0.f, 0.f, 0.f};
#pragma unroll
                for (int ks = 0; ks < 4; ++ks) {
                    const bf16x8 b1 = *(const LAS bf16x8*)(L + (16 * nt + r16) * 272 + (32 * ks + 8 * g4) * 2);
                    const bf16x8 b2 = *(const LAS bf16x8*)(L + 34816 + (16 * nt + r16) * 272 + (32 * ks + 8 * g4) * 2);
                    s1[nt] = __builtin_amdgcn_mfma_f32_16x16x32_bf16(a1[ks], b1, s1[nt], 0, 0, 0);
                    s2[nt] = __builtin_amdgcn_mfma_f32_16x16x32_bf16(a2[ks], b2, s2[nt], 0, 0, 0); } }
#pragma unroll
            for (int i = 0; i < 4; ++i) {
                f32x4 cv[8]; const int crow = (grp * 32 + it) * 2 + i; const bool cdo = i < 2;
                if (cdo) conv_row_load(F, crow, cv);
                float l1[8], l2[8];
#pragma unroll
                for (int nt = 0; nt < 8; ++nt) {
                    l1[nt] = bitsf((fbits(s1[nt][i]) & ~0x7Fu) | (unsigned)(16 * nt + r16));
                    l2[nt] = bitsf((fbits(s2[nt][i]) & ~0x7Fu) | (unsigned)(16 * nt + r16)); }
                __builtin_amdgcn_sched_barrier(0);
                const float v1 = row_top16(l1, r16); __builtin_amdgcn_sched_barrier(0);
                const float v2 = row_top16(l2, r16); __builtin_amdgcn_sched_barrier(0);
                float cnd[4]; const float NEG = -__builtin_inff();
#pragma unroll
                for (int sl = 0; sl < 4; ++sl) { const unsigned by = (ctab >> (8 * sl)) & 0xFFu;
                    const float w1 = __shfl(v1, (int)(by >> 4), 16), w2 = __shfl(v2, (int)(by & 15u), 16);
                    cnd[sl] = by == 0xFFu ? NEG : bitsf((fbits(w1 + w2) & ~0xFFu) | by); }
                CE_DESC(cnd[0], cnd[1]); CE_DESC(cnd[2], cnd[3]); CE_DESC(cnd[0], cnd[2]); CE_DESC(cnd[1], cnd[3]); CE_DESC(cnd[1], cnd[2]);
                float fin = 0.f;
#pragma unroll
                for (int k = 0; k < 16; ++k) {
                    const float m = row_allmax(cnd[0]);
                    fin = (r16 == k) ? m : fin;
                    const bool win = (cnd[0] == m);
                    cnd[0] = win ? cnd[1] : cnd[0]; cnd[1] = win ? cnd[2] : cnd[1]; cnd[2] = win ? cnd[3] : cnd[2]; cnd[3] = win ? NEG : cnd[3];
                }
                const unsigned fb = __builtin_bit_cast(unsigned, fin); const int ra = (fb >> 4) & 15, rb = fb & 15;
                const float pv1 = __shfl(v1, ra, 16), pv2 = __shfl(v2, rb, 16);
                const int i1 = __builtin_bit_cast(unsigned, pv1) & 0x7F, i2 = __builtin_bit_cast(unsigned, pv2) & 0x7F;
                const float vs = pv1 + pv2;
                const float mx = row_allmax(vs); const float ex = fexp(vs - mx); const float sm = row_allsum(ex);
                const size_t o = (size_t)(t0 + 4 * g4 + i) * NSEL + hd * PTOPK + r16;
                F.EIDX[o] = i1 * PNK + i2; F.EW[o] = ex / sm;
                __builtin_amdgcn_sched_barrier(0);
                if (cdo) conv_row_finish(F, crow, cv);
                __builtin_amdgcn_sched_barrier(0);
            }
        }
    }
}

__device__ __forceinline__ void cvt16(const v4u& r, float (&f)[16]) {
    const unsigned dd[4] = {r.x, r.y, r.z, r.w};
#pragma unroll
    for (int c = 0; c < 4; ++c) { const f32x2 lo = __builtin_amdgcn_cvt_pk_f32_fp8((int)dd[c], false), hi = __builtin_amdgcn_cvt_pk_f32_fp8((int)dd[c], true);
        f[4 * c] = lo[0]; f[4 * c + 1] = lo[1]; f[4 * c + 2] = hi[0]; f[4 * c + 3] = hi[1]; }
}
__device__ __forceinline__ void p9a_udots(Frame& F) {
    const int lane = F.lane, sub = lane & 7, g = lane >> 3;
    const bool b2 = (lane & 4) != 0, b1 = (lane & 2) != 0, b0 = (lane & 1) != 0;
    for (int vid = F.bx; vid < 256; vid += F.G) { const int x = vid & 7, c = vid >> 3;
        for (int si = 0; si < 2; ++si) { const int s = x + 8 * si;
            const unsigned char* tab = F.U8 + (size_t)s * ((size_t)NEXP * 128); const unsigned so = 16u * (unsigned)sub;
            const int tb = c * 512 + F.wave;
            v4u rc[8]; int idp, idq; v4u hq;
            { const int* ei = F.EIDX + (size_t)tb * NSEL; idp = ei[lane]; idq = ei[64 + lane];
              hq = *(const GAS v4u*)(F.H8 + (size_t)tb * DM + 128 * s + 16 * sub); }
#pragma unroll
            for (int i = 0; i < 8; ++i) { const int id = __shfl(idp, 8 * i + g); rc[i] = *(const GAS v4u*)(tab + ((unsigned)id * 128u + so)); }
            idp = idq;
#pragma unroll 1
            for (int k = 0; k < 64; ++k) { const int t = tb + 8 * k; const int t1 = tb + 8 * (k + 1 < 64 ? k + 1 : 63);
                const int hd[4] = {(int)hq.x, (int)hq.y, (int)hq.z, (int)hq.w};
                hq = *(const GAS v4u*)(F.H8 + (size_t)t1 * DM + 128 * s + 16 * sub);
                const int* ei1 = F.EIDX + (size_t)t1 * NSEL;
                float p[16];
#pragma unroll
                for (int h = 0; h < 2; ++h) {
                    idq = ei1[64 * h + lane];
#pragma unroll
                    for (int i = 0; i < 8; ++i) { const unsigned dd[4] = {rc[i].x, rc[i].y, rc[i].z, rc[i].w};
                        const int id = __shfl(idp, 8 * i + g);
                        rc[i] = *(const GAS v4u*)(tab + ((unsigned)id * 128u + so));
                        int pa = 0;
#pragma unroll
                        for (int c4 = 0; c4 < 4; ++c4) pa = __builtin_amdgcn_sdot4((int)dd[c4], hd[c4], pa, false);
                        p[8 * h + i] = (float)pa; }
                    idp = idq; }
                float q8[8], q4[4], q2[2];
#pragma unroll
                for (int i = 0; i < 8; ++i) { const float keep = b2 ? p[8 + i] : p[i], send = b2 ? p[i] : p[8 + i]; q8[i] = keep + __shfl_xor(send, 4); }
#pragma unroll
                for (int i = 0; i < 4; ++i) { const float keep = b1 ? q8[4 + i] : q8[i], send = b1 ? q8[i] : q8[4 + i]; q4[i] = keep + __shfl_xor(send, 2); }
#pragma unroll
                for (int i = 0; i < 2; ++i) { const float keep = b0 ? q4[2 + i] : q4[i], send = b0 ? q4[i] : q4[2 + i]; q2[i] = keep + __shfl_xor(send, 1); }
                bf16_t* pd = (bf16_t*)F.PD + ((size_t)s * T + t) * NSEL + 16 * sub + g;
                pd[0] = (bf16_t)f2bf(q2[0]); pd[8] = (bf16_t)f2bf(q2[1]);
            }
        }
    }
}
__device__ __forceinline__ void p9b_act(Frame& F) {
    const size_t gt = (size_t)F.vcu * NTHR + F.tid, ngt = (size_t)F.G * NTHR;
    for (size_t idx = gt; idx < (size_t)T * NSEL; idx += ngt) {
        const int ex = F.EIDX[idx]; float sum = 0.f;
#pragma unroll
        for (int s = 0; s < 16; ++s) sum += bf_lo((unsigned)((const bf16_t*)F.PD)[(size_t)s * T * NSEL + idx]);
        F.ACT[idx] = gelu_tanh(sum * (F.USC[ex] * F.RS[idx >> 7])) * F.EW[idx] * F.VSC[ex];
    }
}
__device__ __forceinline__ void p9c_vacc(Frame& F) {
    const int lane = F.lane, sub = lane & 7, g = lane >> 3;
    const bool b5 = (lane & 32) != 0, b4 = (lane & 16) != 0, b3 = (lane & 8) != 0;
    for (int vid = F.bx; vid < 256; vid += F.G) { const int x = vid & 7, c = vid >> 3;
        for (int si = 0; si < 2; ++si) { const int s = x + 8 * si;
            const unsigned char* tab = F.V8 + (size_t)s * ((size_t)NEXP * 128); const unsigned so = 16u * (unsigned)sub;
            const int tb = c * 512 + F.wave;
            v4u rc[8]; int idp, idq; float acp, acq;
            { const int* ei = F.EIDX + (size_t)tb * NSEL; const float* ap = F.ACT + (size_t)tb * NSEL;
              idp = ei[lane]; acp = ap[lane]; idq = ei[64 + lane]; acq = ap[64 + lane]; }
            float ac[8];
#pragma unroll
            for (int i = 0; i < 8; ++i) { const int id = __shfl(idp, 8 * i + g); ac[i] = __shfl(acp, 8 * i + g); rc[i] = *(const GAS v4u*)(tab + ((unsigned)id * 128u + so)); }
            idp = idq; acp = acq;
#pragma unroll 1
            for (int k = 0; k < 64; ++k) { const int t = tb + 8 * k; const int t1 = tb + 8 * (k + 1 < 64 ? k + 1 : 63);
                const int* ei1 = F.EIDX + (size_t)t1 * NSEL; const float* ap1 = F.ACT + (size_t)t1 * NSEL;
                float ya[16];
#pragma unroll
                for (int i = 0; i < 16; ++i) ya[i] = 0.f;
#pragma unroll
                for (int h = 0; h < 2; ++h) {
                    idq = ei1[64 * h + lane]; acq = ap1[64 * h + lane];
#pragma unroll
                    for (int i = 0; i < 8; ++i) { float f[16]; cvt16(rc[i], f); const float a = ac[i];
                        const int id = __shfl(idp, 8 * i + g); ac[i] = __shfl(acp, 8 * i + g);
                        rc[i] = *(const GAS v4u*)(tab + ((unsigned)id * 128u + so));
#pragma unroll
                        for (int q = 0; q < 16; ++q) ya[q] = fmaf(a, f[q], ya[q]); }
                    idp = idq; acp = acq; }
                float y8[8], y4[4], y2[2];
#pragma unroll
                for (int i = 0; i < 8; ++i) { const float keep = b5 ? ya[8 + i] : ya[i], send = b5 ? ya[i] : ya[8 + i]; y8[i] = keep + __shfl_xor(send, 32); }
#pragma unroll
                for (int i = 0; i < 4; ++i) { const float keep = b4 ? y8[4 + i] : y8[i], send = b4 ? y8[i] : y8[4 + i]; y4[i] = keep + __shfl_xor(send, 16); }
#pragma unroll
                for (int i = 0; i < 2; ++i) { const float keep = b3 ? y4[2 + i] : y4[i], send = b3 ? y4[i] : y4[2 + i]; y2[i] = keep + __shfl_xor(send, 8); }
                bf16_t* yp = (bf16_t*)F.Y + (size_t)t * DM + 128 * s + 16 * sub + 2 * g;
                *(GAS unsigned*)yp = pk2(y2[0], y2[1]);
            }
        }
    }
}
__device__ __forceinline__ void p9d_final(Frame& F) {
    const int lane = F.lane; const int gw = F.vcu * NWAVES + F.wave, NGW = F.G * NWAVES;
    for (int t = gw; t < T; t += NGW) {
        const int b = t >> 12;
        float* op = F.out + (size_t)t * DM; const float* ga = F.MOD + (size_t)b * NADA + 5 * DM; const bf16_t* yp = (const bf16_t*)F.Y + (size_t)t * DM; const bf16_t* xp = F.X1 + (size_t)t * DM;
        f32x4 v[8]; float ss = 0.f;
#pragma unroll
        for (int j = 0; j < 8; ++j) { const int col = 4 * (lane + 64 * j); const v2u xw = *(const GAS v2u*)(xp + col); const f32x4 xa = (f32x4){bf_lo(xw.x), bf_hi(xw.x), bf_lo(xw.y), bf_hi(xw.y)}, g4v = *(const GAS f32x4*)(ga + col); const v2u yw = *(const GAS v2u*)(yp + col); const f32x4 yv = (f32x4){bf_lo(yw.x), bf_hi(yw.x), bf_lo(yw.y), bf_hi(yw.y)};
            v[j] = xa + g4v * yv; ss += (v[j][0] * v[j][0] + v[j][1] * v[j][1]) + (v[j][2] * v[j][2] + v[j][3] * v[j][3]); }
        const float rstd = __builtin_amdgcn_rsqf(wave_sum(ss) * (1.f / DM) + EPS);
#pragma unroll
        for (int j = 0; j < 8; ++j) { const int col = 4 * (lane + 64 * j); const f32x4 gf = *(const GAS f32x4*)(F.g_final + col); *(GAS f32x4*)(op + col) = v[j] * rstd * gf; }
    }
}

__global__ void __launch_bounds__(NWAVES * 64, 2) hymba_fwd(Args args) {
    unsigned char* const lds = g_lds;
    Frame F;
    F.lds = (LAS unsigned char*)lds;
    F.MISC = (volatile LAS unsigned*)(F.lds + MISC_OFF);
    { const int t0_ = (int)__builtin_amdgcn_workitem_id_x();
      F.wave = __builtin_amdgcn_readfirstlane(t0_ >> 6); }
    F.tid = ktid(F.wave); F.lane = F.tid & 63;
    for (int u = F.tid; u < (LDS_BYTES - LDSCTL_OFF) / 4; u += NWAVES * 64) ((LAS unsigned*)(F.lds + LDSCTL_OFF))[u] = 0u;
    __syncthreads();
    F.G = gridDim.x; F.bx = blockIdx.x; { const int bx = blockIdx.x; F.vcu = (F.G % 8 == 0) ? (bx % 8) * (F.G / 8) + bx / 8 : bx; }
    unsigned char* ws0 = args.ws;
    F.ctl = (gu32*)(ws0 + WS_CTL);
#define FILL_PTRS(F) do { const __attribute__((address_space(4))) void* kp_ = (const __attribute__((address_space(4))) void*)__builtin_amdgcn_kernarg_segment_ptr(); asm volatile("" : "+s"(kp_)); \
    const float* const __attribute__((address_space(4)))* in_ = (const float* const __attribute__((address_space(4)))*)kp_; \
    unsigned char* ws = (unsigned char*)in_[25]; \
    { int t_ = ktid(F.wave); asm volatile("" : "+v"(t_)); F.tid = t_; F.lane = t_ & 63; } \
    F.x = in_[0]; F.c = in_[1]; F.w_ada = in_[2]; F.b_ada = in_[3]; F.g_mix = in_[4]; F.w_in = in_[5]; F.b_f = in_[6]; \
    F.conv_w = in_[7]; F.conv_b = in_[8]; F.lru_w_a = in_[9]; F.lru_b_a = in_[10]; F.lru_w_x = in_[11]; F.lru_b_x = in_[12]; \
    F.lru_lambda = in_[13]; F.g_attn_out = in_[14]; F.g_lru_out = in_[15]; F.w_out = in_[16]; F.g_ffn = in_[17]; \
    F.peer_w_q = in_[18]; F.peer_k1 = in_[19]; F.peer_k2 = in_[20]; F.peer_u = in_[21]; F.peer_v = in_[22]; F.g_final = in_[23]; \
    F.out = (float*)in_[24]; \
    F.MOD = (float*)(ws + WS_MOD); F.LF = (float*)(ws + WS_LF); F.KB = (float*)(ws + WS_KB); F.SUMM = (float*)(ws + WS_SUMM); \
    F.EW = (float*)(ws + WS_EW); F.EIDX = (int*)(ws + WS_EIDX); \
    F.WLRU = (bf16_t*)(ws + WS_WLRU); F.K1 = (bf16_t*)(ws + WS_K1); F.K2 = (bf16_t*)(ws + WS_K2); F.WIN = (bf16_t*)(ws + WS_WIN); \
    F.WOUT = (bf16_t*)(ws + WS_WOUT); F.WQ = (bf16_t*)(ws + WS_WQ); F.U8 = ws + WS_U; F.V8 = ws + WS_V; F.USC = (float*)(ws + WS_USC); F.VSC = (float*)(ws + WS_VSC); F.PD = (float*)(ws + WS_PD); F.Y = (float*)(ws + WS_Y); F.ACT = (float*)(ws + WS_ACT); \
    F.H = (bf16_t*)(ws + WS_H); F.Q = (bf16_t*)(ws + WS_Q); F.K = (bf16_t*)(ws + WS_K); F.VV = (bf16_t*)(ws + WS_VV); F.QP = (bf16_t*)(ws + WS_QP); \
    F.LX = (bf16_t*)(ws + WS_LX); F.GLY = (bf16_t*)(ws + WS_GLY); F.MRG = (bf16_t*)(ws + WS_MRG); F.HL = (bf16_t*)(ws + WS_HL); F.AC = (bf16_t*)(ws + WS_AC); F.PART = (float*)(ws + WS_PART); F.X1 = (bf16_t*)(ws + WS_X1); F.OB = (bf16_t*)(ws + WS_OB); F.LW = (float*)(ws + WS_LW); F.SPLIT = (unsigned*)(ws + WS_SPLIT); F.H8 = ws + WS_H8; F.M8 = ws + WS_M8; F.RS = (float*)(ws + WS_RS); F.WQ8 = ws + WS_WQ8; F.WIN8 = ws + WS_WIN8; F.WOUT8 = ws + WS_WOUT8; F.CS = (float*)(ws + WS_CS); F.WF = (float*)(ws + WS_WF); } while (0)
    XcdBarrier bar; bar.bar = (unsigned*)(F.ctl + CW_BAR); bar.x = 0; bar.st = nullptr;
    if (N_LAUNCHES == 1) bar = xcd_barrier_post((unsigned*)(F.ctl + CW_BAR), F.MISC + 8, F.wave);
#define GRID_BAR() do { if (N_LAUNCHES == 1) xcd_barrier(bar, F.wave); } while (0)
    const int lo = args.ph_lo, hi = args.ph_hi;
#ifdef TIME_PHASE
#define TSTAMP(k) do { if (((k) == TIME_PHASE || (k) == TIME_PHASE + 1) && blockIdx.x == 0 && ktid(F.wave) == 0) { const unsigned long long t_ = __builtin_amdgcn_s_memrealtime(); \
        F.MISC[20 + 2 * ((k) - TIME_PHASE)] = (unsigned)t_; F.MISC[21 + 2 * ((k) - TIME_PHASE)] = (unsigned)(t_ >> 32); } } while (0)
#else
#define TSTAMP(k) do { } while (0)
#endif
#ifndef PHASE_MASK
#define PHASE_MASK 0xffff
#endif
#define IN(k) (((PHASE_MASK >> (k)) & 1) && lo <= (k) && (k) < hi)
#define BOTH(k) (IN(k) && IN((k) + 1))
#ifndef REPEAT_PHASE
#define REPEAT_PHASE -1
#endif
#define REP(k)
#define REPBAR(k)

    TSTAMP(0);
    if (IN(0)) { FILL_PTRS(F); p0_prologue<15>(F);
#if REPEAT_PHASE == 0
        GRID_BAR(); FILL_PTRS(F); p0_prologue<15>(F);
#endif
#if REPEAT_PHASE >= 100 && REPEAT_PHASE < 116
        GRID_BAR(); FILL_PTRS(F); p0_prologue<REPEAT_PHASE - 100>(F);
#endif
        if (BOTH(0)) GRID_BAR(); }
    TSTAMP(1);
    if (IN(1)) { FILL_PTRS(F);
        quant_rows_i8(F, F.WIN, F.WIN8, F.CS + 4096, (const unsigned*)F.ctl + CW_CMAX + 4096, 5120);
        quant_rows_i8(F, F.WOUT, F.WOUT8, F.CS + 2048, (const unsigned*)F.ctl + CW_CMAX + 2048, DM);
        p_modnorm<true, true, false>(F, F.x, F.g_mix, 0, DM);
#if REPEAT_PHASE == 1
        GRID_BAR(); FILL_PTRS(F); p_modnorm<true, true, false>(F, F.x, F.g_mix, 0, DM);
#endif
        if (BOTH(1)) GRID_BAR(); }
    TSTAMP(2);
    if (IN(2)) {
        FILL_PTRS(F); p2_cumsum(F); __syncthreads();
        { pg8::Gemm g{(const bf16_t*)F.H8, (const bf16_t*)F.WIN8, T, 5120, DM / 2}; pg8::StaticOrder S; S.init(T, 5120, F.G, (int)blockIdx.x);
          pg8::EpiProj<true> E{F.Q, 0, F.RS, F.CS + 4096};
          pg8::gemm_phase<pg8::EpiProj<true>, pg8::StaticOrder, true, true, true>(F.lds + RING_OFF, g, S, E, F.wave); }
        if (BOTH(2)) GRID_BAR();
    }
    TSTAMP(3);
    if (IN(3)) {
        FILL_PTRS(F);
        if (N_LAUNCHES == 1) { p3_norms(F); GRID_BAR(); FILL_PTRS(F); }
        { int tk = p3_attention(F, (char*)lds + RING_OFF);
          while (tk < 1024 + BATCH * 64) { const int u = tk - 1024; lru_unit(F, u >> 6, u & 63); tk = att_dequeue(F); }
          FILL_PTRS(F);
          while (tk < 1280 + (2 * NEXP - CONV_P8_ROWS) / 32) { conv_item(F, CONV_P8_ROWS / 32 + tk - 1280); tk = att_dequeue(F); } }
#if REPEAT_PHASE == 3
        GRID_BAR(); FILL_PTRS(F);
        p3_attention(F, (char*)lds + RING_OFF);
        for (int u = F.vcu; u < BATCH * 64; u += F.G) lru_unit(F, u >> 6, u & 63);
#endif
#if REPEAT_PHASE == 30
        GRID_BAR(); FILL_PTRS(F);
        p3_attention(F, (char*)lds + RING_OFF);
#endif
#if REPEAT_PHASE == 31
        GRID_BAR(); FILL_PTRS(F);
        for (int u = F.vcu; u < BATCH * 64; u += F.G) lru_unit(F, u >> 6, u & 63);
#endif
        if (BOTH(3)) GRID_BAR();
    }
    TSTAMP(4);
    if (IN(4)) {
        FILL_PTRS(F);
        for (int u = F.vcu; u < BATCH * 64; u += F.G) lru_final(F, u >> 6, u & 63);
#if REPEAT_PHASE == 4
        GRID_BAR(); FILL_PTRS(F);
        for (int u = F.vcu; u < BATCH * 64; u += F.G) lru_final(F, u >> 6, u & 63);
#endif
        if (BOTH(4)) GRID_BAR();
    }
    TSTAMP(5);
    if (IN(5)) {
        FILL_PTRS(F);
        pg8::Gemm g{(const bf16_t*)F.M8, (const bf16_t*)F.WOUT8, T, DM, DM / 2}; pg8::StaticOrder S; S.init(T, DM, F.G, (int)blockIdx.x);
        pg8::EpiRes E{F.x, F.X1, DM, F.MOD + 2 * DM, NADA, F.RS, F.CS + 2048};
        pg8::gemm_phase<pg8::EpiRes, pg8::StaticOrder, true, true, true>(F.lds + RING_OFF, g, S, E, F.wave);
        if (BOTH(5)) GRID_BAR();
    }
    TSTAMP(6);
    if (IN(6)) { FILL_PTRS(F); quant_rows_i8(F, F.WQ, F.WQ8, F.CS, (const unsigned*)F.ctl + CW_CMAX, DM);
        p_modnorm<false, true, false>(F, F.out, F.g_ffn, 3 * DM, 4 * DM); if (BOTH(6)) GRID_BAR(); }
    TSTAMP(7);
    if (IN(7)) {
        FILL_PTRS(F);
        pg8::Gemm g{(const bf16_t*)F.H8, (const bf16_t*)F.WQ8, T, DM, DM / 2}; pg8::StaticOrder S; S.init(T, DM, F.G, (int)blockIdx.x);
        pg8::EpiPlainI8 E{F.QP, DM, F.RS, F.CS};
        pg8::gemm_phase<pg8::EpiPlainI8, pg8::StaticOrder, true, true, true>(F.lds + RING_OFF, g, S, E, F.wave);
        if (BOTH(7)) GRID_BAR();
    }
    TSTAMP(8);
    if (IN(8)) { FILL_PTRS(F); p8_topk(F);
#if REPEAT_PHASE == 8
        GRID_BAR(); FILL_PTRS(F); p8_topk(F);
#endif
        if (BOTH(8)) GRID_BAR(); }
    TSTAMP(9);
    if (IN(9)) { FILL_PTRS(F); p9a_udots(F);
#if REPEAT_PHASE == 9
        GRID_BAR(); FILL_PTRS(F); p9a_udots(F);
#endif
        if (BOTH(9)) GRID_BAR(); }
    TSTAMP(10);
    if (IN(10)) { FILL_PTRS(F); p9b_act(F);
#if REPEAT_PHASE == 10
        GRID_BAR(); FILL_PTRS(F); p9b_act(F);
#endif
        if (BOTH(10)) GRID_BAR(); }
    TSTAMP(11);
    if (IN(11)) { FILL_PTRS(F); p9c_vacc(F);
#if REPEAT_PHASE == 11
        GRID_BAR(); FILL_PTRS(F); p9c_vacc(F);
#endif
        if (BOTH(11)) GRID_BAR(); }
    TSTAMP(12);
    if (IN(12)) { FILL_PTRS(F); p9d_final(F); }
#ifdef TIME_PHASE
    if (TIME_PHASE == 12) { GRID_BAR(); }
    TSTAMP(13);
    if (blockIdx.x == 0 && ktid(F.wave) == 0) { const unsigned long long tp0_ = ((unsigned long long)F.MISC[21] << 32) | F.MISC[20], tp1_ = ((unsigned long long)F.MISC[23] << 32) | F.MISC[22];
        const unsigned long long dt = tp1_ - tp0_, te = __builtin_amdgcn_s_memrealtime(); while (__builtin_amdgcn_s_memrealtime() - te < (unsigned long long)TIME_AMP * dt) __builtin_amdgcn_s_sleep(8); }
#endif
#undef IN
#undef BOTH
#undef GRID_BAR
}

extern "C" void kernel_launch(void* const* d_in, const int* in_sizes, int n_in, void* d_out, int out_size, void* d_ws, size_t ws_size, hipStream_t stream) {
    static int grid = 0;
    if (grid == 0) {
        if (n_in != 24 || in_sizes[0] != T * DM || out_size != T * DM || ws_size < WS_END) {
            fprintf(stderr, "kernel_launch: built for 24 inputs, x/out of %d floats, >= %zu bytes of workspace; got n_in %d, in0 %d, out %d, ws %zu; nothing launched\n", T * DM, (size_t)WS_END, n_in, n_in > 0 ? in_sizes[0] : -1, out_size, ws_size); grid = -1; return; }
        int dev = 0, cus = 0, per_cu = 0;
        if (hipGetDevice(&dev) != hipSuccess || hipDeviceGetAttribute(&cus, hipDeviceAttributeMultiprocessorCount, dev) != hipSuccess) { fprintf(stderr, "kernel_launch: device query failed\n"); grid = -1; return; }
        if (hipFuncSetAttribute((const void*)hymba_fwd, hipFuncAttributeMaxDynamicSharedMemorySize, LDS_BYTES) != hipSuccess) { fprintf(stderr, "kernel_launch: hipFuncSetAttribute failed\n"); grid = -1; return; }
        if (hipOccupancyMaxActiveBlocksPerMultiprocessor(&per_cu, (const void*)hymba_fwd, NWAVES * 64, LDS_BYTES) != hipSuccess || per_cu < 1)
            fprintf(stderr, "kernel_launch: note: occupancy query reports %d workgroups per CU\n", per_cu);
        (void)hipGetLastError();
        grid = cus;
    }
    if (grid < 0) return;
    if (hipMemsetAsync((char*)d_ws + WS_CTL, 0, CTL_ZERO_BYTES, stream) != hipSuccess) { fprintf(stderr, "kernel_launch: hipMemsetAsync failed\n"); return; }
    Args a{};
    for (int i = 0; i < 24; ++i) a.in[i] = (const float*)d_in[i];
    a.out = (float*)d_out; a.ws = (unsigned char*)d_ws;
    for (int li = 0; li < N_LAUNCHES; ++li) {
        a.ph_lo = (N_LAUNCHES == 1) ? 0 : li; a.ph_hi = (N_LAUNCHES == 1) ? N_PHASES : li + 1; a.li = li;
        hipLaunchKernelGGL(hymba_fwd, dim3(grid), dim3(NWAVES * 64), LDS_BYTES, stream, a);
        const hipError_t le = hipPeekAtLastError();
        if (le != hipSuccess) { fprintf(stderr, "kernel_launch: launch %d failed: %s\n", li, hipGetErrorName(le)); break; }
    }
}
```

```cpp
#include <hip/hip_runtime.h>
#include <hip/hip_bf16.h>
#include <cstdio>
#include <cstdint>

constexpr int BATCH = 4, SEQ = 4096, DM = 2048, T = BATCH * SEQ;
constexpr int AW = 1024, NH = 8, HD = 128, LW = 1024, NLB = 8, LBD = 128;
constexpr int INC = 5128, OFF_F = 3072, OFF_LX = 3080;
constexpr int PH = 8, PNK = 128, PQD = 256, PTOPK = 16, NEXP = 16384, NSEL = PH * PTOPK;
constexpr int NADA = 6 * DM;
constexpr float EPS = 1e-6f;
constexpr int NWAVES = 8, NTHR = 512;

#ifndef MK_N_LAUNCHES
#define MK_N_LAUNCHES 1
#endif
constexpr int N_PHASES = 13;
constexpr int N_LAUNCHES = MK_N_LAUNCHES;

constexpr size_t MiB = 1u << 20;
constexpr size_t WS_CTL = 0, CTL_ZERO_BYTES = 128 * 1024;
constexpr size_t WS_MOD = 1 * MiB;
constexpr size_t WS_LF = WS_MOD + 256 * 1024;
constexpr size_t WS_KB = WS_LF + 512 * 1024;
constexpr size_t WS_SUMM = WS_KB + 512 * 1024;
constexpr size_t WS_WLRU = 5 * MiB;
constexpr size_t WS_K1 = WS_WLRU + 512 * 1024;
constexpr size_t WS_K2 = WS_K1 + 256 * 1024;
constexpr size_t WS_WIN = 6 * MiB;
constexpr size_t WS_WOUT = 26 * MiB;
constexpr size_t WS_WQ = 34 * MiB;
constexpr size_t WS_U = 42 * MiB, WS_V = 106 * MiB;
constexpr size_t WS_USC = WS_SUMM + 2 * MiB, WS_VSC = WS_USC + 64 * 1024;
constexpr size_t WS_H = 170 * MiB;
constexpr size_t WS_Q = 234 * MiB, WS_K = 266 * MiB, WS_VV = 298 * MiB;
constexpr size_t WS_QP = 234 * MiB;
constexpr size_t WS_EIDX = 298 * MiB, WS_EW = 306 * MiB;
constexpr size_t WS_LX = 330 * MiB, WS_GLY = 362 * MiB;
constexpr size_t WS_MRG = 394 * MiB;
constexpr size_t WS_PART = 458 * MiB;
constexpr size_t WS_HL = 170 * MiB, WS_AC = 202 * MiB;
constexpr size_t WS_OB = 74 * MiB;
constexpr size_t WS_LW = 138 * MiB;
constexpr size_t WS_SPLIT = WS_LW + 2 * MiB;
constexpr size_t WS_CS = WS_LW + 3 * MiB + 128 * 1024;
constexpr size_t WS_WQ8 = 330 * MiB;
constexpr size_t WS_WIN8 = 42 * MiB, WS_WOUT8 = 52 * MiB;
constexpr size_t WS_RS = WS_LW + 3 * MiB;
constexpr size_t WS_H8 = 74 * MiB;
constexpr size_t WS_M8 = 234 * MiB;
constexpr size_t WS_PD = 330 * MiB;
constexpr size_t WS_Y = 170 * MiB;
constexpr size_t WS_ACT = 314 * MiB;
constexpr size_t WS_X1 = 464 * MiB;
constexpr size_t WS_END = 528 * MiB;
static_assert(WS_K == WS_Q + 32 * MiB && WS_VV == WS_Q + 64 * MiB && WS_LX == WS_Q + 96 * MiB && WS_GLY == WS_Q + 128 * MiB, "EpiProj: destinations 32 MiB apart");
constexpr int CW_BAR = 4096;
static_assert((9216 + 9216) * 4 <= 128 * 1024, "control words inside the per-call memset");
constexpr int CW_KMAX = 8192, CW_QMAX = 8256, CW_QUEUE = 8832, CW_CMAX = 9216;

constexpr int RING_OFF = 0, RING_BYTES = 131072;
constexpr int LDSCTL_OFF = RING_BYTES, MISC_OFF = LDSCTL_OFF + 320;
constexpr int LDS_BYTES = 147456;
static_assert(MISC_OFF + 128 <= LDS_BYTES, "LDS map");

#define GAS __attribute__((address_space(1)))
#define LAS __attribute__((address_space(3)))
typedef unsigned short bf16_t;
typedef unsigned v4u __attribute__((ext_vector_type(4)));
typedef unsigned v2u __attribute__((ext_vector_type(2)));
typedef float f32x4 __attribute__((ext_vector_type(4)));
typedef float f32x2 __attribute__((ext_vector_type(2)));
typedef short bf16x8 __attribute__((ext_vector_type(8)));
typedef __bf16 bf16x2_t __attribute__((ext_vector_type(2)));
typedef GAS unsigned gu32;
#define RLX_AGENT __ATOMIC_RELAXED, __HIP_MEMORY_SCOPE_AGENT
#define LDS_WAIT() asm volatile("s_waitcnt lgkmcnt(0)" ::: "memory")
#define VM_WAIT() asm volatile("s_waitcnt vmcnt(0)" ::: "memory")

extern __shared__ __attribute__((aligned(16))) unsigned char g_lds[];
__device__ __forceinline__ int ktid(int kw) { int l; asm volatile("v_mbcnt_lo_u32_b32 %0, -1, 0\n\tv_mbcnt_hi_u32_b32 %0, -1, %0" : "=v"(l)); return kw * 64 + l; }
__device__ __forceinline__ unsigned fbits(float x) { return __builtin_bit_cast(unsigned, x); }
__device__ __forceinline__ float bitsf(unsigned x) { return __builtin_bit_cast(float, x); }
__device__ __forceinline__ bf16x2_t asbf2(unsigned x) { return __builtin_bit_cast(bf16x2_t, x); }
__device__ __forceinline__ unsigned f2bf(float f) { unsigned u = __builtin_bit_cast(unsigned, f); return (u + 0x7fffu + ((u >> 16) & 1u)) >> 16; }
__device__ __forceinline__ unsigned pk2(float lo, float hi) { f32x2 v = {lo, hi}; bf16x2_t b = __builtin_convertvector(v, bf16x2_t); return __builtin_bit_cast(unsigned, b); }
__device__ __forceinline__ float bf_lo(unsigned d) { return __builtin_bit_cast(float, d << 16); }
__device__ __forceinline__ float bf_hi(unsigned d) { return __builtin_bit_cast(float, d & 0xffff0000u); }
__device__ __forceinline__ float fexp(float x) { return __builtin_amdgcn_exp2f(x * 1.4426950408889634f); }
__device__ __forceinline__ float sigmoidf_(float z) { return __builtin_amdgcn_rcpf(1.f + fexp(-z)); }
__device__ __forceinline__ float gelu_tanh(float x) { const float z = x * (1.5957691216057308f + 0.07135481627260025f * x * x); return x * __builtin_amdgcn_rcpf(1.f + fexp(-z)); }
__device__ __forceinline__ float softplusf_(float z) { return fmaxf(z, 0.f) + log1pf(fexp(-fabsf(z))); }
__device__ __forceinline__ float wave_sum(float v) {
#pragma unroll
    for (int o = 1; o < 64; o <<= 1) v += __shfl_xor(v, o);
    return v;
}
#define XB_TMO      128
#define XB_XCNT(j)  (256  + 64 * (j))
#define XB_XSUB(j)  (1280 + 64 * (j))
#define XB_XGEN(j)  (2304 + 64 * (j))
#define XB_TOP      3328
#define XB_TOPGEN   3392
#define XCD_BAR_WORDS 3456
#define XB_SPIN_CAP (1u << 18)

__device__ __forceinline__ unsigned xb_ld(unsigned* p)              { return __hip_atomic_load(p, __ATOMIC_RELAXED, __HIP_MEMORY_SCOPE_AGENT); }
__device__ __forceinline__ unsigned xb_add(unsigned* p, unsigned v) { return __hip_atomic_fetch_add(p, v, __ATOMIC_RELAXED, __HIP_MEMORY_SCOPE_AGENT); }
__device__ __forceinline__ unsigned xb_xcc_id() { return (unsigned)__builtin_amdgcn_s_getreg((3 << 11) | 20) & 0xFu; }
#define XB_SPIN(cond, bar) do { unsigned _sp = 0; while (cond) { __builtin_amdgcn_s_sleep(1); \
    if ((++_sp & 255u) == 0u) { if (xb_ld(&(bar)[XB_TMO])) break; if (_sp > XB_SPIN_CAP) { atomicAdd(&(bar)[XB_TMO], 1u); break; } } } } while (0)

struct XcdBarrier {
    unsigned* bar; unsigned x;
    volatile LAS unsigned* st;
};

__device__ __forceinline__ XcdBarrier xcd_barrier_post(unsigned* bar, volatile LAS unsigned* st, int kw) {
    XcdBarrier b; b.bar = bar; b.x = xb_xcc_id(); b.st = st;
    if (ktid(kw) == 0) (void)xb_add(&bar[XB_XCNT(b.x)], 1u);
    return b;
}
__device__ __forceinline__ void xcd_barrier_complete(unsigned* bar, unsigned x, unsigned& nloc, unsigned& nx) {
    const unsigned G = gridDim.x * gridDim.y * gridDim.z;
    unsigned sum, cnt, mine, sp = 0u;
    for (;;) {
        sum = 0u; cnt = 0u; mine = 0u;
#pragma unroll
        for (unsigned j = 0; j < 16; ++j) { const unsigned c = xb_ld(&bar[XB_XCNT(j)]); sum += c; cnt += (c > 0u) ? 1u : 0u; mine = (j == x) ? c : mine; }
        if (sum == G) break;
        __builtin_amdgcn_s_sleep(1);
        if ((++sp & 255u) == 0u) { if (xb_ld(&bar[XB_TMO])) break; if (sp > XB_SPIN_CAP) { atomicAdd(&bar[XB_TMO], 1u); break; } }
    }
    nloc = mine > 0u ? mine : 1u; nx = cnt > 0u ? cnt : 1u;
}

__device__ __forceinline__ void xcd_barrier(const XcdBarrier& b, int kw) {
    asm volatile("s_waitcnt vmcnt(0)" ::: "memory");
    __syncthreads();
    if (ktid(kw) == 0) {
        unsigned* bar = b.bar;
        __builtin_amdgcn_s_waitcnt(0);
        unsigned nloc = b.st[0], nx = b.st[1];
        if (nloc == 0u) { xcd_barrier_complete(bar, b.x, nloc, nx); b.st[0] = nloc; b.st[1] = nx; }
        const unsigned old = xb_add(&bar[XB_XSUB(b.x)], 1u);
        const unsigned gen = old / nloc;
        if (old + 1u == (gen + 1u) * nloc) {
            __builtin_amdgcn_fence(__ATOMIC_RELEASE, "agent");
            asm volatile("s_waitcnt vmcnt(0)" ::: "memory");
            const unsigned og = xb_add(&bar[XB_TOP], 1u);
            const unsigned tg = og / nx;
            if (og + 1u == (tg + 1u) * nx) xb_add(&bar[XB_TOPGEN], 1u);
            else XB_SPIN(xb_ld(&bar[XB_TOPGEN]) == tg, bar);
            __builtin_amdgcn_fence(__ATOMIC_ACQUIRE, "agent");
            xb_add(&bar[XB_XGEN(b.x)], 1u);
            asm volatile("s_waitcnt vmcnt(0)" ::: "memory");
        } else {
            XB_SPIN(xb_ld(&bar[XB_XGEN(b.x)]) == gen, bar);
            __builtin_amdgcn_fence(__ATOMIC_ACQUIRE, "agent");
            asm volatile("s_waitcnt vmcnt(0)" ::: "memory");
        }
    }
    __syncthreads();
}

namespace pg8 {
#define PG8_LAS __attribute__((address_space(3)))
typedef unsigned short bf16_t;
typedef short bf16x8 __attribute__((ext_vector_type(8)));
typedef float f32x4 __attribute__((ext_vector_type(4)));
typedef unsigned u32x4 __attribute__((ext_vector_type(4)));
typedef int i32x4 __attribute__((ext_vector_type(4)));
typedef int i32x8 __attribute__((ext_vector_type(8)));
constexpr int BM = 256, BK = 64, HALF = 128, HTB = HALF * BK * 2  , STAGE_BYTES = 8 * HTB, NXCD = 8, WGM = 8;

__host__ __device__ __forceinline__ int lds_byte(int r, int c) { const int st = (r >> 4) * 2 + (c >> 5), rr = r & 15, cc = c & 31, ob = rr * 64 + cc * 2; return st * 1024 + (ob ^ (((ob >> 9) & 1) << 5)); }
__host__ __device__ __forceinline__ void stage_rc(int b, int& R, int& C) { const int st = b / 1024, sb = b % 1024, swz = sb ^ (((sb >> 9) & 1) << 5); R = (st >> 1) * 16 + swz / 64; C = (st & 1) * 32 + (swz % 64) / 2; }
__host__ __device__ __forceinline__ int perm32(int rho) { const int n = rho >> 4, i = rho & 15; return 8 * (i >> 2) + 4 * n + (i & 3); }

struct Unit { int pm, pn; };
struct Gemm { const bf16_t* A; const bf16_t* Bt; int M, N, K; };

struct StaticOrder {
    int nM, nN, nwg, G, c;
    __host__ __device__ void init(int M, int N, int G_, int c_) { nM = M / BM; nN = N / BM; nwg = nM * nN; G = G_; c = c_; }
    __host__ __device__ bool next(int i, Unit& u) const {
        const long L = (long)i * G + c; if (L >= nwg) return false;
        int wgid = (int)L; { const int q = nwg / NXCD, r = nwg % NXCD, xcd = wgid % NXCD, off = wgid / NXCD; wgid = (xcd < r ? xcd * (q + 1) : r * (q + 1) + (xcd - r) * q) + off; }
        const int nig = WGM * nN, gid = wgid / nig, fm = gid * WGM, gsz = (nM - fm) < WGM ? (nM - fm) : WGM;
        u.pm = fm + ((wgid % nig) % gsz); u.pn = (wgid % nig) / gsz; return true;
    }
    __device__ __forceinline__ void a_ready(const Unit&) const {}
    __device__ __forceinline__ void done(const Unit&) const {}
};


__device__ __forceinline__ unsigned cvt_pk_bf16(float lo, float hi) { unsigned r; asm volatile("v_cvt_pk_bf16_f32 %0, %1, %2" : "=v"(r) : "v"(lo), "v"(hi)); return r; }

struct EpiPlainI8 {
    static constexpr bool PERM = true, AFTER_DRAIN = false;
    bf16_t* O; int ldc; const float* rs; const float* cs;
    __device__ __forceinline__ void operator()(const f32x4 (&acc)[2][2][4][2], const Unit& u, int wr, int wc, int fr_, int fq_) const {
        int le; asm volatile("v_mbcnt_lo_u32_b32 %0, -1, 0\n\tv_mbcnt_hi_u32_b32 %0, -1, %0" : "=v"(le)); const int fr = le & 15, fq = le >> 4;
        const int row0 = u.pm * BM + wr * 64 + fr, col0 = u.pn * BM + wc * 32 + 8 * fq;
        f32x4 cv[2][2];
#pragma unroll
        for (int bj = 0; bj < 2; ++bj)
#pragma unroll
            for (int n = 0; n < 2; ++n) cv[bj][n] = *(const f32x4*)(cs + col0 + bj * HALF + n * 4);
#pragma unroll
        for (int ai = 0; ai < 2; ++ai)
#pragma unroll
            for (int m = 0; m < 4; ++m) { const int row = row0 + ai * HALF + m * 16; bf16_t* rowp = O + (size_t)row * ldc + col0; const float sc = rs[row];
#pragma unroll
                for (int bj = 0; bj < 2; ++bj) { const f32x4 v0 = acc[ai][bj][m][0] * sc * cv[bj][0], v1 = acc[ai][bj][m][1] * sc * cv[bj][1];
                    u32x4 w; w.x = cvt_pk_bf16(v0[0], v0[1]); w.y = cvt_pk_bf16(v0[2], v0[3]); w.z = cvt_pk_bf16(v1[0], v1[1]); w.w = cvt_pk_bf16(v1[2], v1[3]);
                    *(u32x4*)(rowp + bj * HALF) = w; } }
    }
};
template <bool SCALED>
struct EpiProj {
    static constexpr bool PERM = true, AFTER_DRAIN = false;
    bf16_t* Q;
    int cat0; const float* rs; const float* cs;
    __device__ __forceinline__ void operator()(const f32x4 (&acc)[2][2][4][2], const Unit& u, int wr, int wc, int fr_, int fq_) const {
        int fr = fr_, fq = fq_;
        if constexpr (SCALED) { int le; asm volatile("v_mbcnt_lo_u32_b32 %0, -1, 0\n\tv_mbcnt_hi_u32_b32 %0, -1, %0" : "=v"(le)); fr = le & 15; fq = le >> 4; }
        const int row0 = u.pm * BM + wr * 64 + fr; const int cat = cat0 + (u.pn >> 2), pnl = u.pn & 3;
        bf16_t* basep = Q + (size_t)cat * ((size_t)16 << 20);
        const bool headmajor = cat < 3, dogelu = cat == 4;
#pragma unroll
        for (int ai = 0; ai < 2; ++ai)
#pragma unroll
            for (int m = 0; m < 4; ++m) { const int row = row0 + ai * HALF + m * 16; const int b = row >> 12, s = row & 4095; float sc = 1.f; if constexpr (SCALED) sc = rs[row];
#pragma unroll
                for (int bj = 0; bj < 2; ++bj) { f32x4 v0 = acc[ai][bj][m][0], v1 = acc[ai][bj][m][1];
                    if constexpr (SCALED) { const float* cp = cs + u.pn * BM + bj * HALF + wc * 32 + 8 * fq; v0 *= sc * *(const f32x4*)cp; v1 *= sc * *(const f32x4*)(cp + 4); }
                    const int colt = pnl * BM + bj * HALF + wc * 32 + 8 * fq;
                    const int head = colt >> 7, d = colt & 127;
                    const size_t offA = ((size_t)((b * 8 + head) * 4096 + s)) * 128 + d, offB = (size_t)row * 1024 + colt;
                    bf16_t* dst = basep + (headmajor ? offA : offB);
                    if (dogelu) {
#pragma unroll
                        for (int e = 0; e < 4; ++e) { v0[e] = gelu_tanh(v0[e]); v1[e] = gelu_tanh(v1[e]); } }
                    u32x4 w; w.x = cvt_pk_bf16(v0[0], v0[1]); w.y = cvt_pk_bf16(v0[2], v0[3]); w.z = cvt_pk_bf16(v1[0], v1[1]); w.w = cvt_pk_bf16(v1[2], v1[3]);
                    *(u32x4*)dst = w; } }
    }
};
struct EpiRes {
    static constexpr bool PERM = true, AFTER_DRAIN = false;
    const float* base; bf16_t* out; int ldc; const float* gate; int gstride; const float* rs; const float* cs;
    __device__ __forceinline__ void operator()(const f32x4 (&acc)[2][2][4][2], const Unit& u, int wr, int wc, int fr, int fq) const {
        const int row0 = u.pm * BM + wr * 64 + fr, col0 = u.pn * BM + wc * 32 + 8 * fq;
        const int b = (u.pm * BM) >> 12;
        f32x4 gv[2][2];
#pragma unroll
        for (int bj = 0; bj < 2; ++bj)
#pragma unroll
            for (int n = 0; n < 2; ++n) gv[bj][n] = *(const f32x4*)(gate + (size_t)b * gstride + col0 + bj * HALF + n * 4) * *(const f32x4*)(cs + col0 + bj * HALF + n * 4);
#pragma unroll
        for (int ai = 0; ai < 2; ++ai)
#pragma unroll
            for (int m = 0; m < 4; ++m) { const size_t off = (size_t)(row0 + ai * HALF + m * 16) * ldc + col0; const float sr = rs[row0 + ai * HALF + m * 16];
#pragma unroll
                for (int bj = 0; bj < 2; ++bj) { const f32x4 b0 = *(const f32x4*)(base + off + bj * HALF), b1 = *(const f32x4*)(base + off + bj * HALF + 4);
                    const f32x4 v0 = b0 + gv[bj][0] * (acc[ai][bj][m][0] * sr), v1 = b1 + gv[bj][1] * (acc[ai][bj][m][1] * sr);
                    u32x4 w; w.x = cvt_pk_bf16(v0[0], v0[1]); w.y = cvt_pk_bf16(v0[2], v0[3]); w.z = cvt_pk_bf16(v1[0], v1[1]); w.w = cvt_pk_bf16(v1[2], v1[3]);
                    *(u32x4*)(out + off + bj * HALF) = w; } }
    }
};

template <class Epi, class Sched, bool ALIGN_EPI = false, bool SP2 = false, bool I8 = false>
__device__ __forceinline__ void gemm_phase(PG8_LAS unsigned char* lds, const Gemm g, const Sched& S, const Epi& E, const int kw) {
    const int tid = ktid(kw), wid = kw, lane = tid & 63, wr = wid >> 2, wc = wid & 3, fr = lane & 15, fq = lane >> 4;
    const int K = g.K, nt = K / BK;
    unsigned voffA[2], voffB[2];
#pragma unroll
    for (int i = 0; i < 2; ++i) { int R, C; stage_rc(tid * 16 + i * 8192, R, C); const int Rb = Epi::PERM ? ((R & ~31) + perm32(R & 31)) : R;
        voffA[i] = (unsigned)(R * K + C) * 2u; voffB[i] = (unsigned)(Rb * K + C) * 2u; }
    const size_t kstep = (size_t)(BK * 2);
    const size_t hstep = (size_t)HALF * K * 2;
    const size_t tstep = 2 * hstep;
    const unsigned ldsw = (unsigned)wid * 1024u;
    const int aoff = lds_byte(wr * 64 + fr, fq * 8), boff = lds_byte(wc * 32 + fr, fq * 8);
#define PG8_SA(b, h) (((b) * 2 + (h)) * HTB)
#define PG8_SB(b, h) ((4 + (b) * 2 + (h)) * HTB)
#define PG8_STAGE(bufoff, gbase, voff) do { _Pragma("unroll") for (int _i = 0; _i < 2; ++_i) \
        __builtin_amdgcn_global_load_lds((const unsigned*)((const char*)(gbase) + (voff)[_i]), (PG8_LAS unsigned*)(lds + (bufoff) + ldsw + _i * 8192), 16, 0, 0); } while (0)
#define PG8_LDA(dst, b, h) do { _Pragma("unroll") for (int m = 0; m < 4; ++m) _Pragma("unroll") for (int k = 0; k < 2; ++k) dst[m][k] = *(const PG8_LAS bf16x8*)(lds + PG8_SA(b, h) + aoff + m * 2048 + k * 1024); } while (0)
#define PG8_LDB(dst, b, h) do { _Pragma("unroll") for (int n = 0; n < 2; ++n) _Pragma("unroll") for (int k = 0; k < 2; ++k) dst[n][k] = *(const PG8_LAS bf16x8*)(lds + PG8_SB(b, h) + boff + n * 2048 + k * 1024); } while (0)
#define PG8_MMA(ai, bj, At, Bt) do { __builtin_amdgcn_s_setprio(1); _Pragma("unroll") for (int m = 0; m < 4; ++m) _Pragma("unroll") for (int n = 0; n < 2; ++n) { \
        if constexpr (I8) { _Pragma("unroll") for (int k = 0; k < 2; ++k) acc[ai][bj][m][n] = __builtin_bit_cast(f32x4, __builtin_amdgcn_mfma_i32_16x16x64_i8(__builtin_bit_cast(i32x4, Bt[n][k]), __builtin_bit_cast(i32x4, At[m][k]), __builtin_bit_cast(i32x4, acc[ai][bj][m][n]), 0, 0, 0)); } \
        else { _Pragma("unroll") for (int k = 0; k < 2; ++k) acc[ai][bj][m][n] = __builtin_amdgcn_mfma_f32_16x16x32_bf16(Bt[n][k], At[m][k], acc[ai][bj][m][n], 0, 0, 0); } } \
        __builtin_amdgcn_s_setprio(0); } while (0)
#define PG8_WAIT_V(n) asm volatile("s_waitcnt vmcnt(" #n ")" ::: "memory")
#define PG8_WAIT_L(n) asm volatile("s_waitcnt lgkmcnt(" #n ")" ::: "memory")
#define PG8_BAR __builtin_amdgcn_s_barrier()
#define PG8_SCHED __builtin_amdgcn_sched_barrier(0)
    Unit cur, nxt; int ui = 0;
    if (!S.next(0, cur)) return;
    f32x4 acc[2][2][4][2];
#pragma unroll
    for (int a = 0; a < 2; ++a)
#pragma unroll
        for (int b = 0; b < 2; ++b)
#pragma unroll
            for (int m = 0; m < 4; ++m)
#pragma unroll
                for (int n = 0; n < 2; ++n) acc[a][b][m][n] = (f32x4){0.f, 0.f, 0.f, 0.f};
    bf16x8 At[4][2], B0[2][2], B1[2][2];
    const char* cA = (const char*)g.A + (size_t)cur.pm * tstep; const char* cB = (const char*)g.Bt + (size_t)cur.pn * tstep;
    S.a_ready(cur);
    if constexpr (SP2) {
        PG8_STAGE(PG8_SB(0, 0), cB, voffB); PG8_STAGE(PG8_SB(0, 1), cB + hstep, voffB); PG8_STAGE(PG8_SA(0, 0), cA, voffA); PG8_STAGE(PG8_SA(0, 1), cA + hstep, voffA);
        if (wr == 1) PG8_BAR;
        PG8_WAIT_V(2); PG8_BAR;
        PG8_STAGE(PG8_SB(1, 0), cB + kstep, voffB); PG8_STAGE(PG8_SA(1, 0), cA + kstep, voffA); PG8_STAGE(PG8_SB(1, 1), cB + hstep + kstep, voffB);
        PG8_WAIT_V(6); PG8_BAR;
    } else {
        PG8_STAGE(PG8_SB(0, 0), cB, voffB); PG8_STAGE(PG8_SA(0, 0), cA, voffA); PG8_STAGE(PG8_SB(0, 1), cB + hstep, voffB); PG8_STAGE(PG8_SA(0, 1), cA + hstep, voffA);
        if (wr == 1) PG8_BAR;
        PG8_WAIT_V(4); PG8_BAR;
        PG8_STAGE(PG8_SB(1, 0), cB + kstep, voffB); PG8_STAGE(PG8_SA(1, 0), cA + kstep, voffA); PG8_STAGE(PG8_SB(1, 1), cB + hstep + kstep, voffB);
        PG8_WAIT_V(6); PG8_BAR;
    }
    for (;;) {
        const bool has_next = S.next(ui + 1, nxt);
        const char* nA = has_next ? (const char*)g.A + (size_t)nxt.pm * tstep : cA; const char* nB = has_next ? (const char*)g.Bt + (size_t)nxt.pn * tstep : cB;
        for (int t = 0; t < nt; t += 2) {
            const bool last = (t == nt - 2);
            const char* a1 = cA + (size_t)(t + 1) * kstep;
            const char* a2 = last ? nA : cA + (size_t)(t + 2) * kstep; const char* b2 = last ? nB : cB + (size_t)(t + 2) * kstep;
            const char* a3 = a2 + kstep; const char* b3 = b2 + kstep;
            if (last && has_next) S.a_ready(nxt);
            if constexpr (SP2) {
            PG8_LDB(B0, 0, 0); PG8_LDB(B1, 0, 1); PG8_SCHED; PG8_LDA(At, 0, 0); PG8_STAGE(PG8_SA(1, 1), a1 + hstep, voffA);
            PG8_WAIT_V(8); PG8_WAIT_L(0); PG8_BAR; PG8_MMA(0, 0, At, B0); PG8_MMA(0, 1, At, B1); PG8_BAR; PG8_SCHED;
            PG8_LDA(At, 0, 1); PG8_STAGE(PG8_SB(0, 0), b2, voffB); PG8_STAGE(PG8_SB(0, 1), b2 + hstep, voffB); PG8_STAGE(PG8_SA(0, 0), a2, voffA);
            PG8_WAIT_V(8); PG8_WAIT_L(0); PG8_BAR; PG8_MMA(1, 0, At, B0); PG8_MMA(1, 1, At, B1); PG8_BAR; PG8_SCHED;
            PG8_LDB(B0, 1, 0); PG8_LDB(B1, 1, 1); PG8_SCHED; PG8_LDA(At, 1, 0); PG8_STAGE(PG8_SA(0, 1), a2 + hstep, voffA);
            PG8_WAIT_V(8); PG8_WAIT_L(0); PG8_BAR; PG8_MMA(0, 0, At, B0); PG8_MMA(0, 1, At, B1); PG8_BAR; PG8_SCHED;
            PG8_LDA(At, 1, 1); PG8_STAGE(PG8_SB(1, 0), b3, voffB); PG8_STAGE(PG8_SB(1, 1), b3 + hstep, voffB); PG8_STAGE(PG8_SA(1, 0), a3, voffA);
            PG8_WAIT_V(8); PG8_WAIT_L(0); PG8_BAR; PG8_MMA(1, 0, At, B0); PG8_MMA(1, 1, At, B1); PG8_BAR; PG8_SCHED;
            } else {
            PG8_LDB(B0, 0, 0); PG8_SCHED; PG8_LDA(At, 0, 0); PG8_STAGE(PG8_SA(1, 1), a1 + hstep, voffA);
            PG8_WAIT_L(8); PG8_BAR; PG8_WAIT_L(0); PG8_MMA(0, 0, At, B0); PG8_BAR; PG8_SCHED;
            PG8_LDB(B1, 0, 1); PG8_STAGE(PG8_SB(0, 0), b2, voffB);
            PG8_BAR; PG8_WAIT_L(0); PG8_MMA(0, 1, At, B1); PG8_BAR;
            PG8_LDA(At, 0, 1); PG8_STAGE(PG8_SA(0, 0), a2, voffA);
            PG8_BAR; PG8_WAIT_L(0); PG8_MMA(1, 0, At, B0); PG8_BAR; PG8_SCHED;
            PG8_STAGE(PG8_SB(0, 1), b2 + hstep, voffB);
            PG8_WAIT_V(6); PG8_BAR; PG8_MMA(1, 1, At, B1); PG8_BAR;
            PG8_LDB(B0, 1, 0); PG8_SCHED; PG8_LDA(At, 1, 0); PG8_STAGE(PG8_SA(0, 1), a2 + hstep, voffA);
            PG8_WAIT_L(8); PG8_BAR; PG8_WAIT_L(0); PG8_MMA(0, 0, At, B0); PG8_BAR; PG8_SCHED;
            PG8_LDB(B1, 1, 1); PG8_STAGE(PG8_SB(1, 0), b3, voffB);
            PG8_BAR; PG8_WAIT_L(0); PG8_MMA(0, 1, At, B1); PG8_BAR;
            PG8_LDA(At, 1, 1); PG8_STAGE(PG8_SA(1, 0), a3, voffA);
            PG8_BAR; PG8_WAIT_L(0); PG8_MMA(1, 0, At, B0); PG8_BAR; PG8_SCHED;
            PG8_STAGE(PG8_SB(1, 1), b3 + hstep, voffB);
            PG8_WAIT_V(6); PG8_BAR; PG8_MMA(1, 1, At, B1); PG8_BAR;
            }
        }
        if constexpr (I8) {
            _Pragma("unroll") for (int a = 0; a < 2; ++a) _Pragma("unroll") for (int b = 0; b < 2; ++b) _Pragma("unroll") for (int m = 0; m < 4; ++m) _Pragma("unroll") for (int n = 0; n < 2; ++n)
                acc[a][b][m][n] = __builtin_convertvector(__builtin_bit_cast(i32x4, acc[a][b][m][n]), f32x4); }
        if constexpr (ALIGN_EPI) { if (wr == 0) PG8_BAR; }
        if constexpr (!Epi::AFTER_DRAIN) { E(acc, cur, wr, wc, fr, fq); S.done(cur); }
        if (!has_next) break;
#pragma unroll
        for (int a = 0; a < 2; ++a)
#pragma unroll
            for (int b = 0; b < 2; ++b)
#pragma unroll
                for (int m = 0; m < 4; ++m)
#pragma unroll
                    for (int n = 0; n < 2; ++n) acc[a][b][m][n] = (f32x4){0.f, 0.f, 0.f, 0.f};
        cur = nxt; cA = nA; cB = nB; ++ui;
        if constexpr (ALIGN_EPI) { if (wr == 1) PG8_BAR; }
    }
    PG8_WAIT_V(0);
    if constexpr (!ALIGN_EPI) { if (wr == 0) PG8_BAR; }
    PG8_BAR;
    if constexpr (Epi::AFTER_DRAIN) { E.fused(acc, cur, wr, wc, fr, fq, lds, wid, lane); S.done(cur); }
#undef PG8_SA
#undef PG8_SB
#undef PG8_STAGE
#undef PG8_LDA
#undef PG8_LDB
#undef PG8_MMA
#undef PG8_WAIT_V
#undef PG8_WAIT_L
#undef PG8_BAR
#undef PG8_SCHED
}
}

namespace att {
typedef unsigned short bf16;
typedef short bf16x8 __attribute__((ext_vector_type(8)));
typedef short s16x4 __attribute__((ext_vector_type(4)));
typedef float f32x16 __attribute__((ext_vector_type(16)));
typedef float f32x4 __attribute__((ext_vector_type(4)));
typedef unsigned u32x4 __attribute__((ext_vector_type(4)));
template <class A, class Bt> struct same_t { static constexpr bool v = false; };
template <class A> struct same_t<A, A> { static constexpr bool v = true; };
constexpr int D = 128;
constexpr float THR = 8.f;
constexpr bool WSKIP = false;
constexpr float SCALE = 0.08838834764831845f;
constexpr int NW = 8, QBLK = 32, KVBLK = 64, QB = NW * QBLK;
constexpr int SHM_V = KVBLK * D * 2, SHM_K = KVBLK * D * 2;
constexpr int LDS_BIAS = 2 * SHM_V + 2 * SHM_K + NW * 64 * 4;
constexpr int LDS_BYTES = LDS_BIAS + 4096 * 4;
constexpr int OP = 2048;
#define KSWZ(row, colB) ((row) * 256 + ((colB) ^ (((row) & 7) << 4)))
#define SBAR() __builtin_amdgcn_sched_barrier(0)
__device__ __forceinline__ int v_st(int k, int c) { const int kk = (k & ~0xC) | ((k & 4) << 1) | ((k & 8) >> 1); return ((kk >> 3) * 4 + (c >> 5)) * 512 + ((kk & 7) * 32 + (c & 31)) * 2; }
__device__ __forceinline__ int v_rd_base(int lane) { return ((lane & 3) << 3) | (((lane >> 2) & 3) << 6) | (((lane >> 4) & 1) << 5) | (((lane >> 5) & 1) << 8); }
constexpr int v_rd_off(int d0, int ks, int half) { return d0 * 512 + ks * 4096 + half * 2048; }
__device__ __forceinline__ int crow(int r, int hi) { return (r & 3) + 8 * (r >> 2) + 4 * hi; }
__device__ __forceinline__ unsigned cvtpk(float lo, float hi) {
    unsigned r; asm volatile("v_cvt_pk_bf16_f32 %0, %1, %2" : "=v"(r) : "v"(lo), "v"(hi)); return r;
}
__device__ __forceinline__ bf16x8 pack8(f32x4 a, f32x4 b) {
    u32x4 w = {cvtpk(a[0], a[1]), cvtpk(a[2], a[3]), cvtpk(b[0], b[1]), cvtpk(b[2], b[3])};
    return *reinterpret_cast<bf16x8*>(&w);
}
template <class T> __device__ __forceinline__ bf16x8 load8(const T* p) {
    if constexpr (same_t<T, float>::v) { return pack8(*(const f32x4*)p, *(const f32x4*)(p + 4)); }
    else { return *reinterpret_cast<const bf16x8*>(p); }
}
__device__ __forceinline__ void mask_tile(f32x16& p0, f32x16& p1, int dq, unsigned W) {
    const float NEG = -__builtin_inff();
#pragma unroll
    for (int r = 0; r < 16; ++r) {
        const int c = (r & 3) + 8 * (r >> 2);
        if ((unsigned)(dq - c) >= W) p0[r] = NEG;
        if ((unsigned)(dq - c - 32) >= W) p1[r] = NEG;
    }
}
__device__ __forceinline__ void partialSM(f32x16& p0, f32x16& p1, float& m_reg, float& mn, float& alpha) {
    float pmax = p0[0]; for (int r = 1; r < 16; ++r) pmax = fmaxf(pmax, p0[r]); for (int r = 0; r < 16; ++r) pmax = fmaxf(pmax, p1[r]);
    { auto rr = __builtin_amdgcn_permlane32_swap(__float_as_uint(pmax), __float_as_uint(pmax), false, false);
      pmax = fmaxf(__uint_as_float(rr[0]), __uint_as_float(rr[1])); }
    constexpr float C2 = 1.4426950408889634f * SCALE;
    if (__builtin_expect(__all((pmax - m_reg) * SCALE <= THR), 1)) { mn = m_reg; alpha = 1.f; }
    else { mn = fmaxf(m_reg, pmax); alpha = __builtin_amdgcn_exp2f((m_reg - mn) * C2); m_reg = mn; }
    const float mnL = -mn * C2;
    for (int r = 0; r < 16; ++r) p0[r] = fmaf(p0[r], C2, mnL); for (int r = 0; r < 16; ++r) p1[r] = fmaf(p1[r], C2, mnL);
    for (int r = 0; r < 16; ++r) p0[r] = __builtin_amdgcn_exp2f(p0[r]);
}
__device__ __forceinline__ void finishSM(f32x16& p0, f32x16& p1, float alpha, float& l_reg, bf16x8& pa0, bf16x8& pa1, bf16x8& pa2, bf16x8& pa3) {
    for (int r = 0; r < 16; ++r) p1[r] = __builtin_amdgcn_exp2f(p1[r]);
    float ps = 0; for (int r = 0; r < 16; ++r) ps += p0[r]; for (int r = 0; r < 16; ++r) ps += p1[r];
    { auto rr = __builtin_amdgcn_permlane32_swap(__float_as_uint(ps), __float_as_uint(ps), false, false);
      ps = __uint_as_float(rr[0]) + __uint_as_float(rr[1]); }
    l_reg = l_reg * alpha + ps;
#define PK4(P, B_, OUT) do { unsigned a0 = cvtpk(P[B_+0], P[B_+1]), a1 = cvtpk(P[B_+2], P[B_+3]);                          \
        unsigned b0 = cvtpk(P[B_+4], P[B_+5]), b1 = cvtpk(P[B_+6], P[B_+7]);                                             \
        auto r0 = __builtin_amdgcn_permlane32_swap(a0, b0, false, false); auto r1 = __builtin_amdgcn_permlane32_swap(a1, b1, false, false); \
        u32x4 w = {r0[0], r1[0], r0[1], r1[1]}; OUT = *reinterpret_cast<bf16x8*>(&w); } while (0)
    PK4(p0, 0, pa0); PK4(p0, 8, pa1); PK4(p1, 0, pa2); PK4(p1, 8, pa3);
#undef PK4
}
template <int KB, bool SK>
__device__ __forceinline__ void qkt(f32x16& p0, f32x16& p1, const char* K_lds, int r32, int hi, const bf16x8* qr, bool act, const float* bl) {
    if (SK && !act) { const float NEG = -__builtin_inff();
#pragma unroll
        for (int r = 0; r < 16; ++r) { p0[r] = NEG; p1[r] = NEG; } return; }
    { const f32x4 c0 = *(const f32x4*)(bl), c1 = *(const f32x4*)(bl + 8), c2 = *(const f32x4*)(bl + 16), c3 = *(const f32x4*)(bl + 24);
      const f32x4 e0 = *(const f32x4*)(bl + 32), e1 = *(const f32x4*)(bl + 40), e2 = *(const f32x4*)(bl + 48), e3 = *(const f32x4*)(bl + 56);
      p0 = (f32x16){c0[0], c0[1], c0[2], c0[3], c1[0], c1[1], c1[2], c1[3], c2[0], c2[1], c2[2], c2[3], c3[0], c3[1], c3[2], c3[3]};
      p1 = (f32x16){e0[0], e0[1], e0[2], e0[3], e1[0], e1[1], e1[2], e1[3], e2[0], e2[1], e2[2], e2[3], e3[0], e3[1], e3[2], e3[3]}; }
    const char* kb[4];
#pragma unroll
    for (int dd = 0; dd < 4; ++dd) kb[dd] = K_lds + KB * SHM_K + KSWZ(r32, (dd * 16 + hi * 8) * 2);
#pragma unroll
    for (int d0 = 0; d0 < 8; ++d0) { const char* a = kb[d0 & 3] + (d0 >> 2) * 128;
        bf16x8 b0 = *reinterpret_cast<const bf16x8*>(a);
        bf16x8 b1 = *reinterpret_cast<const bf16x8*>(a + 32 * 256);
        p0 = __builtin_amdgcn_mfma_f32_32x32x16_bf16(b0, qr[d0], p0, 0, 0, 0);
        p1 = __builtin_amdgcn_mfma_f32_32x32x16_bf16(b1, qr[d0], p1, 0, 0, 0); }
}
template <int VB, bool SK>
__device__ __forceinline__ void pv_tile(f32x16* o, int vb0, bf16x8 pa0, bf16x8 pa1, bf16x8 pa2, bf16x8 pa3, bool act) {
    if (SK && !act) return;
#define TRRD(dst, off) asm volatile("ds_read_b64_tr_b16 %0, %1 offset:%2" : "=&v"(dst) : "v"(vb0), "i"(off) : "memory")
#define PV_D0(d0) do { s16x4 l0, l1, l2, l3, h0, h1, h2, h3; constexpr int b_ = VB * SHM_V + v_rd_off(d0, 0, 0);     \
        TRRD(l0, b_); TRRD(h0, b_ + 2048); TRRD(l1, b_ + 4096); TRRD(h1, b_ + 6144); TRRD(l2, b_ + 8192); TRRD(h2, b_ + 10240); TRRD(l3, b_ + 12288); TRRD(h3, b_ + 14336); \
        asm volatile("s_waitcnt lgkmcnt(0)" ::: "memory"); SBAR();                 \
        o[d0] = __builtin_amdgcn_mfma_f32_32x32x16_bf16(pa0, (bf16x8){l0[0], l0[1], l0[2], l0[3], h0[0], h0[1], h0[2], h0[3]}, o[d0], 0, 0, 0);   \
        o[d0] = __builtin_amdgcn_mfma_f32_32x32x16_bf16(pa1, (bf16x8){l1[0], l1[1], l1[2], l1[3], h1[0], h1[1], h1[2], h1[3]}, o[d0], 0, 0, 0);   \
        o[d0] = __builtin_amdgcn_mfma_f32_32x32x16_bf16(pa2, (bf16x8){l2[0], l2[1], l2[2], l2[3], h2[0], h2[1], h2[2], h2[3]}, o[d0], 0, 0, 0);   \
        o[d0] = __builtin_amdgcn_mfma_f32_32x32x16_bf16(pa3, (bf16x8){l3[0], l3[1], l3[2], l3[3], h3[0], h3[1], h3[2], h3[3]}, o[d0], 0, 0, 0); } while (0)
    PV_D0(0); PV_D0(1); PV_D0(2); PV_D0(3);
#undef PV_D0
#undef TRRD
}


struct BlockRef { unsigned char* ws; int bh, P0, jbot, jtop, far;
    __device__ __forceinline__ const bf16* Qp() const { return (const bf16*)(ws + WS_Q) + ((size_t)bh * SEQ + P0) * D; }
    __device__ __forceinline__ const bf16* Kp() const { return (const bf16*)(ws + WS_K) + (size_t)bh * SEQ * D; }
    __device__ __forceinline__ const bf16* Vp() const { return (const bf16*)(ws + WS_VV) + (size_t)bh * SEQ * D; }
    __device__ __forceinline__ const float* KBp() const { return (const float*)(ws + WS_KB) + (size_t)bh * SEQ; }
    __device__ __forceinline__ int opitch() const { return far ? AW : DM; }
    __device__ __forceinline__ bf16* Op() const { const size_t rowb = (size_t)(bh >> 3) * SEQ + P0; return far ? (bf16*)(ws + WS_OB) + rowb * AW + (bh & 7) * D : (bf16*)(ws + WS_MRG) + rowb * DM + (bh & 7) * D; }
    __device__ __forceinline__ float* LWp() const { const size_t rowb = (size_t)(bh >> 3) * SEQ + P0; return (float*)(ws + WS_LW) + (size_t)far * T * 8 + rowb * 8 + (bh & 7); } };
struct Seam { bf16x8 qr[8]; bf16x8 st_v0, st_v1, st_k0, st_k1; };
#define ROW(p, k0, rr) ((p) + (size_t)((k0) + (rr)) * D + sc)
#define VMW() asm volatile("s_waitcnt vmcnt(0)" ::: "memory")
#define VMWN(n) asm volatile("s_waitcnt vmcnt(%0)" :: "i"(n) : "memory")
#define SLOAD_H(Kp, Vp, k0) do { S.st_v0 = load8<bf16>(ROW(Vp, k0, sr)); S.st_v1 = load8<bf16>(ROW(Vp, k0, 32 + sr));              \
                         S.st_k0 = load8<bf16>(ROW(Kp, k0, sr)); S.st_k1 = load8<bf16>(ROW(Kp, k0, 32 + sr)); } while (0)
#define SWRITE_HK(bf) do { *(bf16x8*)(K_lds + (bf) * SHM_K + kws) = S.st_k0; *(bf16x8*)(K_lds + (bf) * SHM_K + kws + 32 * 256) = S.st_k1; } while (0)
#define SWRITE_HV(bf) do { *(bf16x8*)(V_lds + (bf) * SHM_V + vst0) = S.st_v0; *(bf16x8*)(V_lds + (bf) * SHM_V + vst1) = S.st_v1; } while (0)
#define SWRITE_H(bf) do { SWRITE_HV(bf); SWRITE_HK(bf); } while (0)
__device__ __forceinline__ void fox_prime(const BlockRef& cur, char* lds, Seam& S, int kw) {
    const int tid = ktid(kw), wid = kw, lane = tid & 63, r32 = lane & 31, hi = lane >> 5;
    const int sr = tid >> 4, sc = (tid & 15) * 8, kws = KSWZ(sr, sc * 2); char* K_lds = lds + 2 * SHM_V;
#pragma unroll
    for (int d0 = 0; d0 < 8; ++d0) S.qr[d0] = load8<bf16>(cur.Qp() + (size_t)(wid * QBLK + r32) * D + d0 * 16 + hi * 8);
    SLOAD_H(cur.Kp(), cur.Vp(), cur.jtop * KVBLK); VMW(); SWRITE_HK(0);
    __syncthreads();
}
__device__ __forceinline__ void fox_block(const BlockRef& cur, const BlockRef& nxt, char* lds, Seam& S, int kw) {
    constexpr bool SK = false; constexpr unsigned W = 0x7fffffffu;
    const int tid = ktid(kw), wid = kw, lane = tid & 63, r32 = lane & 31, hi = lane >> 5;
    const int JH = cur.jtop;
    const int NT = JH + 1 - cur.jbot;
    const int qlo = cur.P0 + wid * QBLK, qm = qlo + r32 - 4 * hi;
    char* V_lds = lds; char* K_lds = lds + 2 * SHM_V;
    float* ws = (float*)(lds + 2 * SHM_V + 2 * SHM_K) + wid * 64; float* li_l = ws, * al_l = ws + 32;
    float m_reg = -1e30f, l_reg = 0; f32x16 o[4] = {};
    const int sr = tid >> 4, sc = (tid & 15) * 8, vst0 = v_st(sr, sc), vst1 = v_st(32 + sr, sc), kws = KSWZ(sr, sc * 2);
    const int vb0 = (int)(uintptr_t)V_lds + v_rd_base(lane);
    const bf16* Kh = cur.Kp(); const bf16* Vh = cur.Vp();
    float* bias_l = (float*)(lds + LDS_BIAS);
    { const int nb4 = 16 * (cur.jtop + 1); int i0 = ktid(kw); asm volatile("" : "+v"(i0));
      for (int i = 16 * cur.jbot + i0; i < nb4; i += NW * 64) ((f32x4*)bias_l)[i] = ((const f32x4*)cur.KBp())[i]; }
    __syncthreads();
    const float* KBh = bias_l + 4 * hi;
#define RESC(a) do { if (__any((a) < 1.f)) { if (hi == 0) al_l[r32] = (a); asm volatile("s_waitcnt lgkmcnt(0)" ::: "memory");              \
                     for (int d_ = 0; d_ < 4; ++d_) for (int r = 0; r < 16; ++r) o[d_][r] *= al_l[crow(r, hi)]; } } while (0)
#define KBASE(t) ((JH - (t)) * KVBLK)
#define ACT(t) true
#define MASKT(P0_, P1_, t) do { const int kb_ = KBASE(t); if (kb_ + KVBLK - 1 > qlo) mask_tile(P0_, P1_, qm - kb_, W); } while (0)
    constexpr int NQL = 8;
#define SEAM_K0() do { VMWN(NQL); SWRITE_HK(0); SBAR(); } while (0)
    f32x16 pA0, pA1, pB0, pB1; float mnA, mnB, alA, alB; bf16x8 pa0, pa1, pa2, pa3;
    SWRITE_HV(0); SBAR();
    if (NT > 1) { SLOAD_H(Kh, Vh, KBASE(1)); }
    SBAR(); qkt<0, SK>(pA0, pA1, K_lds, r32, hi, S.qr, ACT(0), KBh + KBASE(0));
    MASKT(pA0, pA1, 0); partialSM(pA0, pA1, m_reg, mnA, alA);
    if (NT > 1) { VMW(); SWRITE_H(1); }
    __syncthreads();
#define HALF_STEP(PX0, PX1, mnX, alX, PY0, PY1, alY, t, KB, VB, SB) do {                                                      \
        SBAR(); qkt<KB, SK>(PX0, PX1, K_lds, r32, hi, S.qr, ACT(t), KBh + KBASE(t));                                             \
        finishSM(PY0, PY1, alY, l_reg, pa0, pa1, pa2, pa3); SBAR();                                                           \
        if ((t) + 1 < NT) { SLOAD_H(Kh, Vh, KBASE((t) + 1)); SBAR(); }                                                        \
        pv_tile<VB, SK>(o, vb0, pa0, pa1, pa2, pa3, ACT((t) - 1)); MASKT(PX0, PX1, (t)); partialSM(PX0, PX1, m_reg, mnX, alX);  \
        __syncthreads();                                                                                                      \
        if ((t) + 1 < NT) { VMW(); SWRITE_H(SB); }                                                                            \
        RESC(alX); __syncthreads(); } while (0)
    for (int t = 1; t + 1 < NT; t += 2) {
        HALF_STEP(pB0, pB1, mnB, alB, pA0, pA1, alA, t, 1, 0, 0);
        HALF_STEP(pA0, pA1, mnA, alA, pB0, pB1, alB, t + 1, 0, 1, 1);
    }
    const bool even = (NT & 1) == 0;
    if (even) { SBAR(); qkt<1, SK>(pB0, pB1, K_lds, r32, hi, S.qr, ACT(NT - 1), KBh + KBASE(NT - 1)); SBAR(); }
    SLOAD_H(nxt.Kp(), nxt.Vp(), nxt.jtop * KVBLK); SBAR();
#pragma unroll
    for (int d0 = 0; d0 < 8; ++d0) S.qr[d0] = load8<bf16>(nxt.Qp() + (size_t)(wid * QBLK + r32) * D + d0 * 16 + hi * 8);
    SBAR();
    finishSM(pA0, pA1, alA, l_reg, pa0, pa1, pa2, pa3); SBAR();
    pv_tile<0, SK>(o, vb0, pa0, pa1, pa2, pa3, true);
    if (even) { MASKT(pB0, pB1, NT - 1); partialSM(pB0, pB1, m_reg, mnB, alB); __syncthreads(); RESC(alB);
        finishSM(pB0, pB1, alB, l_reg, pa0, pa1, pa2, pa3); SBAR(); pv_tile<1, SK>(o, vb0, pa0, pa1, pa2, pa3, true); }
    SBAR(); SEAM_K0();
    { int le = ktid(kw); asm volatile("" : "+v"(le)); const int r32e = le & 31, hie = (le >> 5) & 1;
      if (hie == 0) { li_l[r32e] = l_reg; cur.LWp()[(size_t)(wid * QBLK + r32e) * 8] = m_reg * (1.4426950408889634f * SCALE) + __builtin_amdgcn_logf(l_reg); }
      asm volatile("s_waitcnt lgkmcnt(0)" ::: "memory");
      float rli[16];
#pragma unroll
      for (int r = 0; r < 16; ++r) rli[r] = __builtin_amdgcn_rcpf(li_l[crow(r, hie)]);
      bf16* Ow = cur.Op() + (size_t)(wid * QBLK) * cur.opitch() + r32e;
#pragma unroll
      for (int r = 0; r < 16; ++r) { const int orow = crow(r, hie);
#pragma unroll
          for (int d0 = 0; d0 < 4; ++d0) { const float v = o[d0][r] * rli[r];
              const float vn = __shfl_xor(v, 1);
              if ((r32e & 1) == 0) *(unsigned*)(Ow + (size_t)orow * cur.opitch() + d0 * 32) = cvtpk(v, vn); } } }
    __syncthreads();
#undef RESC
#undef KBASE
#undef ACT
#undef MASKT
#undef SEAM_K0
#undef HALF_STEP
}
#undef ROW
#undef VMW
#undef VMWN
#undef SLOAD_H
#undef SWRITE_HK
#undef SWRITE_HV
#undef SWRITE_H
#undef KSWZ
#undef SBAR
}

struct Frame {
    LAS unsigned char* lds;
    volatile LAS unsigned* MISC;
    gu32* ctl;
    int tid, lane, wave;
    int vcu, G, bx;
    const float *x, *c, *w_ada, *b_ada, *g_mix, *w_in, *b_f, *conv_w, *conv_b, *lru_w_a, *lru_b_a, *lru_w_x, *lru_b_x, *lru_lambda,
                *g_attn_out, *g_lru_out, *w_out, *g_ffn, *peer_w_q, *peer_k1, *peer_k2, *peer_u, *peer_v, *g_final;
    float* out;
    float *MOD, *LF, *KB, *SUMM, *EW, *USC, *VSC, *PD, *Y, *ACT, *PART;
    int* EIDX;
    bf16_t *WLRU, *K1, *K2, *WIN, *WOUT, *WQ, *H, *Q, *K, *VV, *QP, *LX, *GLY, *MRG, *HL, *AC, *X1, *OB;
    float* LW; unsigned* SPLIT;
    unsigned char *U8, *V8, *H8, *M8, *WQ8, *WIN8, *WOUT8;
    float *RS, *CS;
};

struct Args { const float* in[24]; float* out; unsigned char* ws; int ph_lo, ph_hi, li, pad; };

__device__ __forceinline__ void p0_transpose_item(const float* W, int ldw, int K, bf16_t* WT, int kb, int scol, int drow, const float* gk, LAS float* scr, int lane, unsigned* cmax = nullptr) {
    const int k0 = 64 * kb;
    float wv[32];
#pragma unroll
    for (int i = 0; i < 32; ++i) { const int kk = 2 * i + (lane >> 5); wv[i] = W[(size_t)(k0 + kk) * ldw + scol + (lane & 31)]; }
    if (gk) {
#pragma unroll
        for (int i = 0; i < 32; ++i) wv[i] *= gk[k0 + 2 * i + (lane >> 5)]; }
    if (cmax) { float am = 0.f;
#pragma unroll
        for (int i = 0; i < 32; ++i) am = fmaxf(am, fabsf(wv[i]));
        am = fmaxf(am, __shfl_xor(am, 32));
        if (lane < 32) __hip_atomic_fetch_max(cmax + drow + lane, fbits(am), RLX_AGENT); }
#pragma unroll
    for (int i = 0; i < 32; ++i) { const int kk = 2 * i + (lane >> 5); scr[kk * 33 + (lane & 31)] = wv[i]; }
    LDS_WAIT(); asm volatile("" ::: "memory");
    const int c = lane & 7;
#pragma unroll
    for (int j = 0; j < 4; ++j) { const int n = (lane >> 3) + 8 * j; const LAS float* s = scr + (8 * c) * 33 + n;
        v4u o; o.x = pk2(s[0 * 33], s[1 * 33]); o.y = pk2(s[2 * 33], s[3 * 33]); o.z = pk2(s[4 * 33], s[5 * 33]); o.w = pk2(s[6 * 33], s[7 * 33]);
        *(GAS v4u*)(WT + (size_t)(drow + n) * K + k0 + 8 * c) = o; }
    LDS_WAIT(); asm volatile("" ::: "memory");
}
__device__ __forceinline__ void p0_convert(const float* src, bf16_t* dst, size_t n8, size_t gt, size_t ngt) {
#pragma unroll 4
    for (size_t i = gt; i < n8; i += ngt) { const f32x4 a = *(const GAS f32x4*)(src + i * 8), b = *(const GAS f32x4*)(src + i * 8 + 4);
        v4u o; o.x = pk2(a[0], a[1]); o.y = pk2(a[2], a[3]); o.z = pk2(b[0], b[1]); o.w = pk2(b[2], b[3]); *(GAS v4u*)(dst + i * 8) = o; }
}
template <int PARTS>
__device__ __forceinline__ void p0_prologue(Frame& F) {
    if (PARTS & 1) {
        LAS float* scs = (LAS float*)F.lds;
        LAS float* red = scs + 4 * 2048;
        for (int i = F.tid; i < 4 * DM; i += NTHR) { const float cv = F.c[i]; scs[i] = cv * sigmoidf_(cv); }
        __syncthreads();
        for (int cb = F.bx; cb < 192; cb += F.G) {
            const int cq = F.tid & 15, rl = F.tid >> 4;
            { float acc[4][4];
#pragma unroll
              for (int b = 0; b < 4; ++b)
#pragma unroll
                  for (int j = 0; j < 4; ++j) acc[b][j] = 0.f;
              const float* wp = F.w_ada + (size_t)rl * NADA + cb * 64 + cq * 4;
#pragma unroll 16
              for (int r = rl; r < DM; r += 32, wp += (size_t)32 * NADA) { const f32x4 w = *(const GAS f32x4*)wp;
#pragma unroll
                  for (int b = 0; b < 4; ++b) { const float sv = scs[b * DM + r]; acc[b][0] += sv * w[0]; acc[b][1] += sv * w[1]; acc[b][2] += sv * w[2]; acc[b][3] += sv * w[3]; } }
#pragma unroll
              for (int b = 0; b < 4; ++b)
#pragma unroll
                  for (int j = 0; j < 4; ++j) red[rl * 256 + cq * 16 + b * 4 + j] = acc[b][j]; }
            __syncthreads();
            if (F.tid < 256) { float sm = 0.f;
                for (int r = 0; r < 32; ++r) sm += red[r * 256 + F.tid];
                const int q = F.tid >> 4, b = (F.tid >> 2) & 3, j = F.tid & 3, col = cb * 64 + q * 4 + j;
                F.MOD[b * NADA + col] = sm + F.b_ada[col]; }
            __syncthreads();
        }
        __syncthreads();
    }
    if (PARTS & 2) {
        LAS float* scr = (LAS float*)(F.lds + F.wave * 16384);
        const int gw = F.vcu * NWAVES + F.wave, NGW = F.G * NWAVES;
        constexpr int I_IN1 = 32 * 96, I_IN2 = 32 * 64, I_SQ = 32 * 64, I_LRU = 16 * 8;
        constexpr int NITEMS = I_IN1 + I_IN2 + 2 * I_SQ + I_LRU;
        for (int it = gw; it < NITEMS; it += NGW) {
            int r = it;
            unsigned* cmx = (unsigned*)F.ctl + CW_CMAX;
            if (r < I_IN1) { const int kb = r / 96, nb = r % 96; p0_transpose_item(F.w_in, INC, DM, F.WIN, kb, 32 * nb, 32 * nb, nullptr, scr, F.lane, cmx + 4096); continue; } r -= I_IN1;
            if (r < I_IN2) { const int kb = r / 64, nb = r % 64; p0_transpose_item(F.w_in, INC, DM, F.WIN, kb, OFF_LX + 32 * nb, OFF_F + 32 * nb, nullptr, scr, F.lane, cmx + 4096); continue; } r -= I_IN2;
            if (r < I_SQ) { const int kb = r / 64, nb = r % 64; const float* gk = kb < 16 ? F.g_attn_out : F.g_lru_out - AW;
                p0_transpose_item(F.w_out, DM, DM, F.WOUT, kb, 32 * nb, 32 * nb, gk, scr, F.lane, cmx + 2048); continue; } r -= I_SQ;
            if (r < I_SQ) { const int kb = r / 64, nb = r % 64; p0_transpose_item(F.peer_w_q, DM, DM, F.WQ, kb, 32 * nb, 32 * nb, nullptr, scr, F.lane, (unsigned*)F.ctl + CW_CMAX); continue; } r -= I_SQ;
            { const int mat = r >> 3, sub = r & 7, n = mat >> 1, which = mat & 1, kb = sub >> 2, nb = sub & 3;
              const float* src = (which ? F.lru_w_x : F.lru_w_a) + (size_t)n * LBD * LBD;
              p0_transpose_item(src, LBD, LBD, F.WLRU + (size_t)(n * 256 + which * 128) * LBD, kb, 32 * nb, 32 * nb, nullptr, scr, F.lane); }
        }
    }
    if (PARTS & 4) {
        const size_t gt = (size_t)F.vcu * NTHR + F.tid, ngt = (size_t)F.G * NTHR;
        p0_convert(F.peer_k1, F.K1, (size_t)PH * PNK * 128 / 8, gt, ngt);
        p0_convert(F.peer_k2, F.K2, (size_t)PH * PNK * 128 / 8, gt, ngt);
    }
}

__device__ __forceinline__ unsigned pk_i8(float a, float b, float c, float d) {
    const int ia = (int)__builtin_rintf(a), ib = (int)__builtin_rintf(b), ic = (int)__builtin_rintf(c), id = (int)__builtin_rintf(d);
    return (unsigned)(ia & 255) | ((unsigned)(ib & 255) << 8) | ((unsigned)(ic & 255) << 16) | ((unsigned)id << 24);
}
constexpr int CONV_P8_ROWS = 2 * NEXP;
__device__ __forceinline__ void conv_row_load(Frame& F, int r, f32x4 (&v)[8]) {
    const bool isv = r >= NEXP; const int rr = isv ? r - NEXP : r;
    const GAS f32x4* src = (const GAS f32x4*)((isv ? F.peer_v : F.peer_u) + (size_t)rr * DM) + F.lane;
#pragma unroll
    for (int j = 0; j < 8; ++j) v[j] = __builtin_nontemporal_load(src + 64 * j);
}
template <bool I8>
__device__ __forceinline__ void conv_row_finish(Frame& F, int r, const f32x4 (&v)[8]) {
    const bool isv = r >= NEXP; const int rr = isv ? r - NEXP : r; float am = 0.f;
#pragma unroll
    for (int j = 0; j < 8; ++j) am = fmaxf(am, fmaxf(fmaxf(fabsf(v[j][0]), fabsf(v[j][1])), fmaxf(fabsf(v[j][2]), fabsf(v[j][3]))));
#pragma unroll
    for (int o = 1; o < 64; o <<= 1) am = fmaxf(am, __shfl_xor(am, o));
    constexpr float TOP = I8 ? 127.f : 416.f;
    const float sc = am > 0.f ? TOP / am : 1.f;
    GAS unsigned char* dstb = (GAS unsigned char*)(isv ? F.V8 : F.U8) + (size_t)(F.lane >> 5) * ((size_t)NEXP * 128) + (size_t)rr * 128 + (F.lane & 31) * 4;
#pragma unroll
    for (int j = 0; j < 8; ++j) { unsigned pkv;
        if (I8) pkv = pk_i8(v[j][0] * sc, v[j][1] * sc, v[j][2] * sc, v[j][3] * sc);
        else { int pk = 0; pk = __builtin_amdgcn_cvt_pk_fp8_f32(v[j][0] * sc, v[j][1] * sc, pk, false); pk = __builtin_amdgcn_cvt_pk_fp8_f32(v[j][2] * sc, v[j][3] * sc, pk, true); pkv = (unsigned)pk; }
        __builtin_nontemporal_store(pkv, (GAS unsigned*)(dstb + (size_t)(2 * j) * ((size_t)NEXP * 128))); }
    if (F.lane == 0) (isv ? F.VSC : F.USC)[rr] = am > 0.f ? am * (1.f / TOP) : 1.f;
}
__device__ __forceinline__ void conv_item(Frame& F, int item) {
#pragma unroll 1
    for (int pr = 0; pr < 2; ++pr) {
        f32x4 v[2][8]; float am[2] = {0.f, 0.f};
#pragma unroll
        for (int u = 0; u < 2; ++u) { const int r = item * 32 + F.wave * 4 + pr * 2 + u; const bool isv = r >= NEXP; const int rr = isv ? r - NEXP : r;
            const GAS f32x4* src = (const GAS f32x4*)((isv ? F.peer_v : F.peer_u) + (size_t)rr * DM) + F.lane;
#pragma unroll
            for (int j = 0; j < 8; ++j) v[u][j] = src[64 * j]; }
#pragma unroll
        for (int u = 0; u < 2; ++u) { const int r = item * 32 + F.wave * 4 + pr * 2 + u; const bool isv = r >= NEXP; const int rr = isv ? r - NEXP : r;
#pragma unroll
            for (int j = 0; j < 8; ++j) am[u] = fmaxf(am[u], fmaxf(fmaxf(fabsf(v[u][j][0]), fabsf(v[u][j][1])), fmaxf(fabsf(v[u][j][2]), fabsf(v[u][j][3]))));
#pragma unroll
            for (int o = 1; o < 64; o <<= 1) am[u] = fmaxf(am[u], __shfl_xor(am[u], o));
            const float sc = am[u] > 0.f ? 416.f / am[u] : 1.f;
            GAS unsigned char* dstb = (GAS unsigned char*)(isv ? F.V8 : F.U8) + (size_t)(F.lane >> 5) * ((size_t)NEXP * 128) + (size_t)rr * 128 + (F.lane & 31) * 4;
#pragma unroll
            for (int j = 0; j < 8; ++j) { int pk = 0; pk = __builtin_amdgcn_cvt_pk_fp8_f32(v[u][j][0] * sc, v[u][j][1] * sc, pk, false); pk = __builtin_amdgcn_cvt_pk_fp8_f32(v[u][j][2] * sc, v[u][j][3] * sc, pk, true);
                *(GAS unsigned*)(dstb + (size_t)(2 * j) * ((size_t)NEXP * 128)) = (unsigned)pk; }
            if (F.lane == 0) (isv ? F.VSC : F.USC)[rr] = am[u] > 0.f ? am[u] / 416.f : 1.f; }
    }
}

__device__ __forceinline__ void quant_rows_i8(Frame& F, const bf16_t* WT, unsigned char* W8, float* cs, const unsigned* cmax, int rows) {
    const int gw = F.vcu * NWAVES + F.wave, NGW = F.G * NWAVES;
    for (int r = gw; r < rows; r += NGW) {
        const float am = bitsf(cmax[r]) * 1.004f;
        const float s8 = am > 0.f ? 127.f / am : 1.f;
        const GAS v4u* src = (const GAS v4u*)(WT + (size_t)r * DM) + F.lane; GAS v2u* dst = (GAS v2u*)(W8 + (size_t)r * DM) + F.lane;
#pragma unroll
        for (int j = 0; j < 4; ++j) { const v4u w = src[64 * j];
            v2u o; o.x = pk_i8(bf_lo(w.x) * s8, bf_hi(w.x) * s8, bf_lo(w.y) * s8, bf_hi(w.y) * s8); o.y = pk_i8(bf_lo(w.z) * s8, bf_hi(w.z) * s8, bf_lo(w.w) * s8, bf_hi(w.w) * s8);
            dst[64 * j] = o; }
        if (F.lane == 0) cs[r] = am > 0.f ? am * (1.f / 127.f) : 1.f;
    }
}

template <bool WITH_F, bool I8OUT = false, bool BF16OUT = true>
__device__ __forceinline__ void p_modnorm(Frame& F, const float* xin, const float* g, int off_sh, int off_sc) {
    LAS float* gsv = (LAS float*)F.lds;
    LAS float* shv = gsv + DM;
    LAS float* wfT = shv + DM;
    if (WITH_F) { for (int i = F.tid; i < 8 * DM; i += NTHR) { const int k = i >> 3, j = i & 7; wfT[j * DM + k] = F.w_in[(size_t)k * INC + OFF_F + j]; } }
    for (int rb = F.bx; rb < T / 64; rb += F.G) {
        const int b = rb >> 6;
        __syncthreads();
        for (int k = F.tid; k < DM; k += NTHR) { gsv[k] = g[k] * (1.f + F.MOD[b * NADA + off_sc + k]); shv[k] = F.MOD[b * NADA + off_sh + k]; }
        __syncthreads();
        for (int i = 0; i < 8; ++i) {
            const int row = rb * 64 + F.wave * 8 + i;
            f32x4 v[8]; float ss = 0.f;
            if (WITH_F) { const GAS f32x4* xr = (const GAS f32x4*)(xin + (size_t)row * DM) + F.lane;
#pragma unroll
                for (int j = 0; j < 8; ++j) v[j] = xr[64 * j]; }
            else { const GAS v2u* xr = (const GAS v2u*)(F.X1 + (size_t)row * DM) + F.lane;
#pragma unroll
                for (int j = 0; j < 8; ++j) { const v2u w = xr[64 * j]; v[j] = (f32x4){bf_lo(w.x), bf_hi(w.x), bf_lo(w.y), bf_hi(w.y)}; } }
#pragma unroll
            for (int j = 0; j < 8; ++j) ss += (v[j][0] * v[j][0] + v[j][1] * v[j][1]) + (v[j][2] * v[j][2] + v[j][3] * v[j][3]);
            const float rstd = __builtin_amdgcn_rsqf(wave_sum(ss) * (1.f / DM) + EPS);
#pragma unroll
            for (int j = 0; j < 8; ++j) { const f32x4 gg = ((const LAS f32x4*)gsv)[F.lane + 64 * j], sh = ((const LAS f32x4*)shv)[F.lane + 64 * j]; v[j] = v[j] * rstd * gg + sh; }
            if (BF16OUT) { GAS v2u* o8 = (GAS v2u*)(F.H + (size_t)row * DM) + F.lane;
#pragma unroll
                for (int j = 0; j < 8; ++j) { v2u w; w.x = pk2(v[j][0], v[j][1]); w.y = pk2(v[j][2], v[j][3]); o8[64 * j] = w; } }
            if (I8OUT) {
                float am = 0.f;
#pragma unroll
                for (int j = 0; j < 8; ++j) am = fmaxf(am, fmaxf(fmaxf(fabsf(v[j][0]), fabsf(v[j][1])), fmaxf(fabsf(v[j][2]), fabsf(v[j][3]))));
#pragma unroll
                for (int o = 1; o < 64; o <<= 1) am = fmaxf(am, __shfl_xor(am, o));
                const float s8 = am > 0.f ? 127.f / am : 1.f;
                GAS unsigned* o4 = (GAS unsigned*)(F.H8 + (size_t)row * DM) + F.lane;
#pragma unroll
                for (int j = 0; j < 8; ++j) o4[64 * j] = pk_i8(v[j][0] * s8, v[j][1] * s8, v[j][2] * s8, v[j][3] * s8);
                if (F.lane == 0) F.RS[row] = am > 0.f ? am * (1.f / 127.f) : 1.f;
            }
            if (WITH_F) {
                float fa[8];
#pragma unroll
                for (int jj = 0; jj < 8; ++jj) { float a = 0.f;
#pragma unroll
                    for (int j = 0; j < 8; ++j) { const f32x4 w = ((const LAS f32x4*)(wfT + jj * DM))[F.lane + 64 * j]; a += (v[j][0] * w[0] + v[j][1] * w[1]) + (v[j][2] * w[2] + v[j][3] * w[3]); }
                    fa[jj] = a; __builtin_amdgcn_sched_barrier(0); }
                const bool c5 = (F.lane & 32) != 0, c4 = (F.lane & 16) != 0, c3 = (F.lane & 8) != 0;
                float f4[4], f2[2], mine;
#pragma unroll
                for (int q = 0; q < 4; ++q) { const float keep = c5 ? fa[4 + q] : fa[q], send = c5 ? fa[q] : fa[4 + q]; f4[q] = keep + __shfl_xor(send, 32); }
#pragma unroll
                for (int q = 0; q < 2; ++q) { const float keep = c4 ? f4[2 + q] : f4[q], send = c4 ? f4[q] : f4[2 + q]; f2[q] = keep + __shfl_xor(send, 16); }
                { const float keep = c3 ? f2[1] : f2[0], send = c3 ? f2[0] : f2[1]; mine = keep + __shfl_xor(send, 8); }
                mine += __shfl_xor(mine, 4); mine += __shfl_xor(mine, 2); mine += __shfl_xor(mine, 1);
                if ((F.lane & 7) == 0) { const int jf = F.lane >> 3; const float z = mine + F.b_f[jf]; const float lf = fminf(z, 0.f) - log1pf(fexp(-fabsf(z)));
                    F.LF[(size_t)(b * NH + jf) * SEQ + (row & (SEQ - 1))] = lf; }
            }
        }
    }
}

__device__ __forceinline__ void p2_cumsum(Frame& F) {
    LAS float* wt = (LAS float*)F.lds;
    for (int bh = F.bx; bh < BATCH * NH; bh += F.G) {
        const float* src = F.LF + (size_t)bh * SEQ + F.tid * 8;
        const f32x4 a = *(const GAS f32x4*)src, b = *(const GAS f32x4*)(src + 4);
        float p[8]; p[0] = a[0]; p[1] = p[0] + a[1]; p[2] = p[1] + a[2]; p[3] = p[2] + a[3]; p[4] = p[3] + b[0]; p[5] = p[4] + b[1]; p[6] = p[5] + b[2]; p[7] = p[6] + b[3];
        float incl = p[7];
#pragma unroll
        for (int o = 1; o < 64; o <<= 1) { const float n = __shfl_up(incl, o); if (F.lane >= o) incl += n; }
        __syncthreads();
        if (F.lane == 63) wt[F.wave] = incl;
        __syncthreads();
        float off = incl - p[7];
        for (int w = 0; w < F.wave; ++w) off += wt[w];
        constexpr float NIS = -1.0f / 0.08838834764831845f;
        f32x4 o0, o1;
        o0[0] = (off + p[0]) * NIS; o0[1] = (off + p[1]) * NIS; o0[2] = (off + p[2]) * NIS; o0[3] = (off + p[3]) * NIS;
        o1[0] = (off + p[4]) * NIS; o1[1] = (off + p[5]) * NIS; o1[2] = (off + p[6]) * NIS; o1[3] = (off + p[7]) * NIS;
        float* dst = F.KB + (size_t)bh * SEQ + F.tid * 8;
        *(GAS f32x4*)dst = o0; *(GAS f32x4*)(dst + 4) = o1;
    }
}

constexpr int L_LX = 0, L_A = 17408, L_XC = 34816, L_SA = 68608, L_SUM = 102400, L_CW = 106496, L_END = 126976;
constexpr int XS = 132;
typedef float f32x4v __attribute__((ext_vector_type(4)));
#define LDS_BAR() do { asm volatile("s_waitcnt lgkmcnt(0)" ::: "memory"); __builtin_amdgcn_s_barrier(); asm volatile("" ::: "memory"); } while (0)
__device__ __forceinline__ void lru_unit(Frame& F, int b, int chunk) {
    LAS unsigned char* L = F.lds;
    int tid_ = ktid(F.wave); asm volatile("" : "+v"(tid_));
    const int tid = tid_, lane = tid_ & 63, wave = F.wave;
    const int s0 = chunk * 64; const size_t row0 = (size_t)b * SEQ + s0;
    __syncthreads();
    LAS float* cwl = (LAS float*)(L + L_CW);
    for (int i = tid; i < 5 * LW; i += NTHR) cwl[i] = i < 4 * LW ? F.conv_w[i] : F.conv_b[i - 4 * LW];
    const int r16 = lane & 15, g4 = lane >> 4;
    v4u lxv[3]; bf16x8 bwa[4], bwx[4]; float pba, pbx, plam;
#define LRU_LOAD_LX(nn) do { _Pragma("unroll") for (int q_ = 0; q_ < 3; ++q_) { const int idx = tid + q_ * NTHR; const int r = idx >> 4, c8 = idx & 15; const int s = s0 - 3 + r; \
        v4u val = {0u, 0u, 0u, 0u}; if (idx < 67 * 16 && s >= 0) val = *(const GAS v4u*)(F.LX + ((size_t)b * SEQ + s) * LW + (nn) * LBD + c8 * 8); lxv[q_] = val; } } while (0)
#define LRU_LOAD_W(nn) do { const bf16_t* wa_ = F.WLRU + ((size_t)((nn) * 256 + 16 * wave + r16)) * LBD + 8 * g4; const bf16_t* wx_ = wa_ + (size_t)128 * LBD; \
        _Pragma("unroll") for (int ks = 0; ks < 4; ++ks) { bwa[ks] = *(const GAS bf16x8*)(wa_ + 32 * ks); bwx[ks] = *(const GAS bf16x8*)(wx_ + 32 * ks); } \
        const int chg_ = (nn) * LBD + 16 * wave + r16; pba = F.lru_b_a[chg_]; pbx = F.lru_b_x[chg_]; plam = F.lru_lambda[chg_]; } while (0)
    LRU_LOAD_LX(0); LRU_LOAD_W(0);
    for (int n = 0; n < NLB; ++n) {
        const int nn = n + 1 < NLB ? n + 1 : n;
        LDS_BAR();
#pragma unroll
        for (int q = 0; q < 3; ++q) { const int idx = tid + q * NTHR; if (idx < 67 * 16) *(LAS v4u*)(L + L_LX + (idx >> 4) * 256 + (idx & 15) * 16) = lxv[q]; }
        LDS_BAR();
        LRU_LOAD_LX(nn);
        { const int tok = tid >> 3, c16 = tid & 7; const int chg = n * LBD + c16 * 16;
          float xc[16];
#pragma unroll
          for (int e = 0; e < 16; e += 4) { const f32x4 cb = *(const LAS f32x4*)(cwl + 4 * LW + chg + e); xc[e] = cb[0]; xc[e + 1] = cb[1]; xc[e + 2] = cb[2]; xc[e + 3] = cb[3]; }
#pragma unroll
          for (int k = 0; k < 4; ++k) {
              const v4u x0 = *(const LAS v4u*)(L + L_LX + (tok + k) * 256 + c16 * 32), x1 = *(const LAS v4u*)(L + L_LX + (tok + k) * 256 + c16 * 32 + 16);
              const unsigned xd[8] = {x0.x, x0.y, x0.z, x0.w, x1.x, x1.y, x1.z, x1.w};
#pragma unroll
              for (int e = 0; e < 16; e += 4) { const f32x4 w = *(const LAS f32x4*)(cwl + k * LW + chg + e);
                  xc[e] += w[0] * bf_lo(xd[e / 2]); xc[e + 1] += w[1] * bf_hi(xd[e / 2]); xc[e + 2] += w[2] * bf_lo(xd[e / 2 + 1]); xc[e + 3] += w[3] * bf_hi(xd[e / 2 + 1]); } }
          v4u a0, a1; a0.x = pk2(xc[0], xc[1]); a0.y = pk2(xc[2], xc[3]); a0.z = pk2(xc[4], xc[5]); a0.w = pk2(xc[6], xc[7]);
          a1.x = pk2(xc[8], xc[9]); a1.y = pk2(xc[10], xc[11]); a1.z = pk2(xc[12], xc[13]); a1.w = pk2(xc[14], xc[15]);
          *(LAS v4u*)(L + L_A + tok * 272 + c16 * 32) = a0; *(LAS v4u*)(L + L_A + tok * 272 + c16 * 32 + 16) = a1;
          LAS float* xo = (LAS float*)(L + L_XC) + tok * XS + c16 * 16;
#pragma unroll
          for (int e = 0; e < 16; e += 4) *(LAS f32x4*)(xo + e) = (f32x4){xc[e], xc[e + 1], xc[e + 2], xc[e + 3]};
        }
        LDS_BAR();
        f32x4 acc_a[4], acc_x[4];
#pragma unroll
        for (int m = 0; m < 4; ++m) { acc_a[m] = (f32x4){0.f, 0.f, 0.f, 0.f}; acc_x[m] = (f32x4){0.f, 0.f, 0.f, 0.f}; }
#pragma unroll
        for (int ks = 0; ks < 4; ++ks) {
#pragma unroll
            for (int m = 0; m < 4; ++m) { const bf16x8 af = *(const LAS bf16x8*)(L + L_A + (16 * m + r16) * 272 + (32 * ks + 8 * g4) * 2);
                acc_a[m] = __builtin_amdgcn_mfma_f32_16x16x32_bf16(af, bwa[ks], acc_a[m], 0, 0, 0);
                acc_x[m] = __builtin_amdgcn_mfma_f32_16x16x32_bf16(af, bwx[ks], acc_x[m], 0, 0, 0); } }
        const float ba_ = pba, bx_ = pbx; const float sp8 = 8.f * softplusf_(-plam);
        LRU_LOAD_W(nn);
        { const int chl = 16 * wave + r16;
          LAS float* xcp = (LAS float*)(L + L_XC) + chl; LAS float* sap = (LAS float*)(L + L_SA) + chl;
#pragma unroll
          for (int m = 0; m < 4; ++m)
#pragma unroll
              for (int i = 0; i < 4; ++i) { const int tt = 16 * m + 4 * g4 + i;
                  const float rg = sigmoidf_(acc_a[m][i] + ba_), ig = sigmoidf_(acc_x[m][i] + bx_);
                  const float la = -sp8 * rg; const float a = fexp(la); const float x2 = 2.f * la;
                  const float em1 = (x2 > -0.3f) ? x2 * (1.f + x2 * (0.5f + x2 * (0.16666667f + x2 * (0.041666668f + x2 * (0.008333334f + x2 * 0.0013888889f))))) : (fexp(x2) - 1.f);
                  const float bt = __builtin_amdgcn_sqrtf(fmaxf(-em1, 0.f)) * (ig * xcp[tt * XS]);
                  sap[tt * XS] = a; xcp[tt * XS] = bt; } }
        LDS_BAR();
        { const int chl = tid & 127, sub = tid >> 7;
          const LAS float* sap = (const LAS float*)(L + L_SA) + (16 * sub) * XS + chl; const LAS float* sbp = (const LAS float*)(L + L_XC) + (16 * sub) * XS + chl;
          float av[16], bv[16];
#pragma unroll
          for (int j = 0; j < 16; ++j) { av[j] = sap[j * XS]; bv[j] = sbp[j * XS]; }
          float P = 1.f, Hh = 0.f;
#pragma unroll
          for (int j = 0; j < 16; ++j) { Hh = av[j] * Hh + bv[j]; P *= av[j]; }
          LAS f32x2* sm = (LAS f32x2*)(L + L_SUM);
          sm[sub * 128 + chl] = (f32x2){P, Hh};
          LDS_BAR();
          float h = 0.f, cp = 1.f;
          for (int s = 0; s < sub; ++s) { const f32x2 ph = sm[s * 128 + chl]; h = ph[0] * h + ph[1]; cp *= ph[0]; }
          bf16_t* hl = F.HL + (row0 + 16 * sub) * LW + n * LBD + chl; bf16_t* ac = F.AC + (row0 + 16 * sub) * LW + n * LBD + chl;
#pragma unroll
          for (int j = 0; j < 16; ++j) { h = av[j] * h + bv[j]; cp *= av[j]; hl[(size_t)j * LW] = (bf16_t)f2bf(h); ac[(size_t)j * LW] = (bf16_t)f2bf(cp); }
          if (sub == 3) *((GAS f32x2*)F.SUMM + ((size_t)(b * 64 + chunk)) * LW + n * LBD + chl) = (f32x2){cp, h};
        }
    }
}

__device__ __forceinline__ void lru_final(Frame& F, int b, int chunk) {
    LAS float* hin = (LAS float*)F.lds;
    int tid_ = ktid(F.wave); asm volatile("" : "+v"(tid_));
    const int tid = tid_;
    const size_t row0 = (size_t)b * SEQ + chunk * 64;
    __syncthreads();
    { float h0 = 0.f, h1 = 0.f;
      const GAS f32x2* sp = (const GAS f32x2*)F.SUMM + (size_t)(b * 64) * LW + tid;
      for (int c0 = 0; c0 < chunk; c0 += 16) { f32x2 pa[16], pb[16];
#pragma unroll
          for (int q = 0; q < 16; ++q) { const size_t o = (size_t)(c0 + q < chunk ? c0 + q : chunk - 1) * LW; pa[q] = sp[o]; pb[q] = sp[o + NTHR]; }
#pragma unroll
          for (int q = 0; q < 16; ++q) if (c0 + q < chunk) { h0 = pa[q][0] * h0 + pa[q][1]; h1 = pb[q][0] * h1 + pb[q][1]; } }
      hin[tid] = h0; hin[tid + NTHR] = h1; }
    __syncthreads();
    const int tt = tid >> 3, part = tid & 7;
    const bf16_t* hlp = F.HL + (row0 + tt) * LW; const bf16_t* acp = F.AC + (row0 + tt) * LW; const bf16_t* glp = F.GLY + (row0 + tt) * LW;
    bf16_t* rowp = F.MRG + (row0 + tt) * DM;
    const int qb = chunk >> 2; const size_t rowg = row0 + tt;
#define ATT_HALF_PIECE(e_, dst_) do { const int c0_ = ((e_) * 8 + part) * 8, hd_ = (e_) >> 1; v4u a_ = *(const GAS v4u*)(rowp + c0_);                                         \
        if (F.SPLIT[(b * NH + hd_) * (SEQ / 256) + qb]) {                                                                                                                       \
            const float la = F.LW[rowg * 8 + hd_], lb = F.LW[(size_t)T * 8 + rowg * 8 + hd_]; const float mx = fmaxf(la, lb);                                                   \
            const float wa = __builtin_amdgcn_exp2f(la - mx), wb = __builtin_amdgcn_exp2f(lb - mx); const float inv = __builtin_amdgcn_rcpf(wa + wb); const float fa = wa * inv, fb = wb * inv; \
            const v4u fv = *(const GAS v4u*)(F.OB + rowg * AW + c0_); const unsigned da[4] = {a_.x, a_.y, a_.z, a_.w}, db[4] = {fv.x, fv.y, fv.z, fv.w}; unsigned r_[4];           \
            _Pragma("unroll") for (int q = 0; q < 4; ++q) r_[q] = pk2(bf_lo(da[q]) * fa + bf_lo(db[q]) * fb, bf_hi(da[q]) * fa + bf_hi(db[q]) * fb);                            \
            a_.x = r_[0]; a_.y = r_[1]; a_.z = r_[2]; a_.w = r_[3]; }                                                                                                           \
        dst_ = a_; } while (0)
    float sa = 0.f, ama = 0.f;
#pragma unroll
    for (int e = 0; e < 16; ++e) { v4u a; ATT_HALF_PIECE(e, a); const unsigned d[4] = {a.x, a.y, a.z, a.w};
#pragma unroll
        for (int q = 0; q < 4; ++q) { const float lo = bf_lo(d[q]), hi = bf_hi(d[q]); sa += lo * lo + hi * hi; ama = fmaxf(ama, fmaxf(fabsf(lo), fabsf(hi))); } }
    sa += __shfl_xor(sa, 1); sa += __shfl_xor(sa, 2); sa += __shfl_xor(sa, 4);
    const float ra = __builtin_amdgcn_rsqf(sa * (1.f / AW) + EPS);
    __builtin_amdgcn_sched_barrier(0);
    v4u ovl[16]; float ssq = 0.f, aml = 0.f;
#pragma unroll
    for (int e = 0; e < 16; ++e) { const int c0 = (e * 8 + part) * 8;
        const v4u hv = *(const GAS v4u*)(hlp + c0), av = *(const GAS v4u*)(acp + c0), gv = *(const GAS v4u*)(glp + c0);
        const f32x4 c4a = *(const LAS f32x4*)(hin + c0), c4b = *(const LAS f32x4*)(hin + c0 + 4);
        const unsigned hd[4] = {hv.x, hv.y, hv.z, hv.w}, ad[4] = {av.x, av.y, av.z, av.w}, gd[4] = {gv.x, gv.y, gv.z, gv.w};
        const float ci[8] = {c4a[0], c4a[1], c4a[2], c4a[3], c4b[0], c4b[1], c4b[2], c4b[3]}; unsigned r[4];
#pragma unroll
        for (int q = 0; q < 4; ++q) { const float o0 = (bf_lo(hd[q]) + bf_lo(ad[q]) * ci[2 * q]) * bf_lo(gd[q]), o1 = (bf_hi(hd[q]) + bf_hi(ad[q]) * ci[2 * q + 1]) * bf_hi(gd[q]);
            ssq += o0 * o0 + o1 * o1; aml = fmaxf(aml, fmaxf(fabsf(o0), fabsf(o1))); r[q] = pk2(o0, o1); }
        ovl[e].x = r[0]; ovl[e].y = r[1]; ovl[e].z = r[2]; ovl[e].w = r[3]; }
    ssq += __shfl_xor(ssq, 1); ssq += __shfl_xor(ssq, 2); ssq += __shfl_xor(ssq, 4);
    const float rl = __builtin_amdgcn_rsqf(ssq * (1.f / LW) + EPS);
    float am = fmaxf(aml * rl * 1.004f, ama * ra);
    am = fmaxf(am, __shfl_xor(am, 1)); am = fmaxf(am, __shfl_xor(am, 2)); am = fmaxf(am, __shfl_xor(am, 4));
    const float s8 = am > 0.f ? 127.f / am : 1.f; const float rl8 = rl * s8, ra8 = ra * s8;
    unsigned char* row8 = F.M8 + (row0 + tt) * DM;
#pragma unroll
    for (int e = 0; e < 16; ++e) { const int c0 = (e * 8 + part) * 8; const unsigned dl[4] = {ovl[e].x, ovl[e].y, ovl[e].z, ovl[e].w};
        *(GAS v2u*)(row8 + AW + c0) = (v2u){pk_i8(bf_lo(dl[0]) * rl8, bf_hi(dl[0]) * rl8, bf_lo(dl[1]) * rl8, bf_hi(dl[1]) * rl8), pk_i8(bf_lo(dl[2]) * rl8, bf_hi(dl[2]) * rl8, bf_lo(dl[3]) * rl8, bf_hi(dl[3]) * rl8)}; }
    __builtin_amdgcn_sched_barrier(0);
#pragma unroll
    for (int e = 0; e < 16; ++e) { const int c0 = (e * 8 + part) * 8; v4u a; ATT_HALF_PIECE(e, a); const unsigned da[4] = {a.x, a.y, a.z, a.w};
        *(GAS v2u*)(row8 + c0) = (v2u){pk_i8(bf_lo(da[0]) * ra8, bf_hi(da[0]) * ra8, bf_lo(da[1]) * ra8, bf_hi(da[1]) * ra8), pk_i8(bf_lo(da[2]) * ra8, bf_hi(da[2]) * ra8, bf_lo(da[3]) * ra8, bf_hi(da[3]) * ra8)}; }
#undef ATT_HALF_PIECE
    if (part == 0) F.RS[row0 + tt] = am > 0.f ? am * (1.f / 127.f) : 1.f;
}

constexpr float ATT_TH = 24.f;
__device__ __forceinline__ void p3_norms(Frame& F) {
    const int lane = F.lane; const int gw = F.vcu * NWAVES + F.wave, NGW = F.G * NWAVES;
    for (int it = gw; it < 4096; it += NGW) { const bool isq = it >= 2048; const int r64 = it & 2047;
        const bf16_t* rowp = (isq ? F.Q : F.K) + ((size_t)r64 * 64 + lane) * HD; float ss = 0.f;
#pragma unroll
        for (int e = 0; e < 16; ++e) { const v4u v = *(const GAS v4u*)(rowp + 8 * e); const unsigned d[4] = {v.x, v.y, v.z, v.w};
#pragma unroll
            for (int q = 0; q < 4; ++q) { const float lo = bf_lo(d[q]), hi = bf_hi(d[q]); ss += lo * lo + hi * hi; } }
#pragma unroll
        for (int o = 1; o < 64; o <<= 1) ss = fmaxf(ss, __shfl_xor(ss, o));
        if (lane == 0) { unsigned* w = (unsigned*)F.ctl + (isq ? CW_QMAX + (r64 >> 2) : CW_KMAX + (r64 >> 6)); __hip_atomic_fetch_max(w, fbits(ss), RLX_AGENT); }
    }
}
constexpr int ATT_SPLIT_MIN = 24;
struct AttItem { att::BlockRef r; bool valid; };
__device__ __forceinline__ AttItem att_ref(Frame& F, int L) {
    constexpr int NQB = SEQ / att::QB;
    const int qb = NQB - 1 - (L >> 6), bh = L & 31; const bool far = (L & 32) != 0;
    AttItem it; att::BlockRef& r = it.r;
    const int tid_ = ktid(F.wave);
    r.ws = (unsigned char*)F.ctl; r.bh = bh; r.P0 = qb * att::QB; r.far = far ? 1 : 0;
    const float* KB = r.KBp();
    int jlo = 0;
    if (N_LAUNCHES == 1) {
        const float k2 = bitsf(__hip_atomic_load((unsigned*)F.ctl + CW_KMAX + bh, RLX_AGENT)), q2 = bitsf(__hip_atomic_load((unsigned*)F.ctl + CW_QMAX + bh * NQB + qb, RLX_AGENT));
        const float thr = KB[r.P0] - 2.f * __builtin_sqrtf(k2 * q2) * 1.0001f - ATT_TH * (1.0f / 0.08838834764831845f);
        const int j = tid_ & 63; const bool cut = j < (r.P0 >> 6) && KB[64 * j + 63] < thr;
        jlo = __builtin_popcountll(__ballot(cut));
    }
    jlo = __builtin_amdgcn_readfirstlane(jlo);
    const int JH = (r.P0 >> 6) + 3, ntf = JH + 1 - jlo; const bool split = ntf >= ATT_SPLIT_MIN; const int jmid = jlo + (ntf - 4) / 2;
    if (!far) { r.jbot = split ? jmid : jlo; r.jtop = JH; it.valid = true; if (tid_ == 0) F.SPLIT[bh * NQB + qb] = split ? 1u : 0u; }
    else { r.jbot = jlo; r.jtop = jmid - 1; it.valid = split; }
    return it;
}
__device__ __forceinline__ int att_dequeue(Frame& F) {
    if (ktid(F.wave) == 0) F.MISC[16] = __hip_atomic_fetch_add((unsigned*)F.ctl + CW_QUEUE, 1u, RLX_AGENT);
    __syncthreads();
    const int v = (int)F.MISC[16];
    __syncthreads();
    return __builtin_amdgcn_readfirstlane(v);
}
__device__ __forceinline__ int att_next(Frame& F, int total) {
    for (;;) { const int L = att_dequeue(F); if (L >= total) return L; if (att_ref(F, L).valid) return L; }
}
__device__ __forceinline__ int p3_attention(Frame& F, char* lds) {
    constexpr int TOTAL = 2 * BATCH * NH * (SEQ / att::QB);
    int Lc = att_next(F, TOTAL); if (Lc >= TOTAL) return Lc;
    att::Seam S;
    { const AttItem c0 = att_ref(F, Lc); att::fox_prime(c0.r, lds, S, F.wave); }
    for (;;) {
        const int Ln = att_next(F, TOTAL); const bool last = Ln >= TOTAL;
        const AttItem c = att_ref(F, Lc); const AttItem n = att_ref(F, last ? Lc : Ln);
        att::fox_block(c.r, n.r, lds, S, F.wave);
        if (last) return Ln;
        Lc = Ln;
    }
}

template <int N> __device__ __forceinline__ float row_ror(float v) { return __builtin_bit_cast(float, __builtin_amdgcn_update_dpp(0, __builtin_bit_cast(int, v), 0x120 + N, 0xf, 0xf, false)); }
__device__ __forceinline__ float fmax_s(float a, float b) { float r; asm("v_max_f32_e32 %0, %1, %2" : "=v"(r) : "v"(a), "v"(b)); return r; }
__device__ __forceinline__ float fmin_s(float a, float b) { float r; asm("v_min_f32_e32 %0, %1, %2" : "=v"(r) : "v"(a), "v"(b)); return r; }
__device__ __forceinline__ float row_allmax(float v) {
    asm volatile("s_nop 1\n\tv_max_f32_dpp %0, %0, %0 row_ror:8 row_mask:0xf bank_mask:0xf\n\t"
                 "s_nop 1\n\tv_max_f32_dpp %0, %0, %0 row_ror:4 row_mask:0xf bank_mask:0xf\n\t"
                 "s_nop 1\n\tv_max_f32_dpp %0, %0, %0 row_ror:2 row_mask:0xf bank_mask:0xf\n\t"
                 "s_nop 1\n\tv_max_f32_dpp %0, %0, %0 row_ror:1 row_mask:0xf bank_mask:0xf" : "+v"(v));
    return v;
}
__device__ __forceinline__ float row_allsum(float v) { v += row_ror<8>(v); v += row_ror<4>(v); v += row_ror<2>(v); v += row_ror<1>(v); return v; }
#define CE_DESC(a, b) do { const float hi_ = fmax_s(a, b), lo_ = fmin_s(a, b); a = hi_; b = lo_; } while (0)
__device__ __forceinline__ float row_top16(float (&Lv)[8], int r16) {
    CE_DESC(Lv[0], Lv[1]); CE_DESC(Lv[2], Lv[3]); CE_DESC(Lv[4], Lv[5]); CE_DESC(Lv[6], Lv[7]);
    CE_DESC(Lv[0], Lv[2]); CE_DESC(Lv[1], Lv[3]); CE_DESC(Lv[4], Lv[6]); CE_DESC(Lv[5], Lv[7]);
    CE_DESC(Lv[1], Lv[2]); CE_DESC(Lv[5], Lv[6]);
    CE_DESC(Lv[0], Lv[4]); CE_DESC(Lv[1], Lv[5]); CE_DESC(Lv[2], Lv[6]); CE_DESC(Lv[3], Lv[7]);
    CE_DESC(Lv[2], Lv[4]); CE_DESC(Lv[3], Lv[5]);
    CE_DESC(Lv[1], Lv[2]); CE_DESC(Lv[3], Lv[4]); CE_DESC(Lv[5], Lv[6]);
    float res = 0.f; const float NEG = -__builtin_inff();
#pragma unroll
    for (int k = 0; k < 16; ++k) {
        const float m = row_allmax(Lv[0]);
        res = (r16 == k) ? m : res;
        const bool win = (Lv[0] == m);
#pragma unroll
        for (int j = 0; j < 7; ++j) Lv[j] = win ? Lv[j + 1] : Lv[j];
        Lv[7] = win ? NEG : Lv[7];
    }
    return res;
}
__device__ __forceinline__ void p8_topk(Frame& F) {
    LAS unsigned char* L = F.lds;
    const int lane = F.lane, wave = F.wave, r16 = lane & 15, g4 = lane >> 4;
    unsigned ctab;
    { constexpr unsigned CT[16] = {0x03020100u, 0x13121110u, 0x23222120u, 0x33323130u, 0x04424140u, 0x06055150u, 0x08076160u, 0x0a097170u,
                                   0x0d0c0b80u, 0x140f0e90u, 0x171615a0u, 0xffff24b0u, 0xffffffc0u, 0xffffffd0u, 0xffffffe0u, 0xfffffff0u};
      ctab = CT[0];
#pragma unroll
      for (int i = 1; i < 16; ++i) ctab = (r16 == i) ? CT[i] : ctab; }
    for (int grp = F.bx; grp < 256; grp += F.G) {
        const int hd = grp & 7, widx = grp >> 3;
        __syncthreads();
        for (int idx = F.tid; idx < 2 * 128 * 16; idx += NTHR) { const int half = idx >> 11, row = (idx >> 4) & 127, c8 = idx & 15;
            const bf16_t* src = (half ? F.K2 : F.K1) + ((size_t)hd * PNK + row) * 128 + c8 * 8;
            *(LAS v4u*)(L + half * 34816 + row * 272 + c8 * 16) = *(const GAS v4u*)src; }
        __syncthreads();
        for (int it = wave; it < 32; it += NWAVES) {
            const int t0 = widx * 512 + it * 16;
            bf16x8 a1[4], a2[4];
            { const bf16_t* qp = F.QP + (size_t)(t0 + r16) * DM + hd * PQD + 8 * g4;
#pragma unroll
              for (int ks = 0; ks < 4; ++ks) { a1[ks] = *(const GAS bf16x8*)(qp + 32 * ks); a2[ks] = *(const GAS bf16x8*)(qp + 128 + 32 * ks); } }
            f32x4 s1[8], s2[8];
#pragma unroll
            for (int nt = 0; nt < 8; ++nt) { s1[nt] = (f32x4){0.f, 0.f, 0.f, 0.f}; s2[nt] = (f32x4){0.f, 0.f, 0.f, 0.f};
#pragma unroll
                for (int ks = 0; ks < 4; ++ks) {
                    const bf16x8 b1 = *(const LAS bf16x8*)(L + (16 * nt + r16) * 272 + (32 * ks + 8 * g4) * 2);
                    const bf16x8 b2 = *(const LAS bf16x8*)(L + 34816 + (16 * nt + r16) * 272 + (32 * ks + 8 * g4) * 2);
                    s1[nt] = __builtin_amdgcn_mfma_f32_16x16x32_bf16(a1[ks], b1, s1[nt], 0, 0, 0);
                    s2[nt] = __builtin_amdgcn_mfma_f32_16x16x32_bf16(a2[ks], b2, s2[nt], 0, 0, 0); } }
#pragma unroll
            for (int i = 0; i < 4; ++i) {
                f32x4 cv[8]; const int crow = (grp * 32 + it) * 2 + i; const bool cdo = i < 2;
                if (cdo) conv_row_load(F, crow, cv);
                float l1[8], l2[8];
#pragma unroll
                for (int nt = 0; nt < 8; ++nt) {
                    l1[nt] = bitsf((fbits(s1[nt][i]) & ~0x7Fu) | (unsigned)(16 * nt + r16));
                    l2[nt] = bitsf((fbits(s2[nt][i]) & ~0x7Fu) | (unsigned)(16 * nt + r16)); }
                __builtin_amdgcn_sched_barrier(0);
                const float v1 = row_top16(l1, r16); __builtin_amdgcn_sched_barrier(0);
                const float v2 = row_top16(l2, r16); __builtin_amdgcn_sched_barrier(0);
                float cnd[4]; const float NEG = -__builtin_inff();
#pragma unroll
                for (int sl = 0; sl < 4; ++sl) { const unsigned by = (ctab >> (8 * sl)) & 0xFFu;
                    const float w1 = __shfl(v1, (int)(by >> 4), 16), w2 = __shfl(v2, (int)(by & 15u), 16);
                    cnd[sl] = by == 0xFFu ? NEG : bitsf((fbits(w1 + w2) & ~0xFFu) | by); }
                CE_DESC(cnd[0], cnd[1]); CE_DESC(cnd[2], cnd[3]); CE_DESC(cnd[0], cnd[2]); CE_DESC(cnd[1], cnd[3]); CE_DESC(cnd[1], cnd[2]);
                float fin = 0.f;
#pragma unroll
                for (int k = 0; k < 16; ++k) {
                    const float m = row_allmax(cnd[0]);
                    fin = (r16 == k) ? m : fin;
                    const bool win = (cnd[0] == m);
                    cnd[0] = win ? cnd[1] : cnd[0]; cnd[1] = win ? cnd[2] : cnd[1]; cnd[2] = win ? cnd[3] : cnd[2]; cnd[3] = win ? NEG : cnd[3];
                }
                const unsigned fb = __builtin_bit_cast(unsigned, fin); const int ra = (fb >> 4) & 15, rb = fb & 15;
                const float pv1 = __shfl(v1, ra, 16), pv2 = __shfl(v2, rb, 16);
                const int i1 = __builtin_bit_cast(unsigned, pv1) & 0x7F, i2 = __builtin_bit_cast(unsigned, pv2) & 0x7F;
                const float vs = pv1 + pv2;
                const float mx = row_allmax(vs); const float ex = fexp(vs - mx); const float sm = row_allsum(ex);
                const size_t o = (size_t)(t0 + 4 * g4 + i) * NSEL + hd * PTOPK + r16;
                F.EIDX[o] = i1 * PNK + i2; F.EW[o] = ex / sm;
                __builtin_amdgcn_sched_barrier(0);
                if (cdo) conv_row_finish<true>(F, crow, cv);
                __builtin_amdgcn_sched_barrier(0);
            }
        }
    }
}

__device__ __forceinline__ void cvt16(const v4u& r, float (&f)[16]) {
    const unsigned dd[4] = {r.x, r.y, r.z, r.w};
#pragma unroll
    for (int c = 0; c < 4; ++c) { const f32x2 lo = __builtin_amdgcn_cvt_pk_f32_fp8((int)dd[c], false), hi = __builtin_amdgcn_cvt_pk_f32_fp8((int)dd[c], true);
        f[4 * c] = lo[0]; f[4 * c + 1] = lo[1]; f[4 * c + 2] = hi[0]; f[4 * c + 3] = hi[1]; }
}
__device__ __forceinline__ void p9a_udots(Frame& F) {
    const int lane = F.lane, sub = lane & 7, g = lane >> 3;
    const bool b2 = (lane & 4) != 0, b1 = (lane & 2) != 0, b0 = (lane & 1) != 0;
    for (int vid = F.bx; vid < 256; vid += F.G) { const int x = vid & 7, c = vid >> 3;
        for (int si = 0; si < 2; ++si) { const int s = x + 8 * si;
            const unsigned char* tab = F.U8 + (size_t)s * ((size_t)NEXP * 128); const unsigned so = 16u * (unsigned)sub;
            const int tb = c * 512 + F.wave;
            v4u rc[8]; int idp, idq; v4u hq;
            { const int* ei = F.EIDX + (size_t)tb * NSEL; idp = ei[lane]; idq = ei[64 + lane];
              hq = *(const GAS v4u*)(F.H8 + (size_t)tb * DM + 128 * s + 16 * sub); }
#pragma unroll
            for (int i = 0; i < 8; ++i) { const int id = __shfl(idp, 8 * i + g); rc[i] = *(const GAS v4u*)(tab + ((unsigned)id * 128u + so)); }
            idp = idq;
            f32x4 cv[8];
#pragma unroll 1
            for (int k = 0; k < 64; ++k) { const int t = tb + 8 * k; const int t1 = tb + 8 * (k + 1 < 64 ? k + 1 : 63);
                { const int crow = NEXP + ((vid * NWAVES + F.wave) * 2 + si) * 4 + (k >> 4);
                  if ((k & 15) == 0) conv_row_load(F, crow, cv);
                  if ((k & 15) == 8) conv_row_finish<false>(F, crow, cv); }
                const int hd[4] = {(int)hq.x, (int)hq.y, (int)hq.z, (int)hq.w};
                hq = *(const GAS v4u*)(F.H8 + (size_t)t1 * DM + 128 * s + 16 * sub);
                const int* ei1 = F.EIDX + (size_t)t1 * NSEL;
                float p[16];
#pragma unroll
                for (int h = 0; h < 2; ++h) {
                    idq = ei1[64 * h + lane];
#pragma unroll
                    for (int i = 0; i < 8; ++i) { const unsigned dd[4] = {rc[i].x, rc[i].y, rc[i].z, rc[i].w};
                        const int id = __shfl(idp, 8 * i + g);
                        rc[i] = *(const GAS v4u*)(tab + ((unsigned)id * 128u + so));
                        int pa = 0;
#pragma unroll
                        for (int c4 = 0; c4 < 4; ++c4) pa = __builtin_amdgcn_sdot4((int)dd[c4], hd[c4], pa, false);
                        p[8 * h + i] = (float)pa; }
                    idp = idq; }
                float q8[8], q4[4], q2[2];
#pragma unroll
                for (int i = 0; i < 8; ++i) { const float keep = b2 ? p[8 + i] : p[i], send = b2 ? p[i] : p[8 + i]; q8[i] = keep + __shfl_xor(send, 4); }
#pragma unroll
                for (int i = 0; i < 4; ++i) { const float keep = b1 ? q8[4 + i] : q8[i], send = b1 ? q8[i] : q8[4 + i]; q4[i] = keep + __shfl_xor(send, 2); }
#pragma unroll
                for (int i = 0; i < 2; ++i) { const float keep = b0 ? q4[2 + i] : q4[i], send = b0 ? q4[i] : q4[2 + i]; q2[i] = keep + __shfl_xor(send, 1); }
                bf16_t* pd = (bf16_t*)F.PD + ((size_t)s * T + t) * NSEL + 16 * sub + g;
                pd[0] = (bf16_t)f2bf(q2[0]); pd[8] = (bf16_t)f2bf(q2[1]);
            }
        }
    }
}
__device__ __forceinline__ void p9b_act(Frame& F) {
    const size_t gt = (size_t)F.vcu * NTHR + F.tid, ngt = (size_t)F.G * NTHR;
    for (size_t idx = gt; idx < (size_t)T * NSEL; idx += ngt) {
        const int ex = F.EIDX[idx]; float sum = 0.f;
#pragma unroll
        for (int s = 0; s < 16; ++s) sum += bf_lo((unsigned)((const bf16_t*)F.PD)[(size_t)s * T * NSEL + idx]);
        F.ACT[idx] = gelu_tanh(sum * (F.USC[ex] * F.RS[idx >> 7])) * F.EW[idx] * F.VSC[ex];
    }
}
__device__ __forceinline__ void p9c_vacc(Frame& F) {
    const int lane = F.lane, sub = lane & 7, g = lane >> 3;
    const bool b5 = (lane & 32) != 0, b4 = (lane & 16) != 0, b3 = (lane & 8) != 0;
    for (int vid = F.bx; vid < 256; vid += F.G) { const int x = vid & 7, c = vid >> 3;
        for (int si = 0; si < 2; ++si) { const int s = x + 8 * si;
            const unsigned char* tab = F.V8 + (size_t)s * ((size_t)NEXP * 128); const unsigned so = 16u * (unsigned)sub;
            const int tb = c * 512 + F.wave;
            v4u rc[8]; int idp, idq; float acp, acq;
            { const int* ei = F.EIDX + (size_t)tb * NSEL; const float* ap = F.ACT + (size_t)tb * NSEL;
              idp = ei[lane]; acp = ap[lane]; idq = ei[64 + lane]; acq = ap[64 + lane]; }
            float ac[8];
#pragma unroll
            for (int i = 0; i < 8; ++i) { const int id = __shfl(idp, 8 * i + g); ac[i] = __shfl(acp, 8 * i + g); rc[i] = *(const GAS v4u*)(tab + ((unsigned)id * 128u + so)); }
            idp = idq; acp = acq;
#pragma unroll 1
            for (int k = 0; k < 64; ++k) { const int t = tb + 8 * k; const int t1 = tb + 8 * (k + 1 < 64 ? k + 1 : 63);
                const int* ei1 = F.EIDX + (size_t)t1 * NSEL; const float* ap1 = F.ACT + (size_t)t1 * NSEL;
                float ya[16];
#pragma unroll
                for (int i = 0; i < 16; ++i) ya[i] = 0.f;
#pragma unroll
                for (int h = 0; h < 2; ++h) {
                    idq = ei1[64 * h + lane]; acq = ap1[64 * h + lane];
#pragma unroll
                    for (int i = 0; i < 8; ++i) { float f[16]; cvt16(rc[i], f); const float a = ac[i];
                        const int id = __shfl(idp, 8 * i + g); ac[i] = __shfl(acp, 8 * i + g);
                        rc[i] = *(const GAS v4u*)(tab + ((unsigned)id * 128u + so));
#pragma unroll
                        for (int q = 0; q < 16; ++q) ya[q] = fmaf(a, f[q], ya[q]); }
                    idp = idq; acp = acq; }
                float y8[8], y4[4], y2[2];
#pragma unroll
                for (int i = 0; i < 8; ++i) { const float keep = b5 ? ya[8 + i] : ya[i], send = b5 ? ya[i] : ya[8 + i]; y8[i] = keep + __shfl_xor(send, 32); }
#pragma unroll
                for (int i = 0; i < 4; ++i) { const float keep = b4 ? y8[4 + i] : y8[i], send = b4 ? y8[i] : y8[4 + i]; y4[i] = keep + __shfl_xor(send, 16); }
#pragma unroll
                for (int i = 0; i < 2; ++i) { const float keep = b3 ? y4[2 + i] : y4[i], send = b3 ? y4[i] : y4[2 + i]; y2[i] = keep + __shfl_xor(send, 8); }
                bf16_t* yp = (bf16_t*)F.Y + (size_t)t * DM + 128 * s + 16 * sub + 2 * g;
                *(GAS unsigned*)yp = pk2(y2[0], y2[1]);
            }
        }
    }
}
__device__ __forceinline__ void p9d_final(Frame& F) {
    const int lane = F.lane; const int gw = F.vcu * NWAVES + F.wave, NGW = F.G * NWAVES;
    for (int t = gw; t < T; t += NGW) {
        const int b = t >> 12;
        float* op = F.out + (size_t)t * DM; const float* ga = F.MOD + (size_t)b * NADA + 5 * DM; const bf16_t* yp = (const bf16_t*)F.Y + (size_t)t * DM; const bf16_t* xp = F.X1 + (size_t)t * DM;
        f32x4 v[8]; float ss = 0.f;
#pragma unroll
        for (int j = 0; j < 8; ++j) { const int col = 4 * (lane + 64 * j); const v2u xw = *(const GAS v2u*)(xp + col); const f32x4 xa = (f32x4){bf_lo(xw.x), bf_hi(xw.x), bf_lo(xw.y), bf_hi(xw.y)}, g4v = *(const GAS f32x4*)(ga + col); const v2u yw = *(const GAS v2u*)(yp + col); const f32x4 yv = (f32x4){bf_lo(yw.x), bf_hi(yw.x), bf_lo(yw.y), bf_hi(yw.y)};
            v[j] = xa + g4v * yv; ss += (v[j][0] * v[j][0] + v[j][1] * v[j][1]) + (v[j][2] * v[j][2] + v[j][3] * v[j][3]); }
        const float rstd = __builtin_amdgcn_rsqf(wave_sum(ss) * (1.f / DM) + EPS);
#pragma unroll
        for (int j = 0; j < 8; ++j) { const int col = 4 * (lane + 64 * j); const f32x4 gf = *(const GAS f32x4*)(F.g_final + col); *(GAS f32x4*)(op + col) = v[j] * rstd * gf; }
    }
}

__global__ void __launch_bounds__(NWAVES * 64, 2) hymba_fwd(Args args) {
    unsigned char* const lds = g_lds;
    Frame F;
    F.lds = (LAS unsigned char*)lds;
    F.MISC = (volatile LAS unsigned*)(F.lds + MISC_OFF);
    { const int t0_ = (int)__builtin_amdgcn_workitem_id_x();
      F.wave = __builtin_amdgcn_readfirstlane(t0_ >> 6); }
    F.tid = ktid(F.wave); F.lane = F.tid & 63;
    for (int u = F.tid; u < (LDS_BYTES - LDSCTL_OFF) / 4; u += NWAVES * 64) ((LAS unsigned*)(F.lds + LDSCTL_OFF))[u] = 0u;
    __syncthreads();
    F.G = gridDim.x; F.bx = blockIdx.x; { const int bx = blockIdx.x; F.vcu = (F.G % 8 == 0) ? (bx % 8) * (F.G / 8) + bx / 8 : bx; }
    unsigned char* ws0 = args.ws;
    F.ctl = (gu32*)(ws0 + WS_CTL);
#define FILL_PTRS(F) do { const __attribute__((address_space(4))) void* kp_ = (const __attribute__((address_space(4))) void*)__builtin_amdgcn_kernarg_segment_ptr(); asm volatile("" : "+s"(kp_)); \
    const float* const __attribute__((address_space(4)))* in_ = (const float* const __attribute__((address_space(4)))*)kp_; \
    unsigned char* ws = (unsigned char*)in_[25]; \
    { int t_ = ktid(F.wave); asm volatile("" : "+v"(t_)); F.tid = t_; F.lane = t_ & 63; } \
    F.x = in_[0]; F.c = in_[1]; F.w_ada = in_[2]; F.b_ada = in_[3]; F.g_mix = in_[4]; F.w_in = in_[5]; F.b_f = in_[6]; \
    F.conv_w = in_[7]; F.conv_b = in_[8]; F.lru_w_a = in_[9]; F.lru_b_a = in_[10]; F.lru_w_x = in_[11]; F.lru_b_x = in_[12]; \
    F.lru_lambda = in_[13]; F.g_attn_out = in_[14]; F.g_lru_out = in_[15]; F.w_out = in_[16]; F.g_ffn = in_[17]; \
    F.peer_w_q = in_[18]; F.peer_k1 = in_[19]; F.peer_k2 = in_[20]; F.peer_u = in_[21]; F.peer_v = in_[22]; F.g_final = in_[23]; \
    F.out = (float*)in_[24]; \
    F.MOD = (float*)(ws + WS_MOD); F.LF = (float*)(ws + WS_LF); F.KB = (float*)(ws + WS_KB); F.SUMM = (float*)(ws + WS_SUMM); \
    F.EW = (float*)(ws + WS_EW); F.EIDX = (int*)(ws + WS_EIDX); \
    F.WLRU = (bf16_t*)(ws + WS_WLRU); F.K1 = (bf16_t*)(ws + WS_K1); F.K2 = (bf16_t*)(ws + WS_K2); F.WIN = (bf16_t*)(ws + WS_WIN); \
    F.WOUT = (bf16_t*)(ws + WS_WOUT); F.WQ = (bf16_t*)(ws + WS_WQ); F.U8 = ws + WS_U; F.V8 = ws + WS_V; F.USC = (float*)(ws + WS_USC); F.VSC = (float*)(ws + WS_VSC); F.PD = (float*)(ws + WS_PD); F.Y = (float*)(ws + WS_Y); F.ACT = (float*)(ws + WS_ACT); \
    F.H = (bf16_t*)(ws + WS_H); F.Q = (bf16_t*)(ws + WS_Q); F.K = (bf16_t*)(ws + WS_K); F.VV = (bf16_t*)(ws + WS_VV); F.QP = (bf16_t*)(ws + WS_QP); \
    F.LX = (bf16_t*)(ws + WS_LX); F.GLY = (bf16_t*)(ws + WS_GLY); F.MRG = (bf16_t*)(ws + WS_MRG); F.HL = (bf16_t*)(ws + WS_HL); F.AC = (bf16_t*)(ws + WS_AC); F.PART = (float*)(ws + WS_PART); F.X1 = (bf16_t*)(ws + WS_X1); F.OB = (bf16_t*)(ws + WS_OB); F.LW = (float*)(ws + WS_LW); F.SPLIT = (unsigned*)(ws + WS_SPLIT); F.H8 = ws + WS_H8; F.M8 = ws + WS_M8; F.RS = (float*)(ws + WS_RS); F.WQ8 = ws + WS_WQ8; F.WIN8 = ws + WS_WIN8; F.WOUT8 = ws + WS_WOUT8; F.CS = (float*)(ws + WS_CS); } while (0)
    XcdBarrier bar; bar.bar = (unsigned*)(F.ctl + CW_BAR); bar.x = 0; bar.st = nullptr;
    if (N_LAUNCHES == 1) bar = xcd_barrier_post((unsigned*)(F.ctl + CW_BAR), F.MISC + 8, F.wave);
#define GRID_BAR() do { if (N_LAUNCHES == 1) xcd_barrier(bar, F.wave); } while (0)
    const int lo = args.ph_lo, hi = args.ph_hi;
#ifdef TIME_PHASE
#define TSTAMP(k) do { if (((k) == TIME_PHASE || (k) == TIME_PHASE + 1) && blockIdx.x == 0 && ktid(F.wave) == 0) { const unsigned long long t_ = __builtin_amdgcn_s_memrealtime(); \
        F.MISC[20 + 2 * ((k) - TIME_PHASE)] = (unsigned)t_; F.MISC[21 + 2 * ((k) - TIME_PHASE)] = (unsigned)(t_ >> 32); } } while (0)
#else
#define TSTAMP(k) do { } while (0)
#endif
#ifndef PHASE_MASK
#define PHASE_MASK 0xffff
#endif
#define IN(k) (((PHASE_MASK >> (k)) & 1) && lo <= (k) && (k) < hi)
#define BOTH(k) (IN(k) && IN((k) + 1))
#ifndef REPEAT_PHASE
#define REPEAT_PHASE -1
#endif
#define REP(k)
#define REPBAR(k)

    TSTAMP(0);
    if (IN(0)) { FILL_PTRS(F); p0_prologue<15>(F);
#if REPEAT_PHASE == 0
        GRID_BAR(); FILL_PTRS(F); p0_prologue<15>(F);
#endif
#if REPEAT_PHASE >= 100 && REPEAT_PHASE < 116
        GRID_BAR(); FILL_PTRS(F); p0_prologue<REPEAT_PHASE - 100>(F);
#endif
        if (BOTH(0)) GRID_BAR(); }
    TSTAMP(1);
    if (IN(1)) { FILL_PTRS(F);
        quant_rows_i8(F, F.WIN, F.WIN8, F.CS + 4096, (const unsigned*)F.ctl + CW_CMAX + 4096, 5120);
        quant_rows_i8(F, F.WOUT, F.WOUT8, F.CS + 2048, (const unsigned*)F.ctl + CW_CMAX + 2048, DM);
        p_modnorm<true, true, false>(F, F.x, F.g_mix, 0, DM);
#if REPEAT_PHASE == 1
        GRID_BAR(); FILL_PTRS(F); p_modnorm<true, true, false>(F, F.x, F.g_mix, 0, DM);
#endif
        if (BOTH(1)) GRID_BAR(); }
    TSTAMP(2);
    if (IN(2)) {
        FILL_PTRS(F); p2_cumsum(F); __syncthreads();
        { pg8::Gemm g{(const bf16_t*)F.H8, (const bf16_t*)F.WIN8, T, 5120, DM / 2}; pg8::StaticOrder S; S.init(T, 5120, F.G, (int)blockIdx.x);
          pg8::EpiProj<true> E{F.Q, 0, F.RS, F.CS + 4096};
          pg8::gemm_phase<pg8::EpiProj<true>, pg8::StaticOrder, true, true, true>(F.lds + RING_OFF, g, S, E, F.wave); }
        if (BOTH(2)) GRID_BAR();
    }
    TSTAMP(3);
    if (IN(3)) {
        FILL_PTRS(F);
        if (N_LAUNCHES == 1) { p3_norms(F); GRID_BAR(); FILL_PTRS(F); }
        { int tk = p3_attention(F, (char*)lds + RING_OFF);
          while (tk < 1024 + BATCH * 64) { const int u = tk - 1024; lru_unit(F, u >> 6, u & 63); tk = att_dequeue(F); }
          FILL_PTRS(F);
          while (tk < 1280 + (2 * NEXP - CONV_P8_ROWS) / 32) { conv_item(F, CONV_P8_ROWS / 32 + tk - 1280); tk = att_dequeue(F); } }
#if REPEAT_PHASE == 3
        GRID_BAR(); FILL_PTRS(F);
        p3_attention(F, (char*)lds + RING_OFF);
        for (int u = F.vcu; u < BATCH * 64; u += F.G) lru_unit(F, u >> 6, u & 63);
#endif
#if REPEAT_PHASE == 30
        GRID_BAR(); FILL_PTRS(F);
        p3_attention(F, (char*)lds + RING_OFF);
#endif
#if REPEAT_PHASE == 31
        GRID_BAR(); FILL_PTRS(F);
        for (int u = F.vcu; u < BATCH * 64; u += F.G) lru_unit(F, u >> 6, u & 63);
#endif
        if (BOTH(3)) GRID_BAR();
    }
    TSTAMP(4);
    if (IN(4)) {
        FILL_PTRS(F);
        for (int u = F.vcu; u < BATCH * 64; u += F.G) lru_final(F, u >> 6, u & 63);
#if REPEAT_PHASE == 4
        GRID_BAR(); FILL_PTRS(F);
        for (int u = F.vcu; u < BATCH * 64; u += F.G) lru_final(F, u >> 6, u & 63);
#endif
        if (BOTH(4)) GRID_BAR();
    }
    TSTAMP(5);
    if (IN(5)) {
        FILL_PTRS(F);
        pg8::Gemm g{(const bf16_t*)F.M8, (const bf16_t*)F.WOUT8, T, DM, DM / 2}; pg8::StaticOrder S; S.init(T, DM, F.G, (int)blockIdx.x);
        pg8::EpiRes E{F.x, F.X1, DM, F.MOD + 2 * DM, NADA, F.RS, F.CS + 2048};
        pg8::gemm_phase<pg8::EpiRes, pg8::StaticOrder, true, true, true>(F.lds + RING_OFF, g, S, E, F.wave);
        if (BOTH(5)) GRID_BAR();
    }
    TSTAMP(6);
    if (IN(6)) { FILL_PTRS(F); quant_rows_i8(F, F.WQ, F.WQ8, F.CS, (const unsigned*)F.ctl + CW_CMAX, DM);
        p_modnorm<false, true, false>(F, F.out, F.g_ffn, 3 * DM, 4 * DM); if (BOTH(6)) GRID_BAR(); }
    TSTAMP(7);
    if (IN(7)) {
        FILL_PTRS(F);
        pg8::Gemm g{(const bf16_t*)F.H8, (const bf16_t*)F.WQ8, T, DM, DM / 2}; pg8::StaticOrder S; S.init(T, DM, F.G, (int)blockIdx.x);
        pg8::EpiPlainI8 E{F.QP, DM, F.RS, F.CS};
        pg8::gemm_phase<pg8::EpiPlainI8, pg8::StaticOrder, true, true, true>(F.lds + RING_OFF, g, S, E, F.wave);
        if (BOTH(7)) GRID_BAR();
    }
    TSTAMP(8);
    if (IN(8)) { FILL_PTRS(F); p8_topk(F);
#if REPEAT_PHASE == 8
        GRID_BAR(); FILL_PTRS(F); p8_topk(F);
#endif
        if (BOTH(8)) GRID_BAR(); }
    TSTAMP(9);
    if (IN(9)) { FILL_PTRS(F); p9a_udots(F);
#if REPEAT_PHASE == 9
        GRID_BAR(); FILL_PTRS(F); p9a_udots(F);
#endif
        if (BOTH(9)) GRID_BAR(); }
    TSTAMP(10);
    if (IN(10)) { FILL_PTRS(F); p9b_act(F);
#if REPEAT_PHASE == 10
        GRID_BAR(); FILL_PTRS(F); p9b_act(F);
#endif
        if (BOTH(10)) GRID_BAR(); }
    TSTAMP(11);
    if (IN(11)) { FILL_PTRS(F); p9c_vacc(F);
#if REPEAT_PHASE == 11
        GRID_BAR(); FILL_PTRS(F); p9c_vacc(F);
#endif
        if (BOTH(11)) GRID_BAR(); }
    TSTAMP(12);
    if (IN(12)) { FILL_PTRS(F); p9d_final(F); }
#ifdef TIME_PHASE
    if (TIME_PHASE == 12) { GRID_BAR(); }
    TSTAMP(13);
    if (blockIdx.x == 0 && ktid(F.wave) == 0) { const unsigned long long tp0_ = ((unsigned long long)F.MISC[21] << 32) | F.MISC[20], tp1_ = ((unsigned long long)F.MISC[23] << 32) | F.MISC[22];
        const unsigned long long dt = tp1_ - tp0_, te = __builtin_amdgcn_s_memrealtime(); while (__builtin_amdgcn_s_memrealtime() - te < (unsigned long long)TIME_AMP * dt) __builtin_amdgcn_s_sleep(8); }
#endif
#undef IN
#undef BOTH
#undef GRID_BAR
}

extern "C" void kernel_launch(void* const* d_in, const int* in_sizes, int n_in, void* d_out, int out_size, void* d_ws, size_t ws_size, hipStream_t stream) {
    static int grid = 0;
    if (grid == 0) {
        if (n_in != 24 || in_sizes[0] != T * DM || out_size != T * DM || ws_size < WS_END) {
            fprintf(stderr, "kernel_launch: built for 24 inputs, x/out of %d floats, >= %zu bytes of workspace; got n_in %d, in0 %d, out %d, ws %zu; nothing launched\n", T * DM, (size_t)WS_END, n_in, n_in > 0 ? in_sizes[0] : -1, out_size, ws_size); grid = -1; return; }
        int dev = 0, cus = 0, per_cu = 0;
        if (hipGetDevice(&dev) != hipSuccess || hipDeviceGetAttribute(&cus, hipDeviceAttributeMultiprocessorCount, dev) != hipSuccess) { fprintf(stderr, "kernel_launch: device query failed\n"); grid = -1; return; }
        if (hipFuncSetAttribute((const void*)hymba_fwd, hipFuncAttributeMaxDynamicSharedMemorySize, LDS_BYTES) != hipSuccess) { fprintf(stderr, "kernel_launch: hipFuncSetAttribute failed\n"); grid = -1; return; }
        if (hipOccupancyMaxActiveBlocksPerMultiprocessor(&per_cu, (const void*)hymba_fwd, NWAVES * 64, LDS_BYTES) != hipSuccess || per_cu < 1)
            fprintf(stderr, "kernel_launch: note: occupancy query reports %d workgroups per CU\n", per_cu);
        (void)hipGetLastError();
        grid = cus;
    }
    if (grid < 0) return;
    if (hipMemsetAsync((char*)d_ws + WS_CTL, 0, CTL_ZERO_BYTES, stream) != hipSuccess) { fprintf(stderr, "kernel_launch: hipMemsetAsync failed\n"); return; }
    Args a{};
    for (int i = 0; i < 24; ++i) a.in[i] = (const float*)d_in[i];
    a.out = (float*)d_out; a.ws = (unsigned char*)d_ws;
    for (int li = 0; li < N_LAUNCHES; ++li) {
        a.ph_lo = (N_LAUNCHES == 1) ? 0 : li; a.ph_hi = (N_LAUNCHES == 1) ? N_PHASES : li + 1; a.li = li;
        hipLaunchKernelGGL(hymba_fwd, dim3(grid), dim3(NWAVES * 64), LDS_BYTES, stream, a);
        const hipError_t le = hipPeekAtLastError();
        if (le != hipSuccess) { fprintf(stderr, "kernel_launch: launch %d failed: %s\n", li, hipGetErrorName(le)); break; }
    }
}
```
